# Optimizing an MI355X kernel written in HIP

```python
import jax, jax.numpy as jnp
from jax import lax
import numpy as np

D_MODEL = 1024
BATCH = 2
SEQ = 16384
DEPTH = 4

N_A_LAYERS = DEPTH // 2
N_B_LAYERS = DEPTH - N_A_LAYERS
HEAD_DIM = 64
ATTN_SCALE = HEAD_DIM ** -0.5
ROT_DIM = HEAD_DIM // 4
ROPE_THETA = 500000.0
CONV_CH = 3 * D_MODEL // 4
CONV_WIDTH = 31
MEM_TOKENS = 256
MEM_HEADS = 4
MEM_WIDTH = MEM_HEADS * HEAD_DIM
DIL_GROUPS = ((128, 1), (512, 4), (2048, 16))
N_DIL_GROUPS = len(DIL_GROUPS)
DIL_HEADS = 4
DIL_WIDTH = DIL_HEADS * HEAD_DIM
DIL_BLOCK = 128
A_IN_WIDTH = 2 * CONV_CH + MEM_WIDTH
A_OUT_WIDTH = CONV_CH + MEM_WIDTH
B_IN_WIDTH = N_DIL_GROUPS * DIL_WIDTH + MEM_WIDTH
B_OUT_WIDTH = DIL_WIDTH + MEM_WIDTH
SHARED_KV_WIDTH = N_DIL_GROUPS * 2 * DIL_WIDTH
N_EXPERTS = 32
TOP_K = 4
D_FF = D_MODEL
SWIGLU_ALPHA = 1.702
SWIGLU_LIMIT = 7.0
MOE_BLOCK = 256
DEEPNORM_ALPHA = (2 * DEPTH) ** 0.25
DEEPNORM_BETA = (8 * DEPTH) ** -0.25
LN_EPS = 1e-5

kernel_name = "yoco_conformer_dilated_moe_trunk"


def layer_norm(x, g, b):
    xf = x.astype(jnp.float32)
    mu = jnp.mean(xf, -1, keepdims=True)
    var = jnp.mean(jnp.square(xf - mu), -1, keepdims=True)
    return ((xf - mu) * lax.rsqrt(var + LN_EPS) * g.astype(jnp.float32) + b.astype(jnp.float32)).astype(x.dtype)


def partial_rotary(t, positions):
    half = ROT_DIM // 2
    inv_freq = jnp.power(ROPE_THETA, -jnp.arange(half, dtype=jnp.float32) / half)
    ang = positions.astype(jnp.float32)[..., None] * inv_freq
    cos = jnp.cos(ang)[:, :, None, :]
    sin = jnp.sin(ang)[:, :, None, :]
    tf = t[..., :ROT_DIM].astype(jnp.float32)
    x1, x2 = tf[..., :half], tf[..., half:]
    rot = jnp.concatenate([x1 * cos - x2 * sin, x2 * cos + x1 * sin], -1).astype(t.dtype)
    return jnp.concatenate([rot, t[..., ROT_DIM:]], -1)


def conformer_conv(u, dw, dw_b, g, b):
    a, gate = jnp.split(u, 2, axis=-1)
    h = a * jax.nn.sigmoid(gate)
    h = lax.conv_general_dilated(h, dw[:, None, :], window_strides=(1,), padding=[(CONV_WIDTH - 1, 0)],
                                 dimension_numbers=("NWC", "WIO", "NWC"), feature_group_count=CONV_CH) + dw_b
    return jax.nn.silu(layer_norm(h, g, b))


def memory_attention(q, mem_kv):
    B, S = q.shape[:2]
    k, v = jnp.split(mem_kv, 2, axis=-1)
    k = k.reshape(B, -1, MEM_HEADS, HEAD_DIM)
    v = v.reshape(B, -1, MEM_HEADS, HEAD_DIM)
    q = q.reshape(B, S, MEM_HEADS, HEAD_DIM)
    s = jnp.einsum("bshe,bmhe->bhsm", q, k, preferred_element_type=jnp.float32) * ATTN_SCALE
    p = jax.nn.softmax(s, axis=-1).astype(v.dtype)
    return jnp.einsum("bhsm,bmhe->bshe", p, v).reshape(B, S, MEM_WIDTH)


def dilated_branch(q, k, v, window, dilation):
    B, S, H, E = q.shape
    span = window // dilation
    blk = DIL_BLOCK
    chunk = dilation * blk
    Lp = -(-S // chunk) * chunk
    M = Lp // dilation
    nb = M // blk

    def split(t):
        t = jnp.pad(t, ((0, 0), (0, Lp - S), (0, 0), (0, 0)))
        t = t.reshape(B, M, dilation, H, E).transpose(0, 2, 1, 3, 4)
        return t.reshape(B, dilation, nb, blk, H, E)

    def with_prev(t):
        prev = jnp.pad(t, ((0, 0), (0, 0), (1, 0), (0, 0), (0, 0), (0, 0)))[:, :, :-1]
        return jnp.concatenate([prev, t], axis=3)

    qb = split(q)
    kc = with_prev(split(k))
    vc = with_prev(split(v))
    s = jnp.einsum("brnqhe,brnkhe->brnhqk", qb, kc, preferred_element_type=jnp.float32) * ATTN_SCALE
    qi = jnp.arange(blk)[:, None]
    ki = jnp.arange(2 * blk)[None, :]
    dist = qi + blk - ki
    band = (dist >= 0) & (dist <= span)
    not_before_start = (jnp.arange(nb)[:, None, None] > 0) | (ki >= blk)[None]
    mask = band[None] & not_before_start
    s = jnp.where(mask[None, None, :, None], s, -jnp.inf)
    lse = jax.nn.logsumexp(s, axis=-1)
    p = jnp.exp(s - lse[..., None]).astype(v.dtype)
    o = jnp.einsum("brnhqk,brnkhe->brnqhe", p, vc)
    o = o.reshape(B, dilation, M, H, E).transpose(0, 2, 1, 3, 4).reshape(B, Lp, H, E)[:, :S]
    lse = lse.transpose(0, 1, 2, 4, 3).reshape(B, dilation, M, H).transpose(0, 2, 1, 3).reshape(B, Lp, H)[:, :S]
    return o, lse


def clamped_swiglu(h):
    g, lin = jnp.split(h, 2, axis=-1)
    g = jnp.minimum(g, SWIGLU_LIMIT)
    lin = jnp.clip(lin, -SWIGLU_LIMIT, SWIGLU_LIMIT)
    return g * jax.nn.sigmoid(SWIGLU_ALPHA * g) * (lin + 1.0)


def routed_moe(x, w_r, b_r, w_up, b_up, w_down, b_down):
    B, S, D = x.shape
    T = B * S
    TK = T * TOP_K
    xt = x.reshape(T, D)
    logits = (xt @ w_r + b_r).astype(jnp.float32)
    top_val, top_idx = lax.top_k(logits, TOP_K)
    gates = jax.nn.softmax(top_val, axis=-1)
    e_flat = top_idx.reshape(TK)
    order = jnp.argsort(e_flat)
    e_sorted = e_flat[order]
    tok_sorted = order // TOP_K
    gate_sorted = gates.reshape(TK)[order]
    counts = jnp.bincount(e_flat, length=N_EXPERTS)
    padded = (counts + MOE_BLOCK - 1) // MOE_BLOCK * MOE_BLOCK
    start = jnp.cumsum(counts) - counts
    pend = jnp.cumsum(padded)
    pstart = pend - padded
    dest = pstart[e_sorted] + jnp.arange(TK) - start[e_sorted]
    n_blocks = (TK + N_EXPERTS * (MOE_BLOCK - 1) + MOE_BLOCK - 1) // MOE_BLOCK
    rows = jnp.zeros((n_blocks * MOE_BLOCK, D), x.dtype).at[dest].set(xt[tok_sorted])
    block_expert = jnp.minimum(jnp.searchsorted(pend, jnp.arange(n_blocks) * MOE_BLOCK, side="right"), N_EXPERTS - 1)

    def expert_block(args):
        r, e = args
        h = clamped_swiglu(r @ w_up[e] + b_up[e])
        return h @ w_down[e] + b_down[e]

    y_rows = lax.map(expert_block, (rows.reshape(n_blocks, MOE_BLOCK, D), block_expert))
    y = y_rows.reshape(-1, D)[dest] * gate_sorted[:, None].astype(x.dtype)
    return jax.ops.segment_sum(y, tok_sorted, num_segments=T).reshape(B, S, D)


def setup_inputs(seed: int = 0) -> dict:
    key = jax.random.key(seed)
    ks = jax.random.split(key, 26)
    nrm = lambda k, shape, scale: jax.random.normal(k, shape, jnp.float32) * scale
    D = D_MODEL
    return {
        "x": nrm(ks[0], (BATCH, SEQ, D), 1.0),
        "mem": nrm(ks[1], (BATCH, MEM_TOKENS, D), 1.0),
        "positions": (jnp.arange(SEQ, dtype=jnp.int32)[None, :]
                      + jax.random.randint(ks[2], (BATCH, 1), 0, 4096, dtype=jnp.int32)),
        "a_w_in": nrm(ks[3], (N_A_LAYERS, D, A_IN_WIDTH), D ** -0.5),
        "a_b_in": nrm(ks[4], (N_A_LAYERS, A_IN_WIDTH), 0.02),
        "a_dw": nrm(ks[5], (N_A_LAYERS, CONV_WIDTH, CONV_CH), CONV_WIDTH ** -0.5),
        "a_dw_b": nrm(ks[6], (N_A_LAYERS, CONV_CH), 0.02),
        "a_cn_g": 1.0 + nrm(ks[7], (N_A_LAYERS, CONV_CH), 0.02),
        "a_cn_b": nrm(ks[8], (N_A_LAYERS, CONV_CH), 0.02),
        "a_w_out": nrm(ks[9], (N_A_LAYERS, A_OUT_WIDTH, D), A_OUT_WIDTH ** -0.5 * DEEPNORM_BETA),
        "a_b_out": nrm(ks[10], (N_A_LAYERS, D), 0.02),
        "w_kv_shared": nrm(ks[11], (D, SHARED_KV_WIDTH), D ** -0.5),
        "b_w_q": nrm(ks[12], (N_B_LAYERS, D, B_IN_WIDTH), D ** -0.5),
        "b_w_out": nrm(ks[13], (N_B_LAYERS, B_OUT_WIDTH, D), B_OUT_WIDTH ** -0.5 * DEEPNORM_BETA),
        "b_b_out": nrm(ks[14], (N_B_LAYERS, D), 0.02),
        "mem_w_kv": nrm(ks[15], (DEPTH, D, 2 * MEM_WIDTH), D ** -0.5),
        "ln_g": 1.0 + nrm(ks[16], (DEPTH, 2, D), 0.02),
        "ln_b": nrm(ks[17], (DEPTH, 2, D), 0.02),
        "router_w": nrm(ks[18], (DEPTH, D, N_EXPERTS), D ** -0.5),
        "router_b": nrm(ks[19], (DEPTH, N_EXPERTS), 0.01),
        "exp_w_up": nrm(ks[20], (DEPTH, N_EXPERTS, D, 2 * D_FF), D ** -0.5),
        "exp_b_up": nrm(ks[21], (DEPTH, N_EXPERTS, 2 * D_FF), 0.02),
        "exp_w_down": nrm(ks[22], (DEPTH, N_EXPERTS, D_FF, D), D_FF ** -0.5 * DEEPNORM_BETA),
        "exp_b_down": nrm(ks[23], (DEPTH, N_EXPERTS, D), 0.02),
    }


def reference(x, mem, positions, a_w_in, a_b_in, a_dw, a_dw_b, a_cn_g, a_cn_b, a_w_out, a_b_out,
              w_kv_shared, b_w_q, b_w_out, b_b_out, mem_w_kv, ln_g, ln_b,
              router_w, router_b, exp_w_up, exp_b_up, exp_w_down, exp_b_down):
    B, S, D = x.shape
    shared_k = None
    shared_v = None
    for l in range(DEPTH):
        mem_kv = mem @ mem_w_kv[l]
        if l < N_A_LAYERS:
            h = x @ a_w_in[l] + a_b_in[l]
            conv_out = conformer_conv(h[..., :2 * CONV_CH], a_dw[l], a_dw_b[l], a_cn_g[l], a_cn_b[l])
            mem_out = memory_attention(h[..., 2 * CONV_CH:], mem_kv)
            y = jnp.concatenate([conv_out, mem_out], axis=-1) @ a_w_out[l] + a_b_out[l]
        else:
            j = l - N_A_LAYERS
            if j == 0:
                kv = (x @ w_kv_shared).reshape(B, S, N_DIL_GROUPS, 2, DIL_HEADS, HEAD_DIM)
                shared_k = partial_rotary(kv[:, :, :, 0].reshape(B, S, N_DIL_GROUPS * DIL_HEADS, HEAD_DIM),
                                          positions).reshape(B, S, N_DIL_GROUPS, DIL_HEADS, HEAD_DIM)
                shared_v = kv[:, :, :, 1]
            h = x @ b_w_q[j]
            q_dil = partial_rotary(h[..., :N_DIL_GROUPS * DIL_WIDTH].reshape(B, S, N_DIL_GROUPS * DIL_HEADS, HEAD_DIM),
                                   positions).reshape(B, S, N_DIL_GROUPS, DIL_HEADS, HEAD_DIM)
            outs, lses = [], []
            for g, (window, dilation) in enumerate(DIL_GROUPS):
                o_g, lse_g = dilated_branch(q_dil[:, :, g], shared_k[:, :, g], shared_v[:, :, g], window, dilation)
                outs.append(o_g)
                lses.append(lse_g)
            wts = jax.nn.softmax(jnp.stack(lses), axis=0)
            dil_out = jnp.einsum("gbsh,gbshe->bshe", wts, jnp.stack(outs).astype(jnp.float32))
            dil_out = dil_out.astype(x.dtype).reshape(B, S, DIL_WIDTH)
            mem_out = memory_attention(h[..., N_DIL_GROUPS * DIL_WIDTH:], mem_kv)
            y = jnp.concatenate([dil_out, mem_out], axis=-1) @ b_w_out[j] + b_b_out[j]
        x = layer_norm(DEEPNORM_ALPHA * x + y, ln_g[l, 0], ln_b[l, 0])
        f = routed_moe(x, router_w[l], router_b[l], exp_w_up[l], exp_b_up[l], exp_w_down[l], exp_b_down[l])
        x = layer_norm(DEEPNORM_ALPHA * x + f, ln_g[l, 1], ln_b[l, 1])
    return x
```

```cpp
#include <hip/hip_runtime.h>
#include <cstdio>
#include <cstdint>
namespace pg8 {
#define PG8_LAS __attribute__((address_space(3)))
typedef unsigned short bf16_t;
typedef short bf16x8 __attribute__((ext_vector_type(8)));
typedef float f32x4 __attribute__((ext_vector_type(4)));
typedef unsigned u32x4 __attribute__((ext_vector_type(4)));
constexpr int BM = 256, BK = 64, HALF = 128, HTB = HALF * BK * 2  , STAGE_BYTES = 8 * HTB, NXCD = 8, WGM = 8;

__host__ __device__ __forceinline__ int lds_byte(int r, int c) { const int st = (r >> 4) * 2 + (c >> 5), rr = r & 15, cc = c & 31, ob = rr * 64 + cc * 2; return st * 1024 + (ob ^ (((ob >> 9) & 1) << 5)); }
__host__ __device__ __forceinline__ void stage_rc(int b, int& R, int& C) { const int st = b / 1024, sb = b % 1024, swz = sb ^ (((sb >> 9) & 1) << 5); R = (st >> 1) * 16 + swz / 64; C = (st & 1) * 32 + (swz % 64) / 2; }
__host__ __device__ __forceinline__ int perm32(int rho) { const int n = rho >> 4, i = rho & 15; return 8 * (i >> 2) + 4 * n + (i & 3); }

struct Unit { int pm, pn; };
struct Gemm { const bf16_t* A; const bf16_t* Bt; int M, N, K; };

struct StaticOrder {
    int nM, nN, nwg, G, c;
    __host__ __device__ void init(int M, int N, int G_, int c_) { nM = M / BM; nN = N / BM; nwg = nM * nN; G = G_; c = c_; }
    __host__ __device__ bool next(int i, Unit& u) const {
        const long L = (long)i * G + c; if (L >= nwg) return false;
        int wgid = (int)L; { const int q = nwg / NXCD, r = nwg % NXCD, xcd = wgid % NXCD, off = wgid / NXCD; wgid = (xcd < r ? xcd * (q + 1) : r * (q + 1) + (xcd - r) * q) + off; }
        const int nig = WGM * nN, gid = wgid / nig, fm = gid * WGM, gsz = (nM - fm) < WGM ? (nM - fm) : WGM;
        u.pm = fm + ((wgid % nig) % gsz); u.pn = (wgid % nig) / gsz; return true;
    }
    __device__ __forceinline__ void a_ready(const Unit&) const {}
    __device__ __forceinline__ void done(const Unit&) const {}
};

__device__ __forceinline__ unsigned cvt_pk_bf16(float lo, float hi) { unsigned r; asm volatile("v_cvt_pk_bf16_f32 %0, %1, %2" : "=v"(r) : "v"(lo), "v"(hi)); return r; }
typedef float f32x2 __attribute__((ext_vector_type(2)));
template <class Epi, class Sched, bool ALIGN_EPI = false, bool SP2 = false>
__device__ __forceinline__ void gemm_phase(PG8_LAS unsigned char* lds, const Gemm g, const Sched& S, const Epi& E) {
    int tid_ = threadIdx.x; asm volatile("" : "+v"(tid_));
    const int tid = tid_, wid = __builtin_amdgcn_readfirstlane(tid >> 6), lane = tid & 63, wr = wid >> 2, wc = wid & 3, fr = lane & 15, fq = lane >> 4;
    const int K = g.K, nt = K / BK;
    unsigned voffA[2], voffB[2];
#pragma unroll
    for (int i = 0; i < 2; ++i) { int R, C; stage_rc(tid * 16 + i * 8192, R, C); const int Rb = Epi::PERM ? ((R & ~31) + perm32(R & 31)) : R;
        voffA[i] = (unsigned)(R * K + C) * 2u; voffB[i] = (unsigned)(Rb * K + C) * 2u; }
    const size_t kstep = (size_t)(BK * 2);
    const size_t hstep = (size_t)HALF * K * 2;
    const size_t tstep = 2 * hstep;
    const unsigned ldsw = (unsigned)wid * 1024u;
    const int aoff = lds_byte(wr * 64 + fr, fq * 8), boff = lds_byte(wc * 32 + fr, fq * 8);
#define PG8_SA(b, h) (((b) * 2 + (h)) * HTB)
#define PG8_SB(b, h) ((4 + (b) * 2 + (h)) * HTB)
#define PG8_STAGE(bufoff, gbase, voff) do { _Pragma("unroll") for (int _i = 0; _i < 2; ++_i) \
        __builtin_amdgcn_global_load_lds((const unsigned*)((const char*)(gbase) + (voff)[_i]), (PG8_LAS unsigned*)(lds + (bufoff) + ldsw + _i * 8192), 16, 0, 0); } while (0)
#define PG8_LDA(dst, b, h) do { _Pragma("unroll") for (int m = 0; m < 4; ++m) _Pragma("unroll") for (int k = 0; k < 2; ++k) dst[m][k] = *(const PG8_LAS bf16x8*)(lds + PG8_SA(b, h) + aoff + m * 2048 + k * 1024); } while (0)
#define PG8_LDB(dst, b, h) do { _Pragma("unroll") for (int n = 0; n < 2; ++n) _Pragma("unroll") for (int k = 0; k < 2; ++k) dst[n][k] = *(const PG8_LAS bf16x8*)(lds + PG8_SB(b, h) + boff + n * 2048 + k * 1024); } while (0)
#define PG8_MMA(ai, bj, At, Bt) do { __builtin_amdgcn_s_setprio(1); _Pragma("unroll") for (int m = 0; m < 4; ++m) _Pragma("unroll") for (int n = 0; n < 2; ++n) _Pragma("unroll") for (int k = 0; k < 2; ++k) \
        acc[ai][bj][m][n] = __builtin_amdgcn_mfma_f32_16x16x32_bf16(Bt[n][k], At[m][k], acc[ai][bj][m][n], 0, 0, 0); __builtin_amdgcn_s_setprio(0); } while (0)
#define PG8_WAIT_V(n) asm volatile("s_waitcnt vmcnt(" #n ")" ::: "memory")
#define PG8_WAIT_L(n) asm volatile("s_waitcnt lgkmcnt(" #n ")" ::: "memory")
#define PG8_BAR __builtin_amdgcn_s_barrier()
#define PG8_SCHED __builtin_amdgcn_sched_barrier(0)
    Unit cur, nxt; int ui = 0;
    if (!S.next(0, cur)) return;
    f32x4 acc[2][2][4][2];
#pragma unroll
    for (int a = 0; a < 2; ++a)
#pragma unroll
        for (int b = 0; b < 2; ++b)
#pragma unroll
            for (int m = 0; m < 4; ++m)
#pragma unroll
                for (int n = 0; n < 2; ++n) acc[a][b][m][n] = (f32x4){0.f, 0.f, 0.f, 0.f};
    bf16x8 At[4][2], B0[2][2], B1[2][2];
    const char* cA = (const char*)g.A + (size_t)cur.pm * tstep; const char* cB = (const char*)g.Bt + (size_t)cur.pn * tstep;
    S.a_ready(cur);
    if constexpr (SP2) {
        PG8_STAGE(PG8_SB(0, 0), cB, voffB); PG8_STAGE(PG8_SB(0, 1), cB + hstep, voffB); PG8_STAGE(PG8_SA(0, 0), cA, voffA); PG8_STAGE(PG8_SA(0, 1), cA + hstep, voffA);
        if (wr == 1) PG8_BAR;
        PG8_WAIT_V(2); PG8_BAR;
        PG8_STAGE(PG8_SB(1, 0), cB + kstep, voffB); PG8_STAGE(PG8_SA(1, 0), cA + kstep, voffA); PG8_STAGE(PG8_SB(1, 1), cB + hstep + kstep, voffB);
        PG8_WAIT_V(6); PG8_BAR;
    } else {
        PG8_STAGE(PG8_SB(0, 0), cB, voffB); PG8_STAGE(PG8_SA(0, 0), cA, voffA); PG8_STAGE(PG8_SB(0, 1), cB + hstep, voffB); PG8_STAGE(PG8_SA(0, 1), cA + hstep, voffA);
        if (wr == 1) PG8_BAR;
        PG8_WAIT_V(4); PG8_BAR;
        PG8_STAGE(PG8_SB(1, 0), cB + kstep, voffB); PG8_STAGE(PG8_SA(1, 0), cA + kstep, voffA); PG8_STAGE(PG8_SB(1, 1), cB + hstep + kstep, voffB);
        PG8_WAIT_V(6); PG8_BAR;
    }
    for (;;) {
        const bool has_next = S.next(ui + 1, nxt);
        const char* nA = has_next ? (const char*)g.A + (size_t)nxt.pm * tstep : cA; const char* nB = has_next ? (const char*)g.Bt + (size_t)nxt.pn * tstep : cB;
        for (int t = 0; t < nt; t += 2) {
            const bool last = (t == nt - 2);
            const char* a1 = cA + (size_t)(t + 1) * kstep;
            const char* a2 = last ? nA : cA + (size_t)(t + 2) * kstep; const char* b2 = last ? nB : cB + (size_t)(t + 2) * kstep;
            const char* a3 = a2 + kstep; const char* b3 = b2 + kstep;
            if (last && has_next) S.a_ready(nxt);
            if constexpr (SP2) {
            PG8_LDB(B0, 0, 0); PG8_LDB(B1, 0, 1); PG8_SCHED; PG8_LDA(At, 0, 0); PG8_STAGE(PG8_SA(1, 1), a1 + hstep, voffA);
            PG8_WAIT_V(8); PG8_WAIT_L(0); PG8_BAR; PG8_MMA(0, 0, At, B0); PG8_MMA(0, 1, At, B1); PG8_BAR; PG8_SCHED;
            PG8_LDA(At, 0, 1); PG8_STAGE(PG8_SB(0, 0), b2, voffB); PG8_STAGE(PG8_SB(0, 1), b2 + hstep, voffB); PG8_STAGE(PG8_SA(0, 0), a2, voffA);
            PG8_WAIT_V(8); PG8_WAIT_L(0); PG8_BAR; PG8_MMA(1, 0, At, B0); PG8_MMA(1, 1, At, B1); PG8_BAR; PG8_SCHED;
            PG8_LDB(B0, 1, 0); PG8_LDB(B1, 1, 1); PG8_SCHED; PG8_LDA(At, 1, 0); PG8_STAGE(PG8_SA(0, 1), a2 + hstep, voffA);
            PG8_WAIT_V(8); PG8_WAIT_L(0); PG8_BAR; PG8_MMA(0, 0, At, B0); PG8_MMA(0, 1, At, B1); PG8_BAR; PG8_SCHED;
            PG8_LDA(At, 1, 1); PG8_STAGE(PG8_SB(1, 0), b3, voffB); PG8_STAGE(PG8_SB(1, 1), b3 + hstep, voffB); PG8_STAGE(PG8_SA(1, 0), a3, voffA);
            PG8_WAIT_V(8); PG8_WAIT_L(0); PG8_BAR; PG8_MMA(1, 0, At, B0); PG8_MMA(1, 1, At, B1); PG8_BAR; PG8_SCHED;
            } else {
            PG8_LDB(B0, 0, 0); PG8_SCHED; PG8_LDA(At, 0, 0); PG8_STAGE(PG8_SA(1, 1), a1 + hstep, voffA);
            PG8_WAIT_L(8); PG8_BAR; PG8_WAIT_L(0); PG8_MMA(0, 0, At, B0); PG8_BAR; PG8_SCHED;
            PG8_LDB(B1, 0, 1); PG8_STAGE(PG8_SB(0, 0), b2, voffB);
            PG8_BAR; PG8_WAIT_L(0); PG8_MMA(0, 1, At, B1); PG8_BAR;
            PG8_LDA(At, 0, 1); PG8_STAGE(PG8_SA(0, 0), a2, voffA);
            PG8_BAR; PG8_WAIT_L(0); PG8_MMA(1, 0, At, B0); PG8_BAR; PG8_SCHED;
            PG8_STAGE(PG8_SB(0, 1), b2 + hstep, voffB);
            PG8_WAIT_V(6); PG8_BAR; PG8_MMA(1, 1, At, B1); PG8_BAR;
            PG8_LDB(B0, 1, 0); PG8_SCHED; PG8_LDA(At, 1, 0); PG8_STAGE(PG8_SA(0, 1), a2 + hstep, voffA);
            PG8_WAIT_L(8); PG8_BAR; PG8_WAIT_L(0); PG8_MMA(0, 0, At, B0); PG8_BAR; PG8_SCHED;
            PG8_LDB(B1, 1, 1); PG8_STAGE(PG8_SB(1, 0), b3, voffB);
            PG8_BAR; PG8_WAIT_L(0); PG8_MMA(0, 1, At, B1); PG8_BAR;
            PG8_LDA(At, 1, 1); PG8_STAGE(PG8_SA(1, 0), a3, voffA);
            PG8_BAR; PG8_WAIT_L(0); PG8_MMA(1, 0, At, B0); PG8_BAR; PG8_SCHED;
            PG8_STAGE(PG8_SB(1, 1), b3 + hstep, voffB);
            PG8_WAIT_V(6); PG8_BAR; PG8_MMA(1, 1, At, B1); PG8_BAR;
            }
        }
        if constexpr (ALIGN_EPI) { if (wr == 0) PG8_BAR; }
        if constexpr (!Epi::AFTER_DRAIN) { E(acc, cur, wr, wc, fr, fq); S.done(cur); }
        if (!has_next) break;
#pragma unroll
        for (int a = 0; a < 2; ++a)
#pragma unroll
            for (int b = 0; b < 2; ++b)
#pragma unroll
                for (int m = 0; m < 4; ++m)
#pragma unroll
                    for (int n = 0; n < 2; ++n) acc[a][b][m][n] = (f32x4){0.f, 0.f, 0.f, 0.f};
        cur = nxt; cA = nA; cB = nB; ++ui;
        if constexpr (ALIGN_EPI) { if (wr == 1) PG8_BAR; }
    }
    PG8_WAIT_V(0);
    if constexpr (!ALIGN_EPI) { if (wr == 0) PG8_BAR; }
    PG8_BAR;
    if constexpr (Epi::AFTER_DRAIN) { E.fused(acc, cur, wr, wc, fr, fq, lds, wid, lane); S.done(cur); }
#undef PG8_SA
#undef PG8_SB
#undef PG8_STAGE
#undef PG8_LDA
#undef PG8_LDB
#undef PG8_MMA
#undef PG8_WAIT_V
#undef PG8_WAIT_L
#undef PG8_BAR
#undef PG8_SCHED
}
}
#define MK_N_LAUNCHES 0

#define GAS __attribute__((address_space(1)))
#define LAS __attribute__((address_space(3)))
typedef unsigned short bf16;
typedef unsigned v4u __attribute__((ext_vector_type(4)));
typedef unsigned v2u __attribute__((ext_vector_type(2)));
typedef float f32x4 __attribute__((ext_vector_type(4)));
typedef short bf16x8 __attribute__((ext_vector_type(8)));

constexpr int NWAVES = 8, NTHR = 512;
constexpr int NB = 2, SEQ = 16384, T = NB * SEQ, D = 1024;
constexpr int CONV_CH = 768, CONV_W = 31, AIN = 1792, KVW = 1536, NEXP = 32, DFF = 1024;
constexpr int MAXTILES = (T * 4) / 256 + NEXP;
constexpr int XROWS = MAXTILES * 256;
constexpr float DN_ALPHA = 1.681792830507429f;
constexpr float LN_EPS = 1e-5f;

constexpr size_t MiB = 1u << 20;
constexpr size_t al(size_t x) { return (x + MiB - 1) / MiB * MiB; }
constexpr size_t WS_CTL = 0, CTL_ZERO_BYTES = MiB;
constexpr size_t WS_ROT  = WS_CTL + MiB;
constexpr size_t WS_WIN  = WS_ROT  + al((size_t)T * 16 * 4);
constexpr size_t WS_WOA  = WS_WIN  + al((size_t)2 * AIN * D * 2);
constexpr size_t WS_WKV  = WS_WOA  + al((size_t)2 * D * D * 2);
constexpr size_t WS_WQ   = WS_WKV  + al((size_t)KVW * D * 2);
constexpr size_t WS_WOB  = WS_WQ   + al((size_t)2 * D * D * 2);
constexpr size_t WS_WMEM = WS_WOB  + al((size_t)2 * D * 512 * 2);
constexpr size_t WS_WUP  = WS_WMEM + al((size_t)4 * 512 * D * 2);
constexpr size_t WS_WDN  = WS_WUP  + al((size_t)4 * NEXP * 2 * DFF * D * 2);
constexpr size_t WS_MEMB = WS_WDN  + al((size_t)4 * NEXP * D * DFF * 2);
constexpr size_t WS_MEMKV= WS_MEMB + al((size_t)512 * D * 2);
constexpr size_t WS_XB   = WS_MEMKV+ al((size_t)512 * 2048 * 2);
constexpr size_t WS_X1B  = WS_XB   + al((size_t)T * D * 2);
constexpr size_t WS_XR1  = WS_X1B  + al((size_t)T * D * 2);
constexpr size_t WS_XR2  = WS_XR1  + al((size_t)T * D * 4);
constexpr size_t WS_Z    = WS_XR2  + al((size_t)T * D * 4);
constexpr size_t WS_HGLU = WS_Z    + al((size_t)T * D * 4);
constexpr size_t WS_QM   = WS_HGLU + al((size_t)T * CONV_CH * 2);
constexpr size_t WS_A2   = WS_QM   + al((size_t)T * 256 * 2);
constexpr size_t WS_QB   = WS_A2   + al((size_t)T * D * 2);
constexpr size_t WS_KVB  = WS_QB   + al((size_t)T * D * 2);
constexpr size_t WS_OG   = WS_KVB  + al((size_t)T * KVW * 2);
constexpr size_t WS_LSE  = WS_OG   + al((size_t)3 * T * 256 * 2);
constexpr size_t WS_TES  = WS_LSE  + al((size_t)3 * T * 4 * 4);
constexpr size_t WS_TGATE= WS_TES  + al((size_t)T * 4 * 4);
constexpr size_t WS_TROW = WS_TGATE+ al((size_t)T * 4 * 4);
constexpr size_t WS_XS   = WS_TROW + al((size_t)T * 4 * 4);
constexpr size_t WS_H    = WS_XS   + al((size_t)XROWS * D * 2);
constexpr size_t WS_Y    = WS_H    + al((size_t)XROWS * DFF * 2);
constexpr size_t WS_END  = WS_Y    + al((size_t)XROWS * D * 2);
constexpr int CW_BAR = 4096;
constexpr int CW_CNT = 8192;
constexpr int LDS_SCR = 133120;
constexpr int LDS_MISC = LDS_SCR;
constexpr int LDS_TB = LDS_MISC + 64;
constexpr int LDS_TE = LDS_TB + 192;
constexpr int LDS_RT = LDS_TE + 2304;
constexpr int LDS_PTR = LDS_RT + 2304;
constexpr int LDS_BYTES = 147456;
static_assert(LDS_PTR + 256 <= LDS_BYTES, "LDS map");

#define LDS_WAIT() asm volatile("s_waitcnt lgkmcnt(0)" ::: "memory")
#define VM_WAIT() asm volatile("s_waitcnt vmcnt(0)" ::: "memory")
__device__ __forceinline__ unsigned f2bf(float f) { unsigned u = __builtin_bit_cast(unsigned, f); return (u + 0x7fffu + ((u >> 16) & 1u)) >> 16; }
__device__ __forceinline__ unsigned pk2(float lo, float hi) { return f2bf(lo) | (f2bf(hi) << 16); }
__device__ __forceinline__ float bflo(unsigned w) { return __builtin_bit_cast(float, w << 16); }
__device__ __forceinline__ float bfhi(unsigned w) { return __builtin_bit_cast(float, w & 0xffff0000u); }
__device__ __forceinline__ float wave_sum(float v) {
#pragma unroll
    for (int o = 1; o < 64; o <<= 1) v += __shfl_xor(v, o);
    return v;
}
__device__ __forceinline__ float sigmoidf_(float x) { return 1.0f / (1.0f + __expf(-x)); }
#define XB_TMO      128
#define XB_XCNT(j)  (256  + 64 * (j))
#define XB_XSUB(j)  (1280 + 64 * (j))
#define XB_XGEN(j)  (2304 + 64 * (j))
#define XB_TOP      3328
#define XB_TOPGEN   3392
#define XCD_BAR_WORDS 3456
#define XB_SPIN_CAP (1u << 18)

__device__ __forceinline__ unsigned xb_ld(unsigned* p)              { return __hip_atomic_load(p, __ATOMIC_RELAXED, __HIP_MEMORY_SCOPE_AGENT); }
__device__ __forceinline__ unsigned xb_add(unsigned* p, unsigned v) { return __hip_atomic_fetch_add(p, v, __ATOMIC_RELAXED, __HIP_MEMORY_SCOPE_AGENT); }
__device__ __forceinline__ unsigned xb_xcc_id() { return (unsigned)__builtin_amdgcn_s_getreg((3 << 11) | 20) & 0xFu; }
#define XB_SPIN(cond, bar) do { unsigned _sp = 0; while (cond) { __builtin_amdgcn_s_sleep(1); \
    if ((++_sp & 255u) == 0u) { if (xb_ld(&(bar)[XB_TMO])) break; if (_sp > XB_SPIN_CAP) { atomicAdd(&(bar)[XB_TMO], 1u); break; } } } } while (0)

struct XcdBarrier {
    unsigned* bar; unsigned x;
    volatile LAS unsigned* st;
};

__device__ __forceinline__ XcdBarrier xcd_barrier_post(unsigned* bar, volatile LAS unsigned* st) {
    XcdBarrier b; b.bar = bar; b.x = xb_xcc_id(); b.st = st;
    if (threadIdx.x == 0) (void)xb_add(&bar[XB_XCNT(b.x)], 1u);
    return b;
}
__device__ __forceinline__ void xcd_barrier_complete(unsigned* bar, unsigned x, unsigned& nloc, unsigned& nx) {
    const unsigned G = gridDim.x * gridDim.y * gridDim.z;
    unsigned sum, cnt, mine, sp = 0u;
    for (;;) {
        sum = 0u; cnt = 0u; mine = 0u;
#pragma unroll
        for (unsigned j = 0; j < 16; ++j) { const unsigned c = xb_ld(&bar[XB_XCNT(j)]); sum += c; cnt += (c > 0u) ? 1u : 0u; mine = (j == x) ? c : mine; }
        if (sum == G) break;
        __builtin_amdgcn_s_sleep(1);
        if ((++sp & 255u) == 0u) { if (xb_ld(&bar[XB_TMO])) break; if (sp > XB_SPIN_CAP) { atomicAdd(&bar[XB_TMO], 1u); break; } }
    }
    nloc = mine > 0u ? mine : 1u; nx = cnt > 0u ? cnt : 1u;
}

__device__ __forceinline__ void xcd_barrier(const XcdBarrier& b) {
    asm volatile("s_waitcnt vmcnt(0)" ::: "memory");
    __syncthreads();
    if (threadIdx.x == 0) {
        unsigned* bar = b.bar;
        __builtin_amdgcn_s_waitcnt(0);
        unsigned nloc = b.st[0], nx = b.st[1];
        if (nloc == 0u) { xcd_barrier_complete(bar, b.x, nloc, nx); b.st[0] = nloc; b.st[1] = nx; }
        const unsigned old = xb_add(&bar[XB_XSUB(b.x)], 1u);
        const unsigned gen = old / nloc;
        if (old + 1u == (gen + 1u) * nloc) {
            __builtin_amdgcn_fence(__ATOMIC_RELEASE, "agent");
            asm volatile("s_waitcnt vmcnt(0)" ::: "memory");
            const unsigned og = xb_add(&bar[XB_TOP], 1u);
            const unsigned tg = og / nx;
            if (og + 1u == (tg + 1u) * nx) xb_add(&bar[XB_TOPGEN], 1u);
            else XB_SPIN(xb_ld(&bar[XB_TOPGEN]) == tg, bar);
            __builtin_amdgcn_fence(__ATOMIC_ACQUIRE, "agent");
            xb_add(&bar[XB_XGEN(b.x)], 1u);
            asm volatile("s_waitcnt vmcnt(0)" ::: "memory");
        } else {
            XB_SPIN(xb_ld(&bar[XB_XGEN(b.x)]) == gen, bar);
            __builtin_amdgcn_fence(__ATOMIC_ACQUIRE, "agent");
            asm volatile("s_waitcnt vmcnt(0)" ::: "memory");
        }
    }
    __syncthreads();
}

using pg8::Unit; using pg8::cvt_pk_bf16; using pg8::BM; using pg8::HALF;
typedef unsigned u32x4 __attribute__((ext_vector_type(4)));

struct EpiGluQ {
    static constexpr bool PERM = true, AFTER_DRAIN = false;
    bf16* hglu; bf16* qm; const float* bias;
    __device__ __forceinline__ void operator()(const f32x4 (&acc)[2][2][4][2], const Unit& u, int wr, int wc, int fr, int fq) const {
        const int row0 = u.pm * BM + wr * 64 + fr, cw = wc * 32 + 8 * fq;
        if (u.pn < 6) {
            f32x4 ba[2], bg[2];
#pragma unroll
            for (int n = 0; n < 2; ++n) { ba[n] = *(const f32x4*)(bias + u.pn * 128 + cw + 4 * n); bg[n] = *(const f32x4*)(bias + 768 + u.pn * 128 + cw + 4 * n); }
#pragma unroll
            for (int ai = 0; ai < 2; ++ai)
#pragma unroll
                for (int m = 0; m < 4; ++m) {
                    float o[8];
#pragma unroll
                    for (int n = 0; n < 2; ++n) { const f32x4 a = acc[ai][0][m][n] + ba[n], g = acc[ai][1][m][n] + bg[n];
#pragma unroll
                        for (int j = 0; j < 4; ++j) o[4 * n + j] = a[j] * sigmoidf_(g[j]); }
                    u32x4 w; w.x = cvt_pk_bf16(o[0], o[1]); w.y = cvt_pk_bf16(o[2], o[3]); w.z = cvt_pk_bf16(o[4], o[5]); w.w = cvt_pk_bf16(o[6], o[7]);
                    *(u32x4*)(hglu + (size_t)(row0 + ai * HALF + m * 16) * CONV_CH + u.pn * 128 + cw) = w;
                }
        } else {
            f32x4 bv[2][2];
#pragma unroll
            for (int bj = 0; bj < 2; ++bj)
#pragma unroll
                for (int n = 0; n < 2; ++n) bv[bj][n] = *(const f32x4*)(bias + 1536 + bj * HALF + cw + 4 * n);
#pragma unroll
            for (int ai = 0; ai < 2; ++ai)
#pragma unroll
                for (int m = 0; m < 4; ++m)
#pragma unroll
                    for (int bj = 0; bj < 2; ++bj) { const f32x4 v0 = acc[ai][bj][m][0] + bv[bj][0], v1 = acc[ai][bj][m][1] + bv[bj][1];
                        u32x4 w; w.x = cvt_pk_bf16(v0[0], v0[1]); w.y = cvt_pk_bf16(v0[2], v0[3]); w.z = cvt_pk_bf16(v1[0], v1[1]); w.w = cvt_pk_bf16(v1[2], v1[3]);
                        *(u32x4*)(qm + (size_t)(row0 + ai * HALF + m * 16) * 256 + bj * HALF + cw) = w; }
        }
    }
};

struct EpiRes {
    static constexpr bool PERM = false, AFTER_DRAIN = false;
    float* Z; const float* xres; const float* bias;
    __device__ __forceinline__ void operator()(const f32x4 (&acc)[2][2][4][2], const Unit& u, int wr, int wc, int fr, int fq) const {
        const int row0 = u.pm * BM + wr * 64 + fr, col0 = u.pn * BM + wc * 32 + 4 * fq;
        f32x4 bv[2][2];
#pragma unroll
        for (int bj = 0; bj < 2; ++bj)
#pragma unroll
            for (int n = 0; n < 2; ++n) bv[bj][n] = *(const f32x4*)(bias + col0 + bj * HALF + n * 16);
#pragma unroll
        for (int ai = 0; ai < 2; ++ai)
#pragma unroll
            for (int m = 0; m < 4; ++m) { const size_t off = (size_t)(row0 + ai * HALF + m * 16) * D + col0;
#pragma unroll
                for (int bj = 0; bj < 2; ++bj)
#pragma unroll
                    for (int n = 0; n < 2; ++n) { const f32x4 xr = *(const f32x4*)(xres + off + bj * HALF + n * 16);
                        *(f32x4*)(Z + off + bj * HALF + n * 16) = xr * DN_ALPHA + acc[ai][bj][m][n] + bv[bj][n]; } }
    }
};

template <int MODE> struct EpiRot {
    static constexpr bool PERM = true, AFTER_DRAIN = false;
    bf16* O; int ldc; const float* rot;
    __device__ __forceinline__ void operator()(const f32x4 (&acc)[2][2][4][2], const Unit& u, int wr, int wc, int fr, int fq) const {
        const int row0 = u.pm * BM + wr * 64 + fr;
#pragma unroll
        for (int bj = 0; bj < 2; ++bj) {
            const int cb = u.pn * BM + bj * HALF;
            bool rotu = false;
            if (MODE == 0) rotu = (cb < 768) && ((wc & 1) == 0);
            if (MODE == 1) rotu = ((cb & 511) < 256) && ((wc & 1) == 0);
#pragma unroll
            for (int ai = 0; ai < 2; ++ai)
#pragma unroll
                for (int m = 0; m < 4; ++m) {
                    const int row = row0 + ai * HALF + m * 16;
                    float v[8];
#pragma unroll
                    for (int j = 0; j < 4; ++j) { v[j] = acc[ai][bj][m][0][j]; v[4 + j] = acc[ai][bj][m][1][j]; }
                    if (rotu) {
                        float pv[8];
#pragma unroll
                        for (int j = 0; j < 8; ++j) pv[j] = __shfl_xor(v[j], 16);
                        if (fq < 2) {
                            const f32x4 c0 = *(const f32x4*)(rot + (size_t)row * 16), c1 = *(const f32x4*)(rot + (size_t)row * 16 + 4);
                            const f32x4 s0 = *(const f32x4*)(rot + (size_t)row * 16 + 8), s1 = *(const f32x4*)(rot + (size_t)row * 16 + 12);
                            const float sg = (fq == 0) ? -1.0f : 1.0f;
#pragma unroll
                            for (int j = 0; j < 4; ++j) { v[j] = v[j] * c0[j] + sg * pv[j] * s0[j]; v[4 + j] = v[4 + j] * c1[j] + sg * pv[4 + j] * s1[j]; }
                        }
                    }
                    u32x4 w; w.x = cvt_pk_bf16(v[0], v[1]); w.y = cvt_pk_bf16(v[2], v[3]); w.z = cvt_pk_bf16(v[4], v[5]); w.w = cvt_pk_bf16(v[6], v[7]);
                    *(u32x4*)(O + (size_t)row * ldc + cb + wc * 32 + 8 * fq) = w;
                }
        }
    }
};

struct EpiSwiglu {
    static constexpr bool PERM = true, AFTER_DRAIN = false;
    bf16* H; const float* bup;
    __device__ __forceinline__ void operator()(const f32x4 (&acc)[2][2][4][2], const Unit& u, int wr, int wc, int fr, int fq) const {
        const int e = u.pn >> 3, pn = u.pn & 7, row0 = u.pm * BM + wr * 64 + fr, cw = pn * 128 + wc * 32 + 8 * fq;
        f32x4 bg[2], bl[2];
#pragma unroll
        for (int n = 0; n < 2; ++n) { bg[n] = *(const f32x4*)(bup + (size_t)e * 2048 + cw + 4 * n); bl[n] = *(const f32x4*)(bup + (size_t)e * 2048 + 1024 + cw + 4 * n); }
#pragma unroll
        for (int ai = 0; ai < 2; ++ai)
#pragma unroll
            for (int m = 0; m < 4; ++m) {
                float o[8];
#pragma unroll
                for (int n = 0; n < 2; ++n) { const f32x4 g = acc[ai][0][m][n] + bg[n], li = acc[ai][1][m][n] + bl[n];
#pragma unroll
                    for (int j = 0; j < 4; ++j) { const float gg = fminf(g[j], 7.0f), ll = fminf(fmaxf(li[j], -7.0f), 7.0f); o[4 * n + j] = gg * sigmoidf_(1.702f * gg) * (ll + 1.0f); } }
                u32x4 w; w.x = cvt_pk_bf16(o[0], o[1]); w.y = cvt_pk_bf16(o[2], o[3]); w.z = cvt_pk_bf16(o[4], o[5]); w.w = cvt_pk_bf16(o[6], o[7]);
                *(u32x4*)(H + (size_t)(row0 + ai * HALF + m * 16) * DFF + cw) = w;
            }
    }
};

struct EpiDown {
    static constexpr bool PERM = true, AFTER_DRAIN = false;
    bf16* Y; const float* bdn;
    __device__ __forceinline__ void operator()(const f32x4 (&acc)[2][2][4][2], const Unit& u, int wr, int wc, int fr, int fq) const {
        const int e = u.pn >> 2, pn = u.pn & 3, row0 = u.pm * BM + wr * 64 + fr, cw = pn * BM + wc * 32 + 8 * fq;
        f32x4 bv[2][2];
#pragma unroll
        for (int bj = 0; bj < 2; ++bj)
#pragma unroll
            for (int n = 0; n < 2; ++n) bv[bj][n] = *(const f32x4*)(bdn + (size_t)e * D + cw + bj * HALF + 4 * n);
#pragma unroll
        for (int ai = 0; ai < 2; ++ai)
#pragma unroll
            for (int m = 0; m < 4; ++m)
#pragma unroll
                for (int bj = 0; bj < 2; ++bj) { const f32x4 v0 = acc[ai][bj][m][0] + bv[bj][0], v1 = acc[ai][bj][m][1] + bv[bj][1];
                    u32x4 w; w.x = cvt_pk_bf16(v0[0], v0[1]); w.y = cvt_pk_bf16(v0[2], v0[3]); w.z = cvt_pk_bf16(v1[0], v1[1]); w.w = cvt_pk_bf16(v1[2], v1[3]);
                    *(u32x4*)(Y + (size_t)(row0 + ai * HALF + m * 16) * D + cw + bj * HALF) = w; }
    }
};

template <int NTN> struct MoeOrder {
    const LAS int* tile_e; int total, G, c;
    __device__ __forceinline__ bool next(int i, Unit& u) const {
        const int L = i * G + c, grp = L / (8 * NTN), w = L % (8 * NTN), rt = grp * 8 + (w & 7), pn = w >> 3;
        if (rt >= total) return false;
        const int e = __builtin_amdgcn_readfirstlane(tile_e[rt]);
        u.pm = rt; u.pn = e * NTN + pn; return true;
    }
    __device__ __forceinline__ void a_ready(const Unit&) const {}
    __device__ __forceinline__ void done(const Unit&) const {}
};

struct Frame {
    LAS unsigned char* lds;
    int tid, lane, wave, G, gw, NGW;
};
__device__ __forceinline__ unsigned char* ptr_slot(const Frame& F, int k) {
    const unsigned long long v = *(const LAS unsigned long long*)(F.lds + LDS_PTR + 8 * k);
    const unsigned lo = __builtin_amdgcn_readfirstlane((unsigned)v), hi = __builtin_amdgcn_readfirstlane((unsigned)(v >> 32));
    return (unsigned char*)(GAS unsigned char*)(((unsigned long long)hi << 32) | lo);
}
__device__ __forceinline__ const float* inp(const Frame& F, int k) { return (const float*)ptr_slot(F, k); }
__device__ __forceinline__ unsigned char* wsp(const Frame& F) { return ptr_slot(F, 24); }

__device__ __forceinline__ void tr_item(const float* W, int N, bf16* WT, int K, int k0, int n0, int orow0, LAS float* scr, int lane) {
#pragma unroll 16
    for (int i = 0; i < 64; ++i) scr[i * 65 + lane] = W[(size_t)(k0 + i) * N + n0 + lane];
    LDS_WAIT(); asm volatile("" ::: "memory");
    const int c = lane & 7;
#pragma unroll
    for (int j = 0; j < 8; ++j) { const int n = (lane >> 3) + 8 * j; const LAS float* s = scr + (8 * c) * 65 + n;
        v4u o; o.x = pk2(s[0 * 65], s[1 * 65]); o.y = pk2(s[2 * 65], s[3 * 65]); o.z = pk2(s[4 * 65], s[5 * 65]); o.w = pk2(s[6 * 65], s[7 * 65]);
        *(v4u*)(WT + (size_t)(orow0 + n) * K + k0 + 8 * c) = o; }
    LDS_WAIT(); asm volatile("" ::: "memory");
}
template <int PERMT> __device__ __forceinline__ int perm_row(int n0) {
    if (PERMT == 1) { if (n0 >= 1536) return n0; const int bj = n0 / 768, r = n0 % 768; return (r / 128) * 256 + bj * 128 + (r % 128); }
    if (PERMT == 2) { const int bj = n0 / 1024, r = n0 % 1024; return (r / 128) * 256 + bj * 128 + (r % 128); }
    return n0;
}
template <int PERMT> __device__ __forceinline__ void conv_group(Frame& F, const float* src, bf16* dst, int K, int N, int nmat) {
    LAS float* scr = (LAS float*)(F.lds + F.wave * 16640);
    const int nkb = K / 64, nnb = N / 64, per = nkb * nnb, total = per * nmat;
    for (int it = F.gw; it < total; it += F.NGW) {
        const int mat = it / per, r = it % per, kb = r / nnb, nb = r % nnb;
        tr_item(src + (size_t)mat * K * N, N, dst + (size_t)mat * K * N, K, kb * 64, nb * 64, perm_row<PERMT>(nb * 64), scr, F.lane);
    }
}
__device__ __forceinline__ void phase_prologue(Frame& F) {
    unsigned char* ws = wsp(F);
    conv_group<1>(F, inp(F, 3),  (bf16*)(ws + WS_WIN),  D, AIN, 2);
    conv_group<0>(F, inp(F, 9),  (bf16*)(ws + WS_WOA),  D, D, 2);
    conv_group<0>(F, inp(F, 11), (bf16*)(ws + WS_WKV),  D, KVW, 1);
    conv_group<0>(F, inp(F, 12), (bf16*)(ws + WS_WQ),   D, D, 2);
    conv_group<0>(F, inp(F, 13), (bf16*)(ws + WS_WOB),  512, D, 2);
    conv_group<0>(F, inp(F, 15), (bf16*)(ws + WS_WMEM), D, 512, 4);
    conv_group<2>(F, inp(F, 20), (bf16*)(ws + WS_WUP),  D, 2 * DFF, 4 * NEXP);
    conv_group<0>(F, inp(F, 22), (bf16*)(ws + WS_WDN),  DFF, D, 4 * NEXP);
    {
        const size_t gt = (size_t)blockIdx.x * NTHR + F.tid, NT_ = (size_t)F.G * NTHR;
        const float* x = inp(F, 0); bf16* xb = (bf16*)(ws + WS_XB);
        for (size_t i = gt; i < (size_t)T * D / 8; i += NT_) { const f32x4 a = *(const f32x4*)(x + i * 8), b = *(const f32x4*)(x + i * 8 + 4);
            v4u o; o.x = pk2(a[0], a[1]); o.y = pk2(a[2], a[3]); o.z = pk2(b[0], b[1]); o.w = pk2(b[2], b[3]); *(v4u*)(xb + i * 8) = o; }
        const float* mem = inp(F, 1); bf16* mb = (bf16*)(ws + WS_MEMB);
        for (size_t i = gt; i < (size_t)512 * D / 8; i += NT_) { const f32x4 a = *(const f32x4*)(mem + i * 8), b = *(const f32x4*)(mem + i * 8 + 4);
            v4u o; o.x = pk2(a[0], a[1]); o.y = pk2(a[2], a[3]); o.z = pk2(b[0], b[1]); o.w = pk2(b[2], b[3]); *(v4u*)(mb + i * 8) = o; }
        const int* pos = (const int*)inp(F, 2); float* rot = (float*)(ws + WS_ROT);
        for (size_t i = gt; i < (size_t)T * 8; i += NT_) { const int t = (int)(i >> 3), k = (int)(i & 7);
            double f = 1.0;
            f = (k == 1) ? 0.19392274474868576 : f; f = (k == 2) ? 0.03760603093086393 : f; f = (k == 3) ? 0.007292664737217109 : f; f = (k == 4) ? 0.001414213562373095 : f;
            f = (k == 5) ? 0.0002742481756762073 : f; f = (k == 6) ? 5.318295896944988e-05 : f; f = (k == 7) ? 1.031338537721246e-05 : f;
            const double a = (double)pos[t] * f; const double rv = a * 0.15915494309189535; const double fr = rv - floor(rv);
            const float ang = (float)(fr * 6.283185307179586);
            rot[(size_t)t * 16 + k] = cosf(ang); rot[(size_t)t * 16 + 8 + k] = sinf(ang); }
    }
}

__device__ __forceinline__ void phase_conv(Frame& F, const bf16* hglu, const float* dw, const float* dwb, const float* cg, const float* cb, bf16* A2) {
    LAS bf16* tile = (LAS bf16*)F.lds;
    LAS float* red = (LAS float*)(F.lds + 46 * 768 * 2);
    const int L = F.tid & 255, tb = F.tid >> 8, wv = F.wave & 3;
    float w[31][3], bias[3], gg[3], bb[3];
#pragma unroll
    for (int p = 0; p < 3; ++p) { bias[p] = dwb[p * 256 + L]; gg[p] = cg[p * 256 + L]; bb[p] = cb[p * 256 + L];
#pragma unroll
        for (int j = 0; j < 31; ++j) w[j][p] = dw[j * CONV_CH + p * 256 + L]; }
    for (int ti = blockIdx.x; ti < T / 16; ti += F.G) {
        const int t0 = ti * 16, s0 = t0 & (SEQ - 1);
        __syncthreads();
        for (int i = F.tid; i < 46 * 96; i += NTHR) { const int r = i / 96, c = i % 96; v4u v = (v4u){0u, 0u, 0u, 0u};
            if (s0 - 30 + r >= 0) v = *(const v4u*)(hglu + (size_t)(t0 - 30 + r) * CONV_CH + c * 8);
            *(LAS v4u*)(tile + r * CONV_CH + c * 8) = v; }
        __syncthreads();
        float acc[8][3];
#pragma unroll
        for (int t = 0; t < 8; ++t)
#pragma unroll
            for (int p = 0; p < 3; ++p) acc[t][p] = bias[p];
#pragma unroll
        for (int r = 0; r < 38; ++r) {
            float x[3];
#pragma unroll
            for (int p = 0; p < 3; ++p) x[p] = bflo((unsigned)tile[(tb * 8 + r) * CONV_CH + p * 256 + L]);
#pragma unroll
            for (int t = 0; t < 8; ++t) { const int j = r - t; if (j >= 0 && j <= 30) {
#pragma unroll
                for (int p = 0; p < 3; ++p) acc[t][p] += x[p] * w[j][p]; } }
        }
        float mean[8], rstd[8];
#pragma unroll
        for (int t = 0; t < 8; ++t) { const float s = wave_sum(acc[t][0] + acc[t][1] + acc[t][2]); if (F.lane == 0) red[(tb * 4 + wv) * 8 + t] = s; }
        __syncthreads();
#pragma unroll
        for (int t = 0; t < 8; ++t) { const LAS float* rp = red + tb * 32 + t; mean[t] = (rp[0] + rp[8] + rp[16] + rp[24]) * (1.0f / CONV_CH); }
#pragma unroll
        for (int t = 0; t < 8; ++t) { const float d0 = acc[t][0] - mean[t], d1 = acc[t][1] - mean[t], d2 = acc[t][2] - mean[t];
            const float s = wave_sum(d0 * d0 + d1 * d1 + d2 * d2); if (F.lane == 0) red[64 + (tb * 4 + wv) * 8 + t] = s; }
        __syncthreads();
#pragma unroll
        for (int t = 0; t < 8; ++t) { const LAS float* rp = red + 64 + tb * 32 + t; rstd[t] = 1.0f / sqrtf((rp[0] + rp[8] + rp[16] + rp[24]) * (1.0f / CONV_CH) + LN_EPS); }
#pragma unroll
        for (int t = 0; t < 8; ++t)
#pragma unroll
            for (int p = 0; p < 3; ++p) { const float y = (acc[t][p] - mean[t]) * rstd[t] * gg[p] + bb[p]; const float o = y * sigmoidf_(y);
                A2[(size_t)(t0 + tb * 8 + t) * D + p * 256 + L] = (bf16)f2bf(o); }
    }
    __syncthreads();
}

constexpr int KPITCH = 144, VSB = 560;
template <int NT, bool MASK>
__device__ __forceinline__ void attn_wave(const LAS unsigned char* Kl, const LAS unsigned char* Vt, int kt0, bf16x8 bq0, bf16x8 bq1, int lane, int qi, bool first, f32x4 (&o)[4], float& lse) {
    const int r = lane & 15, lg = lane >> 4;
    f32x4 s[NT];
#pragma unroll
    for (int t = 0; t < NT; ++t) {
        const LAS unsigned char* kp = Kl + ((kt0 + t) * 16 + r) * KPITCH + lg * 16;
        const bf16x8 a0 = *(const LAS bf16x8*)kp, a1 = *(const LAS bf16x8*)(kp + 64);
        f32x4 z = (f32x4){0.f, 0.f, 0.f, 0.f};
        z = __builtin_amdgcn_mfma_f32_16x16x32_bf16(a0, bq0, z, 0, 0, 0);
        s[t] = __builtin_amdgcn_mfma_f32_16x16x32_bf16(a1, bq1, z, 0, 0, 0);
    }
    float m = -INFINITY;
#pragma unroll
    for (int t = 0; t < NT; ++t)
#pragma unroll
        for (int j = 0; j < 4; ++j) {
            if (MASK) { const int ki = (kt0 + t) * 16 + 4 * lg + j, dist = qi + 128 - ki; const bool valid = (dist >= 0) && (dist <= 128) && (!first || ki >= 128); s[t][j] = valid ? s[t][j] : -INFINITY; }
            m = fmaxf(m, s[t][j]);
        }
    m = fmaxf(m, __shfl_xor(m, 16)); m = fmaxf(m, __shfl_xor(m, 32));
    const float c = 0.125f * 1.4426950408889634f;
    float sum = 0.f;
#pragma unroll
    for (int t = 0; t < NT; ++t)
#pragma unroll
        for (int j = 0; j < 4; ++j) { const float p = exp2f((s[t][j] - m) * c); s[t][j] = p; sum += p; }
    sum += __shfl_xor(sum, 16); sum += __shfl_xor(sum, 32);
#pragma unroll
    for (int et = 0; et < 4; ++et) o[et] = (f32x4){0.f, 0.f, 0.f, 0.f};
#pragma unroll
    for (int kk = 0; kk < NT / 2; ++kk) {
        v4u pw; pw.x = cvt_pk_bf16(s[2 * kk][0], s[2 * kk][1]); pw.y = cvt_pk_bf16(s[2 * kk][2], s[2 * kk][3]);
        pw.z = cvt_pk_bf16(s[2 * kk + 1][0], s[2 * kk + 1][1]); pw.w = cvt_pk_bf16(s[2 * kk + 1][2], s[2 * kk + 1][3]);
        const bf16x8 bp = __builtin_bit_cast(bf16x8, pw);
#pragma unroll
        for (int et = 0; et < 4; ++et) {
            const LAS unsigned char* vp = Vt + (16 * et + r) * VSB + ((kt0 + 2 * kk) * 16 + 4 * lg) * 2;
            const v2u lo = *(const LAS v2u*)vp, hi = *(const LAS v2u*)(vp + 32);
            v4u av; av.x = lo.x; av.y = lo.y; av.z = hi.x; av.w = hi.y;
            o[et] = __builtin_amdgcn_mfma_f32_16x16x32_bf16(__builtin_bit_cast(bf16x8, av), bp, o[et], 0, 0, 0);
        }
    }
    const float inv = 1.0f / sum;
#pragma unroll
    for (int et = 0; et < 4; ++et) o[et] = o[et] * inv;
    lse = m * 0.125f + __logf(sum);
}
__device__ __forceinline__ void vt_store(LAS unsigned char* Vt, int ki, int c, v4u v) {
    LAS unsigned short* p = (LAS unsigned short*)(Vt + (c * 8) * VSB + ki * 2);
    p[0 * (VSB / 2)] = (unsigned short)(v.x & 0xffffu); p[1 * (VSB / 2)] = (unsigned short)(v.x >> 16);
    p[2 * (VSB / 2)] = (unsigned short)(v.y & 0xffffu); p[3 * (VSB / 2)] = (unsigned short)(v.y >> 16);
    p[4 * (VSB / 2)] = (unsigned short)(v.z & 0xffffu); p[5 * (VSB / 2)] = (unsigned short)(v.z >> 16);
    p[6 * (VSB / 2)] = (unsigned short)(v.w & 0xffffu); p[7 * (VSB / 2)] = (unsigned short)(v.w >> 16);
}
constexpr int ATT_K_OFF = 0, ATT_V_OFF = 272 * KPITCH;

__device__ __forceinline__ void phase_memattn(Frame& F, const bf16* q, int qp, int qc0, const bf16* memkv, int l, bf16* out, int op, int oc0) {
    LAS unsigned char* Kl = F.lds + ATT_K_OFF; LAS unsigned char* Vt = F.lds + ATT_V_OFF;
    const int r = F.lane & 15, lg = F.lane >> 4;
    for (int u = blockIdx.x; u < 256; u += F.G) {
        const int b = u >> 7, h = (u >> 5) & 3, qc = u & 31;
        __syncthreads();
#pragma unroll
        for (int k = 0; k < 4; ++k) { const int i = F.tid + NTHR * k, ki = i >> 3, c = i & 7;
            const bf16* src = memkv + (size_t)(b * 256 + ki) * 2048 + l * 512 + h * 64 + c * 8;
            const v4u kv = *(const v4u*)src, vv = *(const v4u*)(src + 256);
            *(LAS v4u*)(Kl + ki * KPITCH + c * 16) = kv; vt_store(Vt, ki, c, vv); }
        __syncthreads();
        for (int pass = 0; pass < 4; ++pass) {
            const int tok = b * SEQ + qc * 512 + pass * 128 + F.wave * 16 + r;
            const bf16* qr = q + (size_t)tok * qp + qc0 + h * 64 + 8 * lg;
            const bf16x8 bq0 = *(const bf16x8*)qr, bq1 = *(const bf16x8*)(qr + 32);
            f32x4 o[4]; float lse;
            attn_wave<16, false>(Kl, Vt, 0, bq0, bq1, F.lane, 0, false, o, lse);
            bf16* orow = out + (size_t)tok * op + oc0 + h * 64 + 4 * lg;
#pragma unroll
            for (int et = 0; et < 4; ++et) { v2u w; w.x = cvt_pk_bf16(o[et][0], o[et][1]); w.y = cvt_pk_bf16(o[et][2], o[et][3]); *(v2u*)(orow + 16 * et) = w; }
        }
    }
    __syncthreads();
}

__device__ __forceinline__ void phase_dilated(Frame& F, const bf16* q  , const bf16* kv  , bf16* og  , float* lseo  ) {
    LAS unsigned char* Kl = F.lds + ATT_K_OFF; LAS unsigned char* Vt = F.lds + ATT_V_OFF;
    const int r16 = F.lane & 15, lg = F.lane >> 4;
    for (int u = blockIdx.x; u < 3072; u += F.G) {
        const int b = u / 1536, rem = u % 1536, grp = rem >> 9, h = (rem >> 7) & 3, blk = rem & 127;
        const int dsh = 2 * grp, d = 1 << dsh, nblk = SEQ >> (7 + dsh), res = blk / nblk, n = blk % nblk;
        __syncthreads();
        for (int i = F.tid; i < 272 * 8; i += NTHR) { const int ki = i >> 3, c = i & 7; const int mk = (n - 1) * 128 + ki;
            v4u kvv = (v4u){0u, 0u, 0u, 0u}, vv = (v4u){0u, 0u, 0u, 0u};
            if (ki < 256 && mk >= 0) { const bf16* src = kv + (size_t)(b * SEQ + mk * d + res) * KVW + grp * 512 + h * 64 + c * 8; kvv = *(const v4u*)src; vv = *(const v4u*)(src + 256); }
            *(LAS v4u*)(Kl + ki * KPITCH + c * 16) = kvv; vt_store(Vt, ki, c, vv); }
        __syncthreads();
        const int qi = F.wave * 16 + r16;
        const int tok = b * SEQ + (n * 128 + qi) * d + res;
        const bf16* qr = q + (size_t)tok * D + grp * 256 + h * 64 + 8 * lg;
        const bf16x8 bq0 = *(const bf16x8*)qr, bq1 = *(const bf16x8*)(qr + 32);
        f32x4 o[4]; float lse;
        attn_wave<10, true>(Kl, Vt, F.wave, bq0, bq1, F.lane, qi, n == 0, o, lse);
        bf16* orow = og + ((size_t)grp * T + tok) * 256 + h * 64 + 4 * lg;
#pragma unroll
        for (int et = 0; et < 4; ++et) { v2u w; w.x = cvt_pk_bf16(o[et][0], o[et][1]); w.y = cvt_pk_bf16(o[et][2], o[et][3]); *(v2u*)(orow + 16 * et) = w; }
        if (lg == 0) lseo[((size_t)grp * T + tok) * 4 + h] = lse;
    }
    __syncthreads();
}
__device__ __forceinline__ void phase_dil_combine(Frame& F, const bf16* og, const float* lse, bf16* A2b  ) {
    const size_t gt = (size_t)blockIdx.x * NTHR + F.tid, NT_ = (size_t)F.G * NTHR;
    for (size_t i = gt; i < (size_t)T * 32; i += NT_) {
        const int t = (int)(i >> 5), h = (int)((i >> 3) & 3), c8 = (int)(i & 7);
        const float l0 = lse[((size_t)0 * T + t) * 4 + h], l1 = lse[((size_t)1 * T + t) * 4 + h], l2 = lse[((size_t)2 * T + t) * 4 + h];
        const float mx = fmaxf(l0, fmaxf(l1, l2)); float w0 = __expf(l0 - mx), w1 = __expf(l1 - mx), w2 = __expf(l2 - mx); const float inv = 1.0f / (w0 + w1 + w2); w0 *= inv; w1 *= inv; w2 *= inv;
        const v4u a = *(const v4u*)(og + ((size_t)0 * T + t) * 256 + h * 64 + c8 * 8), bq = *(const v4u*)(og + ((size_t)1 * T + t) * 256 + h * 64 + c8 * 8), cq = *(const v4u*)(og + ((size_t)2 * T + t) * 256 + h * 64 + c8 * 8);
        v4u o;
        o.x = pk2(w0 * bflo(a.x) + w1 * bflo(bq.x) + w2 * bflo(cq.x), w0 * bfhi(a.x) + w1 * bfhi(bq.x) + w2 * bfhi(cq.x));
        o.y = pk2(w0 * bflo(a.y) + w1 * bflo(bq.y) + w2 * bflo(cq.y), w0 * bfhi(a.y) + w1 * bfhi(bq.y) + w2 * bfhi(cq.y));
        o.z = pk2(w0 * bflo(a.z) + w1 * bflo(bq.z) + w2 * bflo(cq.z), w0 * bfhi(a.z) + w1 * bfhi(bq.z) + w2 * bfhi(cq.z));
        o.w = pk2(w0 * bflo(a.w) + w1 * bflo(bq.w) + w2 * bflo(cq.w), w0 * bfhi(a.w) + w1 * bfhi(bq.w) + w2 * bfhi(cq.w));
        *(v4u*)(A2b + (size_t)t * 512 + h * 64 + c8 * 8) = o;
    }
}

__device__ __forceinline__ void phase_ln_route(Frame& F, const float* z, const float* g, const float* bt, const float* rw, const float* rb,
                                               float* x1f, bf16* x1b, int* tok_es, float* tok_gate, unsigned* cnt_g) {
    LAS float* wT = (LAS float*)F.lds;
    LAS int* lcnt = (LAS int*)(F.lds + LDS_RT); LAS int* base = lcnt + 32; LAS int* rec = lcnt + 64;
    __syncthreads();
    for (int i = F.tid; i < 1024 * 32; i += NTHR) { const int c = i >> 5, e = i & 31; wT[e * 1028 + c] = rw[i]; }
    f32x4 g4[4], b4[4];
#pragma unroll
    for (int j = 0; j < 4; ++j) { g4[j] = *(const f32x4*)(g + 4 * F.lane + 256 * j); b4[j] = *(const f32x4*)(bt + 4 * F.lane + 256 * j); }
    const int my_e = (F.lane >> 1) & 31; const float my_rb = rb[my_e];
    const bool h5 = (F.lane & 32) != 0, h4 = (F.lane & 16) != 0, h3 = (F.lane & 8) != 0, h2 = (F.lane & 4) != 0, h1 = (F.lane & 2) != 0;
    __syncthreads();
    for (int chunk = blockIdx.x; chunk < T / 128; chunk += F.G) {
        if (F.tid < 32) lcnt[F.tid] = 0;
        __syncthreads();
        for (int tt = 0; tt < 16; ++tt) {
            const int tl = F.wave * 16 + tt, t = chunk * 128 + tl;
            f32x4 v[4]; float s = 0.f;
#pragma unroll
            for (int j = 0; j < 4; ++j) { v[j] = *(const f32x4*)(z + (size_t)t * D + 4 * F.lane + 256 * j); s += (v[j][0] + v[j][1]) + (v[j][2] + v[j][3]); }
            const float mean = wave_sum(s) * (1.0f / D); float s2 = 0.f;
#pragma unroll
            for (int j = 0; j < 4; ++j) { v[j] = v[j] - mean; s2 += (v[j][0] * v[j][0] + v[j][1] * v[j][1]) + (v[j][2] * v[j][2] + v[j][3] * v[j][3]); }
            const float rstd = 1.0f / sqrtf(wave_sum(s2) * (1.0f / D) + LN_EPS);
#pragma unroll
            for (int j = 0; j < 4; ++j) { v[j] = v[j] * rstd * g4[j] + b4[j];
                *(f32x4*)(x1f + (size_t)t * D + 4 * F.lane + 256 * j) = v[j];
                v2u w; w.x = pk2(v[j][0], v[j][1]); w.y = pk2(v[j][2], v[j][3]); *(v2u*)(x1b + (size_t)t * D + 4 * F.lane + 256 * j) = w; }
            float p[32];
#pragma unroll
            for (int e = 0; e < 32; ++e) { float a = 0.f;
#pragma unroll
                for (int j = 0; j < 4; ++j) { const f32x4 wv = *(const LAS f32x4*)(wT + e * 1028 + 4 * F.lane + 256 * j); a += (v[j][0] * wv[0] + v[j][1] * wv[1]) + (v[j][2] * wv[2] + v[j][3] * wv[3]); }
                p[e] = a; }
#pragma unroll
            for (int i = 0; i < 16; ++i) { const float keep = h5 ? p[i + 16] : p[i], send = h5 ? p[i] : p[i + 16]; p[i] = keep + __shfl_xor(send, 32); }
#pragma unroll
            for (int i = 0; i < 8; ++i) { const float keep = h4 ? p[i + 8] : p[i], send = h4 ? p[i] : p[i + 8]; p[i] = keep + __shfl_xor(send, 16); }
#pragma unroll
            for (int i = 0; i < 4; ++i) { const float keep = h3 ? p[i + 4] : p[i], send = h3 ? p[i] : p[i + 4]; p[i] = keep + __shfl_xor(send, 8); }
#pragma unroll
            for (int i = 0; i < 2; ++i) { const float keep = h2 ? p[i + 2] : p[i], send = h2 ? p[i] : p[i + 2]; p[i] = keep + __shfl_xor(send, 4); }
            { const float keep = h1 ? p[1] : p[0], send = h1 ? p[0] : p[1]; p[0] = keep + __shfl_xor(send, 2); }
            float val = p[0] + __shfl_xor(p[0], 1) + my_rb;
            float tv[4]; int ti[4];
#pragma unroll
            for (int k = 0; k < 4; ++k) { float kv = val; int ki = my_e;
#pragma unroll
                for (int off = 1; off < 64; off <<= 1) { const float ov = __shfl_xor(kv, off); const int oi = __shfl_xor(ki, off); const bool take = (ov > kv) || (ov == kv && oi < ki); kv = take ? ov : kv; ki = take ? oi : ki; }
                tv[k] = kv; ti[k] = ki; if (my_e == ki) val = -INFINITY; }
            const float e1 = __expf(tv[1] - tv[0]), e2 = __expf(tv[2] - tv[0]), e3 = __expf(tv[3] - tv[0]); const float inv = 1.0f / (1.0f + e1 + e2 + e3);
            if (F.lane < 4) { const int k = F.lane; const int ee = (k == 0) ? ti[0] : (k == 1) ? ti[1] : (k == 2) ? ti[2] : ti[3];
                const float gk = ((k == 0) ? 1.0f : (k == 1) ? e1 : (k == 2) ? e2 : e3) * inv;
                const int slot = __hip_atomic_fetch_add(lcnt + ee, 1, __ATOMIC_RELAXED, __HIP_MEMORY_SCOPE_WORKGROUP);
                rec[tl * 4 + k] = ee | (slot << 8); tok_gate[(size_t)t * 4 + k] = gk; }
        }
        __syncthreads();
        if (F.tid < 32) base[F.tid] = (int)__hip_atomic_fetch_add(cnt_g + F.tid, (unsigned)lcnt[F.tid], __ATOMIC_RELAXED, __HIP_MEMORY_SCOPE_AGENT);
        __syncthreads();
        { const int rr = rec[F.tid], e = rr & 255, slot = (rr >> 8) + base[e]; tok_es[(size_t)chunk * 512 + F.tid] = e | (slot << 8); }
        __syncthreads();
    }
}

__device__ __forceinline__ int build_tiles(Frame& F, const unsigned* cnt_g) {
    LAS int* tbs = (LAS int*)(F.lds + LDS_TB); LAS int* te = (LAS int*)(F.lds + LDS_TE);
    __syncthreads();
    if (F.tid == 0) { int a = 0; for (int e = 0; e < NEXP; ++e) { tbs[e] = a; a += (int)((cnt_g[e] + 255u) >> 8); } tbs[NEXP] = a; }
    __syncthreads();
    const int total = tbs[NEXP];
    for (int rt = F.tid; rt < total; rt += NTHR) { int e = 0; for (int k = 1; k < NEXP; ++k) e = (rt >= tbs[k]) ? k : e; te[rt] = e; }
    __syncthreads();
    return total;
}
__device__ __forceinline__ void phase_gather(Frame& F, const unsigned* cnt_g, const bf16* x1b, const int* tok_es, int* tok_row, bf16* Xs) {
    (void)build_tiles(F, cnt_g);
    const LAS int* tbs = (const LAS int*)(F.lds + LDS_TB);
    for (int t = F.gw; t < T; t += F.NGW) {
        const v4u a = *(const v4u*)(x1b + (size_t)t * D + F.lane * 16), b = *(const v4u*)(x1b + (size_t)t * D + F.lane * 16 + 8);
#pragma unroll
        for (int k = 0; k < 4; ++k) { const int es = tok_es[(size_t)t * 4 + k], e = es & 255, row = tbs[e] * 256 + (es >> 8);
            *(v4u*)(Xs + (size_t)row * D + F.lane * 16) = a; *(v4u*)(Xs + (size_t)row * D + F.lane * 16 + 8) = b;
            if (F.lane == k) tok_row[(size_t)t * 4 + k] = row; }
    }
}
__device__ __forceinline__ void phase_combine_ln(Frame& F, const float* x1f, const bf16* Y, const int* tok_row, const float* tok_gate, const float* g, const float* bt, float* xout, bf16* xb) {
    f32x4 g4[4], b4[4];
#pragma unroll
    for (int j = 0; j < 4; ++j) { g4[j] = *(const f32x4*)(g + 4 * F.lane + 256 * j); b4[j] = *(const f32x4*)(bt + 4 * F.lane + 256 * j); }
    for (int t = F.gw; t < T; t += F.NGW) {
        f32x4 v[4];
#pragma unroll
        for (int j = 0; j < 4; ++j) v[j] = *(const f32x4*)(x1f + (size_t)t * D + 4 * F.lane + 256 * j) * DN_ALPHA;
#pragma unroll
        for (int k = 0; k < 4; ++k) { const int row = tok_row[(size_t)t * 4 + k]; const float gk = tok_gate[(size_t)t * 4 + k];
#pragma unroll
            for (int j = 0; j < 4; ++j) { const v2u w = *(const v2u*)(Y + (size_t)row * D + 4 * F.lane + 256 * j);
                v[j][0] += gk * bflo(w.x); v[j][1] += gk * bfhi(w.x); v[j][2] += gk * bflo(w.y); v[j][3] += gk * bfhi(w.y); } }
        float s = 0.f;
#pragma unroll
        for (int j = 0; j < 4; ++j) s += (v[j][0] + v[j][1]) + (v[j][2] + v[j][3]);
        const float mean = wave_sum(s) * (1.0f / D); float s2 = 0.f;
#pragma unroll
        for (int j = 0; j < 4; ++j) { v[j] = v[j] - mean; s2 += (v[j][0] * v[j][0] + v[j][1] * v[j][1]) + (v[j][2] * v[j][2] + v[j][3] * v[j][3]); }
        const float rstd = 1.0f / sqrtf(wave_sum(s2) * (1.0f / D) + LN_EPS);
#pragma unroll
        for (int j = 0; j < 4; ++j) { v[j] = v[j] * rstd * g4[j] + b4[j];
            *(f32x4*)(xout + (size_t)t * D + 4 * F.lane + 256 * j) = v[j];
            v2u w; w.x = pk2(v[j][0], v[j][1]); w.y = pk2(v[j][2], v[j][3]); *(v2u*)(xb + (size_t)t * D + 4 * F.lane + 256 * j) = w; }
    }
}
#ifndef EN_ALL
#define EN_ALL 1
#endif
#ifndef EN_P0
#define EN_P0 EN_ALL
#endif
#ifndef EN_A1
#define EN_A1 EN_ALL
#endif
#ifndef EN_MKV
#define EN_MKV EN_ALL
#endif
#ifndef EN_CONV
#define EN_CONV EN_ALL
#endif
#ifndef EN_MATT
#define EN_MATT EN_ALL
#endif
#ifndef EN_A3
#define EN_A3 EN_ALL
#endif
#ifndef EN_B1
#define EN_B1 EN_ALL
#endif
#ifndef EN_B1KV
#define EN_B1KV EN_ALL
#endif
#ifndef EN_DIL
#define EN_DIL EN_ALL
#endif
#ifndef EN_DILC
#define EN_DILC EN_ALL
#endif
#ifndef EN_B4
#define EN_B4 EN_ALL
#endif
#ifndef EN_M1
#define EN_M1 EN_ALL
#endif
#ifndef EN_M2
#define EN_M2 EN_ALL
#endif
#ifndef EN_M3
#define EN_M3 EN_ALL
#endif
#ifndef EN_M4
#define EN_M4 EN_ALL
#endif
#ifndef EN_M5
#define EN_M5 EN_ALL
#endif

#ifndef MK_N_LAUNCHES
#define MK_N_LAUNCHES 1
#endif
constexpr int NPHASE = 1 + 2 * 8 + 2 * 9;
struct Args { const void* in[24]; float* out; unsigned char* ws; int ph_lo, ph_hi; };
static_assert(sizeof(Args) == 24 * 8 + 8 + 8 + 8, "Args has no padding");

__global__ void __launch_bounds__(NTHR, 2) fwd(Args args) {
    extern __shared__ __attribute__((aligned(16))) unsigned char lds_raw[];
    LAS unsigned char* const ldsb = (LAS unsigned char*)lds_raw;
    if (threadIdx.x < 16) ((LAS unsigned*)(ldsb + LDS_MISC))[threadIdx.x] = 0u;
    if (threadIdx.x == 0) {
        LAS unsigned long long* pt = (LAS unsigned long long*)(ldsb + LDS_PTR);
#pragma unroll
        for (int i = 0; i < 24; ++i) pt[i] = (unsigned long long)args.in[i];
        pt[24] = (unsigned long long)args.ws; pt[25] = (unsigned long long)args.out;
    }
    __syncthreads();
    const int lo = args.ph_lo, hi = args.ph_hi;
    const bool use_bar = (hi - lo) > 1;
    unsigned xcc = 0;
    if (use_bar) { const XcdBarrier b0 = xcd_barrier_post((unsigned*)(args.ws + WS_CTL) + CW_BAR, (volatile LAS unsigned*)(ldsb + LDS_MISC)); xcc = b0.x; }
#define IN(k) (lo <= (k) && (k) < hi)
#define FRAME() Frame F; { int t_ = threadIdx.x; asm volatile("" : "+v"(t_)); F.lds = ldsb; F.tid = t_; F.lane = t_ & 63; F.wave = __builtin_amdgcn_readfirstlane(t_ >> 6); \
                           F.G = gridDim.x; F.gw = blockIdx.x * NWAVES + F.wave; F.NGW = F.G * NWAVES; } unsigned char* ws = wsp(F); (void)ws
#define SEAM(k) do { if (IN(k) && IN((k) + 1)) { asm volatile("" ::: "memory"); Frame Fb; Fb.lds = ldsb; XcdBarrier b_; b_.bar = (unsigned*)(wsp(Fb) + WS_CTL) + CW_BAR; b_.x = xcc; b_.st = (volatile LAS unsigned*)(ldsb + LDS_MISC); xcd_barrier(b_); } } while (0)
#define WSB(T_, off) ((T_*)(ws + (off)))

    if (EN_P0 && IN(0)) { FRAME(); phase_prologue(F); }
    SEAM(0);

    for (int l = 0; l < 4; ++l) {
        const int pb = (l < 2) ? 1 + 8 * l : 17 + 9 * (l - 2);
        int pm;
        if (l < 2) {
            if (IN(pb + 0)) {
                if (EN_A1) { FRAME();
                  pg8::Gemm g{WSB(bf16, WS_XB), WSB(const bf16, WS_WIN) + (size_t)l * AIN * D, T, AIN, D}; pg8::StaticOrder S; S.init(T, AIN, F.G, (int)blockIdx.x);
                  EpiGluQ E{WSB(bf16, WS_HGLU), WSB(bf16, WS_QM), inp(F, 4) + (size_t)l * AIN};
                  pg8::gemm_phase<EpiGluQ, pg8::StaticOrder, true, true>(F.lds, g, S, E); }
                if (EN_MKV && l == 0) { FRAME();
                  pg8::Gemm g{WSB(bf16, WS_MEMB), WSB(const bf16, WS_WMEM), 512, 2048, D}; pg8::StaticOrder S; S.init(512, 2048, F.G, (int)blockIdx.x);
                  EpiRot<2> E{WSB(bf16, WS_MEMKV), 2048, nullptr};
                  pg8::gemm_phase<EpiRot<2>, pg8::StaticOrder, true, true>(F.lds, g, S, E); }
            }
            SEAM(pb + 0);
            if (IN(pb + 1)) {
                if (EN_CONV) { FRAME();
                  phase_conv(F, WSB(const bf16, WS_HGLU), inp(F, 5) + (size_t)l * CONV_W * CONV_CH, inp(F, 6) + (size_t)l * CONV_CH, inp(F, 7) + (size_t)l * CONV_CH, inp(F, 8) + (size_t)l * CONV_CH, WSB(bf16, WS_A2)); }
                if (EN_MATT) { FRAME(); phase_memattn(F, WSB(const bf16, WS_QM), 256, 0, WSB(const bf16, WS_MEMKV), l, WSB(bf16, WS_A2), D, 768); }
            }
            SEAM(pb + 1);
            if (EN_A3 && IN(pb + 2)) { FRAME();
                pg8::Gemm g{WSB(bf16, WS_A2), WSB(const bf16, WS_WOA) + (size_t)l * D * D, T, D, D}; pg8::StaticOrder S; S.init(T, D, F.G, (int)blockIdx.x);
                EpiRes E{WSB(float, WS_Z), (l == 0) ? inp(F, 0) : WSB(const float, WS_XR2), inp(F, 10) + (size_t)l * D};
                pg8::gemm_phase<EpiRes, pg8::StaticOrder, true, true>(F.lds, g, S, E);
            }
            SEAM(pb + 2);
            pm = pb + 3;
        } else {
            const int j = l - 2;
            if (IN(pb + 0)) {
                if (EN_B1) { FRAME();
                  pg8::Gemm g{WSB(bf16, WS_XB), WSB(const bf16, WS_WQ) + (size_t)j * D * D, T, D, D}; pg8::StaticOrder S; S.init(T, D, F.G, (int)blockIdx.x);
                  EpiRot<0> E{WSB(bf16, WS_QB), D, WSB(const float, WS_ROT)};
                  pg8::gemm_phase<EpiRot<0>, pg8::StaticOrder, true, true>(F.lds, g, S, E); }
                if (EN_B1KV && j == 0) { FRAME();
                  pg8::Gemm g{WSB(bf16, WS_XB), WSB(const bf16, WS_WKV), T, KVW, D}; pg8::StaticOrder S; S.init(T, KVW, F.G, (int)blockIdx.x);
                  EpiRot<1> E{WSB(bf16, WS_KVB), KVW, WSB(const float, WS_ROT)};
                  pg8::gemm_phase<EpiRot<1>, pg8::StaticOrder, true, true>(F.lds, g, S, E); }
            }
            SEAM(pb + 0);
            if (IN(pb + 1)) {
                if (EN_DIL) { FRAME(); phase_dilated(F, WSB(const bf16, WS_QB), WSB(const bf16, WS_KVB), WSB(bf16, WS_OG), WSB(float, WS_LSE)); }
                if (EN_MATT) { FRAME(); phase_memattn(F, WSB(const bf16, WS_QB), D, 768, WSB(const bf16, WS_MEMKV), l, WSB(bf16, WS_A2), 512, 256); }
            }
            SEAM(pb + 1);
            if (EN_DILC && IN(pb + 2)) { FRAME(); phase_dil_combine(F, WSB(const bf16, WS_OG), WSB(const float, WS_LSE), WSB(bf16, WS_A2)); }
            SEAM(pb + 2);
            if (EN_B4 && IN(pb + 3)) { FRAME();
                pg8::Gemm g{WSB(bf16, WS_A2), WSB(const bf16, WS_WOB) + (size_t)j * D * 512, T, D, 512}; pg8::StaticOrder S; S.init(T, D, F.G, (int)blockIdx.x);
                EpiRes E{WSB(float, WS_Z), WSB(const float, WS_XR2), inp(F, 14) + (size_t)j * D};
                pg8::gemm_phase<EpiRes, pg8::StaticOrder, true, true>(F.lds, g, S, E);
            }
            SEAM(pb + 3);
            pm = pb + 4;
        }
        if (EN_M1 && IN(pm + 0)) { FRAME();
            phase_ln_route(F, WSB(const float, WS_Z), inp(F, 16) + (size_t)(l * 2 + 0) * D, inp(F, 17) + (size_t)(l * 2 + 0) * D, inp(F, 18) + (size_t)l * D * NEXP, inp(F, 19) + (size_t)l * NEXP,
                           WSB(float, WS_XR1), WSB(bf16, WS_X1B), WSB(int, WS_TES), WSB(float, WS_TGATE), WSB(unsigned, WS_CTL) + CW_CNT + 32 * l);
        }
        SEAM(pm + 0);
        if (EN_M2 && IN(pm + 1)) { FRAME(); phase_gather(F, WSB(const unsigned, WS_CTL) + CW_CNT + 32 * l, WSB(const bf16, WS_X1B), WSB(const int, WS_TES), WSB(int, WS_TROW), WSB(bf16, WS_XS)); }
        SEAM(pm + 1);
        if (EN_M3 && IN(pm + 2)) { FRAME();
            const int total = build_tiles(F, WSB(const unsigned, WS_CTL) + CW_CNT + 32 * l);
            pg8::Gemm g{WSB(bf16, WS_XS), WSB(const bf16, WS_WUP) + (size_t)l * NEXP * 2 * DFF * D, XROWS, NEXP * 2 * DFF, D};
            MoeOrder<8> S{(const LAS int*)(F.lds + LDS_TE), total, F.G, (int)blockIdx.x};
            EpiSwiglu E{WSB(bf16, WS_H), inp(F, 21) + (size_t)l * NEXP * 2 * DFF};
            pg8::gemm_phase<EpiSwiglu, MoeOrder<8>, true, true>(F.lds, g, S, E);
        }
        SEAM(pm + 2);
        if (EN_M4 && IN(pm + 3)) { FRAME();
            const int total = build_tiles(F, WSB(const unsigned, WS_CTL) + CW_CNT + 32 * l);
            pg8::Gemm g{WSB(bf16, WS_H), WSB(const bf16, WS_WDN) + (size_t)l * NEXP * DFF * D, XROWS, NEXP * D, DFF};
            MoeOrder<4> S{(const LAS int*)(F.lds + LDS_TE), total, F.G, (int)blockIdx.x};
            EpiDown E{WSB(bf16, WS_Y), inp(F, 23) + (size_t)l * NEXP * D};
            pg8::gemm_phase<EpiDown, MoeOrder<4>, true, true>(F.lds, g, S, E);
        }
        SEAM(pm + 3);
        if (EN_M5 && IN(pm + 4)) { FRAME();
            phase_combine_ln(F, WSB(const float, WS_XR1), WSB(const bf16, WS_Y), WSB(const int, WS_TROW), WSB(const float, WS_TGATE), inp(F, 16) + (size_t)(l * 2 + 1) * D, inp(F, 17) + (size_t)(l * 2 + 1) * D,
                             (l == 3) ? (float*)ptr_slot(F, 25) : WSB(float, WS_XR2), WSB(bf16, WS_XB));
        }
        if (l < 3) SEAM(pm + 4);
    }
#undef IN
#undef SEAM
#undef WSB
#undef FRAME
}

extern "C" void kernel_launch(void* const* d_in, const int* in_sizes, int n_in, void* d_out, int out_size, void* d_ws, size_t ws_size, hipStream_t stream) {
    static int grid = 0;
    if (grid == 0) {
        if (n_in != 24 || in_sizes[0] != T * D || out_size != T * D || ws_size < WS_END) {
            fprintf(stderr, "kernel_launch: unexpected shapes (n_in %d, in0 %d, out %d, ws %zu < %zu); nothing launched\n", n_in, n_in > 0 ? in_sizes[0] : -1, out_size, ws_size, (size_t)WS_END); grid = -1; return; }
        if (hipFuncSetAttribute((const void*)fwd, hipFuncAttributeMaxDynamicSharedMemorySize, LDS_BYTES) != hipSuccess) { fprintf(stderr, "kernel_launch: hipFuncSetAttribute failed\n"); grid = -1; return; }
        int per_cu = 0;
        if (hipOccupancyMaxActiveBlocksPerMultiprocessor(&per_cu, (const void*)fwd, NTHR, LDS_BYTES) != hipSuccess || per_cu < 1) fprintf(stderr, "kernel_launch: note: occupancy query says %d\n", per_cu);
        (void)hipGetLastError();
        grid = 256;
    }
    if (grid < 0) return;
    (void)hipMemsetAsync((char*)d_ws + WS_CTL, 0, CTL_ZERO_BYTES, stream);
    Args a{};
    for (int i = 0; i < 24; ++i) a.in[i] = d_in[i];
    a.out = (float*)d_out; a.ws = (unsigned char*)d_ws;
#if MK_N_LAUNCHES == 1
    a.ph_lo = 0; a.ph_hi = NPHASE;
    hipLaunchKernelGGL(fwd, dim3(grid), dim3(NTHR), LDS_BYTES, stream, a);
#else
    for (int k = 0; k < NPHASE; ++k) { a.ph_lo = k; a.ph_hi = k + 1; hipLaunchKernelGGL(fwd, dim3(grid), dim3(NTHR), LDS_BYTES, stream, a); }
#endif
}
```

```cpp
#include <hip/hip_runtime.h>
#include <cstdio>
#include <cstdint>
namespace pg8 {
#define PG8_LAS __attribute__((address_space(3)))
typedef unsigned short bf16_t;
typedef short bf16x8 __attribute__((ext_vector_type(8)));
typedef float f32x4 __attribute__((ext_vector_type(4)));
typedef unsigned u32x4 __attribute__((ext_vector_type(4)));
constexpr int BM = 256, BK = 64, HALF = 128, HTB = HALF * BK * 2  , STAGE_BYTES = 8 * HTB, NXCD = 8, WGM = 8;

__host__ __device__ __forceinline__ int lds_byte(int r, int c) { const int st = (r >> 4) * 2 + (c >> 5), rr = r & 15, cc = c & 31, ob = rr * 64 + cc * 2; return st * 1024 + (ob ^ (((ob >> 9) & 1) << 5)); }
__host__ __device__ __forceinline__ void stage_rc(int b, int& R, int& C) { const int st = b / 1024, sb = b % 1024, swz = sb ^ (((sb >> 9) & 1) << 5); R = (st >> 1) * 16 + swz / 64; C = (st & 1) * 32 + (swz % 64) / 2; }
__host__ __device__ __forceinline__ int perm32(int rho) { const int n = rho >> 4, i = rho & 15; return 8 * (i >> 2) + 4 * n + (i & 3); }

struct Unit { int pm, pn; };
struct Gemm { const bf16_t* A; const bf16_t* Bt; int M, N, K; };

struct StaticOrder {
    int nM, nN, nwg, G, c;
    __host__ __device__ void init(int M, int N, int G_, int c_) { nM = M / BM; nN = N / BM; nwg = nM * nN; G = G_; c = c_; }
    __host__ __device__ bool next(int i, Unit& u) const {
        const long L = (long)i * G + c; if (L >= nwg) return false;
        int wgid = (int)L; { const int q = nwg / NXCD, r = nwg % NXCD, xcd = wgid % NXCD, off = wgid / NXCD; wgid = (xcd < r ? xcd * (q + 1) : r * (q + 1) + (xcd - r) * q) + off; }
        const int nig = WGM * nN, gid = wgid / nig, fm = gid * WGM, gsz = (nM - fm) < WGM ? (nM - fm) : WGM;
        u.pm = fm + ((wgid % nig) % gsz); u.pn = (wgid % nig) / gsz; return true;
    }
    __device__ __forceinline__ void a_ready(const Unit&) const {}
    __device__ __forceinline__ void done(const Unit&) const {}
};

__device__ __forceinline__ unsigned cvt_pk_bf16(float lo, float hi) { unsigned r; asm volatile("v_cvt_pk_bf16_f32 %0, %1, %2" : "=v"(r) : "v"(lo), "v"(hi)); return r; }
typedef float f32x2 __attribute__((ext_vector_type(2)));
template <class Epi, class Sched, bool ALIGN_EPI = false, bool SP2 = false>
__device__ __forceinline__ void gemm_phase(PG8_LAS unsigned char* lds, const Gemm g, const Sched& S, const Epi& E) {
    int tid_ = threadIdx.x; asm volatile("" : "+v"(tid_));
    const int tid = tid_, wid = __builtin_amdgcn_readfirstlane(tid >> 6), lane = tid & 63, wr = wid >> 2, wc = wid & 3, fr = lane & 15, fq = lane >> 4;
    const int K = g.K, nt = K / BK;
    unsigned voffA[2], voffB[2];
#pragma unroll
    for (int i = 0; i < 2; ++i) { int R, C; stage_rc(tid * 16 + i * 8192, R, C); const int Rb = Epi::PERM ? ((R & ~31) + perm32(R & 31)) : R;
        voffA[i] = (unsigned)(R * K + C) * 2u; voffB[i] = (unsigned)(Rb * K + C) * 2u; }
    const size_t kstep = (size_t)(BK * 2);
    const size_t hstep = (size_t)HALF * K * 2;
    const size_t tstep = 2 * hstep;
    const unsigned ldsw = (unsigned)wid * 1024u;
    const int aoff = lds_byte(wr * 64 + fr, fq * 8), boff = lds_byte(wc * 32 + fr, fq * 8);
#define PG8_SA(b, h) (((b) * 2 + (h)) * HTB)
#define PG8_SB(b, h) ((4 + (b) * 2 + (h)) * HTB)
#define PG8_STAGE(bufoff, gbase, voff) do { _Pragma("unroll") for (int _i = 0; _i < 2; ++_i) \
        __builtin_amdgcn_global_load_lds((const unsigned*)((const char*)(gbase) + (voff)[_i]), (PG8_LAS unsigned*)(lds + (bufoff) + ldsw + _i * 8192), 16, 0, 0); } while (0)
#define PG8_LDA(dst, b, h) do { _Pragma("unroll") for (int m = 0; m < 4; ++m) _Pragma("unroll") for (int k = 0; k < 2; ++k) dst[m][k] = *(const PG8_LAS bf16x8*)(lds + PG8_SA(b, h) + aoff + m * 2048 + k * 1024); } while (0)
#define PG8_LDB(dst, b, h) do { _Pragma("unroll") for (int n = 0; n < 2; ++n) _Pragma("unroll") for (int k = 0; k < 2; ++k) dst[n][k] = *(const PG8_LAS bf16x8*)(lds + PG8_SB(b, h) + boff + n * 2048 + k * 1024); } while (0)
#define PG8_MMA(ai, bj, At, Bt) do { __builtin_amdgcn_s_setprio(1); _Pragma("unroll") for (int m = 0; m < 4; ++m) _Pragma("unroll") for (int n = 0; n < 2; ++n) _Pragma("unroll") for (int k = 0; k < 2; ++k) \
        acc[ai][bj][m][n] = __builtin_amdgcn_mfma_f32_16x16x32_bf16(Bt[n][k], At[m][k], acc[ai][bj][m][n], 0, 0, 0); __builtin_amdgcn_s_setprio(0); } while (0)
#define PG8_WAIT_V(n) asm volatile("s_waitcnt vmcnt(" #n ")" ::: "memory")
#define PG8_WAIT_L(n) asm volatile("s_waitcnt lgkmcnt(" #n ")" ::: "memory")
#define PG8_BAR __builtin_amdgcn_s_barrier()
#define PG8_SCHED __builtin_amdgcn_sched_barrier(0)
    Unit cur, nxt; int ui = 0;
    if (!S.next(0, cur)) return;
    f32x4 acc[2][2][4][2];
#pragma unroll
    for (int a = 0; a < 2; ++a)
#pragma unroll
        for (int b = 0; b < 2; ++b)
#pragma unroll
            for (int m = 0; m < 4; ++m)
#pragma unroll
                for (int n = 0; n < 2; ++n) acc[a][b][m][n] = (f32x4){0.f, 0.f, 0.f, 0.f};
    bf16x8 At[4][2], B0[2][2], B1[2][2];
    const char* cA = (const char*)g.A + (size_t)cur.pm * tstep; const char* cB = (const char*)g.Bt + (size_t)cur.pn * tstep;
    S.a_ready(cur);
    if constexpr (SP2) {
        PG8_STAGE(PG8_SB(0, 0), cB, voffB); PG8_STAGE(PG8_SB(0, 1), cB + hstep, voffB); PG8_STAGE(PG8_SA(0, 0), cA, voffA); PG8_STAGE(PG8_SA(0, 1), cA + hstep, voffA);
        if (wr == 1) PG8_BAR;
        PG8_WAIT_V(2); PG8_BAR;
        PG8_STAGE(PG8_SB(1, 0), cB + kstep, voffB); PG8_STAGE(PG8_SA(1, 0), cA + kstep, voffA); PG8_STAGE(PG8_SB(1, 1), cB + hstep + kstep, voffB);
        PG8_WAIT_V(6); PG8_BAR;
    } else {
        PG8_STAGE(PG8_SB(0, 0), cB, voffB); PG8_STAGE(PG8_SA(0, 0), cA, voffA); PG8_STAGE(PG8_SB(0, 1), cB + hstep, voffB); PG8_STAGE(PG8_SA(0, 1), cA + hstep, voffA);
        if (wr == 1) PG8_BAR;
        PG8_WAIT_V(4); PG8_BAR;
        PG8_STAGE(PG8_SB(1, 0), cB + kstep, voffB); PG8_STAGE(PG8_SA(1, 0), cA + kstep, voffA); PG8_STAGE(PG8_SB(1, 1), cB + hstep + kstep, voffB);
        PG8_WAIT_V(6); PG8_BAR;
    }
    for (;;) {
        const bool has_next = S.next(ui + 1, nxt);
        const char* nA = has_next ? (const char*)g.A + (size_t)nxt.pm * tstep : cA; const char* nB = has_next ? (const char*)g.Bt + (size_t)nxt.pn * tstep : cB;
        for (int t = 0; t < nt; t += 2) {
            const bool last = (t == nt - 2);
            const char* a1 = cA + (size_t)(t + 1) * kstep;
            const char* a2 = last ? nA : cA + (size_t)(t + 2) * kstep; const char* b2 = last ? nB : cB + (size_t)(t + 2) * kstep;
            const char* a3 = a2 + kstep; const char* b3 = b2 + kstep;
            if (last && has_next) S.a_ready(nxt);
            if constexpr (SP2) {
            PG8_LDB(B0, 0, 0); PG8_LDB(B1, 0, 1); PG8_SCHED; PG8_LDA(At, 0, 0); PG8_STAGE(PG8_SA(1, 1), a1 + hstep, voffA);
            PG8_WAIT_V(8); PG8_WAIT_L(0); PG8_BAR; PG8_MMA(0, 0, At, B0); PG8_MMA(0, 1, At, B1); PG8_BAR; PG8_SCHED;
            PG8_LDA(At, 0, 1); PG8_STAGE(PG8_SB(0, 0), b2, voffB); PG8_STAGE(PG8_SB(0, 1), b2 + hstep, voffB); PG8_STAGE(PG8_SA(0, 0), a2, voffA);
            PG8_WAIT_V(8); PG8_WAIT_L(0); PG8_BAR; PG8_MMA(1, 0, At, B0); PG8_MMA(1, 1, At, B1); PG8_BAR; PG8_SCHED;
            PG8_LDB(B0, 1, 0); PG8_LDB(B1, 1, 1); PG8_SCHED; PG8_LDA(At, 1, 0); PG8_STAGE(PG8_SA(0, 1), a2 + hstep, voffA);
            PG8_WAIT_V(8); PG8_WAIT_L(0); PG8_BAR; PG8_MMA(0, 0, At, B0); PG8_MMA(0, 1, At, B1); PG8_BAR; PG8_SCHED;
            PG8_LDA(At, 1, 1); PG8_STAGE(PG8_SB(1, 0), b3, voffB); PG8_STAGE(PG8_SB(1, 1), b3 + hstep, voffB); PG8_STAGE(PG8_SA(1, 0), a3, voffA);
            PG8_WAIT_V(8); PG8_WAIT_L(0); PG8_BAR; PG8_MMA(1, 0, At, B0); PG8_MMA(1, 1, At, B1); PG8_BAR; PG8_SCHED;
            } else {
            PG8_LDB(B0, 0, 0); PG8_SCHED; PG8_LDA(At, 0, 0); PG8_STAGE(PG8_SA(1, 1), a1 + hstep, voffA);
            PG8_WAIT_L(8); PG8_BAR; PG8_WAIT_L(0); PG8_MMA(0, 0, At, B0); PG8_BAR; PG8_SCHED;
            PG8_LDB(B1, 0, 1); PG8_STAGE(PG8_SB(0, 0), b2, voffB);
            PG8_BAR; PG8_WAIT_L(0); PG8_MMA(0, 1, At, B1); PG8_BAR;
            PG8_LDA(At, 0, 1); PG8_STAGE(PG8_SA(0, 0), a2, voffA);
            PG8_BAR; PG8_WAIT_L(0); PG8_MMA(1, 0, At, B0); PG8_BAR; PG8_SCHED;
            PG8_STAGE(PG8_SB(0, 1), b2 + hstep, voffB);
            PG8_WAIT_V(6); PG8_BAR; PG8_MMA(1, 1, At, B1); PG8_BAR;
            PG8_LDB(B0, 1, 0); PG8_SCHED; PG8_LDA(At, 1, 0); PG8_STAGE(PG8_SA(0, 1), a2 + hstep, voffA);
            PG8_WAIT_L(8); PG8_BAR; PG8_WAIT_L(0); PG8_MMA(0, 0, At, B0); PG8_BAR; PG8_SCHED;
            PG8_LDB(B1, 1, 1); PG8_STAGE(PG8_SB(1, 0), b3, voffB);
            PG8_BAR; PG8_WAIT_L(0); PG8_MMA(0, 1, At, B1); PG8_BAR;
            PG8_LDA(At, 1, 1); PG8_STAGE(PG8_SA(1, 0), a3, voffA);
            PG8_BAR; PG8_WAIT_L(0); PG8_MMA(1, 0, At, B0); PG8_BAR; PG8_SCHED;
            PG8_STAGE(PG8_SB(1, 1), b3 + hstep, voffB);
            PG8_WAIT_V(6); PG8_BAR; PG8_MMA(1, 1, At, B1); PG8_BAR;
            }
        }
        if constexpr (ALIGN_EPI) { if (wr == 0) PG8_BAR; }
        if constexpr (!Epi::AFTER_DRAIN) { E(acc, cur, wr, wc, fr, fq); S.done(cur); }
        if (!has_next) break;
#pragma unroll
        for (int a = 0; a < 2; ++a)
#pragma unroll
            for (int b = 0; b < 2; ++b)
#pragma unroll
                for (int m = 0; m < 4; ++m)
#pragma unroll
                    for (int n = 0; n < 2; ++n) acc[a][b][m][n] = (f32x4){0.f, 0.f, 0.f, 0.f};
        cur = nxt; cA = nA; cB = nB; ++ui;
        if constexpr (ALIGN_EPI) { if (wr == 1) PG8_BAR; }
    }
    PG8_WAIT_V(0);
    if constexpr (!ALIGN_EPI) { if (wr == 0) PG8_BAR; }
    PG8_BAR;
    if constexpr (Epi::AFTER_DRAIN) { E.fused(acc, cur, wr, wc, fr, fq, lds, wid, lane); S.done(cur); }
#undef PG8_SA
#undef PG8_SB
#undef PG8_STAGE
#undef PG8_LDA
#undef PG8_LDB
#undef PG8_MMA
#undef PG8_WAIT_V
#undef PG8_WAIT_L
#undef PG8_BAR
#undef PG8_SCHED
}
}
#define MK_N_LAUNCHES 1

#define GAS __attribute__((address_space(1)))
#define LAS __attribute__((address_space(3)))
typedef unsigned short bf16;
typedef unsigned v4u __attribute__((ext_vector_type(4)));
typedef unsigned v2u __attribute__((ext_vector_type(2)));
typedef float f32x4 __attribute__((ext_vector_type(4)));
typedef short bf16x8 __attribute__((ext_vector_type(8)));

constexpr int NWAVES = 8, NTHR = 512;
constexpr int NB = 2, SEQ = 16384, T = NB * SEQ, D = 1024;
constexpr int CONV_CH = 768, CONV_W = 31, AIN = 1792, KVW = 1536, NEXP = 32, DFF = 1024;
constexpr int MAXTILES = (T * 4) / 256 + NEXP;
constexpr int XROWS = MAXTILES * 256;
constexpr float DN_ALPHA = 1.681792830507429f;
constexpr float LN_EPS = 1e-5f;

constexpr size_t MiB = 1u << 20;
constexpr size_t al(size_t x) { return (x + MiB - 1) / MiB * MiB; }
constexpr size_t WS_CTL = 0, CTL_ZERO_BYTES = MiB;
constexpr size_t WS_ROT  = WS_CTL + MiB;
constexpr size_t WS_WIN  = WS_ROT  + al((size_t)T * 16 * 4);
constexpr size_t WS_WOA  = WS_WIN  + al((size_t)2 * AIN * D * 2);
constexpr size_t WS_WKV  = WS_WOA  + al((size_t)2 * D * D * 2);
constexpr size_t WS_WQ   = WS_WKV  + al((size_t)KVW * D * 2);
constexpr size_t WS_WOB  = WS_WQ   + al((size_t)2 * D * D * 2);
constexpr size_t WS_WMEM = WS_WOB  + al((size_t)2 * D * 512 * 2);
constexpr size_t WS_WUP  = WS_WMEM + al((size_t)4 * 512 * D * 2);
constexpr size_t WS_WDN  = WS_WUP  + al((size_t)4 * NEXP * 2 * DFF * D * 2);
constexpr size_t WS_MEMB = WS_WDN  + al((size_t)4 * NEXP * D * DFF * 2);
constexpr size_t WS_MEMKV= WS_MEMB + al((size_t)512 * D * 2);
constexpr size_t WS_XB   = WS_MEMKV+ al((size_t)512 * 2048 * 2);
constexpr size_t WS_X1B  = WS_XB   + al((size_t)T * D * 2);
constexpr size_t WS_XR1  = WS_X1B  + al((size_t)T * D * 2);
constexpr size_t WS_XR2  = WS_XR1  + al((size_t)T * D * 4);
constexpr size_t WS_Z    = WS_XR2  + al((size_t)T * D * 4);
constexpr size_t WS_HGLU = WS_Z    + al((size_t)T * D * 4);
constexpr size_t WS_QM   = WS_HGLU + al((size_t)T * CONV_CH * 2);
constexpr size_t WS_A2   = WS_QM   + al((size_t)T * 256 * 2);
constexpr size_t WS_QB   = WS_A2   + al((size_t)T * D * 2);
constexpr size_t WS_KVB  = WS_QB   + al((size_t)T * D * 2);
constexpr size_t WS_OG   = WS_KVB  + al((size_t)T * KVW * 2);
constexpr size_t WS_LSE  = WS_OG   + al((size_t)3 * T * 256 * 2);
constexpr size_t WS_TES  = WS_LSE  + al((size_t)3 * T * 4 * 4);
constexpr size_t WS_TGATE= WS_TES  + al((size_t)T * 4 * 4);
constexpr size_t WS_TROW = WS_TGATE+ al((size_t)T * 4 * 4);
constexpr size_t WS_XS   = WS_TROW + al((size_t)T * 4 * 4);
constexpr size_t WS_H    = WS_XS   + al((size_t)XROWS * D * 2);
constexpr size_t WS_Y    = WS_H    + al((size_t)XROWS * DFF * 2);
constexpr size_t WS_END  = WS_Y    + al((size_t)XROWS * D * 2);
constexpr int CW_BAR = 4096;
constexpr int CW_CNT = 8192;
constexpr int LDS_SCR = 133120;
constexpr int LDS_MISC = LDS_SCR;
constexpr int LDS_TB = LDS_MISC + 64;
constexpr int LDS_TE = LDS_TB + 192;
constexpr int LDS_RT = LDS_TE + 2304;
constexpr int LDS_PTR = LDS_RT + 2304;
constexpr int LDS_BYTES = 147456;
static_assert(LDS_PTR + 256 <= LDS_BYTES, "LDS map");

#define LDS_WAIT() asm volatile("s_waitcnt lgkmcnt(0)" ::: "memory")
#define VM_WAIT() asm volatile("s_waitcnt vmcnt(0)" ::: "memory")
__device__ __forceinline__ unsigned f2bf(float f) { unsigned u = __builtin_bit_cast(unsigned, f); return (u + 0x7fffu + ((u >> 16) & 1u)) >> 16; }
__device__ __forceinline__ unsigned pk2(float lo, float hi) { return f2bf(lo) | (f2bf(hi) << 16); }
__device__ __forceinline__ float bflo(unsigned w) { return __builtin_bit_cast(float, w << 16); }
__device__ __forceinline__ float bfhi(unsigned w) { return __builtin_bit_cast(float, w & 0xffff0000u); }
__device__ __forceinline__ float wave_sum(float v) {
#pragma unroll
    for (int o = 1; o < 64; o <<= 1) v += __shfl_xor(v, o);
    return v;
}
__device__ __forceinline__ float sigmoidf_(float x) { return 1.0f / (1.0f + __expf(-x)); }
#define XB_TMO      128
#define XB_XCNT(j)  (256  + 64 * (j))
#define XB_XSUB(j)  (1280 + 64 * (j))
#define XB_XGEN(j)  (2304 + 64 * (j))
#define XB_TOP      3328
#define XB_TOPGEN   3392
#define XCD_BAR_WORDS 3456
#define XB_SPIN_CAP (1u << 18)

__device__ __forceinline__ unsigned xb_ld(unsigned* p)              { return __hip_atomic_load(p, __ATOMIC_RELAXED, __HIP_MEMORY_SCOPE_AGENT); }
__device__ __forceinline__ unsigned xb_add(unsigned* p, unsigned v) { return __hip_atomic_fetch_add(p, v, __ATOMIC_RELAXED, __HIP_MEMORY_SCOPE_AGENT); }
__device__ __forceinline__ unsigned xb_xcc_id() { return (unsigned)__builtin_amdgcn_s_getreg((3 << 11) | 20) & 0xFu; }
#define XB_SPIN(cond, bar) do { unsigned _sp = 0; while (cond) { __builtin_amdgcn_s_sleep(1); \
    if ((++_sp & 255u) == 0u) { if (xb_ld(&(bar)[XB_TMO])) break; if (_sp > XB_SPIN_CAP) { atomicAdd(&(bar)[XB_TMO], 1u); break; } } } } while (0)

struct XcdBarrier {
    unsigned* bar; unsigned x;
    volatile LAS unsigned* st;
};

__device__ __forceinline__ XcdBarrier xcd_barrier_post(unsigned* bar, volatile LAS unsigned* st) {
    XcdBarrier b; b.bar = bar; b.x = xb_xcc_id(); b.st = st;
    if (threadIdx.x == 0) (void)xb_add(&bar[XB_XCNT(b.x)], 1u);
    return b;
}
__device__ __forceinline__ void xcd_barrier_complete(unsigned* bar, unsigned x, unsigned& nloc, unsigned& nx) {
    const unsigned G = gridDim.x * gridDim.y * gridDim.z;
    unsigned sum, cnt, mine, sp = 0u;
    for (;;) {
        sum = 0u; cnt = 0u; mine = 0u;
#pragma unroll
        for (unsigned j = 0; j < 16; ++j) { const unsigned c = xb_ld(&bar[XB_XCNT(j)]); sum += c; cnt += (c > 0u) ? 1u : 0u; mine = (j == x) ? c : mine; }
        if (sum == G) break;
        __builtin_amdgcn_s_sleep(1);
        if ((++sp & 255u) == 0u) { if (xb_ld(&bar[XB_TMO])) break; if (sp > XB_SPIN_CAP) { atomicAdd(&bar[XB_TMO], 1u); break; } }
    }
    nloc = mine > 0u ? mine : 1u; nx = cnt > 0u ? cnt : 1u;
}

__device__ __forceinline__ void xcd_barrier(const XcdBarrier& b) {
    asm volatile("s_waitcnt vmcnt(0)" ::: "memory");
    __syncthreads();
    if (threadIdx.x == 0) {
        unsigned* bar = b.bar;
        __builtin_amdgcn_s_waitcnt(0);
        unsigned nloc = b.st[0], nx = b.st[1];
        if (nloc == 0u) { xcd_barrier_complete(bar, b.x, nloc, nx); b.st[0] = nloc; b.st[1] = nx; }
        const unsigned old = xb_add(&bar[XB_XSUB(b.x)], 1u);
        const unsigned gen = old / nloc;
        if (old + 1u == (gen + 1u) * nloc) {
            __builtin_amdgcn_fence(__ATOMIC_RELEASE, "agent");
            asm volatile("s_waitcnt vmcnt(0)" ::: "memory");
            const unsigned og = xb_add(&bar[XB_TOP], 1u);
            const unsigned tg = og / nx;
            if (og + 1u == (tg + 1u) * nx) xb_add(&bar[XB_TOPGEN], 1u);
            else XB_SPIN(xb_ld(&bar[XB_TOPGEN]) == tg, bar);
            __builtin_amdgcn_fence(__ATOMIC_ACQUIRE, "agent");
            xb_add(&bar[XB_XGEN(b.x)], 1u);
            asm volatile("s_waitcnt vmcnt(0)" ::: "memory");
        } else {
            XB_SPIN(xb_ld(&bar[XB_XGEN(b.x)]) == gen, bar);
            __builtin_amdgcn_fence(__ATOMIC_ACQUIRE, "agent");
            asm volatile("s_waitcnt vmcnt(0)" ::: "memory");
        }
    }
    __syncthreads();
}

using pg8::Unit; using pg8::cvt_pk_bf16; using pg8::BM; using pg8::HALF;
typedef unsigned u32x4 __attribute__((ext_vector_type(4)));

struct EpiGluQ {
    static constexpr bool PERM = true, AFTER_DRAIN = false;
    bf16* hglu; bf16* qm; const float* bias;
    __device__ __forceinline__ void operator()(const f32x4 (&acc)[2][2][4][2], const Unit& u, int wr, int wc, int fr, int fq) const {
        const int row0 = u.pm * BM + wr * 64 + fr, cw = wc * 32 + 8 * fq;
        if (u.pn < 6) {
            f32x4 ba[2], bg[2];
#pragma unroll
            for (int n = 0; n < 2; ++n) { ba[n] = *(const f32x4*)(bias + u.pn * 128 + cw + 4 * n); bg[n] = *(const f32x4*)(bias + 768 + u.pn * 128 + cw + 4 * n); }
#pragma unroll
            for (int ai = 0; ai < 2; ++ai)
#pragma unroll
                for (int m = 0; m < 4; ++m) {
                    float o[8];
#pragma unroll
                    for (int n = 0; n < 2; ++n) { const f32x4 a = acc[ai][0][m][n] + ba[n], g = acc[ai][1][m][n] + bg[n];
#pragma unroll
                        for (int j = 0; j < 4; ++j) o[4 * n + j] = a[j] * sigmoidf_(g[j]); }
                    u32x4 w; w.x = cvt_pk_bf16(o[0], o[1]); w.y = cvt_pk_bf16(o[2], o[3]); w.z = cvt_pk_bf16(o[4], o[5]); w.w = cvt_pk_bf16(o[6], o[7]);
                    *(u32x4*)(hglu + (size_t)(row0 + ai * HALF + m * 16) * CONV_CH + u.pn * 128 + cw) = w;
                }
        } else {
            f32x4 bv[2][2];
#pragma unroll
            for (int bj = 0; bj < 2; ++bj)
#pragma unroll
                for (int n = 0; n < 2; ++n) bv[bj][n] = *(const f32x4*)(bias + 1536 + bj * HALF + cw + 4 * n);
#pragma unroll
            for (int ai = 0; ai < 2; ++ai)
#pragma unroll
                for (int m = 0; m < 4; ++m)
#pragma unroll
                    for (int bj = 0; bj < 2; ++bj) { const f32x4 v0 = acc[ai][bj][m][0] + bv[bj][0], v1 = acc[ai][bj][m][1] + bv[bj][1];
                        u32x4 w; w.x = cvt_pk_bf16(v0[0], v0[1]); w.y = cvt_pk_bf16(v0[2], v0[3]); w.z = cvt_pk_bf16(v1[0], v1[1]); w.w = cvt_pk_bf16(v1[2], v1[3]);
                        *(u32x4*)(qm + (size_t)(row0 + ai * HALF + m * 16) * 256 + bj * HALF + cw) = w; }
        }
    }
};

struct EpiRes {
    static constexpr bool PERM = false, AFTER_DRAIN = false;
    float* Z; const float* xres; const float* bias;
    __device__ __forceinline__ void operator()(const f32x4 (&acc)[2][2][4][2], const Unit& u, int wr, int wc, int fr, int fq) const {
        const int row0 = u.pm * BM + wr * 64 + fr, col0 = u.pn * BM + wc * 32 + 4 * fq;
        f32x4 bv[2][2];
#pragma unroll
        for (int bj = 0; bj < 2; ++bj)
#pragma unroll
            for (int n = 0; n < 2; ++n) bv[bj][n] = *(const f32x4*)(bias + col0 + bj * HALF + n * 16);
#pragma unroll
        for (int ai = 0; ai < 2; ++ai)
#pragma unroll
            for (int m = 0; m < 4; ++m) { const size_t off = (size_t)(row0 + ai * HALF + m * 16) * D + col0;
#pragma unroll
                for (int bj = 0; bj < 2; ++bj)
#pragma unroll
                    for (int n = 0; n < 2; ++n) { const f32x4 xr = *(const f32x4*)(xres + off + bj * HALF + n * 16);
                        *(f32x4*)(Z + off + bj * HALF + n * 16) = xr * DN_ALPHA + acc[ai][bj][m][n] + bv[bj][n]; } }
    }
};

template <int MODE> struct EpiRot {
    static constexpr bool PERM = true, AFTER_DRAIN = false;
    bf16* O; int ldc; const float* rot;
    __device__ __forceinline__ void operator()(const f32x4 (&acc)[2][2][4][2], const Unit& u, int wr, int wc, int fr, int fq) const {
        const int row0 = u.pm * BM + wr * 64 + fr;
#pragma unroll
        for (int bj = 0; bj < 2; ++bj) {
            const int cb = u.pn * BM + bj * HALF;
            bool rotu = false;
            if (MODE == 0) rotu = (cb < 768) && ((wc & 1) == 0);
            if (MODE == 1) rotu = ((cb & 511) < 256) && ((wc & 1) == 0);
#pragma unroll
            for (int ai = 0; ai < 2; ++ai)
#pragma unroll
                for (int m = 0; m < 4; ++m) {
                    const int row = row0 + ai * HALF + m * 16;
                    float v[8];
#pragma unroll
                    for (int j = 0; j < 4; ++j) { v[j] = acc[ai][bj][m][0][j]; v[4 + j] = acc[ai][bj][m][1][j]; }
                    if (rotu) {
                        float pv[8];
#pragma unroll
                        for (int j = 0; j < 8; ++j) pv[j] = __shfl_xor(v[j], 16);
                        if (fq < 2) {
                            const f32x4 c0 = *(const f32x4*)(rot + (size_t)row * 16), c1 = *(const f32x4*)(rot + (size_t)row * 16 + 4);
                            const f32x4 s0 = *(const f32x4*)(rot + (size_t)row * 16 + 8), s1 = *(const f32x4*)(rot + (size_t)row * 16 + 12);
                            const float sg = (fq == 0) ? -1.0f : 1.0f;
#pragma unroll
                            for (int j = 0; j < 4; ++j) { v[j] = v[j] * c0[j] + sg * pv[j] * s0[j]; v[4 + j] = v[4 + j] * c1[j] + sg * pv[4 + j] * s1[j]; }
                        }
                    }
                    u32x4 w; w.x = cvt_pk_bf16(v[0], v[1]); w.y = cvt_pk_bf16(v[2], v[3]); w.z = cvt_pk_bf16(v[4], v[5]); w.w = cvt_pk_bf16(v[6], v[7]);
                    *(u32x4*)(O + (size_t)row * ldc + cb + wc * 32 + 8 * fq) = w;
                }
        }
    }
};

struct EpiSwiglu {
    static constexpr bool PERM = true, AFTER_DRAIN = false;
    bf16* H; const float* bup;
    __device__ __forceinline__ void operator()(const f32x4 (&acc)[2][2][4][2], const Unit& u, int wr, int wc, int fr, int fq) const {
        const int e = u.pn >> 3, pn = u.pn & 7, row0 = u.pm * BM + wr * 64 + fr, cw = pn * 128 + wc * 32 + 8 * fq;
        f32x4 bg[2], bl[2];
#pragma unroll
        for (int n = 0; n < 2; ++n) { bg[n] = *(const f32x4*)(bup + (size_t)e * 2048 + cw + 4 * n); bl[n] = *(const f32x4*)(bup + (size_t)e * 2048 + 1024 + cw + 4 * n); }
#pragma unroll
        for (int ai = 0; ai < 2; ++ai)
#pragma unroll
            for (int m = 0; m < 4; ++m) {
                float o[8];
#pragma unroll
                for (int n = 0; n < 2; ++n) { const f32x4 g = acc[ai][0][m][n] + bg[n], li = acc[ai][1][m][n] + bl[n];
#pragma unroll
                    for (int j = 0; j < 4; ++j) { const float gg = fminf(g[j], 7.0f), ll = fminf(fmaxf(li[j], -7.0f), 7.0f); o[4 * n + j] = gg * sigmoidf_(1.702f * gg) * (ll + 1.0f); } }
                u32x4 w; w.x = cvt_pk_bf16(o[0], o[1]); w.y = cvt_pk_bf16(o[2], o[3]); w.z = cvt_pk_bf16(o[4], o[5]); w.w = cvt_pk_bf16(o[6], o[7]);
                *(u32x4*)(H + (size_t)(row0 + ai * HALF + m * 16) * DFF + cw) = w;
            }
    }
};

struct EpiDown {
    static constexpr bool PERM = true, AFTER_DRAIN = false;
    bf16* Y; const float* bdn;
    __device__ __forceinline__ void operator()(const f32x4 (&acc)[2][2][4][2], const Unit& u, int wr, int wc, int fr, int fq) const {
        const int e = u.pn >> 2, pn = u.pn & 3, row0 = u.pm * BM + wr * 64 + fr, cw = pn * BM + wc * 32 + 8 * fq;
        f32x4 bv[2][2];
#pragma unroll
        for (int bj = 0; bj < 2; ++bj)
#pragma unroll
            for (int n = 0; n < 2; ++n) bv[bj][n] = *(const f32x4*)(bdn + (size_t)e * D + cw + bj * HALF + 4 * n);
#pragma unroll
        for (int ai = 0; ai < 2; ++ai)
#pragma unroll
            for (int m = 0; m < 4; ++m)
#pragma unroll
                for (int bj = 0; bj < 2; ++bj) { const f32x4 v0 = acc[ai][bj][m][0] + bv[bj][0], v1 = acc[ai][bj][m][1] + bv[bj][1];
                    u32x4 w; w.x = cvt_pk_bf16(v0[0], v0[1]); w.y = cvt_pk_bf16(v0[2], v0[3]); w.z = cvt_pk_bf16(v1[0], v1[1]); w.w = cvt_pk_bf16(v1[2], v1[3]);
                    *(u32x4*)(Y + (size_t)(row0 + ai * HALF + m * 16) * D + cw + bj * HALF) = w; }
    }
};

template <int NTN> struct MoeOrder {
    const LAS int* tile_e; int total, G, c;
    __device__ __forceinline__ bool next(int i, Unit& u) const {
        const int L = i * G + c, grp = L / (8 * NTN), w = L % (8 * NTN), rt = grp * 8 + (w & 7), pn = w >> 3;
        if (rt >= total) return false;
        const int e = __builtin_amdgcn_readfirstlane(tile_e[rt]);
        u.pm = rt; u.pn = e * NTN + pn; return true;
    }
    __device__ __forceinline__ void a_ready(const Unit&) const {}
    __device__ __forceinline__ void done(const Unit&) const {}
};

struct Frame {
    LAS unsigned char* lds;
    int tid, lane, wave, G, gw, NGW;
};
__device__ __forceinline__ unsigned char* ptr_slot(const Frame& F, int k) {
    const unsigned long long v = *(const LAS unsigned long long*)(F.lds + LDS_PTR + 8 * k);
    const unsigned lo = __builtin_amdgcn_readfirstlane((unsigned)v), hi = __builtin_amdgcn_readfirstlane((unsigned)(v >> 32));
    return (unsigned char*)(GAS unsigned char*)(((unsigned long long)hi << 32) | lo);
}
__device__ __forceinline__ const float* inp(const Frame& F, int k) { return (const float*)ptr_slot(F, k); }
__device__ __forceinline__ unsigned char* wsp(const Frame& F) { return ptr_slot(F, 24); }

__device__ __forceinline__ void tr_item(const float* W, int N, bf16* WT, int K, int k0, int n0, int orow0, LAS float* scr, int lane) {
#pragma unroll 16
    for (int i = 0; i < 64; ++i) scr[i * 65 + lane] = W[(size_t)(k0 + i) * N + n0 + lane];
    LDS_WAIT(); asm volatile("" ::: "memory");
    const int c = lane & 7;
#pragma unroll
    for (int j = 0; j < 8; ++j) { const int n = (lane >> 3) + 8 * j; const LAS float* s = scr + (8 * c) * 65 + n;
        v4u o; o.x = pk2(s[0 * 65], s[1 * 65]); o.y = pk2(s[2 * 65], s[3 * 65]); o.z = pk2(s[4 * 65], s[5 * 65]); o.w = pk2(s[6 * 65], s[7 * 65]);
        *(v4u*)(WT + (size_t)(orow0 + n) * K + k0 + 8 * c) = o; }
    LDS_WAIT(); asm volatile("" ::: "memory");
}
template <int PERMT> __device__ __forceinline__ int perm_row(int n0) {
    if (PERMT == 1) { if (n0 >= 1536) return n0; const int bj = n0 / 768, r = n0 % 768; return (r / 128) * 256 + bj * 128 + (r % 128); }
    if (PERMT == 2) { const int bj = n0 / 1024, r = n0 % 1024; return (r / 128) * 256 + bj * 128 + (r % 128); }
    return n0;
}
template <int PERMT> __device__ __forceinline__ void conv_group(Frame& F, const float* src, bf16* dst, int K, int N, int nmat) {
    LAS float* scr = (LAS float*)(F.lds + F.wave * 16640);
    const int nkb = K / 64, nnb = N / 64, per = nkb * nnb, total = per * nmat;
    for (int it = F.gw; it < total; it += F.NGW) {
        const int mat = it / per, r = it % per, kb = r / nnb, nb = r % nnb;
        tr_item(src + (size_t)mat * K * N, N, dst + (size_t)mat * K * N, K, kb * 64, nb * 64, perm_row<PERMT>(nb * 64), scr, F.lane);
    }
}
__device__ __forceinline__ void phase_prologue(Frame& F) {
    unsigned char* ws = wsp(F);
    conv_group<1>(F, inp(F, 3),  (bf16*)(ws + WS_WIN),  D, AIN, 2);
    conv_group<0>(F, inp(F, 9),  (bf16*)(ws + WS_WOA),  D, D, 2);
    conv_group<0>(F, inp(F, 11), (bf16*)(ws + WS_WKV),  D, KVW, 1);
    conv_group<0>(F, inp(F, 12), (bf16*)(ws + WS_WQ),   D, D, 2);
    conv_group<0>(F, inp(F, 13), (bf16*)(ws + WS_WOB),  512, D, 2);
    conv_group<0>(F, inp(F, 15), (bf16*)(ws + WS_WMEM), D, 512, 4);
    conv_group<2>(F, inp(F, 20), (bf16*)(ws + WS_WUP),  D, 2 * DFF, 4 * NEXP);
    conv_group<0>(F, inp(F, 22), (bf16*)(ws + WS_WDN),  DFF, D, 4 * NEXP);
    {
        const size_t gt = (size_t)blockIdx.x * NTHR + F.tid, NT_ = (size_t)F.G * NTHR;
        const float* x = inp(F, 0); bf16* xb = (bf16*)(ws + WS_XB);
        for (size_t i = gt; i < (size_t)T * D / 8; i += NT_) { const f32x4 a = *(const f32x4*)(x + i * 8), b = *(const f32x4*)(x + i * 8 + 4);
            v4u o; o.x = pk2(a[0], a[1]); o.y = pk2(a[2], a[3]); o.z = pk2(b[0], b[1]); o.w = pk2(b[2], b[3]); *(v4u*)(xb + i * 8) = o; }
        const float* mem = inp(F, 1); bf16* mb = (bf16*)(ws + WS_MEMB);
        for (size_t i = gt; i < (size_t)512 * D / 8; i += NT_) { const f32x4 a = *(const f32x4*)(mem + i * 8), b = *(const f32x4*)(mem + i * 8 + 4);
            v4u o; o.x = pk2(a[0], a[1]); o.y = pk2(a[2], a[3]); o.z = pk2(b[0], b[1]); o.w = pk2(b[2], b[3]); *(v4u*)(mb + i * 8) = o; }
        const int* pos = (const int*)inp(F, 2); float* rot = (float*)(ws + WS_ROT);
        for (size_t i = gt; i < (size_t)T * 8; i += NT_) { const int t = (int)(i >> 3), k = (int)(i & 7);
            double f = 1.0;
            f = (k == 1) ? 0.19392274474868576 : f; f = (k == 2) ? 0.03760603093086393 : f; f = (k == 3) ? 0.007292664737217109 : f; f = (k == 4) ? 0.001414213562373095 : f;
            f = (k == 5) ? 0.0002742481756762073 : f; f = (k == 6) ? 5.318295896944988e-05 : f; f = (k == 7) ? 1.031338537721246e-05 : f;
            const double a = (double)pos[t] * f; const double rv = a * 0.15915494309189535; const double fr = rv - floor(rv);
            const float ang = (float)(fr * 6.283185307179586);
            rot[(size_t)t * 16 + k] = cosf(ang); rot[(size_t)t * 16 + 8 + k] = sinf(ang); }
    }
}

__device__ __forceinline__ void phase_conv(Frame& F, const bf16* hglu, const float* dw, const float* dwb, const float* cg, const float* cb, bf16* A2) {
    LAS bf16* tile = (LAS bf16*)F.lds;
    LAS float* red = (LAS float*)(F.lds + 46 * 768 * 2);
    const int L = F.tid & 255, tb = F.tid >> 8, wv = F.wave & 3;
    float w[31][3], bias[3], gg[3], bb[3];
#pragma unroll
    for (int p = 0; p < 3; ++p) { bias[p] = dwb[p * 256 + L]; gg[p] = cg[p * 256 + L]; bb[p] = cb[p * 256 + L];
#pragma unroll
        for (int j = 0; j < 31; ++j) w[j][p] = dw[j * CONV_CH + p * 256 + L]; }
    for (int ti = blockIdx.x; ti < T / 16; ti += F.G) {
        const int t0 = ti * 16, s0 = t0 & (SEQ - 1);
        __syncthreads();
        for (int i = F.tid; i < 46 * 96; i += NTHR) { const int r = i / 96, c = i % 96; v4u v = (v4u){0u, 0u, 0u, 0u};
            if (s0 - 30 + r >= 0) v = *(const v4u*)(hglu + (size_t)(t0 - 30 + r) * CONV_CH + c * 8);
            *(LAS v4u*)(tile + r * CONV_CH + c * 8) = v; }
        __syncthreads();
        float acc[8][3];
#pragma unroll
        for (int t = 0; t < 8; ++t)
#pragma unroll
            for (int p = 0; p < 3; ++p) acc[t][p] = bias[p];
#pragma unroll
        for (int r = 0; r < 38; ++r) {
            float x[3];
#pragma unroll
            for (int p = 0; p < 3; ++p) x[p] = bflo((unsigned)tile[(tb * 8 + r) * CONV_CH + p * 256 + L]);
#pragma unroll
            for (int t = 0; t < 8; ++t) { const int j = r - t; if (j >= 0 && j <= 30) {
#pragma unroll
                for (int p = 0; p < 3; ++p) acc[t][p] += x[p] * w[j][p]; } }
        }
        float mean[8], rstd[8];
#pragma unroll
        for (int t = 0; t < 8; ++t) { const float s = wave_sum(acc[t][0] + acc[t][1] + acc[t][2]); if (F.lane == 0) red[(tb * 4 + wv) * 8 + t] = s; }
        __syncthreads();
#pragma unroll
        for (int t = 0; t < 8; ++t) { const LAS float* rp = red + tb * 32 + t; mean[t] = (rp[0] + rp[8] + rp[16] + rp[24]) * (1.0f / CONV_CH); }
#pragma unroll
        for (int t = 0; t < 8; ++t) { const float d0 = acc[t][0] - mean[t], d1 = acc[t][1] - mean[t], d2 = acc[t][2] - mean[t];
            const float s = wave_sum(d0 * d0 + d1 * d1 + d2 * d2); if (F.lane == 0) red[64 + (tb * 4 + wv) * 8 + t] = s; }
        __syncthreads();
#pragma unroll
        for (int t = 0; t < 8; ++t) { const LAS float* rp = red + 64 + tb * 32 + t; rstd[t] = 1.0f / sqrtf((rp[0] + rp[8] + rp[16] + rp[24]) * (1.0f / CONV_CH) + LN_EPS); }
#pragma unroll
        for (int t = 0; t < 8; ++t)
#pragma unroll
            for (int p = 0; p < 3; ++p) { const float y = (acc[t][p] - mean[t]) * rstd[t] * gg[p] + bb[p]; const float o = y * sigmoidf_(y);
                A2[(size_t)(t0 + tb * 8 + t) * D + p * 256 + L] = (bf16)f2bf(o); }
    }
    __syncthreads();
}

constexpr int KPITCH = 144, VSB = 560;
template <int NT, bool MASK>
__device__ __forceinline__ void attn_wave(const LAS unsigned char* Kl, const LAS unsigned char* Vt, int kt0, bf16x8 bq0, bf16x8 bq1, int lane, int qi, bool first, f32x4 (&o)[4], float& lse) {
    const int r = lane & 15, lg = lane >> 4;
    f32x4 s[NT];
#pragma unroll
    for (int t = 0; t < NT; ++t) {
        const LAS unsigned char* kp = Kl + ((kt0 + t) * 16 + r) * KPITCH + lg * 16;
        const bf16x8 a0 = *(const LAS bf16x8*)kp, a1 = *(const LAS bf16x8*)(kp + 64);
        f32x4 z = (f32x4){0.f, 0.f, 0.f, 0.f};
        z = __builtin_amdgcn_mfma_f32_16x16x32_bf16(a0, bq0, z, 0, 0, 0);
        s[t] = __builtin_amdgcn_mfma_f32_16x16x32_bf16(a1, bq1, z, 0, 0, 0);
    }
    float m = -INFINITY;
#pragma unroll
    for (int t = 0; t < NT; ++t)
#pragma unroll
        for (int j = 0; j < 4; ++j) {
            if (MASK) { const int ki = (kt0 + t) * 16 + 4 * lg + j, dist = qi + 128 - ki; const bool valid = (dist >= 0) && (dist <= 128) && (!first || ki >= 128); s[t][j] = valid ? s[t][j] : -INFINITY; }
            m = fmaxf(m, s[t][j]);
        }
    m = fmaxf(m, __shfl_xor(m, 16)); m = fmaxf(m, __shfl_xor(m, 32));
    const float c = 0.125f * 1.4426950408889634f;
    float sum = 0.f;
#pragma unroll
    for (int t = 0; t < NT; ++t)
#pragma unroll
        for (int j = 0; j < 4; ++j) { const float p = exp2f((s[t][j] - m) * c); s[t][j] = p; sum += p; }
    sum += __shfl_xor(sum, 16); sum += __shfl_xor(sum, 32);
#pragma unroll
    for (int et = 0; et < 4; ++et) o[et] = (f32x4){0.f, 0.f, 0.f, 0.f};
#pragma unroll
    for (int kk = 0; kk < NT / 2; ++kk) {
        v4u pw; pw.x = cvt_pk_bf16(s[2 * kk][0], s[2 * kk][1]); pw.y = cvt_pk_bf16(s[2 * kk][2], s[2 * kk][3]);
        pw.z = cvt_pk_bf16(s[2 * kk + 1][0], s[2 * kk + 1][1]); pw.w = cvt_pk_bf16(s[2 * kk + 1][2], s[2 * kk + 1][3]);
        const bf16x8 bp = __builtin_bit_cast(bf16x8, pw);
#pragma unroll
        for (int et = 0; et < 4; ++et) {
            const LAS unsigned char* vp = Vt + (16 * et + r) * VSB + ((kt0 + 2 * kk) * 16 + 4 * lg) * 2;
            const v2u lo = *(const LAS v2u*)vp, hi = *(const LAS v2u*)(vp + 32);
            v4u av; av.x = lo.x; av.y = lo.y; av.z = hi.x; av.w = hi.y;
            o[et] = __builtin_amdgcn_mfma_f32_16x16x32_bf16(__builtin_bit_cast(bf16x8, av), bp, o[et], 0, 0, 0);
        }
    }
    const float inv = 1.0f / sum;
#pragma unroll
    for (int et = 0; et < 4; ++et) o[et] = o[et] * inv;
    lse = m * 0.125f + __logf(sum);
}
__device__ __forceinline__ void vt_store(LAS unsigned char* Vt, int ki, int c, v4u v) {
    LAS unsigned short* p = (LAS unsigned short*)(Vt + (c * 8) * VSB + ki * 2);
    p[0 * (VSB / 2)] = (unsigned short)(v.x & 0xffffu); p[1 * (VSB / 2)] = (unsigned short)(v.x >> 16);
    p[2 * (VSB / 2)] = (unsigned short)(v.y & 0xffffu); p[3 * (VSB / 2)] = (unsigned short)(v.y >> 16);
    p[4 * (VSB / 2)] = (unsigned short)(v.z & 0xffffu); p[5 * (VSB / 2)] = (unsigned short)(v.z >> 16);
    p[6 * (VSB / 2)] = (unsigned short)(v.w & 0xffffu); p[7 * (VSB / 2)] = (unsigned short)(v.w >> 16);
}
constexpr int ATT_K_OFF = 0, ATT_V_OFF = 272 * KPITCH;

__device__ __forceinline__ void phase_memattn(Frame& F, const bf16* q, int qp, int qc0, const bf16* memkv, int l, bf16* out, int op, int oc0) {
    LAS unsigned char* Kl = F.lds + ATT_K_OFF; LAS unsigned char* Vt = F.lds + ATT_V_OFF;
    const int r = F.lane & 15, lg = F.lane >> 4;
    for (int u = blockIdx.x; u < 256; u += F.G) {
        const int b = u >> 7, h = (u >> 5) & 3, qc = u & 31;
        __syncthreads();
#pragma unroll
        for (int k = 0; k < 4; ++k) { const int i = F.tid + NTHR * k, ki = i >> 3, c = i & 7;
            const bf16* src = memkv + (size_t)(b * 256 + ki) * 2048 + l * 512 + h * 64 + c * 8;
            const v4u kv = *(const v4u*)src, vv = *(const v4u*)(src + 256);
            *(LAS v4u*)(Kl + ki * KPITCH + c * 16) = kv; vt_store(Vt, ki, c, vv); }
        __syncthreads();
        for (int pass = 0; pass < 4; ++pass) {
            const int tok = b * SEQ + qc * 512 + pass * 128 + F.wave * 16 + r;
            const bf16* qr = q + (size_t)tok * qp + qc0 + h * 64 + 8 * lg;
            const bf16x8 bq0 = *(const bf16x8*)qr, bq1 = *(const bf16x8*)(qr + 32);
            f32x4 o[4]; float lse;
            attn_wave<16, false>(Kl, Vt, 0, bq0, bq1, F.lane, 0, false, o, lse);
            bf16* orow = out + (size_t)tok * op + oc0 + h * 64 + 4 * lg;
#pragma unroll
            for (int et = 0; et < 4; ++et) { v2u w; w.x = cvt_pk_bf16(o[et][0], o[et][1]); w.y = cvt_pk_bf16(o[et][2], o[et][3]); *(v2u*)(orow + 16 * et) = w; }
        }
    }
    __syncthreads();
}

__device__ __forceinline__ void phase_dilated(Frame& F, const bf16* q  , const bf16* kv  , bf16* og  , float* lseo  ) {
    LAS unsigned char* Kl = F.lds + ATT_K_OFF; LAS unsigned char* Vt = F.lds + ATT_V_OFF;
    const int r16 = F.lane & 15, lg = F.lane >> 4;
    for (int u = blockIdx.x; u < 3072; u += F.G) {
        const int b = u / 1536, rem = u % 1536, grp = rem >> 9, h = (rem >> 7) & 3, blk = rem & 127;
        const int dsh = 2 * grp, d = 1 << dsh, nblk = SEQ >> (7 + dsh), res = blk / nblk, n = blk % nblk;
        __syncthreads();
        for (int i = F.tid; i < 272 * 8; i += NTHR) { const int ki = i >> 3, c = i & 7; const int mk = (n - 1) * 128 + ki;
            v4u kvv = (v4u){0u, 0u, 0u, 0u}, vv = (v4u){0u, 0u, 0u, 0u};
            if (ki < 256 && mk >= 0) { const bf16* src = kv + (size_t)(b * SEQ + mk * d + res) * KVW + grp * 512 + h * 64 + c * 8; kvv = *(const v4u*)src; vv = *(const v4u*)(src + 256); }
            *(LAS v4u*)(Kl + ki * KPITCH + c * 16) = kvv; vt_store(Vt, ki, c, vv); }
        __syncthreads();
        const int qi = F.wave * 16 + r16;
        const int tok = b * SEQ + (n * 128 + qi) * d + res;
        const bf16* qr = q + (size_t)tok * D + grp * 256 + h * 64 + 8 * lg;
        const bf16x8 bq0 = *(const bf16x8*)qr, bq1 = *(const bf16x8*)(qr + 32);
        f32x4 o[4]; float lse;
        attn_wave<10, true>(Kl, Vt, F.wave, bq0, bq1, F.lane, qi, n == 0, o, lse);
        bf16* orow = og + ((size_t)grp * T + tok) * 256 + h * 64 + 4 * lg;
#pragma unroll
        for (int et = 0; et < 4; ++et) { v2u w; w.x = cvt_pk_bf16(o[et][0], o[et][1]); w.y = cvt_pk_bf16(o[et][2], o[et][3]); *(v2u*)(orow + 16 * et) = w; }
        if (lg == 0) lseo[((size_t)grp * T + tok) * 4 + h] = lse;
    }
    __syncthreads();
}
__device__ __forceinline__ void phase_dil_combine(Frame& F, const bf16* og, const float* lse, bf16* A2b  ) {
    const size_t gt = (size_t)blockIdx.x * NTHR + F.tid, NT_ = (size_t)F.G * NTHR;
    for (size_t i = gt; i < (size_t)T * 32; i += NT_) {
        const int t = (int)(i >> 5), h = (int)((i >> 3) & 3), c8 = (int)(i & 7);
        const float l0 = lse[((size_t)0 * T + t) * 4 + h], l1 = lse[((size_t)1 * T + t) * 4 + h], l2 = lse[((size_t)2 * T + t) * 4 + h];
        const float mx = fmaxf(l0, fmaxf(l1, l2)); float w0 = __expf(l0 - mx), w1 = __expf(l1 - mx), w2 = __expf(l2 - mx); const float inv = 1.0f / (w0 + w1 + w2); w0 *= inv; w1 *= inv; w2 *= inv;
        const v4u a = *(const v4u*)(og + ((size_t)0 * T + t) * 256 + h * 64 + c8 * 8), bq = *(const v4u*)(og + ((size_t)1 * T + t) * 256 + h * 64 + c8 * 8), cq = *(const v4u*)(og + ((size_t)2 * T + t) * 256 + h * 64 + c8 * 8);
        v4u o;
        o.x = pk2(w0 * bflo(a.x) + w1 * bflo(bq.x) + w2 * bflo(cq.x), w0 * bfhi(a.x) + w1 * bfhi(bq.x) + w2 * bfhi(cq.x));
        o.y = pk2(w0 * bflo(a.y) + w1 * bflo(bq.y) + w2 * bflo(cq.y), w0 * bfhi(a.y) + w1 * bfhi(bq.y) + w2 * bfhi(cq.y));
        o.z = pk2(w0 * bflo(a.z) + w1 * bflo(bq.z) + w2 * bflo(cq.z), w0 * bfhi(a.z) + w1 * bfhi(bq.z) + w2 * bfhi(cq.z));
        o.w = pk2(w0 * bflo(a.w) + w1 * bflo(bq.w) + w2 * bflo(cq.w), w0 * bfhi(a.w) + w1 * bfhi(bq.w) + w2 * bfhi(cq.w));
        *(v4u*)(A2b + (size_t)t * 512 + h * 64 + c8 * 8) = o;
    }
}

__device__ __forceinline__ void phase_ln_route(Frame& F, const float* z, const float* g, const float* bt, const float* rw, const float* rb,
                                               float* x1f, bf16* x1b, int* tok_es, float* tok_gate, unsigned* cnt_g) {
    LAS float* wT = (LAS float*)F.lds;
    LAS int* lcnt = (LAS int*)(F.lds + LDS_RT); LAS int* base = lcnt + 32; LAS int* rec = lcnt + 64;
    __syncthreads();
    for (int i = F.tid; i < 1024 * 32; i += NTHR) { const int c = i >> 5, e = i & 31; wT[e * 1028 + c] = rw[i]; }
    f32x4 g4[4], b4[4];
#pragma unroll
    for (int j = 0; j < 4; ++j) { g4[j] = *(const f32x4*)(g + 4 * F.lane + 256 * j); b4[j] = *(const f32x4*)(bt + 4 * F.lane + 256 * j); }
    const int my_e = (F.lane >> 1) & 31; const float my_rb = rb[my_e];
    const bool h5 = (F.lane & 32) != 0, h4 = (F.lane & 16) != 0, h3 = (F.lane & 8) != 0, h2 = (F.lane & 4) != 0, h1 = (F.lane & 2) != 0;
    __syncthreads();
    for (int chunk = blockIdx.x; chunk < T / 128; chunk += F.G) {
        if (F.tid < 32) lcnt[F.tid] = 0;
        __syncthreads();
        for (int tt = 0; tt < 16; ++tt) {
            const int tl = F.wave * 16 + tt, t = chunk * 128 + tl;
            f32x4 v[4]; float s = 0.f;
#pragma unroll
            for (int j = 0; j < 4; ++j) { v[j] = *(const f32x4*)(z + (size_t)t * D + 4 * F.lane + 256 * j); s += (v[j][0] + v[j][1]) + (v[j][2] + v[j][3]); }
            const float mean = wave_sum(s) * (1.0f / D); float s2 = 0.f;
#pragma unroll
            for (int j = 0; j < 4; ++j) { v[j] = v[j] - mean; s2 += (v[j][0] * v[j][0] + v[j][1] * v[j][1]) + (v[j][2] * v[j][2] + v[j][3] * v[j][3]); }
            const float rstd = 1.0f / sqrtf(wave_sum(s2) * (1.0f / D) + LN_EPS);
#pragma unroll
            for (int j = 0; j < 4; ++j) { v[j] = v[j] * rstd * g4[j] + b4[j];
                *(f32x4*)(x1f + (size_t)t * D + 4 * F.lane + 256 * j) = v[j];
                v2u w; w.x = pk2(v[j][0], v[j][1]); w.y = pk2(v[j][2], v[j][3]); *(v2u*)(x1b + (size_t)t * D + 4 * F.lane + 256 * j) = w; }
            float p[32];
#pragma unroll
            for (int e = 0; e < 32; ++e) { float a = 0.f;
#pragma unroll
                for (int j = 0; j < 4; ++j) { const f32x4 wv = *(const LAS f32x4*)(wT + e * 1028 + 4 * F.lane + 256 * j); a += (v[j][0] * wv[0] + v[j][1] * wv[1]) + (v[j][2] * wv[2] + v[j][3] * wv[3]); }
                p[e] = a; }
#pragma unroll
            for (int i = 0; i < 16; ++i) { const float keep = h5 ? p[i + 16] : p[i], send = h5 ? p[i] : p[i + 16]; p[i] = keep + __shfl_xor(send, 32); }
#pragma unroll
            for (int i = 0; i < 8; ++i) { const float keep = h4 ? p[i + 8] : p[i], send = h4 ? p[i] : p[i + 8]; p[i] = keep + __shfl_xor(send, 16); }
#pragma unroll
            for (int i = 0; i < 4; ++i) { const float keep = h3 ? p[i + 4] : p[i], send = h3 ? p[i] : p[i + 4]; p[i] = keep + __shfl_xor(send, 8); }
#pragma unroll
            for (int i = 0; i < 2; ++i) { const float keep = h2 ? p[i + 2] : p[i], send = h2 ? p[i] : p[i + 2]; p[i] = keep + __shfl_xor(send, 4); }
            { const float keep = h1 ? p[1] : p[0], send = h1 ? p[0] : p[1]; p[0] = keep + __shfl_xor(send, 2); }
            float val = p[0] + __shfl_xor(p[0], 1) + my_rb;
            float tv[4]; int ti[4];
#pragma unroll
            for (int k = 0; k < 4; ++k) { float kv = val; int ki = my_e;
#pragma unroll
                for (int off = 1; off < 64; off <<= 1) { const float ov = __shfl_xor(kv, off); const int oi = __shfl_xor(ki, off); const bool take = (ov > kv) || (ov == kv && oi < ki); kv = take ? ov : kv; ki = take ? oi : ki; }
                tv[k] = kv; ti[k] = ki; if (my_e == ki) val = -INFINITY; }
            const float e1 = __expf(tv[1] - tv[0]), e2 = __expf(tv[2] - tv[0]), e3 = __expf(tv[3] - tv[0]); const float inv = 1.0f / (1.0f + e1 + e2 + e3);
            if (F.lane < 4) { const int k = F.lane; const int ee = (k == 0) ? ti[0] : (k == 1) ? ti[1] : (k == 2) ? ti[2] : ti[3];
                const float gk = ((k == 0) ? 1.0f : (k == 1) ? e1 : (k == 2) ? e2 : e3) * inv;
                const int slot = __hip_atomic_fetch_add(lcnt + ee, 1, __ATOMIC_RELAXED, __HIP_MEMORY_SCOPE_WORKGROUP);
                rec[tl * 4 + k] = ee | (slot << 8); tok_gate[(size_t)t * 4 + k] = gk; }
        }
        __syncthreads();
        if (F.tid < 32) base[F.tid] = (int)__hip_atomic_fetch_add(cnt_g + F.tid, (unsigned)lcnt[F.tid], __ATOMIC_RELAXED, __HIP_MEMORY_SCOPE_AGENT);
        __syncthreads();
        { const int rr = rec[F.tid], e = rr & 255, slot = (rr >> 8) + base[e]; tok_es[(size_t)chunk * 512 + F.tid] = e | (slot << 8); }
        __syncthreads();
    }
}

__device__ __forceinline__ int build_tiles(Frame& F, const unsigned* cnt_g) {
    LAS int* tbs = (LAS int*)(F.lds + LDS_TB); LAS int* te = (LAS int*)(F.lds + LDS_TE);
    __syncthreads();
    if (F.tid == 0) { int a = 0; for (int e = 0; e < NEXP; ++e) { tbs[e] = a; a += (int)((cnt_g[e] + 255u) >> 8); } tbs[NEXP] = a; }
    __syncthreads();
    const int total = tbs[NEXP];
    for (int rt = F.tid; rt < total; rt += NTHR) { int e = 0; for (int k = 1; k < NEXP; ++k) e = (rt >= tbs[k]) ? k : e; te[rt] = e; }
    __syncthreads();
    return total;
}
__device__ __forceinline__ void phase_gather(Frame& F, const unsigned* cnt_g, const bf16* x1b, const int* tok_es, int* tok_row, bf16* Xs) {
    (void)build_tiles(F, cnt_g);
    const LAS int* tbs = (const LAS int*)(F.lds + LDS_TB);
    for (int t = F.gw; t < T; t += F.NGW) {
        const v4u a = *(const v4u*)(x1b + (size_t)t * D + F.lane * 16), b = *(const v4u*)(x1b + (size_t)t * D + F.lane * 16 + 8);
#pragma unroll
        for (int k = 0; k < 4; ++k) { const int es = tok_es[(size_t)t * 4 + k], e = es & 255, row = tbs[e] * 256 + (es >> 8);
            *(v4u*)(Xs + (size_t)row * D + F.lane * 16) = a; *(v4u*)(Xs + (size_t)row * D + F.lane * 16 + 8) = b;
            if (F.lane == k) tok_row[(size_t)t * 4 + k] = row; }
    }
}
__device__ __forceinline__ void phase_combine_ln(Frame& F, const float* x1f, const bf16* Y, const int* tok_row, const float* tok_gate, const float* g, const float* bt, float* xout, bf16* xb) {
    f32x4 g4[4], b4[4];
#pragma unroll
    for (int j = 0; j < 4; ++j) { g4[j] = *(const f32x4*)(g + 4 * F.lane + 256 * j); b4[j] = *(const f32x4*)(bt + 4 * F.lane + 256 * j); }
    for (int t = F.gw; t < T; t += F.NGW) {
        f32x4 v[4];
#pragma unroll
        for (int j = 0; j < 4; ++j) v[j] = *(const f32x4*)(x1f + (size_t)t * D + 4 * F.lane + 256 * j) * DN_ALPHA;
#pragma unroll
        for (int k = 0; k < 4; ++k) { const int row = tok_row[(size_t)t * 4 + k]; const float gk = tok_gate[(size_t)t * 4 + k];
#pragma unroll
            for (int j = 0; j < 4; ++j) { const v2u w = *(const v2u*)(Y + (size_t)row * D + 4 * F.lane + 256 * j);
                v[j][0] += gk * bflo(w.x); v[j][1] += gk * bfhi(w.x); v[j][2] += gk * bflo(w.y); v[j][3] += gk * bfhi(w.y); } }
        float s = 0.f;
#pragma unroll
        for (int j = 0; j < 4; ++j) s += (v[j][0] + v[j][1]) + (v[j][2] + v[j][3]);
        const float mean = wave_sum(s) * (1.0f / D); float s2 = 0.f;
#pragma unroll
        for (int j = 0; j < 4; ++j) { v[j] = v[j] - mean; s2 += (v[j][0] * v[j][0] + v[j][1] * v[j][1]) + (v[j][2] * v[j][2] + v[j][3] * v[j][3]); }
        const float rstd = 1.0f / sqrtf(wave_sum(s2) * (1.0f / D) + LN_EPS);
#pragma unroll
        for (int j = 0; j < 4; ++j) { v[j] = v[j] * rstd * g4[j] + b4[j];
            *(f32x4*)(xout + (size_t)t * D + 4 * F.lane + 256 * j) = v[j];
            v2u w; w.x = pk2(v[j][0], v[j][1]); w.y = pk2(v[j][2], v[j][3]); *(v2u*)(xb + (size_t)t * D + 4 * F.lane + 256 * j) = w; }
    }
}
#ifndef EN_ALL
#define EN_ALL 1
#endif
#ifndef EN_P0
#define EN_P0 EN_ALL
#endif
#ifndef EN_A1
#define EN_A1 EN_ALL
#endif
#ifndef EN_MKV
#define EN_MKV EN_ALL
#endif
#ifndef EN_CONV
#define EN_CONV EN_ALL
#endif
#ifndef EN_MATT
#define EN_MATT EN_ALL
#endif
#ifndef EN_A3
#define EN_A3 EN_ALL
#endif
#ifndef EN_B1
#define EN_B1 EN_ALL
#endif
#ifndef EN_B1KV
#define EN_B1KV EN_ALL
#endif
#ifndef EN_DIL
#define EN_DIL EN_ALL
#endif
#ifndef EN_DILC
#define EN_DILC EN_ALL
#endif
#ifndef EN_B4
#define EN_B4 EN_ALL
#endif
#ifndef EN_M1
#define EN_M1 EN_ALL
#endif
#ifndef EN_M2
#define EN_M2 EN_ALL
#endif
#ifndef EN_M3
#define EN_M3 EN_ALL
#endif
#ifndef EN_M4
#define EN_M4 EN_ALL
#endif
#ifndef EN_M5
#define EN_M5 EN_ALL
#endif

#ifndef MK_N_LAUNCHES
#define MK_N_LAUNCHES 1
#endif
constexpr int NPHASE = 1 + 2 * 8 + 2 * 9;
struct Args { const void* in[24]; float* out; unsigned char* ws; int ph_lo, ph_hi; };
static_assert(sizeof(Args) == 24 * 8 + 8 + 8 + 8, "Args has no padding");

__global__ void __launch_bounds__(NTHR, 2) fwd(Args args) {
    extern __shared__ __attribute__((aligned(16))) unsigned char lds_raw[];
    LAS unsigned char* const ldsb = (LAS unsigned char*)lds_raw;
    if (threadIdx.x < 16) ((LAS unsigned*)(ldsb + LDS_MISC))[threadIdx.x] = 0u;
    if (threadIdx.x == 0) {
        LAS unsigned long long* pt = (LAS unsigned long long*)(ldsb + LDS_PTR);
#pragma unroll
        for (int i = 0; i < 24; ++i) pt[i] = (unsigned long long)args.in[i];
        pt[24] = (unsigned long long)args.ws; pt[25] = (unsigned long long)args.out;
    }
    __syncthreads();
    const int lo = args.ph_lo, hi = args.ph_hi;
    const bool use_bar = (hi - lo) > 1;
    unsigned xcc = 0;
    if (use_bar) { const XcdBarrier b0 = xcd_barrier_post((unsigned*)(args.ws + WS_CTL) + CW_BAR, (volatile LAS unsigned*)(ldsb + LDS_MISC)); xcc = b0.x; }
#define IN(k) (lo <= (k) && (k) < hi)
#define FRAME() Frame F; { int t_ = threadIdx.x; asm volatile("" : "+v"(t_)); F.lds = ldsb; F.tid = t_; F.lane = t_ & 63; F.wave = __builtin_amdgcn_readfirstlane(t_ >> 6); \
                           F.G = gridDim.x; F.gw = blockIdx.x * NWAVES + F.wave; F.NGW = F.G * NWAVES; } unsigned char* ws = wsp(F); (void)ws
#define SEAM(k) do { if (IN(k) && IN((k) + 1)) { asm volatile("" ::: "memory"); Frame Fb; Fb.lds = ldsb; XcdBarrier b_; b_.bar = (unsigned*)(wsp(Fb) + WS_CTL) + CW_BAR; b_.x = xcc; b_.st = (volatile LAS unsigned*)(ldsb + LDS_MISC); xcd_barrier(b_); } } while (0)
#define WSB(T_, off) ((T_*)(ws + (off)))

    if (EN_P0 && IN(0)) { FRAME(); phase_prologue(F); }
    SEAM(0);

    for (int l = 0; l < 4; ++l) {
        const int pb = (l < 2) ? 1 + 8 * l : 17 + 9 * (l - 2);
        int pm;
        if (l < 2) {
            if (IN(pb + 0)) {
                if (EN_A1) { FRAME();
                  pg8::Gemm g{WSB(bf16, WS_XB), WSB(const bf16, WS_WIN) + (size_t)l * AIN * D, T, AIN, D}; pg8::StaticOrder S; S.init(T, AIN, F.G, (int)blockIdx.x);
                  EpiGluQ E{WSB(bf16, WS_HGLU), WSB(bf16, WS_QM), inp(F, 4) + (size_t)l * AIN};
                  pg8::gemm_phase<EpiGluQ, pg8::StaticOrder, true, true>(F.lds, g, S, E); }
                if (EN_MKV && l == 0) { FRAME();
                  pg8::Gemm g{WSB(bf16, WS_MEMB), WSB(const bf16, WS_WMEM), 512, 2048, D}; pg8::StaticOrder S; S.init(512, 2048, F.G, (int)blockIdx.x);
                  EpiRot<2> E{WSB(bf16, WS_MEMKV), 2048, nullptr};
                  pg8::gemm_phase<EpiRot<2>, pg8::StaticOrder, true, true>(F.lds, g, S, E); }
            }
            SEAM(pb + 0);
            if (IN(pb + 1)) {
                if (EN_CONV) { FRAME();
                  phase_conv(F, WSB(const bf16, WS_HGLU), inp(F, 5) + (size_t)l * CONV_W * CONV_CH, inp(F, 6) + (size_t)l * CONV_CH, inp(F, 7) + (size_t)l * CONV_CH, inp(F, 8) + (size_t)l * CONV_CH, WSB(bf16, WS_A2)); }
                if (EN_MATT) { FRAME(); phase_memattn(F, WSB(const bf16, WS_QM), 256, 0, WSB(const bf16, WS_MEMKV), l, WSB(bf16, WS_A2), D, 768); }
            }
            SEAM(pb + 1);
            if (EN_A3 && IN(pb + 2)) { FRAME();
                pg8::Gemm g{WSB(bf16, WS_A2), WSB(const bf16, WS_WOA) + (size_t)l * D * D, T, D, D}; pg8::StaticOrder S; S.init(T, D, F.G, (int)blockIdx.x);
                EpiRes E{WSB(float, WS_Z), (l == 0) ? inp(F, 0) : WSB(const float, WS_XR2), inp(F, 10) + (size_t)l * D};
                pg8::gemm_phase<EpiRes, pg8::StaticOrder, true, true>(F.lds, g, S, E);
            }
            SEAM(pb + 2);
            pm = pb + 3;
        } else {
            const int j = l - 2;
            if (IN(pb + 0)) {
                if (EN_B1) { FRAME();
                  pg8::Gemm g{WSB(bf16, WS_XB), WSB(const bf16, WS_WQ) + (size_t)j * D * D, T, D, D}; pg8::StaticOrder S; S.init(T, D, F.G, (int)blockIdx.x);
                  EpiRot<0> E{WSB(bf16, WS_QB), D, WSB(const float, WS_ROT)};
                  pg8::gemm_phase<EpiRot<0>, pg8::StaticOrder, true, true>(F.lds, g, S, E); }
                if (EN_B1KV && j == 0) { FRAME();
                  pg8::Gemm g{WSB(bf16, WS_XB), WSB(const bf16, WS_WKV), T, KVW, D}; pg8::StaticOrder S; S.init(T, KVW, F.G, (int)blockIdx.x);
                  EpiRot<1> E{WSB(bf16, WS_KVB), KVW, WSB(const float, WS_ROT)};
                  pg8::gemm_phase<EpiRot<1>, pg8::StaticOrder, true, true>(F.lds, g, S, E); }
            }
            SEAM(pb + 0);
            if (IN(pb + 1)) {
                if (EN_DIL) { FRAME(); phase_dilated(F, WSB(const bf16, WS_QB), WSB(const bf16, WS_KVB), WSB(bf16, WS_OG), WSB(float, WS_LSE)); }
                if (EN_MATT) { FRAME(); phase_memattn(F, WSB(const bf16, WS_QB), D, 768, WSB(const bf16, WS_MEMKV), l, WSB(bf16, WS_A2), 512, 256); }
            }
            SEAM(pb + 1);
            if (EN_DILC && IN(pb + 2)) { FRAME(); phase_dil_combine(F, WSB(const bf16, WS_OG), WSB(const float, WS_LSE), WSB(bf16, WS_A2)); }
            SEAM(pb + 2);
            if (EN_B4 && IN(pb + 3)) { FRAME();
                pg8::Gemm g{WSB(bf16, WS_A2), WSB(const bf16, WS_WOB) + (size_t)j * D * 512, T, D, 512}; pg8::StaticOrder S; S.init(T, D, F.G, (int)blockIdx.x);
                EpiRes E{WSB(float, WS_Z), WSB(const float, WS_XR2), inp(F, 14) + (size_t)j * D};
                pg8::gemm_phase<EpiRes, pg8::StaticOrder, true, true>(F.lds, g, S, E);
            }
            SEAM(pb + 3);
            pm = pb + 4;
        }
        if (EN_M1 && IN(pm + 0)) { FRAME();
            phase_ln_route(F, WSB(const float, WS_Z), inp(F, 16) + (size_t)(l * 2 + 0) * D, inp(F, 17) + (size_t)(l * 2 + 0) * D, inp(F, 18) + (size_t)l * D * NEXP, inp(F, 19) + (size_t)l * NEXP,
                           WSB(float, WS_XR1), WSB(bf16, WS_X1B), WSB(int, WS_TES), WSB(float, WS_TGATE), WSB(unsigned, WS_CTL) + CW_CNT + 32 * l);
        }
        SEAM(pm + 0);
        if (EN_M2 && IN(pm + 1)) { FRAME(); phase_gather(F, WSB(const unsigned, WS_CTL) + CW_CNT + 32 * l, WSB(const bf16, WS_X1B), WSB(const int, WS_TES), WSB(int, WS_TROW), WSB(bf16, WS_XS)); }
        SEAM(pm + 1);
        if (EN_M3 && IN(pm + 2)) { FRAME();
            const int total = build_tiles(F, WSB(const unsigned, WS_CTL) + CW_CNT + 32 * l);
            pg8::Gemm g{WSB(bf16, WS_XS), WSB(const bf16, WS_WUP) + (size_t)l * NEXP * 2 * DFF * D, XROWS, NEXP * 2 * DFF, D};
            MoeOrder<8> S{(const LAS int*)(F.lds + LDS_TE), total, F.G, (int)blockIdx.x};
            EpiSwiglu E{WSB(bf16, WS_H), inp(F, 21) + (size_t)l * NEXP * 2 * DFF};
            pg8::gemm_phase<EpiSwiglu, MoeOrder<8>, true, true>(F.lds, g, S, E);
        }
        SEAM(pm + 2);
        if (EN_M4 && IN(pm + 3)) { FRAME();
            const int total = build_tiles(F, WSB(const unsigned, WS_CTL) + CW_CNT + 32 * l);
            pg8::Gemm g{WSB(bf16, WS_H), WSB(const bf16, WS_WDN) + (size_t)l * NEXP * DFF * D, XROWS, NEXP * D, DFF};
            MoeOrder<4> S{(const LAS int*)(F.lds + LDS_TE), total, F.G, (int)blockIdx.x};
            EpiDown E{WSB(bf16, WS_Y), inp(F, 23) + (size_t)l * NEXP * D};
            pg8::gemm_phase<EpiDown, MoeOrder<4>, true, true>(F.lds, g, S, E);
        }
        SEAM(pm + 3);
        if (EN_M5 && IN(pm + 4)) { FRAME();
            phase_combine_ln(F, WSB(const float, WS_XR1), WSB(const bf16, WS_Y), WSB(const int, WS_TROW), WSB(const float, WS_TGATE), inp(F, 16) + (size_t)(l * 2 + 1) * D, inp(F, 17) + (size_t)(l * 2 + 1) * D,
                             (l == 3) ? (float*)ptr_slot(F, 25) : WSB(float, WS_XR2), WSB(bf16, WS_XB));
        }
        if (l < 3) SEAM(pm + 4);
    }
#undef IN
#undef SEAM
#undef WSB
#undef FRAME
}

extern "C" void kernel_launch(void* const* d_in, const int* in_sizes, int n_in, void* d_out, int out_size, void* d_ws, size_t ws_size, hipStream_t stream) {
    static int grid = 0;
    if (grid == 0) {
        if (n_in != 24 || in_sizes[0] != T * D || out_size != T * D || ws_size < WS_END) {
            fprintf(stderr, "kernel_launch: unexpected shapes (n_in %d, in0 %d, out %d, ws %zu < %zu); nothing launched\n", n_in, n_in > 0 ? in_sizes[0] : -1, out_size, ws_size, (size_t)WS_END); grid = -1; return; }
        if (hipFuncSetAttribute((const void*)fwd, hipFuncAttributeMaxDynamicSharedMemorySize, LDS_BYTES) != hipSuccess) { fprintf(stderr, "kernel_launch: hipFuncSetAttribute failed\n"); grid = -1; return; }
        int per_cu = 0;
        if (hipOccupancyMaxActiveBlocksPerMultiprocessor(&per_cu, (const void*)fwd, NTHR, LDS_BYTES) != hipSuccess || per_cu < 1) fprintf(stderr, "kernel_launch: note: occupancy query says %d\n", per_cu);
        (void)hipGetLastError();
        grid = 256;
    }
    if (grid < 0) return;
    (void)hipMemsetAsync((char*)d_ws + WS_CTL, 0, CTL_ZERO_BYTES, stream);
    Args a{};
    for (int i = 0; i < 24; ++i) a.in[i] = d_in[i];
    a.out = (float*)d_out; a.ws = (unsigned char*)d_ws;
#if MK_N_LAUNCHES == 1
    a.ph_lo = 0; a.ph_hi = NPHASE;
    hipLaunchKernelGGL(fwd, dim3(grid), dim3(NTHR), LDS_BYTES, stream, a);
#else
    for (int k = 0; k < NPHASE; ++k) { a.ph_lo = k; a.ph_hi = k + 1; hipLaunchKernelGGL(fwd, dim3(grid), dim3(NTHR), LDS_BYTES, stream, a); }
#endif
}
```

```cpp
#include <hip/hip_runtime.h>
#include <cstdio>
#include <cstdint>
namespace pg8 {
#define PG8_LAS __attribute__((address_space(3)))
typedef unsigned short bf16_t;
typedef short bf16x8 __attribute__((ext_vector_type(8)));
typedef float f32x4 __attribute__((ext_vector_type(4)));
typedef unsigned u32x4 __attribute__((ext_vector_type(4)));
constexpr int BM = 256, BK = 64, HALF = 128, HTB = HALF * BK * 2  , STAGE_BYTES = 8 * HTB, NXCD = 8, WGM = 8;

__host__ __device__ __forceinline__ int lds_byte(int r, int c) { const int st = (r >> 4) * 2 + (c >> 5), rr = r & 15, cc = c & 31, ob = rr * 64 + cc * 2; return st * 1024 + (ob ^ (((ob >> 9) & 1) << 5)); }
__host__ __device__ __forceinline__ void stage_rc(int b, int& R, int& C) { const int st = b / 1024, sb = b % 1024, swz = sb ^ (((sb >> 9) & 1) << 5); R = (st >> 1) * 16 + swz / 64; C = (st & 1) * 32 + (swz % 64) / 2; }
__host__ __device__ __forceinline__ int perm32(int rho) { const int n = rho >> 4, i = rho & 15; return 8 * (i >> 2) + 4 * n + (i & 3); }

struct Unit { int pm, pn; };
struct Gemm { const bf16_t* A; const bf16_t* Bt; int M, N, K; };

struct StaticOrder {
    int nM, nN, nwg, G, c;
    __host__ __device__ void init(int M, int N, int G_, int c_) { nM = M / BM; nN = N / BM; nwg = nM * nN; G = G_; c = c_; }
    __host__ __device__ bool next(int i, Unit& u) const {
        const long L = (long)i * G + c; if (L >= nwg) return false;
        int wgid = (int)L; { const int q = nwg / NXCD, r = nwg % NXCD, xcd = wgid % NXCD, off = wgid / NXCD; wgid = (xcd < r ? xcd * (q + 1) : r * (q + 1) + (xcd - r) * q) + off; }
        const int nig = WGM * nN, gid = wgid / nig, fm = gid * WGM, gsz = (nM - fm) < WGM ? (nM - fm) : WGM;
        u.pm = fm + ((wgid % nig) % gsz); u.pn = (wgid % nig) / gsz; return true;
    }
    __device__ __forceinline__ void a_ready(const Unit&) const {}
    __device__ __forceinline__ void done(const Unit&) const {}
};

__device__ __forceinline__ unsigned cvt_pk_bf16(float lo, float hi) { unsigned r; asm volatile("v_cvt_pk_bf16_f32 %0, %1, %2" : "=v"(r) : "v"(lo), "v"(hi)); return r; }
typedef float f32x2 __attribute__((ext_vector_type(2)));
template <class Epi, class Sched, bool ALIGN_EPI = false, bool SP2 = false>
__device__ __forceinline__ void gemm_phase(PG8_LAS unsigned char* lds, const Gemm g, const Sched& S, const Epi& E) {
    int tid_ = threadIdx.x; asm volatile("" : "+v"(tid_));
    const int tid = tid_, wid = __builtin_amdgcn_readfirstlane(tid >> 6), lane = tid & 63, wr = wid >> 2, wc = wid & 3, fr = lane & 15, fq = lane >> 4;
    const int K = g.K, nt = K / BK;
    unsigned voffA[2], voffB[2];
#pragma unroll
    for (int i = 0; i < 2; ++i) { int R, C; stage_rc(tid * 16 + i * 8192, R, C); const int Rb = Epi::PERM ? ((R & ~31) + perm32(R & 31)) : R;
        voffA[i] = (unsigned)(R * K + C) * 2u; voffB[i] = (unsigned)(Rb * K + C) * 2u; }
    const size_t kstep = (size_t)(BK * 2);
    const size_t hstep = (size_t)HALF * K * 2;
    const size_t tstep = 2 * hstep;
    const unsigned ldsw = (unsigned)wid * 1024u;
    const int aoff = lds_byte(wr * 64 + fr, fq * 8), boff = lds_byte(wc * 32 + fr, fq * 8);
#define PG8_SA(b, h) (((b) * 2 + (h)) * HTB)
#define PG8_SB(b, h) ((4 + (b) * 2 + (h)) * HTB)
#define PG8_STAGE(bufoff, gbase, voff) do { _Pragma("unroll") for (int _i = 0; _i < 2; ++_i) \
        __builtin_amdgcn_global_load_lds((const unsigned*)((const char*)(gbase) + (voff)[_i]), (PG8_LAS unsigned*)(lds + (bufoff) + ldsw + _i * 8192), 16, 0, 0); } while (0)
#define PG8_LDA(dst, b, h) do { _Pragma("unroll") for (int m = 0; m < 4; ++m) _Pragma("unroll") for (int k = 0; k < 2; ++k) dst[m][k] = *(const PG8_LAS bf16x8*)(lds + PG8_SA(b, h) + aoff + m * 2048 + k * 1024); } while (0)
#define PG8_LDB(dst, b, h) do { _Pragma("unroll") for (int n = 0; n < 2; ++n) _Pragma("unroll") for (int k = 0; k < 2; ++k) dst[n][k] = *(const PG8_LAS bf16x8*)(lds + PG8_SB(b, h) + boff + n * 2048 + k * 1024); } while (0)
#define PG8_MMA(ai, bj, At, Bt) do { __builtin_amdgcn_s_setprio(1); _Pragma("unroll") for (int m = 0; m < 4; ++m) _Pragma("unroll") for (int n = 0; n < 2; ++n) _Pragma("unroll") for (int k = 0; k < 2; ++k) \
        acc[ai][bj][m][n] = __builtin_amdgcn_mfma_f32_16x16x32_bf16(Bt[n][k], At[m][k], acc[ai][bj][m][n], 0, 0, 0); __builtin_amdgcn_s_setprio(0); } while (0)
#define PG8_WAIT_V(n) asm volatile("s_waitcnt vmcnt(" #n ")" ::: "memory")
#define PG8_WAIT_L(n) asm volatile("s_waitcnt lgkmcnt(" #n ")" ::: "memory")
#define PG8_BAR __builtin_amdgcn_s_barrier()
#define PG8_SCHED __builtin_amdgcn_sched_barrier(0)
    Unit cur, nxt; int ui = 0;
    if (!S.next(0, cur)) return;
    f32x4 acc[2][2][4][2];
#pragma unroll
    for (int a = 0; a < 2; ++a)
#pragma unroll
        for (int b = 0; b < 2; ++b)
#pragma unroll
            for (int m = 0; m < 4; ++m)
#pragma unroll
                for (int n = 0; n < 2; ++n) acc[a][b][m][n] = (f32x4){0.f, 0.f, 0.f, 0.f};
    bf16x8 At[4][2], B0[2][2], B1[2][2];
    const char* cA = (const char*)g.A + (size_t)cur.pm * tstep; const char* cB = (const char*)g.Bt + (size_t)cur.pn * tstep;
    S.a_ready(cur);
    if constexpr (SP2) {
        PG8_STAGE(PG8_SB(0, 0), cB, voffB); PG8_STAGE(PG8_SB(0, 1), cB + hstep, voffB); PG8_STAGE(PG8_SA(0, 0), cA, voffA); PG8_STAGE(PG8_SA(0, 1), cA + hstep, voffA);
        if (wr == 1) PG8_BAR;
        PG8_WAIT_V(2); PG8_BAR;
        PG8_STAGE(PG8_SB(1, 0), cB + kstep, voffB); PG8_STAGE(PG8_SA(1, 0), cA + kstep, voffA); PG8_STAGE(PG8_SB(1, 1), cB + hstep + kstep, voffB);
        PG8_WAIT_V(6); PG8_BAR;
    } else {
        PG8_STAGE(PG8_SB(0, 0), cB, voffB); PG8_STAGE(PG8_SA(0, 0), cA, voffA); PG8_STAGE(PG8_SB(0, 1), cB + hstep, voffB); PG8_STAGE(PG8_SA(0, 1), cA + hstep, voffA);
        if (wr == 1) PG8_BAR;
        PG8_WAIT_V(4); PG8_BAR;
        PG8_STAGE(PG8_SB(1, 0), cB + kstep, voffB); PG8_STAGE(PG8_SA(1, 0), cA + kstep, voffA); PG8_STAGE(PG8_SB(1, 1), cB + hstep + kstep, voffB);
        PG8_WAIT_V(6); PG8_BAR;
    }
    for (;;) {
        const bool has_next = S.next(ui + 1, nxt);
        const char* nA = has_next ? (const char*)g.A + (size_t)nxt.pm * tstep : cA; const char* nB = has_next ? (const char*)g.Bt + (size_t)nxt.pn * tstep : cB;
        for (int t = 0; t < nt; t += 2) {
            const bool last = (t == nt - 2);
            const char* a1 = cA + (size_t)(t + 1) * kstep;
            const char* a2 = last ? nA : cA + (size_t)(t + 2) * kstep; const char* b2 = last ? nB : cB + (size_t)(t + 2) * kstep;
            const char* a3 = a2 + kstep; const char* b3 = b2 + kstep;
            if (last && has_next) S.a_ready(nxt);
            if constexpr (SP2) {
            PG8_LDB(B0, 0, 0); PG8_LDB(B1, 0, 1); PG8_SCHED; PG8_LDA(At, 0, 0); PG8_STAGE(PG8_SA(1, 1), a1 + hstep, voffA);
            PG8_WAIT_V(8); PG8_WAIT_L(0); PG8_BAR; PG8_MMA(0, 0, At, B0); PG8_MMA(0, 1, At, B1); PG8_BAR; PG8_SCHED;
            PG8_LDA(At, 0, 1); PG8_STAGE(PG8_SB(0, 0), b2, voffB); PG8_STAGE(PG8_SB(0, 1), b2 + hstep, voffB); PG8_STAGE(PG8_SA(0, 0), a2, voffA);
            PG8_WAIT_V(8); PG8_WAIT_L(0); PG8_BAR; PG8_MMA(1, 0, At, B0); PG8_MMA(1, 1, At, B1); PG8_BAR; PG8_SCHED;
            PG8_LDB(B0, 1, 0); PG8_LDB(B1, 1, 1); PG8_SCHED; PG8_LDA(At, 1, 0); PG8_STAGE(PG8_SA(0, 1), a2 + hstep, voffA);
            PG8_WAIT_V(8); PG8_WAIT_L(0); PG8_BAR; PG8_MMA(0, 0, At, B0); PG8_MMA(0, 1, At, B1); PG8_BAR; PG8_SCHED;
            PG8_LDA(At, 1, 1); PG8_STAGE(PG8_SB(1, 0), b3, voffB); PG8_STAGE(PG8_SB(1, 1), b3 + hstep, voffB); PG8_STAGE(PG8_SA(1, 0), a3, voffA);
            PG8_WAIT_V(8); PG8_WAIT_L(0); PG8_BAR; PG8_MMA(1, 0, At, B0); PG8_MMA(1, 1, At, B1); PG8_BAR; PG8_SCHED;
            } else {
            PG8_LDB(B0, 0, 0); PG8_SCHED; PG8_LDA(At, 0, 0); PG8_STAGE(PG8_SA(1, 1), a1 + hstep, voffA);
            PG8_WAIT_L(8); PG8_BAR; PG8_WAIT_L(0); PG8_MMA(0, 0, At, B0); PG8_BAR; PG8_SCHED;
            PG8_LDB(B1, 0, 1); PG8_STAGE(PG8_SB(0, 0), b2, voffB);
            PG8_BAR; PG8_WAIT_L(0); PG8_MMA(0, 1, At, B1); PG8_BAR;
            PG8_LDA(At, 0, 1); PG8_STAGE(PG8_SA(0, 0), a2, voffA);
            PG8_BAR; PG8_WAIT_L(0); PG8_MMA(1, 0, At, B0); PG8_BAR; PG8_SCHED;
            PG8_STAGE(PG8_SB(0, 1), b2 + hstep, voffB);
            PG8_WAIT_V(6); PG8_BAR; PG8_MMA(1, 1, At, B1); PG8_BAR;
            PG8_LDB(B0, 1, 0); PG8_SCHED; PG8_LDA(At, 1, 0); PG8_STAGE(PG8_SA(0, 1), a2 + hstep, voffA);
            PG8_WAIT_L(8); PG8_BAR; PG8_WAIT_L(0); PG8_MMA(0, 0, At, B0); PG8_BAR; PG8_SCHED;
            PG8_LDB(B1, 1, 1); PG8_STAGE(PG8_SB(1, 0), b3, voffB);
            PG8_BAR; PG8_WAIT_L(0); PG8_MMA(0, 1, At, B1); PG8_BAR;
            PG8_LDA(At, 1, 1); PG8_STAGE(PG8_SA(1, 0), a3, voffA);
            PG8_BAR; PG8_WAIT_L(0); PG8_MMA(1, 0, At, B0); PG8_BAR; PG8_SCHED;
            PG8_STAGE(PG8_SB(1, 1), b3 + hstep, voffB);
            PG8_WAIT_V(6); PG8_BAR; PG8_MMA(1, 1, At, B1); PG8_BAR;
            }
        }
        if constexpr (ALIGN_EPI) { if (wr == 0) PG8_BAR; }
        if constexpr (!Epi::AFTER_DRAIN) { E(acc, cur, wr, wc, fr, fq); S.done(cur); }
        if (!has_next) break;
#pragma unroll
        for (int a = 0; a < 2; ++a)
#pragma unroll
            for (int b = 0; b < 2; ++b)
#pragma unroll
                for (int m = 0; m < 4; ++m)
#pragma unroll
                    for (int n = 0; n < 2; ++n) acc[a][b][m][n] = (f32x4){0.f, 0.f, 0.f, 0.f};
        cur = nxt; cA = nA; cB = nB; ++ui;
        if constexpr (ALIGN_EPI) { if (wr == 1) PG8_BAR; }
    }
    PG8_WAIT_V(0);
    if constexpr (!ALIGN_EPI) { if (wr == 0) PG8_BAR; }
    PG8_BAR;
    if constexpr (Epi::AFTER_DRAIN) { E.fused(acc, cur, wr, wc, fr, fq, lds, wid, lane); S.done(cur); }
#undef PG8_SA
#undef PG8_SB
#undef PG8_STAGE
#undef PG8_LDA
#undef PG8_LDB
#undef PG8_MMA
#undef PG8_WAIT_V
#undef PG8_WAIT_L
#undef PG8_BAR
#undef PG8_SCHED
}
}

namespace pg8 {
template <class Epi, class Sched>
__device__ __forceinline__ void gemm_phase_g(PG8_LAS unsigned char* lds, const Gemm g, const Sched& S, const Epi& E) {
    int tid_ = threadIdx.x; asm volatile("" : "+v"(tid_));
    const int tid = tid_, wid = __builtin_amdgcn_readfirstlane(tid >> 6), lane = tid & 63, wr = wid >> 2, wc = wid & 3, fr = lane & 15, fq = lane >> 4;
    const int K = g.K, nt = K / BK;
    unsigned voffB[2];
#pragma unroll
    for (int i = 0; i < 2; ++i) { int R, C; stage_rc(tid * 16 + i * 8192, R, C); const int Rb = Epi::PERM ? ((R & ~31) + perm32(R & 31)) : R; voffB[i] = (unsigned)(Rb * K + C) * 2u; }
    const size_t kstep = (size_t)(BK * 2);
    const size_t hstep = (size_t)HALF * K * 2;
    const size_t tstep = 2 * hstep;
    const unsigned ldsw = (unsigned)wid * 1024u;
    const int aoff = lds_byte(wr * 64 + fr, fq * 8), boff = lds_byte(wc * 32 + fr, fq * 8);
#define PG8_SA(b, h) (((b) * 2 + (h)) * HTB)
#define PG8_SB(b, h) ((4 + (b) * 2 + (h)) * HTB)
#define PG8_STAGE(bufoff, gbase, voff) do { _Pragma("unroll") for (int _i = 0; _i < 2; ++_i) \
        __builtin_amdgcn_global_load_lds((const unsigned*)((const char*)(gbase) + (voff)[_i]), (PG8_LAS unsigned*)(lds + (bufoff) + ldsw + _i * 8192), 16, 0, 0); } while (0)
#define PG8_STAGE2(bufoff, gbase, v0, v1) do { \
        __builtin_amdgcn_global_load_lds((const unsigned*)((const char*)(gbase) + (v0)), (PG8_LAS unsigned*)(lds + (bufoff) + ldsw), 16, 0, 0); \
        __builtin_amdgcn_global_load_lds((const unsigned*)((const char*)(gbase) + (v1)), (PG8_LAS unsigned*)(lds + (bufoff) + ldsw + 8192), 16, 0, 0); } while (0)
#define PG8_LDA(dst, b, h) do { _Pragma("unroll") for (int m = 0; m < 4; ++m) _Pragma("unroll") for (int k = 0; k < 2; ++k) dst[m][k] = *(const PG8_LAS bf16x8*)(lds + PG8_SA(b, h) + aoff + m * 2048 + k * 1024); } while (0)
#define PG8_LDB(dst, b, h) do { _Pragma("unroll") for (int n = 0; n < 2; ++n) _Pragma("unroll") for (int k = 0; k < 2; ++k) dst[n][k] = *(const PG8_LAS bf16x8*)(lds + PG8_SB(b, h) + boff + n * 2048 + k * 1024); } while (0)
#define PG8_MMA(ai, bj, At, Bt) do { __builtin_amdgcn_s_setprio(1); _Pragma("unroll") for (int m = 0; m < 4; ++m) _Pragma("unroll") for (int n = 0; n < 2; ++n) _Pragma("unroll") for (int k = 0; k < 2; ++k) \
        acc[ai][bj][m][n] = __builtin_amdgcn_mfma_f32_16x16x32_bf16(Bt[n][k], At[m][k], acc[ai][bj][m][n], 0, 0, 0); __builtin_amdgcn_s_setprio(0); } while (0)
#define PG8_WAIT_V(n) asm volatile("s_waitcnt vmcnt(" #n ")" ::: "memory")
#define PG8_WAIT_L(n) asm volatile("s_waitcnt lgkmcnt(" #n ")" ::: "memory")
#define PG8_BAR __builtin_amdgcn_s_barrier()
#define PG8_SCHED __builtin_amdgcn_sched_barrier(0)
#define PG8_TOKOFF(u, tz, h, i, dst) do { int R_, C_; stage_rc((tz) * 16 + (i) * 8192, R_, C_); dst = (unsigned)S.tok(u, (h) * HALF + R_) * (unsigned)(K * 2) + (unsigned)(C_ * 2); } while (0)
    Unit cur, nxt, nn; int ui = 0;
    if (!S.next(0, cur)) return;
    bool has_next = S.next(1, nxt);
    unsigned vc00, vc01, vc10, vc11, vn00, vn01, vn10, vn11;
    { int tz = tid_; asm volatile("" : "+v"(tz));
      PG8_TOKOFF(cur, tz, 0, 0, vc00); PG8_TOKOFF(cur, tz, 0, 1, vc01); PG8_TOKOFF(cur, tz, 1, 0, vc10); PG8_TOKOFF(cur, tz, 1, 1, vc11);
      if (has_next) { PG8_TOKOFF(nxt, tz, 0, 0, vn00); PG8_TOKOFF(nxt, tz, 0, 1, vn01); PG8_TOKOFF(nxt, tz, 1, 0, vn10); PG8_TOKOFF(nxt, tz, 1, 1, vn11); }
      else { vn00 = vc00; vn01 = vc01; vn10 = vc10; vn11 = vc11; } }
    f32x4 acc[2][2][4][2];
#pragma unroll
    for (int a = 0; a < 2; ++a)
#pragma unroll
        for (int b = 0; b < 2; ++b)
#pragma unroll
            for (int m = 0; m < 4; ++m)
#pragma unroll
                for (int n = 0; n < 2; ++n) acc[a][b][m][n] = (f32x4){0.f, 0.f, 0.f, 0.f};
    bf16x8 At[4][2], B0[2][2], B1[2][2];
    const char* const cA = (const char*)g.A;
    const char* cB = (const char*)g.Bt + (size_t)cur.pn * tstep;
    PG8_STAGE(PG8_SB(0, 0), cB, voffB); PG8_STAGE(PG8_SB(0, 1), cB + hstep, voffB); PG8_STAGE2(PG8_SA(0, 0), cA, vc00, vc01); PG8_STAGE2(PG8_SA(0, 1), cA, vc10, vc11);
    if (wr == 1) PG8_BAR;
    PG8_WAIT_V(2); PG8_BAR;
    PG8_STAGE(PG8_SB(1, 0), cB + kstep, voffB); PG8_STAGE2(PG8_SA(1, 0), cA + kstep, vc00, vc01); PG8_STAGE(PG8_SB(1, 1), cB + hstep + kstep, voffB);
    PG8_WAIT_V(6); PG8_BAR;
    for (;;) {
        const char* nB = has_next ? (const char*)g.Bt + (size_t)nxt.pn * tstep : cB;
        for (int t = 0; t < nt; t += 2) {
            const bool last = (t == nt - 2);
            const char* a1 = cA + (size_t)(t + 1) * kstep;
            const char* a2 = last ? cA : cA + (size_t)(t + 2) * kstep; const char* b2 = last ? nB : cB + (size_t)(t + 2) * kstep;
            const char* a3 = a2 + kstep; const char* b3 = b2 + kstep;
            const unsigned x00 = last ? vn00 : vc00, x01 = last ? vn01 : vc01, x10 = last ? vn10 : vc10, x11 = last ? vn11 : vc11;
            PG8_LDB(B0, 0, 0); PG8_LDB(B1, 0, 1); PG8_SCHED; PG8_LDA(At, 0, 0); PG8_STAGE2(PG8_SA(1, 1), a1, vc10, vc11);
            PG8_WAIT_V(8); PG8_WAIT_L(0); PG8_BAR; PG8_MMA(0, 0, At, B0); PG8_MMA(0, 1, At, B1); PG8_BAR; PG8_SCHED;
            PG8_LDA(At, 0, 1); PG8_STAGE(PG8_SB(0, 0), b2, voffB); PG8_STAGE(PG8_SB(0, 1), b2 + hstep, voffB); PG8_STAGE2(PG8_SA(0, 0), a2, x00, x01);
            PG8_WAIT_V(8); PG8_WAIT_L(0); PG8_BAR; PG8_MMA(1, 0, At, B0); PG8_MMA(1, 1, At, B1); PG8_BAR; PG8_SCHED;
            PG8_LDB(B0, 1, 0); PG8_LDB(B1, 1, 1); PG8_SCHED; PG8_LDA(At, 1, 0); PG8_STAGE2(PG8_SA(0, 1), a2, x10, x11);
            PG8_WAIT_V(8); PG8_WAIT_L(0); PG8_BAR; PG8_MMA(0, 0, At, B0); PG8_MMA(0, 1, At, B1); PG8_BAR; PG8_SCHED;
            PG8_LDA(At, 1, 1); PG8_STAGE(PG8_SB(1, 0), b3, voffB); PG8_STAGE(PG8_SB(1, 1), b3 + hstep, voffB); PG8_STAGE2(PG8_SA(1, 0), a3, x00, x01);
            PG8_WAIT_V(8); PG8_WAIT_L(0); PG8_BAR; PG8_MMA(1, 0, At, B0); PG8_MMA(1, 1, At, B1); PG8_BAR; PG8_SCHED;
        }
        if (wr == 0) PG8_BAR;
        const bool has_nn = has_next && S.next(ui + 2, nn);
        unsigned w00 = 0, w01 = 0, w10 = 0, w11 = 0;
        if (has_nn) { int tz = tid_; asm volatile("" : "+v"(tz)); PG8_TOKOFF(nn, tz, 0, 0, w00); PG8_TOKOFF(nn, tz, 0, 1, w01); PG8_TOKOFF(nn, tz, 1, 0, w10); PG8_TOKOFF(nn, tz, 1, 1, w11); }
        E(acc, cur, wr, wc, fr, fq); S.done(cur);
        if (!has_next) break;
#pragma unroll
        for (int a = 0; a < 2; ++a)
#pragma unroll
            for (int b = 0; b < 2; ++b)
#pragma unroll
                for (int m = 0; m < 4; ++m)
#pragma unroll
                    for (int n = 0; n < 2; ++n) acc[a][b][m][n] = (f32x4){0.f, 0.f, 0.f, 0.f};
        cur = nxt; cB = nB; ++ui;
        vc00 = vn00; vc01 = vn01; vc10 = vn10; vc11 = vn11;
        if (has_nn) { vn00 = w00; vn01 = w01; vn10 = w10; vn11 = w11; nxt = nn; }
        has_next = has_nn;
        if (wr == 1) PG8_BAR;
    }
    PG8_WAIT_V(0);
    PG8_BAR;
#undef PG8_SA
#undef PG8_SB
#undef PG8_STAGE
#undef PG8_STAGE2
#undef PG8_LDA
#undef PG8_LDB
#undef PG8_MMA
#undef PG8_WAIT_V
#undef PG8_WAIT_L
#undef PG8_BAR
#undef PG8_SCHED
#undef PG8_TOKOFF
}
}
#define MK_N_LAUNCHES 1

#define GAS __attribute__((address_space(1)))
#define LAS __attribute__((address_space(3)))
typedef unsigned short bf16;
typedef unsigned v4u __attribute__((ext_vector_type(4)));
typedef unsigned v2u __attribute__((ext_vector_type(2)));
typedef float f32x4 __attribute__((ext_vector_type(4)));
typedef short bf16x8 __attribute__((ext_vector_type(8)));

constexpr int NWAVES = 8, NTHR = 512;
constexpr int NB = 2, SEQ = 16384, T = NB * SEQ, D = 1024;
constexpr int CONV_CH = 768, CONV_W = 31, AIN = 1792, KVW = 1536, NEXP = 32, DFF = 1024;
constexpr int MAXTILES = (T * 4) / 256 + NEXP;
constexpr int XROWS = MAXTILES * 256;
constexpr float DN_ALPHA = 1.681792830507429f;
constexpr float LN_EPS = 1e-5f;

constexpr size_t MiB = 1u << 20;
constexpr size_t al(size_t x) { return (x + MiB - 1) / MiB * MiB; }
constexpr size_t WS_CTL = 0, CTL_ZERO_BYTES = MiB;
constexpr size_t WS_ROT  = WS_CTL + MiB;
constexpr size_t WS_WIN  = WS_ROT  + al((size_t)T * 16 * 4);
constexpr size_t WS_WOA  = WS_WIN  + al((size_t)2 * AIN * D * 2);
constexpr size_t WS_WKV  = WS_WOA  + al((size_t)2 * D * D * 2);
constexpr size_t WS_WQ   = WS_WKV  + al((size_t)KVW * D * 2);
constexpr size_t WS_WOB  = WS_WQ   + al((size_t)2 * D * D * 2);
constexpr size_t WS_WMEM = WS_WOB  + al((size_t)2 * D * 512 * 2);
constexpr size_t WS_WUP  = WS_WMEM + al((size_t)4 * 512 * D * 2);
constexpr size_t WS_WDN  = WS_WUP  + al((size_t)4 * NEXP * 2 * DFF * D * 2);
constexpr size_t WS_MEMB = WS_WDN  + al((size_t)4 * NEXP * D * DFF * 2);
constexpr size_t WS_MEMKV= WS_MEMB + al((size_t)512 * D * 2);
constexpr size_t WS_XB   = WS_MEMKV+ al((size_t)512 * 2048 * 2);
constexpr size_t WS_X1B  = WS_XB   + al((size_t)T * D * 2);
constexpr size_t WS_XR1  = WS_X1B  + al((size_t)T * D * 2);
constexpr size_t WS_XR2  = WS_XR1  + al((size_t)T * D * 4);
constexpr size_t WS_Z    = WS_XR2  + al((size_t)T * D * 4);
constexpr size_t WS_HGLU = WS_Z    + al((size_t)T * D * 4);
constexpr size_t WS_QM   = WS_HGLU + al((size_t)T * CONV_CH * 2);
constexpr size_t WS_A2   = WS_QM   + al((size_t)T * 256 * 2);
constexpr size_t WS_QB   = WS_A2   + al((size_t)T * D * 2);
constexpr size_t WS_KVB  = WS_QB   + al((size_t)T * D * 2);
constexpr size_t WS_OG   = WS_KVB  + al((size_t)T * KVW * 2);
constexpr size_t WS_LSE  = WS_OG   + al((size_t)3 * T * 256 * 2);
constexpr size_t WS_TES  = WS_LSE  + al((size_t)3 * T * 4 * 4);
constexpr size_t WS_TGATE= WS_TES  + al((size_t)T * 4 * 4);
constexpr size_t WS_TROW = WS_TGATE+ al((size_t)T * 4 * 4);
constexpr size_t WS_RWT  = WS_TROW + al((size_t)T * 4 * 4);
constexpr size_t WS_RTOK = WS_RWT  + al((size_t)4 * NEXP * D * 4);
constexpr size_t WS_H    = WS_RTOK + al((size_t)NEXP * T * 4);
constexpr size_t WS_Y    = WS_H    + al((size_t)XROWS * DFF * 2);
constexpr size_t WS_END  = WS_Y    + al((size_t)XROWS * D * 2);
constexpr int CW_BAR = 4096;
constexpr int CW_CNT = 8192;
constexpr int LDS_SCR = 133120;
constexpr int LDS_MISC = LDS_SCR;
constexpr int LDS_TB = LDS_MISC + 64;
constexpr int LDS_TE = LDS_TB + 320;
constexpr int LDS_RT = LDS_TE + 2304;
constexpr int LDS_PTR = LDS_RT + 2304;
constexpr int LDS_BYTES = 147456;
static_assert(LDS_PTR + 256 <= LDS_BYTES, "LDS map");

#define LDS_WAIT() asm volatile("s_waitcnt lgkmcnt(0)" ::: "memory")
#define VM_WAIT() asm volatile("s_waitcnt vmcnt(0)" ::: "memory")
__device__ __forceinline__ unsigned f2bf(float f) { unsigned u = __builtin_bit_cast(unsigned, f); return (u + 0x7fffu + ((u >> 16) & 1u)) >> 16; }
__device__ __forceinline__ unsigned pk2(float lo, float hi) { return f2bf(lo) | (f2bf(hi) << 16); }
__device__ __forceinline__ float bflo(unsigned w) { return __builtin_bit_cast(float, w << 16); }
__device__ __forceinline__ float bfhi(unsigned w) { return __builtin_bit_cast(float, w & 0xffff0000u); }
__device__ __forceinline__ float wave_sum(float v) {
#pragma unroll
    for (int o = 1; o < 64; o <<= 1) v += __shfl_xor(v, o);
    return v;
}
__device__ __forceinline__ float sigmoidf_(float x) { return 1.0f / (1.0f + __expf(-x)); }
#define XB_TMO      128
#define XB_XCNT(j)  (256  + 64 * (j))
#define XB_XSUB(j)  (1280 + 64 * (j))
#define XB_XGEN(j)  (2304 + 64 * (j))
#define XB_TOP      3328
#define XB_TOPGEN   3392
#define XCD_BAR_WORDS 3456
#define XB_SPIN_CAP (1u << 18)

__device__ __forceinline__ unsigned xb_ld(unsigned* p)              { return __hip_atomic_load(p, __ATOMIC_RELAXED, __HIP_MEMORY_SCOPE_AGENT); }
__device__ __forceinline__ unsigned xb_add(unsigned* p, unsigned v) { return __hip_atomic_fetch_add(p, v, __ATOMIC_RELAXED, __HIP_MEMORY_SCOPE_AGENT); }
__device__ __forceinline__ unsigned xb_xcc_id() { return (unsigned)__builtin_amdgcn_s_getreg((3 << 11) | 20) & 0xFu; }
#define XB_SPIN(cond, bar) do { unsigned _sp = 0; while (cond) { __builtin_amdgcn_s_sleep(1); \
    if ((++_sp & 255u) == 0u) { if (xb_ld(&(bar)[XB_TMO])) break; if (_sp > XB_SPIN_CAP) { atomicAdd(&(bar)[XB_TMO], 1u); break; } } } } while (0)

struct XcdBarrier {
    unsigned* bar; unsigned x;
    volatile LAS unsigned* st;
};

__device__ __forceinline__ XcdBarrier xcd_barrier_post(unsigned* bar, volatile LAS unsigned* st) {
    XcdBarrier b; b.bar = bar; b.x = xb_xcc_id(); b.st = st;
    if (threadIdx.x == 0) (void)xb_add(&bar[XB_XCNT(b.x)], 1u);
    return b;
}
__device__ __forceinline__ void xcd_barrier_complete(unsigned* bar, unsigned x, unsigned& nloc, unsigned& nx) {
    const unsigned G = gridDim.x * gridDim.y * gridDim.z;
    unsigned sum, cnt, mine, sp = 0u;
    for (;;) {
        sum = 0u; cnt = 0u; mine = 0u;
#pragma unroll
        for (unsigned j = 0; j < 16; ++j) { const unsigned c = xb_ld(&bar[XB_XCNT(j)]); sum += c; cnt += (c > 0u) ? 1u : 0u; mine = (j == x) ? c : mine; }
        if (sum == G) break;
        __builtin_amdgcn_s_sleep(1);
        if ((++sp & 255u) == 0u) { if (xb_ld(&bar[XB_TMO])) break; if (sp > XB_SPIN_CAP) { atomicAdd(&bar[XB_TMO], 1u); break; } }
    }
    nloc = mine > 0u ? mine : 1u; nx = cnt > 0u ? cnt : 1u;
}

__device__ __forceinline__ void xcd_barrier(const XcdBarrier& b) {
    asm volatile("s_waitcnt vmcnt(0)" ::: "memory");
    __syncthreads();
    if (threadIdx.x == 0) {
        unsigned* bar = b.bar;
        __builtin_amdgcn_s_waitcnt(0);
        unsigned nloc = b.st[0], nx = b.st[1];
        if (nloc == 0u) { xcd_barrier_complete(bar, b.x, nloc, nx); b.st[0] = nloc; b.st[1] = nx; }
        const unsigned old = xb_add(&bar[XB_XSUB(b.x)], 1u);
        const unsigned gen = old / nloc;
        if (old + 1u == (gen + 1u) * nloc) {
            __builtin_amdgcn_fence(__ATOMIC_RELEASE, "agent");
            asm volatile("s_waitcnt vmcnt(0)" ::: "memory");
            const unsigned og = xb_add(&bar[XB_TOP], 1u);
            const unsigned tg = og / nx;
            if (og + 1u == (tg + 1u) * nx) xb_add(&bar[XB_TOPGEN], 1u);
            else XB_SPIN(xb_ld(&bar[XB_TOPGEN]) == tg, bar);
            __builtin_amdgcn_fence(__ATOMIC_ACQUIRE, "agent");
            xb_add(&bar[XB_XGEN(b.x)], 1u);
            asm volatile("s_waitcnt vmcnt(0)" ::: "memory");
        } else {
            XB_SPIN(xb_ld(&bar[XB_XGEN(b.x)]) == gen, bar);
            __builtin_amdgcn_fence(__ATOMIC_ACQUIRE, "agent");
            asm volatile("s_waitcnt vmcnt(0)" ::: "memory");
        }
    }
    __syncthreads();
}

using pg8::Unit; using pg8::cvt_pk_bf16; using pg8::BM; using pg8::HALF;
typedef unsigned u32x4 __attribute__((ext_vector_type(4)));

struct EpiGluQ {
    static constexpr bool PERM = true, AFTER_DRAIN = false;
    bf16* hglu; bf16* qm; const float* bias;
    __device__ __forceinline__ void operator()(const f32x4 (&acc)[2][2][4][2], const Unit& u, int wr, int wc, int fr, int fq) const {
        const int row0 = u.pm * BM + wr * 64 + fr, cw = wc * 32 + 8 * fq;
        if (u.pn < 6) {
            f32x4 ba[2], bg[2];
#pragma unroll
            for (int n = 0; n < 2; ++n) { ba[n] = *(const f32x4*)(bias + u.pn * 128 + cw + 4 * n); bg[n] = *(const f32x4*)(bias + 768 + u.pn * 128 + cw + 4 * n); }
#pragma unroll
            for (int ai = 0; ai < 2; ++ai)
#pragma unroll
                for (int m = 0; m < 4; ++m) {
                    float o[8];
#pragma unroll
                    for (int n = 0; n < 2; ++n) { const f32x4 a = acc[ai][0][m][n] + ba[n], g = acc[ai][1][m][n] + bg[n];
#pragma unroll
                        for (int j = 0; j < 4; ++j) o[4 * n + j] = a[j] * sigmoidf_(g[j]); }
                    u32x4 w; w.x = cvt_pk_bf16(o[0], o[1]); w.y = cvt_pk_bf16(o[2], o[3]); w.z = cvt_pk_bf16(o[4], o[5]); w.w = cvt_pk_bf16(o[6], o[7]);
                    *(u32x4*)(hglu + (size_t)(row0 + ai * HALF + m * 16) * CONV_CH + u.pn * 128 + cw) = w;
                }
        } else {
            f32x4 bv[2][2];
#pragma unroll
            for (int bj = 0; bj < 2; ++bj)
#pragma unroll
                for (int n = 0; n < 2; ++n) bv[bj][n] = *(const f32x4*)(bias + 1536 + bj * HALF + cw + 4 * n);
#pragma unroll
            for (int ai = 0; ai < 2; ++ai)
#pragma unroll
                for (int m = 0; m < 4; ++m)
#pragma unroll
                    for (int bj = 0; bj < 2; ++bj) { const f32x4 v0 = acc[ai][bj][m][0] + bv[bj][0], v1 = acc[ai][bj][m][1] + bv[bj][1];
                        u32x4 w; w.x = cvt_pk_bf16(v0[0], v0[1]); w.y = cvt_pk_bf16(v0[2], v0[3]); w.z = cvt_pk_bf16(v1[0], v1[1]); w.w = cvt_pk_bf16(v1[2], v1[3]);
                        *(u32x4*)(qm + (size_t)(row0 + ai * HALF + m * 16) * 256 + bj * HALF + cw) = w; }
        }
    }
};

struct EpiRes {
    static constexpr bool PERM = false, AFTER_DRAIN = false;
    float* Z; const float* xres; const float* bias;
    __device__ __forceinline__ void operator()(const f32x4 (&acc)[2][2][4][2], const Unit& u, int wr, int wc, int fr, int fq) const {
        const int row0 = u.pm * BM + wr * 64 + fr, col0 = u.pn * BM + wc * 32 + 4 * fq;
        f32x4 bv[2][2];
#pragma unroll
        for (int bj = 0; bj < 2; ++bj)
#pragma unroll
            for (int n = 0; n < 2; ++n) bv[bj][n] = *(const f32x4*)(bias + col0 + bj * HALF + n * 16);
#pragma unroll
        for (int ai = 0; ai < 2; ++ai)
#pragma unroll
            for (int m = 0; m < 4; ++m) { const size_t off = (size_t)(row0 + ai * HALF + m * 16) * D + col0;
#pragma unroll
                for (int bj = 0; bj < 2; ++bj)
#pragma unroll
                    for (int n = 0; n < 2; ++n) { const f32x4 xr = *(const f32x4*)(xres + off + bj * HALF + n * 16);
                        *(f32x4*)(Z + off + bj * HALF + n * 16) = xr * DN_ALPHA + acc[ai][bj][m][n] + bv[bj][n]; } }
    }
};

template <int MODE> struct EpiRot {
    static constexpr bool PERM = true, AFTER_DRAIN = false;
    bf16* O; int ldc; const float* rot;
    __device__ __forceinline__ void operator()(const f32x4 (&acc)[2][2][4][2], const Unit& u, int wr, int wc, int fr, int fq) const {
        const int row0 = u.pm * BM + wr * 64 + fr;
#pragma unroll
        for (int bj = 0; bj < 2; ++bj) {
            const int cb = u.pn * BM + bj * HALF;
            bool rotu = false;
            if (MODE == 0) rotu = (cb < 768) && ((wc & 1) == 0);
            if (MODE == 1) rotu = ((cb & 511) < 256) && ((wc & 1) == 0);
#pragma unroll
            for (int ai = 0; ai < 2; ++ai)
#pragma unroll
                for (int m = 0; m < 4; ++m) {
                    const int row = row0 + ai * HALF + m * 16;
                    float v[8];
#pragma unroll
                    for (int j = 0; j < 4; ++j) { v[j] = acc[ai][bj][m][0][j]; v[4 + j] = acc[ai][bj][m][1][j]; }
                    if (rotu) {
                        float pv[8];
#pragma unroll
                        for (int j = 0; j < 8; ++j) pv[j] = __shfl_xor(v[j], 16);
                        if (fq < 2) {
                            const f32x4 c0 = *(const f32x4*)(rot + (size_t)row * 16), c1 = *(const f32x4*)(rot + (size_t)row * 16 + 4);
                            const f32x4 s0 = *(const f32x4*)(rot + (size_t)row * 16 + 8), s1 = *(const f32x4*)(rot + (size_t)row * 16 + 12);
                            const float sg = (fq == 0) ? -1.0f : 1.0f;
#pragma unroll
                            for (int j = 0; j < 4; ++j) { v[j] = v[j] * c0[j] + sg * pv[j] * s0[j]; v[4 + j] = v[4 + j] * c1[j] + sg * pv[4 + j] * s1[j]; }
                        }
                    }
                    u32x4 w; w.x = cvt_pk_bf16(v[0], v[1]); w.y = cvt_pk_bf16(v[2], v[3]); w.z = cvt_pk_bf16(v[4], v[5]); w.w = cvt_pk_bf16(v[6], v[7]);
                    *(u32x4*)(O + (size_t)row * ldc + cb + wc * 32 + 8 * fq) = w;
                }
        }
    }
};

struct EpiSwiglu {
    static constexpr bool PERM = true, AFTER_DRAIN = false;
    bf16* H; const float* bup;
    __device__ __forceinline__ void operator()(const f32x4 (&acc)[2][2][4][2], const Unit& u, int wr, int wc, int fr, int fq) const {
        const int e = u.pn >> 3, pn = u.pn & 7, row0 = u.pm * BM + wr * 64 + fr, cw = pn * 128 + wc * 32 + 8 * fq;
        f32x4 bg[2], bl[2];
#pragma unroll
        for (int n = 0; n < 2; ++n) { bg[n] = *(const f32x4*)(bup + (size_t)e * 2048 + cw + 4 * n); bl[n] = *(const f32x4*)(bup + (size_t)e * 2048 + 1024 + cw + 4 * n); }
#pragma unroll
        for (int ai = 0; ai < 2; ++ai)
#pragma unroll
            for (int m = 0; m < 4; ++m) {
                float o[8];
#pragma unroll
                for (int n = 0; n < 2; ++n) { const f32x4 g = acc[ai][0][m][n] + bg[n], li = acc[ai][1][m][n] + bl[n];
#pragma unroll
                    for (int j = 0; j < 4; ++j) { const float gg = fminf(g[j], 7.0f), ll = fminf(fmaxf(li[j], -7.0f), 7.0f); o[4 * n + j] = gg * sigmoidf_(1.702f * gg) * (ll + 1.0f); } }
                u32x4 w; w.x = cvt_pk_bf16(o[0], o[1]); w.y = cvt_pk_bf16(o[2], o[3]); w.z = cvt_pk_bf16(o[4], o[5]); w.w = cvt_pk_bf16(o[6], o[7]);
                *(u32x4*)(H + (size_t)(row0 + ai * HALF + m * 16) * DFF + cw) = w;
            }
    }
};

struct EpiDown {
    static constexpr bool PERM = true, AFTER_DRAIN = false;
    bf16* Y; const float* bdn;
    __device__ __forceinline__ void operator()(const f32x4 (&acc)[2][2][4][2], const Unit& u, int wr, int wc, int fr, int fq) const {
        const int e = u.pn >> 2, pn = u.pn & 3, row0 = u.pm * BM + wr * 64 + fr, cw = pn * BM + wc * 32 + 8 * fq;
        f32x4 bv[2][2];
#pragma unroll
        for (int bj = 0; bj < 2; ++bj)
#pragma unroll
            for (int n = 0; n < 2; ++n) bv[bj][n] = *(const f32x4*)(bdn + (size_t)e * D + cw + bj * HALF + 4 * n);
#pragma unroll
        for (int ai = 0; ai < 2; ++ai)
#pragma unroll
            for (int m = 0; m < 4; ++m)
#pragma unroll
                for (int bj = 0; bj < 2; ++bj) { const f32x4 v0 = acc[ai][bj][m][0] + bv[bj][0], v1 = acc[ai][bj][m][1] + bv[bj][1];
                    u32x4 w; w.x = cvt_pk_bf16(v0[0], v0[1]); w.y = cvt_pk_bf16(v0[2], v0[3]); w.z = cvt_pk_bf16(v1[0], v1[1]); w.w = cvt_pk_bf16(v1[2], v1[3]);
                    *(u32x4*)(Y + (size_t)(row0 + ai * HALF + m * 16) * D + cw + bj * HALF) = w; }
    }
};

template <int NTN> struct MoeOrder {
    const LAS int* tile_e; const LAS int* tbs; const LAS int* cntl; const int* rowtok; int total, G, c;
    __device__ __forceinline__ bool next(int i, Unit& u) const {
        const int L = i * G + c, grp = L / (8 * NTN), w = L % (8 * NTN), rt = grp * 8 + (w & 7), pn = w >> 3;
        if (rt >= total) return false;
        const int e = __builtin_amdgcn_readfirstlane(tile_e[rt]);
        u.pm = rt; u.pn = e * NTN + pn; return true;
    }
    __device__ __forceinline__ int tok(const Unit& u, int r) const {
        const int e = u.pn / NTN, slot = (u.pm - tbs[e]) * 256 + r; int t = 0;
        if (slot < cntl[e]) t = rowtok[(size_t)e * T + slot];
        return t;
    }
    __device__ __forceinline__ void a_ready(const Unit&) const {}
    __device__ __forceinline__ void done(const Unit&) const {}
};

struct Frame {
    LAS unsigned char* lds;
    int tid, lane, wave, G, gw, NGW;
};
__device__ __forceinline__ unsigned char* ptr_slot(const Frame& F, int k) {
    const unsigned long long v = *(const LAS unsigned long long*)(F.lds + LDS_PTR + 8 * k);
    const unsigned lo = __builtin_amdgcn_readfirstlane((unsigned)v), hi = __builtin_amdgcn_readfirstlane((unsigned)(v >> 32));
    return (unsigned char*)(GAS unsigned char*)(((unsigned long long)hi << 32) | lo);
}
__device__ __forceinline__ const float* inp(const Frame& F, int k) { return (const float*)ptr_slot(F, k); }
__device__ __forceinline__ unsigned char* wsp(const Frame& F) { return ptr_slot(F, 24); }

__device__ __forceinline__ void tr_item(const float* W, int N, bf16* WT, int K, int k0, int n0, int orow0, LAS float* scr, int lane) {
#pragma unroll 16
    for (int i = 0; i < 64; ++i) scr[i * 65 + lane] = W[(size_t)(k0 + i) * N + n0 + lane];
    LDS_WAIT(); asm volatile("" ::: "memory");
    const int c = lane & 7;
#pragma unroll
    for (int j = 0; j < 8; ++j) { const int n = (lane >> 3) + 8 * j; const LAS float* s = scr + (8 * c) * 65 + n;
        v4u o; o.x = pk2(s[0 * 65], s[1 * 65]); o.y = pk2(s[2 * 65], s[3 * 65]); o.z = pk2(s[4 * 65], s[5 * 65]); o.w = pk2(s[6 * 65], s[7 * 65]);
        *(v4u*)(WT + (size_t)(orow0 + n) * K + k0 + 8 * c) = o; }
    LDS_WAIT(); asm volatile("" ::: "memory");
}
template <int PERMT> __device__ __forceinline__ int perm_row(int n0) {
    if (PERMT == 1) { if (n0 >= 1536) return n0; const int bj = n0 / 768, r = n0 % 768; return (r / 128) * 256 + bj * 128 + (r % 128); }
    if (PERMT == 2) { const int bj = n0 / 1024, r = n0 % 1024; return (r / 128) * 256 + bj * 128 + (r % 128); }
    return n0;
}
template <int PERMT> __device__ __forceinline__ void conv_group(Frame& F, const float* src, bf16* dst, int K, int N, int nmat) {
    LAS float* scr = (LAS float*)(F.lds + F.wave * 16640);
    const int nkb = K / 64, nnb = N / 64, per = nkb * nnb, total = per * nmat;
    for (int it = F.gw; it < total; it += F.NGW) {
        const int mat = it / per, r = it % per, kb = r / nnb, nb = r % nnb;
        tr_item(src + (size_t)mat * K * N, N, dst + (size_t)mat * K * N, K, kb * 64, nb * 64, perm_row<PERMT>(nb * 64), scr, F.lane);
    }
}
__device__ __forceinline__ void phase_prologue(Frame& F) {
    unsigned char* ws = wsp(F);
    conv_group<1>(F, inp(F, 3),  (bf16*)(ws + WS_WIN),  D, AIN, 2);
    conv_group<0>(F, inp(F, 9),  (bf16*)(ws + WS_WOA),  D, D, 2);
    conv_group<0>(F, inp(F, 11), (bf16*)(ws + WS_WKV),  D, KVW, 1);
    conv_group<0>(F, inp(F, 12), (bf16*)(ws + WS_WQ),   D, D, 2);
    conv_group<0>(F, inp(F, 13), (bf16*)(ws + WS_WOB),  512, D, 2);
    conv_group<0>(F, inp(F, 15), (bf16*)(ws + WS_WMEM), D, 512, 4);
    conv_group<2>(F, inp(F, 20), (bf16*)(ws + WS_WUP),  D, 2 * DFF, 4 * NEXP);
    conv_group<0>(F, inp(F, 22), (bf16*)(ws + WS_WDN),  DFF, D, 4 * NEXP);
    {
        const size_t gt = (size_t)blockIdx.x * NTHR + F.tid, NT_ = (size_t)F.G * NTHR;
        const float* x = inp(F, 0); bf16* xb = (bf16*)(ws + WS_XB);
        for (size_t i = gt; i < (size_t)T * D / 8; i += NT_) { const f32x4 a = *(const f32x4*)(x + i * 8), b = *(const f32x4*)(x + i * 8 + 4);
            v4u o; o.x = pk2(a[0], a[1]); o.y = pk2(a[2], a[3]); o.z = pk2(b[0], b[1]); o.w = pk2(b[2], b[3]); *(v4u*)(xb + i * 8) = o; }
        const float* mem = inp(F, 1); bf16* mb = (bf16*)(ws + WS_MEMB);
        for (size_t i = gt; i < (size_t)512 * D / 8; i += NT_) { const f32x4 a = *(const f32x4*)(mem + i * 8), b = *(const f32x4*)(mem + i * 8 + 4);
            v4u o; o.x = pk2(a[0], a[1]); o.y = pk2(a[2], a[3]); o.z = pk2(b[0], b[1]); o.w = pk2(b[2], b[3]); *(v4u*)(mb + i * 8) = o; }
        { const float* rw = inp(F, 18); float* rwT = (float*)(ws + WS_RWT);
          for (size_t i = gt; i < (size_t)4 * NEXP * D; i += NT_) { const int l = (int)(i >> 15), e = (int)((i >> 10) & 31), c = (int)(i & 1023); rwT[i] = rw[((size_t)l * D + c) * NEXP + e]; } }
        const int* pos = (const int*)inp(F, 2); float* rot = (float*)(ws + WS_ROT);
        for (size_t i = gt; i < (size_t)T * 8; i += NT_) { const int t = (int)(i >> 3), k = (int)(i & 7);
            double f = 1.0;
            f = (k == 1) ? 0.19392274474868576 : f; f = (k == 2) ? 0.03760603093086393 : f; f = (k == 3) ? 0.007292664737217109 : f; f = (k == 4) ? 0.001414213562373095 : f;
            f = (k == 5) ? 0.0002742481756762073 : f; f = (k == 6) ? 5.318295896944988e-05 : f; f = (k == 7) ? 1.031338537721246e-05 : f;
            const double a = (double)pos[t] * f; const double rv = a * 0.15915494309189535; const double fr = rv - floor(rv);
            const float ang = (float)(fr * 6.283185307179586);
            rot[(size_t)t * 16 + k] = cosf(ang); rot[(size_t)t * 16 + 8 + k] = sinf(ang); }
    }
}

__device__ __forceinline__ void phase_conv(Frame& F, const bf16* hglu, const float* dw, const float* dwb, const float* cg, const float* cb, bf16* A2) {
    LAS bf16* tile = (LAS bf16*)F.lds;
    LAS float* red = (LAS float*)(F.lds + 46 * 768 * 2);
    const int L = F.tid & 255, tb = F.tid >> 8, wv = F.wave & 3;
    float w[31][3], bias[3], gg[3], bb[3];
#pragma unroll
    for (int p = 0; p < 3; ++p) { bias[p] = dwb[p * 256 + L]; gg[p] = cg[p * 256 + L]; bb[p] = cb[p * 256 + L];
#pragma unroll
        for (int j = 0; j < 31; ++j) w[j][p] = dw[j * CONV_CH + p * 256 + L]; }
    for (int ti = blockIdx.x; ti < T / 16; ti += F.G) {
        const int t0 = ti * 16, s0 = t0 & (SEQ - 1);
        __syncthreads();
        for (int i = F.tid; i < 46 * 96; i += NTHR) { const int r = i / 96, c = i % 96; v4u v = (v4u){0u, 0u, 0u, 0u};
            if (s0 - 30 + r >= 0) v = *(const v4u*)(hglu + (size_t)(t0 - 30 + r) * CONV_CH + c * 8);
            *(LAS v4u*)(tile + r * CONV_CH + c * 8) = v; }
        __syncthreads();
        float acc[8][3];
#pragma unroll
        for (int t = 0; t < 8; ++t)
#pragma unroll
            for (int p = 0; p < 3; ++p) acc[t][p] = bias[p];
#pragma unroll
        for (int r = 0; r < 38; ++r) {
            float x[3];
#pragma unroll
            for (int p = 0; p < 3; ++p) x[p] = bflo((unsigned)tile[(tb * 8 + r) * CONV_CH + p * 256 + L]);
#pragma unroll
            for (int t = 0; t < 8; ++t) { const int j = r - t; if (j >= 0 && j <= 30) {
#pragma unroll
                for (int p = 0; p < 3; ++p) acc[t][p] += x[p] * w[j][p]; } }
        }
        float mean[8], rstd[8];
#pragma unroll
        for (int t = 0; t < 8; ++t) { const float s = wave_sum(acc[t][0] + acc[t][1] + acc[t][2]); if (F.lane == 0) red[(tb * 4 + wv) * 8 + t] = s; }
        __syncthreads();
#pragma unroll
        for (int t = 0; t < 8; ++t) { const LAS float* rp = red + tb * 32 + t; mean[t] = (rp[0] + rp[8] + rp[16] + rp[24]) * (1.0f / CONV_CH); }
#pragma unroll
        for (int t = 0; t < 8; ++t) { const float d0 = acc[t][0] - mean[t], d1 = acc[t][1] - mean[t], d2 = acc[t][2] - mean[t];
            const float s = wave_sum(d0 * d0 + d1 * d1 + d2 * d2); if (F.lane == 0) red[64 + (tb * 4 + wv) * 8 + t] = s; }
        __syncthreads();
#pragma unroll
        for (int t = 0; t < 8; ++t) { const LAS float* rp = red + 64 + tb * 32 + t; rstd[t] = 1.0f / sqrtf((rp[0] + rp[8] + rp[16] + rp[24]) * (1.0f / CONV_CH) + LN_EPS); }
#pragma unroll
        for (int t = 0; t < 8; ++t)
#pragma unroll
            for (int p = 0; p < 3; ++p) { const float y = (acc[t][p] - mean[t]) * rstd[t] * gg[p] + bb[p]; const float o = y * sigmoidf_(y);
                A2[(size_t)(t0 + tb * 8 + t) * D + p * 256 + L] = (bf16)f2bf(o); }
    }
    __syncthreads();
}

constexpr int KPITCH = 144, VSB = 560;
template <int NT, bool MASK>
__device__ __forceinline__ void attn_wave(const LAS unsigned char* Kl, const LAS unsigned char* Vt, int kt0, bf16x8 bq0, bf16x8 bq1, int lane, int qi, bool first, f32x4 (&o)[4], float& lse) {
    const int r = lane & 15, lg = lane >> 4;
    f32x4 s[NT];
#pragma unroll
    for (int t = 0; t < NT; ++t) {
        const LAS unsigned char* kp = Kl + ((kt0 + t) * 16 + r) * KPITCH + lg * 16;
        const bf16x8 a0 = *(const LAS bf16x8*)kp, a1 = *(const LAS bf16x8*)(kp + 64);
        f32x4 z = (f32x4){0.f, 0.f, 0.f, 0.f};
        z = __builtin_amdgcn_mfma_f32_16x16x32_bf16(a0, bq0, z, 0, 0, 0);
        s[t] = __builtin_amdgcn_mfma_f32_16x16x32_bf16(a1, bq1, z, 0, 0, 0);
    }
    float m = -INFINITY;
#pragma unroll
    for (int t = 0; t < NT; ++t)
#pragma unroll
        for (int j = 0; j < 4; ++j) {
            if (MASK) { const int ki = (kt0 + t) * 16 + 4 * lg + j, dist = qi + 128 - ki; const bool valid = (dist >= 0) && (dist <= 128) && (!first || ki >= 128); s[t][j] = valid ? s[t][j] : -INFINITY; }
            m = fmaxf(m, s[t][j]);
        }
    m = fmaxf(m, __shfl_xor(m, 16)); m = fmaxf(m, __shfl_xor(m, 32));
    const float c = 0.125f * 1.4426950408889634f;
    float sum = 0.f;
#pragma unroll
    for (int t = 0; t < NT; ++t)
#pragma unroll
        for (int j = 0; j < 4; ++j) { const float p = exp2f((s[t][j] - m) * c); s[t][j] = p; sum += p; }
    sum += __shfl_xor(sum, 16); sum += __shfl_xor(sum, 32);
#pragma unroll
    for (int et = 0; et < 4; ++et) o[et] = (f32x4){0.f, 0.f, 0.f, 0.f};
#pragma unroll
    for (int kk = 0; kk < NT / 2; ++kk) {
        v4u pw; pw.x = cvt_pk_bf16(s[2 * kk][0], s[2 * kk][1]); pw.y = cvt_pk_bf16(s[2 * kk][2], s[2 * kk][3]);
        pw.z = cvt_pk_bf16(s[2 * kk + 1][0], s[2 * kk + 1][1]); pw.w = cvt_pk_bf16(s[2 * kk + 1][2], s[2 * kk + 1][3]);
        const bf16x8 bp = __builtin_bit_cast(bf16x8, pw);
#pragma unroll
        for (int et = 0; et < 4; ++et) {
            const LAS unsigned char* vp = Vt + (16 * et + r) * VSB + ((kt0 + 2 * kk) * 16 + 4 * lg) * 2;
            const v2u lo = *(const LAS v2u*)vp, hi = *(const LAS v2u*)(vp + 32);
            v4u av; av.x = lo.x; av.y = lo.y; av.z = hi.x; av.w = hi.y;
            o[et] = __builtin_amdgcn_mfma_f32_16x16x32_bf16(__builtin_bit_cast(bf16x8, av), bp, o[et], 0, 0, 0);
        }
    }
    const float inv = 1.0f / sum;
#pragma unroll
    for (int et = 0; et < 4; ++et) o[et] = o[et] * inv;
    lse = m * 0.125f + __logf(sum);
}
__device__ __forceinline__ void vt_store(LAS unsigned char* Vt, int ki, int c, v4u v) {
    LAS unsigned short* p = (LAS unsigned short*)(Vt + (c * 8) * VSB + ki * 2);
    p[0 * (VSB / 2)] = (unsigned short)(v.x & 0xffffu); p[1 * (VSB / 2)] = (unsigned short)(v.x >> 16);
    p[2 * (VSB / 2)] = (unsigned short)(v.y & 0xffffu); p[3 * (VSB / 2)] = (unsigned short)(v.y >> 16);
    p[4 * (VSB / 2)] = (unsigned short)(v.z & 0xffffu); p[5 * (VSB / 2)] = (unsigned short)(v.z >> 16);
    p[6 * (VSB / 2)] = (unsigned short)(v.w & 0xffffu); p[7 * (VSB / 2)] = (unsigned short)(v.w >> 16);
}
constexpr int ATT_K_OFF = 0, ATT_V_OFF = 272 * KPITCH;

__device__ __forceinline__ void phase_memattn(Frame& F, const bf16* q, int qp, int qc0, const bf16* memkv, int l, bf16* out, int op, int oc0) {
    LAS unsigned char* Kl = F.lds + ATT_K_OFF; LAS unsigned char* Vt = F.lds + ATT_V_OFF;
    const int r = F.lane & 15, lg = F.lane >> 4;
    for (int u = blockIdx.x; u < 256; u += F.G) {
        const int b = u >> 7, h = (u >> 5) & 3, qc = u & 31;
        __syncthreads();
#pragma unroll
        for (int k = 0; k < 4; ++k) { const int i = F.tid + NTHR * k, ki = i >> 3, c = i & 7;
            const bf16* src = memkv + (size_t)(b * 256 + ki) * 2048 + l * 512 + h * 64 + c * 8;
            const v4u kv = *(const v4u*)src, vv = *(const v4u*)(src + 256);
            *(LAS v4u*)(Kl + ki * KPITCH + c * 16) = kv; vt_store(Vt, ki, c, vv); }
        __syncthreads();
        for (int pass = 0; pass < 4; ++pass) {
            const int tok = b * SEQ + qc * 512 + pass * 128 + F.wave * 16 + r;
            const bf16* qr = q + (size_t)tok * qp + qc0 + h * 64 + 8 * lg;
            const bf16x8 bq0 = *(const bf16x8*)qr, bq1 = *(const bf16x8*)(qr + 32);
            f32x4 o[4]; float lse;
            attn_wave<16, false>(Kl, Vt, 0, bq0, bq1, F.lane, 0, false, o, lse);
            bf16* orow = out + (size_t)tok * op + oc0 + h * 64 + 4 * lg;
#pragma unroll
            for (int et = 0; et < 4; ++et) { v2u w; w.x = cvt_pk_bf16(o[et][0], o[et][1]); w.y = cvt_pk_bf16(o[et][2], o[et][3]); *(v2u*)(orow + 16 * et) = w; }
        }
    }
    __syncthreads();
}

__device__ __forceinline__ void phase_dilated(Frame& F, const bf16* q  , const bf16* kv  , bf16* og  , float* lseo  ) {
    LAS unsigned char* Kl = F.lds + ATT_K_OFF; LAS unsigned char* Vt = F.lds + ATT_V_OFF;
    const int r16 = F.lane & 15, lg = F.lane >> 4;
    for (int u = blockIdx.x; u < 3072; u += F.G) {
        const int b = u / 1536, rem = u % 1536, grp = rem >> 9, h = (rem >> 7) & 3, blk = rem & 127;
        const int dsh = 2 * grp, d = 1 << dsh, nblk = SEQ >> (7 + dsh), res = blk / nblk, n = blk % nblk;
        __syncthreads();
        for (int i = F.tid; i < 272 * 8; i += NTHR) { const int ki = i >> 3, c = i & 7; const int mk = (n - 1) * 128 + ki;
            v4u kvv = (v4u){0u, 0u, 0u, 0u}, vv = (v4u){0u, 0u, 0u, 0u};
            if (ki < 256 && mk >= 0) { const bf16* src = kv + (size_t)(b * SEQ + mk * d + res) * KVW + grp * 512 + h * 64 + c * 8; kvv = *(const v4u*)src; vv = *(const v4u*)(src + 256); }
            *(LAS v4u*)(Kl + ki * KPITCH + c * 16) = kvv; vt_store(Vt, ki, c, vv); }
        __syncthreads();
        const int qi = F.wave * 16 + r16;
        const int tok = b * SEQ + (n * 128 + qi) * d + res;
        const bf16* qr = q + (size_t)tok * D + grp * 256 + h * 64 + 8 * lg;
        const bf16x8 bq0 = *(const bf16x8*)qr, bq1 = *(const bf16x8*)(qr + 32);
        f32x4 o[4]; float lse;
        attn_wave<10, true>(Kl, Vt, F.wave, bq0, bq1, F.lane, qi, n == 0, o, lse);
        bf16* orow = og + ((size_t)grp * T + tok) * 256 + h * 64 + 4 * lg;
#pragma unroll
        for (int et = 0; et < 4; ++et) { v2u w; w.x = cvt_pk_bf16(o[et][0], o[et][1]); w.y = cvt_pk_bf16(o[et][2], o[et][3]); *(v2u*)(orow + 16 * et) = w; }
        if (lg == 0) lseo[((size_t)grp * T + tok) * 4 + h] = lse;
    }
    __syncthreads();
}
__device__ __forceinline__ void phase_dil_combine(Frame& F, const bf16* og, const float* lse, bf16* A2b  ) {
    const size_t gt = (size_t)blockIdx.x * NTHR + F.tid, NT_ = (size_t)F.G * NTHR;
    for (size_t i = gt; i < (size_t)T * 32; i += NT_) {
        const int t = (int)(i >> 5), h = (int)((i >> 3) & 3), c8 = (int)(i & 7);
        const float l0 = lse[((size_t)0 * T + t) * 4 + h], l1 = lse[((size_t)1 * T + t) * 4 + h], l2 = lse[((size_t)2 * T + t) * 4 + h];
        const float mx = fmaxf(l0, fmaxf(l1, l2)); float w0 = __expf(l0 - mx), w1 = __expf(l1 - mx), w2 = __expf(l2 - mx); const float inv = 1.0f / (w0 + w1 + w2); w0 *= inv; w1 *= inv; w2 *= inv;
        const v4u a = *(const v4u*)(og + ((size_t)0 * T + t) * 256 + h * 64 + c8 * 8), bq = *(const v4u*)(og + ((size_t)1 * T + t) * 256 + h * 64 + c8 * 8), cq = *(const v4u*)(og + ((size_t)2 * T + t) * 256 + h * 64 + c8 * 8);
        v4u o;
        o.x = pk2(w0 * bflo(a.x) + w1 * bflo(bq.x) + w2 * bflo(cq.x), w0 * bfhi(a.x) + w1 * bfhi(bq.x) + w2 * bfhi(cq.x));
        o.y = pk2(w0 * bflo(a.y) + w1 * bflo(bq.y) + w2 * bflo(cq.y), w0 * bfhi(a.y) + w1 * bfhi(bq.y) + w2 * bfhi(cq.y));
        o.z = pk2(w0 * bflo(a.z) + w1 * bflo(bq.z) + w2 * bflo(cq.z), w0 * bfhi(a.z) + w1 * bfhi(bq.z) + w2 * bfhi(cq.z));
        o.w = pk2(w0 * bflo(a.w) + w1 * bflo(bq.w) + w2 * bflo(cq.w), w0 * bfhi(a.w) + w1 * bfhi(bq.w) + w2 * bfhi(cq.w));
        *(v4u*)(A2b + (size_t)t * 512 + h * 64 + c8 * 8) = o;
    }
}

__device__ __forceinline__ void phase_ln_route(Frame& F, const float* z, const float* g, const float* bt, const float* rwT, const float* rb,
                                               float* x1f, bf16* x1b, int* tok_es, float* tok_gate, int* rowtok, unsigned* cnt_g) {
    LAS float* xt = (LAS float*)F.lds;
    LAS float* part = xt + 16 * 1028;
    LAS int* lcnt = (LAS int*)(F.lds + LDS_RT); LAS int* base = lcnt + 32; LAS int* rec = lcnt + 64;
    const int r16 = F.lane & 15, kq = F.lane >> 4, w = F.wave;
    f32x4 Wr[2][8];
#pragma unroll
    for (int nt = 0; nt < 2; ++nt)
#pragma unroll
        for (int q = 0; q < 8; ++q) Wr[nt][q] = *(const f32x4*)(rwT + (size_t)(16 * nt + r16) * D + 128 * w + 16 * q + 4 * kq);
    f32x4 g4[4], b4[4];
#pragma unroll
    for (int j = 0; j < 4; ++j) { g4[j] = *(const f32x4*)(g + 4 * F.lane + 256 * j); b4[j] = *(const f32x4*)(bt + 4 * F.lane + 256 * j); }
    const int my_e = F.lane & 31, hh = F.lane >> 5; const float my_rb = rb[my_e];
    for (int chunk = blockIdx.x; chunk < T / 128; chunk += F.G) {
        __syncthreads();
        if (F.tid < 32) lcnt[F.tid] = 0;
        f32x4 zn[2][4];
#pragma unroll
        for (int u = 0; u < 2; ++u)
#pragma unroll
            for (int j = 0; j < 4; ++j) zn[u][j] = *(const f32x4*)(z + (size_t)(chunk * 128 + 2 * w + u) * D + 4 * F.lane + 256 * j);
        for (int rd = 0; rd < 8; ++rd) {
#pragma unroll
            for (int u = 0; u < 2; ++u) {
                const int t = chunk * 128 + rd * 16 + 2 * w + u;
                f32x4 v[4]; float s = 0.f;
#pragma unroll
                for (int j = 0; j < 4; ++j) { v[j] = zn[u][j]; s += (v[j][0] + v[j][1]) + (v[j][2] + v[j][3]); }
                const float mean = wave_sum(s) * (1.0f / D); float s2 = 0.f;
#pragma unroll
                for (int j = 0; j < 4; ++j) { v[j] = v[j] - mean; s2 += (v[j][0] * v[j][0] + v[j][1] * v[j][1]) + (v[j][2] * v[j][2] + v[j][3] * v[j][3]); }
                const float rstd = 1.0f / sqrtf(wave_sum(s2) * (1.0f / D) + LN_EPS);
#pragma unroll
                for (int j = 0; j < 4; ++j) { v[j] = v[j] * rstd * g4[j] + b4[j];
                    *(f32x4*)(x1f + (size_t)t * D + 4 * F.lane + 256 * j) = v[j];
                    v2u wv; wv.x = pk2(v[j][0], v[j][1]); wv.y = pk2(v[j][2], v[j][3]); *(v2u*)(x1b + (size_t)t * D + 4 * F.lane + 256 * j) = wv;
                    *(LAS f32x4*)(xt + (2 * w + u) * 1028 + 4 * F.lane + 256 * j) = v[j]; }
            }
            if (rd < 7) {
#pragma unroll
                for (int u = 0; u < 2; ++u)
#pragma unroll
                    for (int j = 0; j < 4; ++j) zn[u][j] = *(const f32x4*)(z + (size_t)(chunk * 128 + (rd + 1) * 16 + 2 * w + u) * D + 4 * F.lane + 256 * j);
            }
            __syncthreads();
            f32x4 a0 = (f32x4){0.f, 0.f, 0.f, 0.f}, a1 = (f32x4){0.f, 0.f, 0.f, 0.f};
#pragma unroll
            for (int q = 0; q < 8; ++q) { const f32x4 av = *(const LAS f32x4*)(xt + r16 * 1028 + 128 * w + 16 * q + 4 * kq);
#pragma unroll
                for (int j = 0; j < 4; ++j) { a0 = __builtin_amdgcn_mfma_f32_16x16x4f32(av[j], Wr[0][q][j], a0, 0, 0, 0); a1 = __builtin_amdgcn_mfma_f32_16x16x4f32(av[j], Wr[1][q][j], a1, 0, 0, 0); } }
#pragma unroll
            for (int jj = 0; jj < 4; ++jj) { part[(w * 16 + 4 * kq + jj) * 33 + r16] = a0[jj]; part[(w * 16 + 4 * kq + jj) * 33 + 16 + r16] = a1[jj]; }
            __syncthreads();
            {
                const int tokl = 2 * w + hh, tl = rd * 16 + tokl, t = chunk * 128 + tl;
                float val = my_rb;
#pragma unroll
                for (int ww = 0; ww < 8; ++ww) val += part[(ww * 16 + tokl) * 33 + my_e];
                float tv[4]; int ti[4];
#pragma unroll
                for (int k = 0; k < 4; ++k) { float kv = val; int ki = my_e;
#pragma unroll
                    for (int off = 1; off < 32; off <<= 1) { const float ov = __shfl_xor(kv, off); const int oi = __shfl_xor(ki, off); const bool take = (ov > kv) || (ov == kv && oi < ki); kv = take ? ov : kv; ki = take ? oi : ki; }
                    tv[k] = kv; ti[k] = ki; if (my_e == ki) val = -INFINITY; }
                const float e1 = __expf(tv[1] - tv[0]), e2 = __expf(tv[2] - tv[0]), e3 = __expf(tv[3] - tv[0]); const float inv = 1.0f / (1.0f + e1 + e2 + e3);
                if (my_e < 4) { const int k = my_e; const int ee = (k == 0) ? ti[0] : (k == 1) ? ti[1] : (k == 2) ? ti[2] : ti[3];
                    const float gk = ((k == 0) ? 1.0f : (k == 1) ? e1 : (k == 2) ? e2 : e3) * inv;
                    const int slot = __hip_atomic_fetch_add(lcnt + ee, 1, __ATOMIC_RELAXED, __HIP_MEMORY_SCOPE_WORKGROUP);
                    rec[tl * 4 + k] = ee | (slot << 8); tok_gate[(size_t)t * 4 + k] = gk; }
            }
        }
        __syncthreads();
        if (F.tid < 32) base[F.tid] = (int)__hip_atomic_fetch_add(cnt_g + F.tid, (unsigned)lcnt[F.tid], __ATOMIC_RELAXED, __HIP_MEMORY_SCOPE_AGENT);
        __syncthreads();
        { const int rr = rec[F.tid], e = rr & 255, slot = (rr >> 8) + base[e]; tok_es[(size_t)chunk * 512 + F.tid] = e | (slot << 8); rowtok[(size_t)e * T + slot] = chunk * 128 + (F.tid >> 2); }
    }
    __syncthreads();
}

__device__ __forceinline__ int build_tiles(Frame& F, const unsigned* cnt_g) {
    LAS int* tbs = (LAS int*)(F.lds + LDS_TB); LAS int* cl = tbs + 40; LAS int* te = (LAS int*)(F.lds + LDS_TE);
    __syncthreads();
    if (F.tid == 0) { int a = 0; for (int e = 0; e < NEXP; ++e) { const int c = (int)cnt_g[e]; tbs[e] = a; cl[e] = c; a += (c + 255) >> 8; } tbs[NEXP] = a; }
    __syncthreads();
    const int total = tbs[NEXP];
    for (int rt = F.tid; rt < total; rt += NTHR) { int e = 0; for (int k = 1; k < NEXP; ++k) e = (rt >= tbs[k]) ? k : e; te[rt] = e; }
    __syncthreads();
    return total;
}
__device__ __forceinline__ void phase_combine_ln(Frame& F, const unsigned* cnt_g, const float* x1f, const bf16* Y, const int* tok_es, const float* tok_gate, const float* g, const float* bt, float* xout, bf16* xb) {
    (void)build_tiles(F, cnt_g);
    const LAS int* tbs = (const LAS int*)(F.lds + LDS_TB);
    f32x4 g4[4], b4[4];
#pragma unroll
    for (int j = 0; j < 4; ++j) { g4[j] = *(const f32x4*)(g + 4 * F.lane + 256 * j); b4[j] = *(const f32x4*)(bt + 4 * F.lane + 256 * j); }
    for (int t = F.gw; t < T; t += F.NGW) {
        f32x4 v[4];
#pragma unroll
        for (int j = 0; j < 4; ++j) v[j] = *(const f32x4*)(x1f + (size_t)t * D + 4 * F.lane + 256 * j) * DN_ALPHA;
#pragma unroll
        for (int k = 0; k < 4; ++k) { const int es = tok_es[(size_t)t * 4 + k]; const int row = tbs[es & 255] * 256 + (es >> 8); const float gk = tok_gate[(size_t)t * 4 + k];
#pragma unroll
            for (int j = 0; j < 4; ++j) { const v2u w = *(const v2u*)(Y + (size_t)row * D + 4 * F.lane + 256 * j);
                v[j][0] += gk * bflo(w.x); v[j][1] += gk * bfhi(w.x); v[j][2] += gk * bflo(w.y); v[j][3] += gk * bfhi(w.y); } }
        float s = 0.f;
#pragma unroll
        for (int j = 0; j < 4; ++j) s += (v[j][0] + v[j][1]) + (v[j][2] + v[j][3]);
        const float mean = wave_sum(s) * (1.0f / D); float s2 = 0.f;
#pragma unroll
        for (int j = 0; j < 4; ++j) { v[j] = v[j] - mean; s2 += (v[j][0] * v[j][0] + v[j][1] * v[j][1]) + (v[j][2] * v[j][2] + v[j][3] * v[j][3]); }
        const float rstd = 1.0f / sqrtf(wave_sum(s2) * (1.0f / D) + LN_EPS);
#pragma unroll
        for (int j = 0; j < 4; ++j) { v[j] = v[j] * rstd * g4[j] + b4[j];
            *(f32x4*)(xout + (size_t)t * D + 4 * F.lane + 256 * j) = v[j];
            v2u w; w.x = pk2(v[j][0], v[j][1]); w.y = pk2(v[j][2], v[j][3]); *(v2u*)(xb + (size_t)t * D + 4 * F.lane + 256 * j) = w; }
    }
}
#ifndef REP_P0
#define REP_P0 1
#endif
#ifndef REP_A1
#define REP_A1 1
#endif
#ifndef REP_MKV
#define REP_MKV 1
#endif
#ifndef REP_CONV
#define REP_CONV 1
#endif
#ifndef REP_MATT
#define REP_MATT 1
#endif
#ifndef REP_A3
#define REP_A3 1
#endif
#ifndef REP_B1
#define REP_B1 1
#endif
#ifndef REP_B1KV
#define REP_B1KV 1
#endif
#ifndef REP_DIL
#define REP_DIL 1
#endif
#ifndef REP_DILC
#define REP_DILC 1
#endif
#ifndef REP_B4
#define REP_B4 1
#endif
#ifndef REP_M2
#define REP_M2 1
#endif
#ifndef REP_M3
#define REP_M3 1
#endif
#ifndef REP_M4
#define REP_M4 1
#endif
#ifndef REP_M5
#define REP_M5 1
#endif
#ifndef EN_ALL
#define EN_ALL 1
#endif
#ifndef EN_P0
#define EN_P0 EN_ALL
#endif
#ifndef EN_A1
#define EN_A1 EN_ALL
#endif
#ifndef EN_MKV
#define EN_MKV EN_ALL
#endif
#ifndef EN_CONV
#define EN_CONV EN_ALL
#endif
#ifndef EN_MATT
#define EN_MATT EN_ALL
#endif
#ifndef EN_A3
#define EN_A3 EN_ALL
#endif
#ifndef EN_B1
#define EN_B1 EN_ALL
#endif
#ifndef EN_B1KV
#define EN_B1KV EN_ALL
#endif
#ifndef EN_DIL
#define EN_DIL EN_ALL
#endif
#ifndef EN_DILC
#define EN_DILC EN_ALL
#endif
#ifndef EN_B4
#define EN_B4 EN_ALL
#endif
#ifndef EN_M1
#define EN_M1 EN_ALL
#endif
#ifndef EN_M2
#define EN_M2 EN_ALL
#endif
#ifndef EN_M3
#define EN_M3 EN_ALL
#endif
#ifndef EN_M4
#define EN_M4 EN_ALL
#endif
#ifndef EN_M5
#define EN_M5 EN_ALL
#endif

#ifndef MK_N_LAUNCHES
#define MK_N_LAUNCHES 1
#endif
constexpr int NPHASE = 1 + 2 * 7 + 2 * 8;
struct Args { const void* in[24]; float* out; unsigned char* ws; int ph_lo, ph_hi; };
static_assert(sizeof(Args) == 24 * 8 + 8 + 8 + 8, "Args has no padding");

__global__ void __launch_bounds__(NTHR, 2) fwd(Args args) {
    extern __shared__ __attribute__((aligned(16))) unsigned char lds_raw[];
    LAS unsigned char* const ldsb = (LAS unsigned char*)lds_raw;
    if (threadIdx.x < 16) ((LAS unsigned*)(ldsb + LDS_MISC))[threadIdx.x] = 0u;
    if (threadIdx.x == 0) {
        LAS unsigned long long* pt = (LAS unsigned long long*)(ldsb + LDS_PTR);
#pragma unroll
        for (int i = 0; i < 24; ++i) pt[i] = (unsigned long long)args.in[i];
        pt[24] = (unsigned long long)args.ws; pt[25] = (unsigned long long)args.out;
    }
    __syncthreads();
    const int lo = args.ph_lo, hi = args.ph_hi;
    const bool use_bar = (hi - lo) > 1;
    unsigned xcc = 0;
    if (use_bar) { const XcdBarrier b0 = xcd_barrier_post((unsigned*)(args.ws + WS_CTL) + CW_BAR, (volatile LAS unsigned*)(ldsb + LDS_MISC)); xcc = b0.x; }
#define IN(k) (lo <= (k) && (k) < hi)
#define FRAME() Frame F; { int t_ = threadIdx.x; asm volatile("" : "+v"(t_)); F.lds = ldsb; F.tid = t_; F.lane = t_ & 63; F.wave = __builtin_amdgcn_readfirstlane(t_ >> 6); \
                           F.G = gridDim.x; F.gw = blockIdx.x * NWAVES + F.wave; F.NGW = F.G * NWAVES; } unsigned char* ws = wsp(F); (void)ws
#define SEAM(k) do { if (IN(k) && IN((k) + 1)) { asm volatile("" ::: "memory"); Frame Fb; Fb.lds = ldsb; XcdBarrier b_; b_.bar = (unsigned*)(wsp(Fb) + WS_CTL) + CW_BAR; b_.x = xcc; b_.st = (volatile LAS unsigned*)(ldsb + LDS_MISC); xcd_barrier(b_); } } while (0)
#define WSB(T_, off) ((T_*)(ws + (off)))

    if (EN_P0 && IN(0)) { for (int rep_ = 0; rep_ < REP_P0; ++rep_) { FRAME(); phase_prologue(F); } }
    SEAM(0);

    for (int l = 0; l < 4; ++l) {
        const int pb = (l < 2) ? 1 + 7 * l : 15 + 8 * (l - 2);
        int pm;
        if (l < 2) {
            if (IN(pb + 0)) {
                for (int rep_ = 0; rep_ < REP_A1; ++rep_) if (EN_A1) { FRAME();
                  pg8::Gemm g{WSB(bf16, WS_XB), WSB(const bf16, WS_WIN) + (size_t)l * AIN * D, T, AIN, D}; pg8::StaticOrder S; S.init(T, AIN, F.G, (int)blockIdx.x);
                  EpiGluQ E{WSB(bf16, WS_HGLU), WSB(bf16, WS_QM), inp(F, 4) + (size_t)l * AIN};
                  pg8::gemm_phase<EpiGluQ, pg8::StaticOrder, true, true>(F.lds, g, S, E); }
                for (int rep_ = 0; rep_ < REP_MKV; ++rep_) if (EN_MKV && l == 0) { FRAME();
                  pg8::Gemm g{WSB(bf16, WS_MEMB), WSB(const bf16, WS_WMEM), 512, 2048, D}; pg8::StaticOrder S; S.init(512, 2048, F.G, (int)blockIdx.x);
                  EpiRot<2> E{WSB(bf16, WS_MEMKV), 2048, nullptr};
                  pg8::gemm_phase<EpiRot<2>, pg8::StaticOrder, true, true>(F.lds, g, S, E); }
            }
            SEAM(pb + 0);
            if (IN(pb + 1)) {
                for (int rep_ = 0; rep_ < REP_CONV; ++rep_) if (EN_CONV) { FRAME();
                  phase_conv(F, WSB(const bf16, WS_HGLU), inp(F, 5) + (size_t)l * CONV_W * CONV_CH, inp(F, 6) + (size_t)l * CONV_CH, inp(F, 7) + (size_t)l * CONV_CH, inp(F, 8) + (size_t)l * CONV_CH, WSB(bf16, WS_A2)); }
                for (int rep_ = 0; rep_ < REP_MATT; ++rep_) if (EN_MATT) { FRAME(); phase_memattn(F, WSB(const bf16, WS_QM), 256, 0, WSB(const bf16, WS_MEMKV), l, WSB(bf16, WS_A2), D, 768); }
            }
            SEAM(pb + 1);
            for (int rep_ = 0; rep_ < REP_A3; ++rep_) if (EN_A3 && IN(pb + 2)) { FRAME();
                pg8::Gemm g{WSB(bf16, WS_A2), WSB(const bf16, WS_WOA) + (size_t)l * D * D, T, D, D}; pg8::StaticOrder S; S.init(T, D, F.G, (int)blockIdx.x);
                EpiRes E{WSB(float, WS_Z), (l == 0) ? inp(F, 0) : WSB(const float, WS_XR2), inp(F, 10) + (size_t)l * D};
                pg8::gemm_phase<EpiRes, pg8::StaticOrder, true, true>(F.lds, g, S, E);
            }
            SEAM(pb + 2);
            pm = pb + 3;
        } else {
            const int j = l - 2;
            if (IN(pb + 0)) {
                for (int rep_ = 0; rep_ < REP_B1; ++rep_) if (EN_B1) { FRAME();
                  pg8::Gemm g{WSB(bf16, WS_XB), WSB(const bf16, WS_WQ) + (size_t)j * D * D, T, D, D}; pg8::StaticOrder S; S.init(T, D, F.G, (int)blockIdx.x);
                  EpiRot<0> E{WSB(bf16, WS_QB), D, WSB(const float, WS_ROT)};
                  pg8::gemm_phase<EpiRot<0>, pg8::StaticOrder, true, true>(F.lds, g, S, E); }
                for (int rep_ = 0; rep_ < REP_B1KV; ++rep_) if (EN_B1KV && j == 0) { FRAME();
                  pg8::Gemm g{WSB(bf16, WS_XB), WSB(const bf16, WS_WKV), T, KVW, D}; pg8::StaticOrder S; S.init(T, KVW, F.G, (int)blockIdx.x);
                  EpiRot<1> E{WSB(bf16, WS_KVB), KVW, WSB(const float, WS_ROT)};
                  pg8::gemm_phase<EpiRot<1>, pg8::StaticOrder, true, true>(F.lds, g, S, E); }
            }
            SEAM(pb + 0);
            if (IN(pb + 1)) {
                for (int rep_ = 0; rep_ < REP_DIL; ++rep_) if (EN_DIL) { FRAME(); phase_dilated(F, WSB(const bf16, WS_QB), WSB(const bf16, WS_KVB), WSB(bf16, WS_OG), WSB(float, WS_LSE)); }
                for (int rep_ = 0; rep_ < REP_MATT; ++rep_) if (EN_MATT) { FRAME(); phase_memattn(F, WSB(const bf16, WS_QB), D, 768, WSB(const bf16, WS_MEMKV), l, WSB(bf16, WS_A2), 512, 256); }
            }
            SEAM(pb + 1);
            for (int rep_ = 0; rep_ < REP_DILC; ++rep_) if (EN_DILC && IN(pb + 2)) { FRAME(); phase_dil_combine(F, WSB(const bf16, WS_OG), WSB(const float, WS_LSE), WSB(bf16, WS_A2)); }
            SEAM(pb + 2);
            for (int rep_ = 0; rep_ < REP_B4; ++rep_) if (EN_B4 && IN(pb + 3)) { FRAME();
                pg8::Gemm g{WSB(bf16, WS_A2), WSB(const bf16, WS_WOB) + (size_t)j * D * 512, T, D, 512}; pg8::StaticOrder S; S.init(T, D, F.G, (int)blockIdx.x);
                EpiRes E{WSB(float, WS_Z), WSB(const float, WS_XR2), inp(F, 14) + (size_t)j * D};
                pg8::gemm_phase<EpiRes, pg8::StaticOrder, true, true>(F.lds, g, S, E);
            }
            SEAM(pb + 3);
            pm = pb + 4;
        }
        if (EN_M1 && IN(pm + 0)) { FRAME();
            phase_ln_route(F, WSB(const float, WS_Z), inp(F, 16) + (size_t)(l * 2 + 0) * D, inp(F, 17) + (size_t)(l * 2 + 0) * D, WSB(const float, WS_RWT) + (size_t)l * NEXP * D, inp(F, 19) + (size_t)l * NEXP,
                           WSB(float, WS_XR1), WSB(bf16, WS_X1B), WSB(int, WS_TES), WSB(float, WS_TGATE), WSB(int, WS_RTOK), WSB(unsigned, WS_CTL) + CW_CNT + 32 * l);
        }
        SEAM(pm + 0);
        for (int rep_ = 0; rep_ < REP_M3; ++rep_) if (EN_M3 && IN(pm + 1)) { FRAME();
            const int total = build_tiles(F, WSB(const unsigned, WS_CTL) + CW_CNT + 32 * l);
            pg8::Gemm g{WSB(bf16, WS_X1B), WSB(const bf16, WS_WUP) + (size_t)l * NEXP * 2 * DFF * D, XROWS, NEXP * 2 * DFF, D};
            MoeOrder<8> S{(const LAS int*)(F.lds + LDS_TE), (const LAS int*)(F.lds + LDS_TB), (const LAS int*)(F.lds + LDS_TB) + 40, WSB(const int, WS_RTOK), total, F.G, (int)blockIdx.x};
            EpiSwiglu E{WSB(bf16, WS_H), inp(F, 21) + (size_t)l * NEXP * 2 * DFF};
            pg8::gemm_phase_g<EpiSwiglu, MoeOrder<8>>(F.lds, g, S, E);
        }
        SEAM(pm + 1);
        for (int rep_ = 0; rep_ < REP_M4; ++rep_) if (EN_M4 && IN(pm + 2)) { FRAME();
            const int total = build_tiles(F, WSB(const unsigned, WS_CTL) + CW_CNT + 32 * l);
            pg8::Gemm g{WSB(bf16, WS_H), WSB(const bf16, WS_WDN) + (size_t)l * NEXP * DFF * D, XROWS, NEXP * D, DFF};
            MoeOrder<4> S{(const LAS int*)(F.lds + LDS_TE), (const LAS int*)(F.lds + LDS_TB), (const LAS int*)(F.lds + LDS_TB) + 40, WSB(const int, WS_RTOK), total, F.G, (int)blockIdx.x};
            EpiDown E{WSB(bf16, WS_Y), inp(F, 23) + (size_t)l * NEXP * D};
            pg8::gemm_phase<EpiDown, MoeOrder<4>, true, true>(F.lds, g, S, E);
        }
        SEAM(pm + 2);
        for (int rep_ = 0; rep_ < REP_M5; ++rep_) if (EN_M5 && IN(pm + 3)) { FRAME();
            phase_combine_ln(F, WSB(const unsigned, WS_CTL) + CW_CNT + 32 * l, WSB(const float, WS_XR1), WSB(const bf16, WS_Y), WSB(const int, WS_TES), WSB(const float, WS_TGATE), inp(F, 16) + (size_t)(l * 2 + 1) * D, inp(F, 17) + (size_t)(l * 2 + 1) * D,
                             (l == 3) ? (float*)ptr_slot(F, 25) : WSB(float, WS_XR2), WSB(bf16, WS_XB));
        }
        if (l < 3) SEAM(pm + 3);
    }
#undef IN
#undef SEAM
#undef WSB
#undef FRAME
}

extern "C" void kernel_launch(void* const* d_in, const int* in_sizes, int n_in, void* d_out, int out_size, void* d_ws, size_t ws_size, hipStream_t stream) {
    static int grid = 0;
    if (grid == 0) {
        if (n_in != 24 || in_sizes[0] != T * D || out_size != T * D || ws_size < WS_END) {
            fprintf(stderr, "kernel_launch: unexpected shapes (n_in %d, in0 %d, out %d, ws %zu < %zu); nothing launched\n", n_in, n_in > 0 ? in_sizes[0] : -1, out_size, ws_size, (size_t)WS_END); grid = -1; return; }
        if (hipFuncSetAttribute((const void*)fwd, hipFuncAttributeMaxDynamicSharedMemorySize, LDS_BYTES) != hipSuccess) { fprintf(stderr, "kernel_launch: hipFuncSetAttribute failed\n"); grid = -1; return; }
        int per_cu = 0;
        if (hipOccupancyMaxActiveBlocksPerMultiprocessor(&per_cu, (const void*)fwd, NTHR, LDS_BYTES) != hipSuccess || per_cu < 1) fprintf(stderr, "kernel_launch: note: occupancy query says %d\n", per_cu);
        (void)hipGetLastError();
        grid = 256;
    }
    if (grid < 0) return;
    (void)hipMemsetAsync((char*)d_ws + WS_CTL, 0, CTL_ZERO_BYTES, stream);
    Args a{};
    for (int i = 0; i < 24; ++i) a.in[i] = d_in[i];
    a.out = (float*)d_out; a.ws = (unsigned char*)d_ws;
#if MK_N_LAUNCHES == 1
    a.ph_lo = 0; a.ph_hi = NPHASE;
    hipLaunchKernelGGL(fwd, dim3(grid), dim3(NTHR), LDS_BYTES, stream, a);
#else
    for (int k = 0; k < NPHASE; ++k) { a.ph_lo = k; a.ph_hi = k + 1; hipLaunchKernelGGL(fwd, dim3(grid), dim3(NTHR), LDS_BYTES, stream, a); }
#endif
}
```

```cpp
#define MK_N_LAUNCHES 1
#include <hip/hip_runtime.h>
#include <cstdio>
#include <cstdint>
namespace pg8 {
#define PG8_LAS __attribute__((address_space(3)))
typedef unsigned short bf16_t;
typedef short bf16x8 __attribute__((ext_vector_type(8)));
typedef float f32x4 __attribute__((ext_vector_type(4)));
typedef unsigned u32x4 __attribute__((ext_vector_type(4)));
constexpr int BM = 256, BK = 64, HALF = 128, HTB = HALF * BK * 2  , STAGE_BYTES = 8 * HTB, NXCD = 8, WGM = 8;

__host__ __device__ __forceinline__ int lds_byte(int r, int c) { const int st = (r >> 4) * 2 + (c >> 5), rr = r & 15, cc = c & 31, ob = rr * 64 + cc * 2; return st * 1024 + (ob ^ (((ob >> 9) & 1) << 5)); }
__host__ __device__ __forceinline__ void stage_rc(int b, int& R, int& C) { const int st = b / 1024, sb = b % 1024, swz = sb ^ (((sb >> 9) & 1) << 5); R = (st >> 1) * 16 + swz / 64; C = (st & 1) * 32 + (swz % 64) / 2; }
__host__ __device__ __forceinline__ int perm32(int rho) { const int n = rho >> 4, i = rho & 15; return 8 * (i >> 2) + 4 * n + (i & 3); }

struct Unit { int pm, pn; };
struct Gemm { const bf16_t* A; const bf16_t* Bt; int M, N, K; };

struct StaticOrder {
    int nM, nN, nwg, G, c;
    __host__ __device__ void init(int M, int N, int G_, int c_) { nM = M / BM; nN = N / BM; nwg = nM * nN; G = G_; c = c_; }
    __host__ __device__ bool next(int i, Unit& u) const {
        const long L = (long)i * G + c; if (L >= nwg) return false;
        int wgid = (int)L; { const int q = nwg / NXCD, r = nwg % NXCD, xcd = wgid % NXCD, off = wgid / NXCD; wgid = (xcd < r ? xcd * (q + 1) : r * (q + 1) + (xcd - r) * q) + off; }
        const int nig = WGM * nN, gid = wgid / nig, fm = gid * WGM, gsz = (nM - fm) < WGM ? (nM - fm) : WGM;
        u.pm = fm + ((wgid % nig) % gsz); u.pn = (wgid % nig) / gsz; return true;
    }
    __device__ __forceinline__ void a_ready(const Unit&) const {}
    __device__ __forceinline__ void done(const Unit&) const {}
};

__device__ __forceinline__ unsigned cvt_pk_bf16(float lo, float hi) { unsigned r; asm volatile("v_cvt_pk_bf16_f32 %0, %1, %2" : "=v"(r) : "v"(lo), "v"(hi)); return r; }
typedef float f32x2 __attribute__((ext_vector_type(2)));
template <class Epi, class Sched, bool ALIGN_EPI = false, bool SP2 = false>
__device__ __forceinline__ void gemm_phase(PG8_LAS unsigned char* lds, const Gemm g, const Sched& S, const Epi& E) {
    int tid_ = threadIdx.x; asm volatile("" : "+v"(tid_));
    const int tid = tid_, wid = __builtin_amdgcn_readfirstlane(tid >> 6), lane = tid & 63, wr = wid >> 2, wc = wid & 3, fr = lane & 15, fq = lane >> 4;
    const int K = g.K, nt = K / BK;
    unsigned voffA[2], voffB[2];
#pragma unroll
    for (int i = 0; i < 2; ++i) { int R, C; stage_rc(tid * 16 + i * 8192, R, C); const int Rb = Epi::PERM ? ((R & ~31) + perm32(R & 31)) : R;
        voffA[i] = (unsigned)(R * K + C) * 2u; voffB[i] = (unsigned)(Rb * K + C) * 2u; }
    const size_t kstep = (size_t)(BK * 2);
    const size_t hstep = (size_t)HALF * K * 2;
    const size_t tstep = 2 * hstep;
    const unsigned ldsw = (unsigned)wid * 1024u;
    const int aoff = lds_byte(wr * 64 + fr, fq * 8), boff = lds_byte(wc * 32 + fr, fq * 8);
#define PG8_SA(b, h) (((b) * 2 + (h)) * HTB)
#define PG8_SB(b, h) ((4 + (b) * 2 + (h)) * HTB)
#define PG8_STAGE(bufoff, gbase, voff) do { _Pragma("unroll") for (int _i = 0; _i < 2; ++_i) \
        __builtin_amdgcn_global_load_lds((const unsigned*)((const char*)(gbase) + (voff)[_i]), (PG8_LAS unsigned*)(lds + (bufoff) + ldsw + _i * 8192), 16, 0, 0); } while (0)
#define PG8_LDA(dst, b, h) do { _Pragma("unroll") for (int m = 0; m < 4; ++m) _Pragma("unroll") for (int k = 0; k < 2; ++k) dst[m][k] = *(const PG8_LAS bf16x8*)(lds + PG8_SA(b, h) + aoff + m * 2048 + k * 1024); } while (0)
#define PG8_LDB(dst, b, h) do { _Pragma("unroll") for (int n = 0; n < 2; ++n) _Pragma("unroll") for (int k = 0; k < 2; ++k) dst[n][k] = *(const PG8_LAS bf16x8*)(lds + PG8_SB(b, h) + boff + n * 2048 + k * 1024); } while (0)
#define PG8_MMA(ai, bj, At, Bt) do { __builtin_amdgcn_s_setprio(1); _Pragma("unroll") for (int m = 0; m < 4; ++m) _Pragma("unroll") for (int n = 0; n < 2; ++n) _Pragma("unroll") for (int k = 0; k < 2; ++k) \
        acc[ai][bj][m][n] = __builtin_amdgcn_mfma_f32_16x16x32_bf16(Bt[n][k], At[m][k], acc[ai][bj][m][n], 0, 0, 0); __builtin_amdgcn_s_setprio(0); } while (0)
#define PG8_WAIT_V(n) asm volatile("s_waitcnt vmcnt(" #n ")" ::: "memory")
#define PG8_WAIT_L(n) asm volatile("s_waitcnt lgkmcnt(" #n ")" ::: "memory")
#define PG8_BAR __builtin_amdgcn_s_barrier()
#define PG8_SCHED __builtin_amdgcn_sched_barrier(0)
    Unit cur, nxt; int ui = 0;
    if (!S.next(0, cur)) return;
    f32x4 acc[2][2][4][2];
#pragma unroll
    for (int a = 0; a < 2; ++a)
#pragma unroll
        for (int b = 0; b < 2; ++b)
#pragma unroll
            for (int m = 0; m < 4; ++m)
#pragma unroll
                for (int n = 0; n < 2; ++n) acc[a][b][m][n] = (f32x4){0.f, 0.f, 0.f, 0.f};
    bf16x8 At[4][2], B0[2][2], B1[2][2];
    const char* cA = (const char*)g.A + (size_t)cur.pm * tstep; const char* cB = (const char*)g.Bt + (size_t)cur.pn * tstep;
    S.a_ready(cur);
    if constexpr (SP2) {
        PG8_STAGE(PG8_SB(0, 0), cB, voffB); PG8_STAGE(PG8_SB(0, 1), cB + hstep, voffB); PG8_STAGE(PG8_SA(0, 0), cA, voffA); PG8_STAGE(PG8_SA(0, 1), cA + hstep, voffA);
        if (wr == 1) PG8_BAR;
        PG8_WAIT_V(2); PG8_BAR;
        PG8_STAGE(PG8_SB(1, 0), cB + kstep, voffB); PG8_STAGE(PG8_SA(1, 0), cA + kstep, voffA); PG8_STAGE(PG8_SB(1, 1), cB + hstep + kstep, voffB);
        PG8_WAIT_V(6); PG8_BAR;
    } else {
        PG8_STAGE(PG8_SB(0, 0), cB, voffB); PG8_STAGE(PG8_SA(0, 0), cA, voffA); PG8_STAGE(PG8_SB(0, 1), cB + hstep, voffB); PG8_STAGE(PG8_SA(0, 1), cA + hstep, voffA);
        if (wr == 1) PG8_BAR;
        PG8_WAIT_V(4); PG8_BAR;
        PG8_STAGE(PG8_SB(1, 0), cB + kstep, voffB); PG8_STAGE(PG8_SA(1, 0), cA + kstep, voffA); PG8_STAGE(PG8_SB(1, 1), cB + hstep + kstep, voffB);
        PG8_WAIT_V(6); PG8_BAR;
    }
    for (;;) {
        const bool has_next = S.next(ui + 1, nxt);
        const char* nA = has_next ? (const char*)g.A + (size_t)nxt.pm * tstep : cA; const char* nB = has_next ? (const char*)g.Bt + (size_t)nxt.pn * tstep : cB;
        for (int t = 0; t < nt; t += 2) {
            const bool last = (t == nt - 2);
            const char* a1 = cA + (size_t)(t + 1) * kstep;
            const char* a2 = last ? nA : cA + (size_t)(t + 2) * kstep; const char* b2 = last ? nB : cB + (size_t)(t + 2) * kstep;
            const char* a3 = a2 + kstep; const char* b3 = b2 + kstep;
            if (last && has_next) S.a_ready(nxt);
            if constexpr (SP2) {
            PG8_LDB(B0, 0, 0); PG8_LDB(B1, 0, 1); PG8_SCHED; PG8_LDA(At, 0, 0); PG8_STAGE(PG8_SA(1, 1), a1 + hstep, voffA);
            PG8_WAIT_V(8); PG8_WAIT_L(0); PG8_BAR; PG8_MMA(0, 0, At, B0); PG8_MMA(0, 1, At, B1); PG8_BAR; PG8_SCHED;
            PG8_LDA(At, 0, 1); PG8_STAGE(PG8_SB(0, 0), b2, voffB); PG8_STAGE(PG8_SB(0, 1), b2 + hstep, voffB); PG8_STAGE(PG8_SA(0, 0), a2, voffA);
            PG8_WAIT_V(8); PG8_WAIT_L(0); PG8_BAR; PG8_MMA(1, 0, At, B0); PG8_MMA(1, 1, At, B1); PG8_BAR; PG8_SCHED;
            PG8_LDB(B0, 1, 0); PG8_LDB(B1, 1, 1); PG8_SCHED; PG8_LDA(At, 1, 0); PG8_STAGE(PG8_SA(0, 1), a2 + hstep, voffA);
            PG8_WAIT_V(8); PG8_WAIT_L(0); PG8_BAR; PG8_MMA(0, 0, At, B0); PG8_MMA(0, 1, At, B1); PG8_BAR; PG8_SCHED;
            PG8_LDA(At, 1, 1); PG8_STAGE(PG8_SB(1, 0), b3, voffB); PG8_STAGE(PG8_SB(1, 1), b3 + hstep, voffB); PG8_STAGE(PG8_SA(1, 0), a3, voffA);
            PG8_WAIT_V(8); PG8_WAIT_L(0); PG8_BAR; PG8_MMA(1, 0, At, B0); PG8_MMA(1, 1, At, B1); PG8_BAR; PG8_SCHED;
            } else {
            PG8_LDB(B0, 0, 0); PG8_SCHED; PG8_LDA(At, 0, 0); PG8_STAGE(PG8_SA(1, 1), a1 + hstep, voffA);
            PG8_WAIT_L(8); PG8_BAR; PG8_WAIT_L(0); PG8_MMA(0, 0, At, B0); PG8_BAR; PG8_SCHED;
            PG8_LDB(B1, 0, 1); PG8_STAGE(PG8_SB(0, 0), b2, voffB);
            PG8_BAR; PG8_WAIT_L(0); PG8_MMA(0, 1, At, B1); PG8_BAR;
            PG8_LDA(At, 0, 1); PG8_STAGE(PG8_SA(0, 0), a2, voffA);
            PG8_BAR; PG8_WAIT_L(0); PG8_MMA(1, 0, At, B0); PG8_BAR; PG8_SCHED;
            PG8_STAGE(PG8_SB(0, 1), b2 + hstep, voffB);
            PG8_WAIT_V(6); PG8_BAR; PG8_MMA(1, 1, At, B1); PG8_BAR;
            PG8_LDB(B0, 1, 0); PG8_SCHED; PG8_LDA(At, 1, 0); PG8_STAGE(PG8_SA(0, 1), a2 + hstep, voffA);
            PG8_WAIT_L(8); PG8_BAR; PG8_WAIT_L(0); PG8_MMA(0, 0, At, B0); PG8_BAR; PG8_SCHED;
            PG8_LDB(B1, 1, 1); PG8_STAGE(PG8_SB(1, 0), b3, voffB);
            PG8_BAR; PG8_WAIT_L(0); PG8_MMA(0, 1, At, B1); PG8_BAR;
            PG8_LDA(At, 1, 1); PG8_STAGE(PG8_SA(1, 0), a3, voffA);
            PG8_BAR; PG8_WAIT_L(0); PG8_MMA(1, 0, At, B0); PG8_BAR; PG8_SCHED;
            PG8_STAGE(PG8_SB(1, 1), b3 + hstep, voffB);
            PG8_WAIT_V(6); PG8_BAR; PG8_MMA(1, 1, At, B1); PG8_BAR;
            }
        }
        if constexpr (ALIGN_EPI) { if (wr == 0) PG8_BAR; }
        if constexpr (!Epi::AFTER_DRAIN) { E(acc, cur, wr, wc, fr, fq); S.done(cur); }
        if (!has_next) break;
#pragma unroll
        for (int a = 0; a < 2; ++a)
#pragma unroll
            for (int b = 0; b < 2; ++b)
#pragma unroll
                for (int m = 0; m < 4; ++m)
#pragma unroll
                    for (int n = 0; n < 2; ++n) acc[a][b][m][n] = (f32x4){0.f, 0.f, 0.f, 0.f};
        cur = nxt; cA = nA; cB = nB; ++ui;
        if constexpr (ALIGN_EPI) { if (wr == 1) PG8_BAR; }
    }
    PG8_WAIT_V(0);
    if constexpr (!ALIGN_EPI) { if (wr == 0) PG8_BAR; }
    PG8_BAR;
    if constexpr (Epi::AFTER_DRAIN) { E.fused(acc, cur, wr, wc, fr, fq, lds, wid, lane); S.done(cur); }
#undef PG8_SA
#undef PG8_SB
#undef PG8_STAGE
#undef PG8_LDA
#undef PG8_LDB
#undef PG8_MMA
#undef PG8_WAIT_V
#undef PG8_WAIT_L
#undef PG8_BAR
#undef PG8_SCHED
}
}

namespace pg8 {
template <class Epi, class Sched>
__device__ __forceinline__ void gemm_phase_g(PG8_LAS unsigned char* lds, const Gemm g, const Sched& S, const Epi& E) {
    int tid_ = threadIdx.x; asm volatile("" : "+v"(tid_));
    const int tid = tid_, wid = __builtin_amdgcn_readfirstlane(tid >> 6), lane = tid & 63, wr = wid >> 2, wc = wid & 3, fr = lane & 15, fq = lane >> 4;
    const int K = g.K, nt = K / BK;
    unsigned voffB[2];
#pragma unroll
    for (int i = 0; i < 2; ++i) { int R, C; stage_rc(tid * 16 + i * 8192, R, C); const int Rb = Epi::PERM ? ((R & ~31) + perm32(R & 31)) : R; voffB[i] = (unsigned)(Rb * K + C) * 2u; }
    const size_t kstep = (size_t)(BK * 2);
    const size_t hstep = (size_t)HALF * K * 2;
    const size_t tstep = 2 * hstep;
    const unsigned ldsw = (unsigned)wid * 1024u;
    const int aoff = lds_byte(wr * 64 + fr, fq * 8), boff = lds_byte(wc * 32 + fr, fq * 8);
#define PG8_SA(b, h) (((b) * 2 + (h)) * HTB)
#define PG8_SB(b, h) ((4 + (b) * 2 + (h)) * HTB)
#define PG8_STAGE(bufoff, gbase, voff) do { _Pragma("unroll") for (int _i = 0; _i < 2; ++_i) \
        __builtin_amdgcn_global_load_lds((const unsigned*)((const char*)(gbase) + (voff)[_i]), (PG8_LAS unsigned*)(lds + (bufoff) + ldsw + _i * 8192), 16, 0, 0); } while (0)
#define PG8_STAGE2(bufoff, gbase, v0, v1) do { \
        __builtin_amdgcn_global_load_lds((const unsigned*)((const char*)(gbase) + (v0)), (PG8_LAS unsigned*)(lds + (bufoff) + ldsw), 16, 0, 0); \
        __builtin_amdgcn_global_load_lds((const unsigned*)((const char*)(gbase) + (v1)), (PG8_LAS unsigned*)(lds + (bufoff) + ldsw + 8192), 16, 0, 0); } while (0)
#define PG8_LDA(dst, b, h) do { _Pragma("unroll") for (int m = 0; m < 4; ++m) _Pragma("unroll") for (int k = 0; k < 2; ++k) dst[m][k] = *(const PG8_LAS bf16x8*)(lds + PG8_SA(b, h) + aoff + m * 2048 + k * 1024); } while (0)
#define PG8_LDB(dst, b, h) do { _Pragma("unroll") for (int n = 0; n < 2; ++n) _Pragma("unroll") for (int k = 0; k < 2; ++k) dst[n][k] = *(const PG8_LAS bf16x8*)(lds + PG8_SB(b, h) + boff + n * 2048 + k * 1024); } while (0)
#define PG8_MMA(ai, bj, At, Bt) do { __builtin_amdgcn_s_setprio(1); _Pragma("unroll") for (int m = 0; m < 4; ++m) _Pragma("unroll") for (int n = 0; n < 2; ++n) _Pragma("unroll") for (int k = 0; k < 2; ++k) \
        acc[ai][bj][m][n] = __builtin_amdgcn_mfma_f32_16x16x32_bf16(Bt[n][k], At[m][k], acc[ai][bj][m][n], 0, 0, 0); __builtin_amdgcn_s_setprio(0); } while (0)
#define PG8_WAIT_V(n) asm volatile("s_waitcnt vmcnt(" #n ")" ::: "memory")
#define PG8_WAIT_L(n) asm volatile("s_waitcnt lgkmcnt(" #n ")" ::: "memory")
#define PG8_BAR __builtin_amdgcn_s_barrier()
#define PG8_SCHED __builtin_amdgcn_sched_barrier(0)
#define PG8_TOKOFF(u, tz, h, i, dst) do { int R_, C_; stage_rc((tz) * 16 + (i) * 8192, R_, C_); dst = (unsigned)S.tok(u, (h) * HALF + R_) * (unsigned)(K * 2) + (unsigned)(C_ * 2); } while (0)
    Unit cur, nxt, nn; int ui = 0;
    if (!S.next(0, cur)) return;
    bool has_next = S.next(1, nxt);
    unsigned vc00, vc01, vc10, vc11, vn00, vn01, vn10, vn11;
    { int tz = tid_; asm volatile("" : "+v"(tz));
      PG8_TOKOFF(cur, tz, 0, 0, vc00); PG8_TOKOFF(cur, tz, 0, 1, vc01); PG8_TOKOFF(cur, tz, 1, 0, vc10); PG8_TOKOFF(cur, tz, 1, 1, vc11);
      if (has_next) { PG8_TOKOFF(nxt, tz, 0, 0, vn00); PG8_TOKOFF(nxt, tz, 0, 1, vn01); PG8_TOKOFF(nxt, tz, 1, 0, vn10); PG8_TOKOFF(nxt, tz, 1, 1, vn11); }
      else { vn00 = vc00; vn01 = vc01; vn10 = vc10; vn11 = vc11; } }
    f32x4 acc[2][2][4][2];
#pragma unroll
    for (int a = 0; a < 2; ++a)
#pragma unroll
        for (int b = 0; b < 2; ++b)
#pragma unroll
            for (int m = 0; m < 4; ++m)
#pragma unroll
                for (int n = 0; n < 2; ++n) acc[a][b][m][n] = (f32x4){0.f, 0.f, 0.f, 0.f};
    bf16x8 At[4][2], B0[2][2], B1[2][2];
    const char* const cA = (const char*)g.A;
    const char* cB = (const char*)g.Bt + (size_t)cur.pn * tstep;
    PG8_STAGE(PG8_SB(0, 0), cB, voffB); PG8_STAGE(PG8_SB(0, 1), cB + hstep, voffB); PG8_STAGE2(PG8_SA(0, 0), cA, vc00, vc01); PG8_STAGE2(PG8_SA(0, 1), cA, vc10, vc11);
    if (wr == 1) PG8_BAR;
    PG8_WAIT_V(2); PG8_BAR;
    PG8_STAGE(PG8_SB(1, 0), cB + kstep, voffB); PG8_STAGE2(PG8_SA(1, 0), cA + kstep, vc00, vc01); PG8_STAGE(PG8_SB(1, 1), cB + hstep + kstep, voffB);
    PG8_WAIT_V(6); PG8_BAR;
    for (;;) {
        const char* nB = has_next ? (const char*)g.Bt + (size_t)nxt.pn * tstep : cB;
        for (int t = 0; t < nt; t += 2) {
            const bool last = (t == nt - 2);
            const char* a1 = cA + (size_t)(t + 1) * kstep;
            const char* a2 = last ? cA : cA + (size_t)(t + 2) * kstep; const char* b2 = last ? nB : cB + (size_t)(t + 2) * kstep;
            const char* a3 = a2 + kstep; const char* b3 = b2 + kstep;
            const unsigned x00 = last ? vn00 : vc00, x01 = last ? vn01 : vc01, x10 = last ? vn10 : vc10, x11 = last ? vn11 : vc11;
            PG8_LDB(B0, 0, 0); PG8_LDB(B1, 0, 1); PG8_SCHED; PG8_LDA(At, 0, 0); PG8_STAGE2(PG8_SA(1, 1), a1, vc10, vc11);
            PG8_WAIT_V(8); PG8_WAIT_L(0); PG8_BAR; PG8_MMA(0, 0, At, B0); PG8_MMA(0, 1, At, B1); PG8_BAR; PG8_SCHED;
            PG8_LDA(At, 0, 1); PG8_STAGE(PG8_SB(0, 0), b2, voffB); PG8_STAGE(PG8_SB(0, 1), b2 + hstep, voffB); PG8_STAGE2(PG8_SA(0, 0), a2, x00, x01);
            PG8_WAIT_V(8); PG8_WAIT_L(0); PG8_BAR; PG8_MMA(1, 0, At, B0); PG8_MMA(1, 1, At, B1); PG8_BAR; PG8_SCHED;
            PG8_LDB(B0, 1, 0); PG8_LDB(B1, 1, 1); PG8_SCHED; PG8_LDA(At, 1, 0); PG8_STAGE2(PG8_SA(0, 1), a2, x10, x11);
            PG8_WAIT_V(8); PG8_WAIT_L(0); PG8_BAR; PG8_MMA(0, 0, At, B0); PG8_MMA(0, 1, At, B1); PG8_BAR; PG8_SCHED;
            PG8_LDA(At, 1, 1); PG8_STAGE(PG8_SB(1, 0), b3, voffB); PG8_STAGE(PG8_SB(1, 1), b3 + hstep, voffB); PG8_STAGE2(PG8_SA(1, 0), a3, x00, x01);
            PG8_WAIT_V(8); PG8_WAIT_L(0); PG8_BAR; PG8_MMA(1, 0, At, B0); PG8_MMA(1, 1, At, B1); PG8_BAR; PG8_SCHED;
        }
        if (wr == 0) PG8_BAR;
        const bool has_nn = has_next && S.next(ui + 2, nn);
        unsigned w00 = 0, w01 = 0, w10 = 0, w11 = 0;
        if (has_nn) { int tz = tid_; asm volatile("" : "+v"(tz)); PG8_TOKOFF(nn, tz, 0, 0, w00); PG8_TOKOFF(nn, tz, 0, 1, w01); PG8_TOKOFF(nn, tz, 1, 0, w10); PG8_TOKOFF(nn, tz, 1, 1, w11); }
        E(acc, cur, wr, wc, fr, fq); S.done(cur);
#if defined(PROBE_EPI2)
        asm volatile("" ::: "memory");
#pragma unroll
        for (int a = 0; a < 2; ++a)
#pragma unroll
            for (int b = 0; b < 2; ++b)
#pragma unroll
                for (int m = 0; m < 4; ++m)
#pragma unroll
                    for (int n = 0; n < 2; ++n) asm volatile("" : "+v"(acc[a][b][m][n]));
        E(acc, cur, wr, wc, fr, fq);
#endif
        if (!has_next) break;
#pragma unroll
        for (int a = 0; a < 2; ++a)
#pragma unroll
            for (int b = 0; b < 2; ++b)
#pragma unroll
                for (int m = 0; m < 4; ++m)
#pragma unroll
                    for (int n = 0; n < 2; ++n) acc[a][b][m][n] = (f32x4){0.f, 0.f, 0.f, 0.f};
        cur = nxt; cB = nB; ++ui;
        vc00 = vn00; vc01 = vn01; vc10 = vn10; vc11 = vn11;
        if (has_nn) { vn00 = w00; vn01 = w01; vn10 = w10; vn11 = w11; nxt = nn; }
        has_next = has_nn;
        if (wr == 1) PG8_BAR;
    }
    PG8_WAIT_V(0);
    PG8_BAR;
#undef PG8_SA
#undef PG8_SB
#undef PG8_STAGE
#undef PG8_STAGE2
#undef PG8_LDA
#undef PG8_LDB
#undef PG8_MMA
#undef PG8_WAIT_V
#undef PG8_WAIT_L
#undef PG8_BAR
#undef PG8_SCHED
#undef PG8_TOKOFF
}
}

#define GAS __attribute__((address_space(1)))
#define LAS __attribute__((address_space(3)))
typedef unsigned short bf16;
typedef unsigned v4u __attribute__((ext_vector_type(4)));
typedef unsigned v2u __attribute__((ext_vector_type(2)));
typedef float f32x4 __attribute__((ext_vector_type(4)));
typedef short bf16x8 __attribute__((ext_vector_type(8)));

constexpr int NWAVES = 8, NTHR = 512;
constexpr int NB = 2, SEQ = 16384, T = NB * SEQ, D = 1024;
constexpr int CONV_CH = 768, CONV_W = 31, AIN = 1792, KVW = 1536, NEXP = 32, DFF = 1024;
constexpr int MAXTILES = (T * 4) / 256 + NEXP;
constexpr int XROWS = MAXTILES * 256;
constexpr float DN_ALPHA = 1.681792830507429f;
constexpr float LN_EPS = 1e-5f;

constexpr size_t MiB = 1u << 20;
constexpr size_t al(size_t x) { return (x + MiB - 1) / MiB * MiB; }
constexpr size_t WS_CTL = 0, CTL_ZERO_BYTES = MiB;
constexpr size_t WS_ROT  = WS_CTL + MiB;
constexpr size_t WS_WIN  = WS_ROT  + al((size_t)T * 16 * 4);
constexpr size_t WS_WOA  = WS_WIN  + al((size_t)2 * AIN * D * 2);
constexpr size_t WS_WKV  = WS_WOA  + al((size_t)2 * D * D * 2);
constexpr size_t WS_WQ   = WS_WKV  + al((size_t)KVW * D * 2);
constexpr size_t WS_WOB  = WS_WQ   + al((size_t)2 * D * D * 2);
constexpr size_t WS_WMEM = WS_WOB  + al((size_t)2 * D * 512 * 2);
constexpr size_t WS_WUP  = WS_WMEM + al((size_t)4 * 512 * D * 2);
constexpr size_t WS_WDN  = WS_WUP  + al((size_t)4 * NEXP * 2 * DFF * D * 2);
constexpr size_t WS_MEMB = WS_WDN  + al((size_t)4 * NEXP * D * DFF * 2);
constexpr size_t WS_MEMKV= WS_MEMB + al((size_t)512 * D * 2);
constexpr size_t WS_XB   = WS_MEMKV+ al((size_t)512 * 2048 * 2);
constexpr size_t WS_X1B  = WS_XB   + al((size_t)T * D * 2);
constexpr size_t WS_XR1  = WS_X1B  + al((size_t)T * D * 2);
constexpr size_t WS_XR2  = WS_XR1  + al((size_t)T * D * 4);
constexpr size_t WS_Z    = WS_XR2  + al((size_t)T * D * 4);
constexpr size_t WS_HGLU = WS_Z    + al((size_t)T * D * 4);
constexpr size_t WS_QM   = WS_HGLU + al((size_t)T * CONV_CH * 2);
constexpr size_t WS_A2   = WS_QM   + al((size_t)T * 256 * 2);
constexpr size_t WS_QB   = WS_A2   + al((size_t)T * D * 2);
constexpr size_t WS_KVB  = WS_QB   + al((size_t)T * D * 2);
constexpr size_t WS_OG   = WS_KVB  + al((size_t)T * KVW * 2);
constexpr size_t WS_LSE  = WS_OG   + al((size_t)3 * T * 256 * 2);
constexpr size_t WS_TES  = WS_LSE  + al((size_t)3 * T * 4 * 4);
constexpr size_t WS_TGATE= WS_TES  + al((size_t)T * 4 * 4);
constexpr size_t WS_TROW = WS_TGATE+ al((size_t)T * 4 * 4);
constexpr size_t WS_RWT  = WS_TROW + al((size_t)T * 4 * 4);
constexpr size_t WS_RTOK = WS_RWT  + al((size_t)4 * NEXP * D * 4);
constexpr size_t WS_H    = WS_RTOK + al((size_t)NEXP * T * 4);
constexpr size_t WS_Y    = WS_H    + al((size_t)XROWS * DFF * 2);
constexpr size_t WS_END  = WS_Y    + al((size_t)XROWS * D * 2);
constexpr int CW_BAR = 4096;
constexpr int CW_CNT = 8192;
constexpr int LDS_SCR = 133120;
constexpr int LDS_MISC = LDS_SCR;
constexpr int LDS_TB = LDS_MISC + 64;
constexpr int LDS_TE = LDS_TB + 320;
constexpr int LDS_RT = LDS_TE + 2304;
constexpr int LDS_PTR = LDS_RT + 2304;
constexpr int LDS_BYTES = 147456;
static_assert(LDS_PTR + 256 <= LDS_BYTES, "LDS map");

#define LDS_WAIT() asm volatile("s_waitcnt lgkmcnt(0)" ::: "memory")
#define VM_WAIT() asm volatile("s_waitcnt vmcnt(0)" ::: "memory")
__device__ __forceinline__ unsigned f2bf(float f) { unsigned u = __builtin_bit_cast(unsigned, f); return (u + 0x7fffu + ((u >> 16) & 1u)) >> 16; }
__device__ __forceinline__ unsigned pk2(float lo, float hi) { return f2bf(lo) | (f2bf(hi) << 16); }
__device__ __forceinline__ float bflo(unsigned w) { return __builtin_bit_cast(float, w << 16); }
__device__ __forceinline__ float bfhi(unsigned w) { return __builtin_bit_cast(float, w & 0xffff0000u); }
__device__ __forceinline__ float wave_sum(float v) {
#pragma unroll
    for (int o = 1; o < 64; o <<= 1) v += __shfl_xor(v, o);
    return v;
}
__device__ __forceinline__ float sigmoidf_(float x) { return __builtin_amdgcn_rcpf(1.0f + __builtin_amdgcn_exp2f(-1.4426950408889634f * x)); }
#define XB_TMO      128
#define XB_XCNT(j)  (256  + 64 * (j))
#define XB_XSUB(j)  (1280 + 64 * (j))
#define XB_XGEN(j)  (2304 + 64 * (j))
#define XB_TOP      3328
#define XB_TOPGEN   3392
#define XCD_BAR_WORDS 3456
#define XB_SPIN_CAP (1u << 18)

__device__ __forceinline__ unsigned xb_ld(unsigned* p)              { return __hip_atomic_load(p, __ATOMIC_RELAXED, __HIP_MEMORY_SCOPE_AGENT); }
__device__ __forceinline__ unsigned xb_add(unsigned* p, unsigned v) { return __hip_atomic_fetch_add(p, v, __ATOMIC_RELAXED, __HIP_MEMORY_SCOPE_AGENT); }
__device__ __forceinline__ unsigned xb_xcc_id() { return (unsigned)__builtin_amdgcn_s_getreg((3 << 11) | 20) & 0xFu; }
#define XB_SPIN(cond, bar) do { unsigned _sp = 0; while (cond) { __builtin_amdgcn_s_sleep(1); \
    if ((++_sp & 255u) == 0u) { if (xb_ld(&(bar)[XB_TMO])) break; if (_sp > XB_SPIN_CAP) { atomicAdd(&(bar)[XB_TMO], 1u); break; } } } } while (0)

struct XcdBarrier {
    unsigned* bar; unsigned x;
    volatile LAS unsigned* st;
};

__device__ __forceinline__ XcdBarrier xcd_barrier_post(unsigned* bar, volatile LAS unsigned* st) {
    XcdBarrier b; b.bar = bar; b.x = xb_xcc_id(); b.st = st;
    if (threadIdx.x == 0) (void)xb_add(&bar[XB_XCNT(b.x)], 1u);
    return b;
}
__device__ __forceinline__ void xcd_barrier_complete(unsigned* bar, unsigned x, unsigned& nloc, unsigned& nx) {
    const unsigned G = gridDim.x * gridDim.y * gridDim.z;
    unsigned sum, cnt, mine, sp = 0u;
    for (;;) {
        sum = 0u; cnt = 0u; mine = 0u;
#pragma unroll
        for (unsigned j = 0; j < 16; ++j) { const unsigned c = xb_ld(&bar[XB_XCNT(j)]); sum += c; cnt += (c > 0u) ? 1u : 0u; mine = (j == x) ? c : mine; }
        if (sum == G) break;
        __builtin_amdgcn_s_sleep(1);
        if ((++sp & 255u) == 0u) { if (xb_ld(&bar[XB_TMO])) break; if (sp > XB_SPIN_CAP) { atomicAdd(&bar[XB_TMO], 1u); break; } }
    }
    nloc = mine > 0u ? mine : 1u; nx = cnt > 0u ? cnt : 1u;
}

__device__ __forceinline__ void xcd_barrier(const XcdBarrier& b) {
    asm volatile("s_waitcnt vmcnt(0)" ::: "memory");
    __syncthreads();
    if (threadIdx.x == 0) {
        unsigned* bar = b.bar;
        __builtin_amdgcn_s_waitcnt(0);
        unsigned nloc = b.st[0], nx = b.st[1];
        if (nloc == 0u) { xcd_barrier_complete(bar, b.x, nloc, nx); b.st[0] = nloc; b.st[1] = nx; }
        const unsigned old = xb_add(&bar[XB_XSUB(b.x)], 1u);
        const unsigned gen = old / nloc;
        if (old + 1u == (gen + 1u) * nloc) {
            __builtin_amdgcn_fence(__ATOMIC_RELEASE, "agent");
            asm volatile("s_waitcnt vmcnt(0)" ::: "memory");
            const unsigned og = xb_add(&bar[XB_TOP], 1u);
            const unsigned tg = og / nx;
            if (og + 1u == (tg + 1u) * nx) xb_add(&bar[XB_TOPGEN], 1u);
            else XB_SPIN(xb_ld(&bar[XB_TOPGEN]) == tg, bar);
            __builtin_amdgcn_fence(__ATOMIC_ACQUIRE, "agent");
            xb_add(&bar[XB_XGEN(b.x)], 1u);
            asm volatile("s_waitcnt vmcnt(0)" ::: "memory");
        } else {
            XB_SPIN(xb_ld(&bar[XB_XGEN(b.x)]) == gen, bar);
            __builtin_amdgcn_fence(__ATOMIC_ACQUIRE, "agent");
            asm volatile("s_waitcnt vmcnt(0)" ::: "memory");
        }
    }
    __syncthreads();
}

using pg8::Unit; using pg8::cvt_pk_bf16; using pg8::BM; using pg8::HALF;
typedef unsigned u32x4 __attribute__((ext_vector_type(4)));

struct EpiGluQ {
    static constexpr bool PERM = true, AFTER_DRAIN = false;
    bf16* hglu; bf16* qm; const float* bias;
    __device__ __forceinline__ void operator()(const f32x4 (&acc)[2][2][4][2], const Unit& u, int wr, int wc, int fr, int fq) const {
        const int row0 = u.pm * BM + wr * 64 + fr, cw = wc * 32 + 8 * fq;
        if (u.pn < 6) {
            f32x4 ba[2], bg[2];
#pragma unroll
            for (int n = 0; n < 2; ++n) { ba[n] = *(const f32x4*)(bias + u.pn * 128 + cw + 4 * n); bg[n] = *(const f32x4*)(bias + 768 + u.pn * 128 + cw + 4 * n); }
#pragma unroll
            for (int ai = 0; ai < 2; ++ai)
#pragma unroll
                for (int m = 0; m < 4; ++m) {
                    float o[8];
#pragma unroll
                    for (int n = 0; n < 2; ++n) { const f32x4 a = acc[ai][0][m][n] + ba[n], g = acc[ai][1][m][n] + bg[n];
#pragma unroll
                        for (int j = 0; j < 4; ++j) o[4 * n + j] = a[j] * sigmoidf_(g[j]); }
                    u32x4 w; w.x = cvt_pk_bf16(o[0], o[1]); w.y = cvt_pk_bf16(o[2], o[3]); w.z = cvt_pk_bf16(o[4], o[5]); w.w = cvt_pk_bf16(o[6], o[7]);
                    *(u32x4*)(hglu + (size_t)(row0 + ai * HALF + m * 16) * CONV_CH + u.pn * 128 + cw) = w;
                }
        } else {
            f32x4 bv[2][2];
#pragma unroll
            for (int bj = 0; bj < 2; ++bj)
#pragma unroll
                for (int n = 0; n < 2; ++n) bv[bj][n] = *(const f32x4*)(bias + 1536 + bj * HALF + cw + 4 * n);
#pragma unroll
            for (int ai = 0; ai < 2; ++ai)
#pragma unroll
                for (int m = 0; m < 4; ++m)
#pragma unroll
                    for (int bj = 0; bj < 2; ++bj) { const f32x4 v0 = acc[ai][bj][m][0] + bv[bj][0], v1 = acc[ai][bj][m][1] + bv[bj][1];
                        u32x4 w; w.x = cvt_pk_bf16(v0[0], v0[1]); w.y = cvt_pk_bf16(v0[2], v0[3]); w.z = cvt_pk_bf16(v1[0], v1[1]); w.w = cvt_pk_bf16(v1[2], v1[3]);
                        *(u32x4*)(qm + (size_t)(row0 + ai * HALF + m * 16) * 256 + bj * HALF + cw) = w; }
        }
    }
};

struct EpiRes {
    static constexpr bool PERM = false, AFTER_DRAIN = false;
    float* Z; const float* xres; const float* bias;
    __device__ __forceinline__ void operator()(const f32x4 (&acc)[2][2][4][2], const Unit& u, int wr, int wc, int fr, int fq) const {
        const int row0 = u.pm * BM + wr * 64 + fr, col0 = u.pn * BM + wc * 32 + 4 * fq;
        f32x4 bv[2][2];
#pragma unroll
        for (int bj = 0; bj < 2; ++bj)
#pragma unroll
            for (int n = 0; n < 2; ++n) bv[bj][n] = *(const f32x4*)(bias + col0 + bj * HALF + n * 16);
#pragma unroll
        for (int ai = 0; ai < 2; ++ai)
#pragma unroll
            for (int m = 0; m < 4; ++m) { const size_t off = (size_t)(row0 + ai * HALF + m * 16) * D + col0;
#pragma unroll
                for (int bj = 0; bj < 2; ++bj)
#pragma unroll
                    for (int n = 0; n < 2; ++n) { const f32x4 xr = *(const f32x4*)(xres + off + bj * HALF + n * 16);
                        *(f32x4*)(Z + off + bj * HALF + n * 16) = xr * DN_ALPHA + acc[ai][bj][m][n] + bv[bj][n]; } }
    }
};

template <int MODE> struct EpiRot {
    static constexpr bool PERM = true, AFTER_DRAIN = false;
    bf16* O; int ldc; const float* rot;
    __device__ __forceinline__ void operator()(const f32x4 (&acc)[2][2][4][2], const Unit& u, int wr, int wc, int fr, int fq) const {
        const int row0 = u.pm * BM + wr * 64 + fr;
#pragma unroll
        for (int bj = 0; bj < 2; ++bj) {
            const int cb = u.pn * BM + bj * HALF;
            bool rotu = false;
            if (MODE == 0) rotu = (cb < 768) && ((wc & 1) == 0);
            if (MODE == 1) rotu = ((cb & 511) < 256) && ((wc & 1) == 0);
#pragma unroll
            for (int ai = 0; ai < 2; ++ai)
#pragma unroll
                for (int m = 0; m < 4; ++m) {
                    const int row = row0 + ai * HALF + m * 16;
                    float v[8];
#pragma unroll
                    for (int j = 0; j < 4; ++j) { v[j] = acc[ai][bj][m][0][j]; v[4 + j] = acc[ai][bj][m][1][j]; }
                    if (rotu) {
                        float pv[8];
#pragma unroll
                        for (int j = 0; j < 8; ++j) pv[j] = __shfl_xor(v[j], 16);
                        if (fq < 2) {
                            const f32x4 c0 = *(const f32x4*)(rot + (size_t)row * 16), c1 = *(const f32x4*)(rot + (size_t)row * 16 + 4);
                            const f32x4 s0 = *(const f32x4*)(rot + (size_t)row * 16 + 8), s1 = *(const f32x4*)(rot + (size_t)row * 16 + 12);
                            const float sg = (fq == 0) ? -1.0f : 1.0f;
#pragma unroll
                            for (int j = 0; j < 4; ++j) { v[j] = v[j] * c0[j] + sg * pv[j] * s0[j]; v[4 + j] = v[4 + j] * c1[j] + sg * pv[4 + j] * s1[j]; }
                        }
                    }
                    u32x4 w; w.x = cvt_pk_bf16(v[0], v[1]); w.y = cvt_pk_bf16(v[2], v[3]); w.z = cvt_pk_bf16(v[4], v[5]); w.w = cvt_pk_bf16(v[6], v[7]);
                    *(u32x4*)(O + (size_t)row * ldc + cb + wc * 32 + 8 * fq) = w;
                }
        }
    }
};

struct EpiSwiglu {
    static constexpr bool PERM = true, AFTER_DRAIN = false;
    bf16* H; const float* bup;
    __device__ __forceinline__ void operator()(const f32x4 (&acc)[2][2][4][2], const Unit& u, int wr, int wc, int fr, int fq) const {
        const int e = u.pn >> 3, pn = u.pn & 7, row0 = u.pm * BM + wr * 64 + fr, cw = pn * 128 + wc * 32 + 8 * fq;
        f32x4 bg[2], bl[2];
#pragma unroll
        for (int n = 0; n < 2; ++n) { bg[n] = *(const f32x4*)(bup + (size_t)e * 2048 + cw + 4 * n); bl[n] = *(const f32x4*)(bup + (size_t)e * 2048 + 1024 + cw + 4 * n); }
#pragma unroll
        for (int ai = 0; ai < 2; ++ai)
#pragma unroll
            for (int m = 0; m < 4; ++m) {
                float o[8];
#pragma unroll
                for (int n = 0; n < 2; ++n) { const f32x4 g = acc[ai][0][m][n] + bg[n], li = acc[ai][1][m][n] + bl[n];
#pragma unroll
                    for (int j = 0; j < 4; ++j) { const float gg = fminf(g[j], 7.0f), ll = fminf(fmaxf(li[j], -7.0f), 7.0f); o[4 * n + j] = gg * sigmoidf_(1.702f * gg) * (ll + 1.0f); } }
                u32x4 w; w.x = cvt_pk_bf16(o[0], o[1]); w.y = cvt_pk_bf16(o[2], o[3]); w.z = cvt_pk_bf16(o[4], o[5]); w.w = cvt_pk_bf16(o[6], o[7]);
                *(u32x4*)(H + (size_t)(row0 + ai * HALF + m * 16) * DFF + cw) = w;
            }
    }
};

struct EpiDown {
    static constexpr bool PERM = true, AFTER_DRAIN = false;
    bf16* Y; const float* bdn;
    __device__ __forceinline__ void operator()(const f32x4 (&acc)[2][2][4][2], const Unit& u, int wr, int wc, int fr, int fq) const {
        const int e = u.pn >> 2, pn = u.pn & 3, row0 = u.pm * BM + wr * 64 + fr, cw = pn * BM + wc * 32 + 8 * fq;
        f32x4 bv[2][2];
#pragma unroll
        for (int bj = 0; bj < 2; ++bj)
#pragma unroll
            for (int n = 0; n < 2; ++n) bv[bj][n] = *(const f32x4*)(bdn + (size_t)e * D + cw + bj * HALF + 4 * n);
#pragma unroll
        for (int ai = 0; ai < 2; ++ai)
#pragma unroll
            for (int m = 0; m < 4; ++m)
#pragma unroll
                for (int bj = 0; bj < 2; ++bj) { const f32x4 v0 = acc[ai][bj][m][0] + bv[bj][0], v1 = acc[ai][bj][m][1] + bv[bj][1];
                    u32x4 w; w.x = cvt_pk_bf16(v0[0], v0[1]); w.y = cvt_pk_bf16(v0[2], v0[3]); w.z = cvt_pk_bf16(v1[0], v1[1]); w.w = cvt_pk_bf16(v1[2], v1[3]);
                    *(u32x4*)(Y + (size_t)(row0 + ai * HALF + m * 16) * D + cw + bj * HALF) = w; }
    }
};

template <int NTN> struct MoeOrder {
    const LAS int* tile_e; const LAS int* tbs; const LAS int* cntl; const int* rowtok; int total, G, c;
    __device__ __forceinline__ bool next(int i, Unit& u) const {
        const int L = i * G + c, grp = L / (8 * NTN), w = L % (8 * NTN), rt = grp * 8 + (w & 7), pn = w >> 3;
        if (rt >= total) return false;
        const int e = __builtin_amdgcn_readfirstlane(tile_e[rt]);
        u.pm = rt; u.pn = e * NTN + pn; return true;
    }
    __device__ __forceinline__ int tok(const Unit& u, int r) const {
        const int e = u.pn / NTN, slot = (u.pm - tbs[e]) * 256 + r; int t = 0;
        if (slot < cntl[e]) t = rowtok[(size_t)e * T + slot];
        return t;
    }
    __device__ __forceinline__ void a_ready(const Unit&) const {}
    __device__ __forceinline__ void done(const Unit&) const {}
};

struct Frame {
    LAS unsigned char* lds;
    int tid, lane, wave, G, gw, NGW;
};
__device__ __forceinline__ unsigned char* ptr_slot(const Frame& F, int k) {
    const unsigned long long v = *(const LAS unsigned long long*)(F.lds + LDS_PTR + 8 * k);
    const unsigned lo = __builtin_amdgcn_readfirstlane((unsigned)v), hi = __builtin_amdgcn_readfirstlane((unsigned)(v >> 32));
    return (unsigned char*)(GAS unsigned char*)(((unsigned long long)hi << 32) | lo);
}
__device__ __forceinline__ const float* inp(const Frame& F, int k) { return (const float*)ptr_slot(F, k); }
__device__ __forceinline__ unsigned char* wsp(const Frame& F) { return ptr_slot(F, 24); }

__device__ __forceinline__ void tr_item(const float* W, int N, bf16* WT, int K, int k0, int n0, int orow0, LAS float* scr, int lane) {
#pragma unroll 16
    for (int i = 0; i < 64; ++i) scr[i * 65 + lane] = W[(size_t)(k0 + i) * N + n0 + lane];
    LDS_WAIT(); asm volatile("" ::: "memory");
    const int c = lane & 7;
#pragma unroll
    for (int j = 0; j < 8; ++j) { const int n = (lane >> 3) + 8 * j; const LAS float* s = scr + (8 * c) * 65 + n;
        v4u o; o.x = pk2(s[0 * 65], s[1 * 65]); o.y = pk2(s[2 * 65], s[3 * 65]); o.z = pk2(s[4 * 65], s[5 * 65]); o.w = pk2(s[6 * 65], s[7 * 65]);
        *(v4u*)(WT + (size_t)(orow0 + n) * K + k0 + 8 * c) = o; }
    LDS_WAIT(); asm volatile("" ::: "memory");
}
template <int PERMT> __device__ __forceinline__ int perm_row(int n0) {
    if (PERMT == 1) { if (n0 >= 1536) return n0; const int bj = n0 / 768, r = n0 % 768; return (r / 128) * 256 + bj * 128 + (r % 128); }
    if (PERMT == 2) { const int bj = n0 / 1024, r = n0 % 1024; return (r / 128) * 256 + bj * 128 + (r % 128); }
    return n0;
}
template <int PERMT> __device__ __forceinline__ void conv_group(Frame& F, const float* src, bf16* dst, int K, int N, int nmat) {
    LAS float* scr = (LAS float*)(F.lds + F.wave * 16640);
    const int nkb = K / 64, nnb = N / 64, per = nkb * nnb, total = per * nmat;
    for (int it = F.gw; it < total; it += F.NGW) {
        const int mat = it / per, r = it % per, kb = r / nnb, nb = r % nnb;
        tr_item(src + (size_t)mat * K * N, N, dst + (size_t)mat * K * N, K, kb * 64, nb * 64, perm_row<PERMT>(nb * 64), scr, F.lane);
    }
}
__device__ __forceinline__ void phase_prologue(Frame& F) {
    unsigned char* ws = wsp(F);
    conv_group<1>(F, inp(F, 3),  (bf16*)(ws + WS_WIN),  D, AIN, 2);
    conv_group<0>(F, inp(F, 9),  (bf16*)(ws + WS_WOA),  D, D, 2);
    conv_group<0>(F, inp(F, 11), (bf16*)(ws + WS_WKV),  D, KVW, 1);
    conv_group<0>(F, inp(F, 12), (bf16*)(ws + WS_WQ),   D, D, 2);
    conv_group<0>(F, inp(F, 13), (bf16*)(ws + WS_WOB),  512, D, 2);
    conv_group<0>(F, inp(F, 15), (bf16*)(ws + WS_WMEM), D, 512, 4);
    conv_group<2>(F, inp(F, 20), (bf16*)(ws + WS_WUP),  D, 2 * DFF, 4 * NEXP);
    conv_group<0>(F, inp(F, 22), (bf16*)(ws + WS_WDN),  DFF, D, 4 * NEXP);
    {
        const size_t gt = (size_t)blockIdx.x * NTHR + F.tid, NT_ = (size_t)F.G * NTHR;
        const float* x = inp(F, 0); bf16* xb = (bf16*)(ws + WS_XB);
        for (size_t i = gt; i < (size_t)T * D / 8; i += NT_) { const f32x4 a = *(const f32x4*)(x + i * 8), b = *(const f32x4*)(x + i * 8 + 4);
            v4u o; o.x = pk2(a[0], a[1]); o.y = pk2(a[2], a[3]); o.z = pk2(b[0], b[1]); o.w = pk2(b[2], b[3]); *(v4u*)(xb + i * 8) = o; }
        const float* mem = inp(F, 1); bf16* mb = (bf16*)(ws + WS_MEMB);
        for (size_t i = gt; i < (size_t)512 * D / 8; i += NT_) { const f32x4 a = *(const f32x4*)(mem + i * 8), b = *(const f32x4*)(mem + i * 8 + 4);
            v4u o; o.x = pk2(a[0], a[1]); o.y = pk2(a[2], a[3]); o.z = pk2(b[0], b[1]); o.w = pk2(b[2], b[3]); *(v4u*)(mb + i * 8) = o; }
        { const float* rw = inp(F, 18); float* rwT = (float*)(ws + WS_RWT);
          for (size_t i = gt; i < (size_t)4 * NEXP * D; i += NT_) { const int l = (int)(i >> 15), e = (int)((i >> 10) & 31), c = (int)(i & 1023); rwT[i] = rw[((size_t)l * D + c) * NEXP + e]; } }
        const int* pos = (const int*)inp(F, 2); float* rot = (float*)(ws + WS_ROT);
        for (size_t i = gt; i < (size_t)T * 8; i += NT_) { const int t = (int)(i >> 3), k = (int)(i & 7);
            double f = 1.0;
            f = (k == 1) ? 0.19392274474868576 : f; f = (k == 2) ? 0.03760603093086393 : f; f = (k == 3) ? 0.007292664737217109 : f; f = (k == 4) ? 0.001414213562373095 : f;
            f = (k == 5) ? 0.0002742481756762073 : f; f = (k == 6) ? 5.318295896944988e-05 : f; f = (k == 7) ? 1.031338537721246e-05 : f;
            const double a = (double)pos[t] * f; const double rv = a * 0.15915494309189535; const double fr = rv - floor(rv);
            const float ang = (float)(fr * 6.283185307179586);
            rot[(size_t)t * 16 + k] = cosf(ang); rot[(size_t)t * 16 + 8 + k] = sinf(ang); }
    }
}

__device__ __forceinline__ void phase_conv(Frame& F, const bf16* hglu, const float* dw, const float* dwb, const float* cg, const float* cb, bf16* A2) {
    LAS bf16* tile = (LAS bf16*)F.lds;
    LAS float* red = (LAS float*)(F.lds + 46 * 768 * 2);
    const int L = F.tid & 255, tb = F.tid >> 8, wv = F.wave & 3;
    float w[31][3], bias[3], gg[3], bb[3];
#pragma unroll
    for (int p = 0; p < 3; ++p) { bias[p] = dwb[p * 256 + L]; gg[p] = cg[p * 256 + L]; bb[p] = cb[p * 256 + L];
#pragma unroll
        for (int j = 0; j < 31; ++j) w[j][p] = dw[j * CONV_CH + p * 256 + L]; }
    for (int ti = blockIdx.x; ti < T / 16; ti += F.G) {
        const int t0 = ti * 16, s0 = t0 & (SEQ - 1);
        __syncthreads();
        for (int i = F.tid; i < 46 * 96; i += NTHR) { const int r = i / 96, c = i % 96; v4u v = (v4u){0u, 0u, 0u, 0u};
            if (s0 - 30 + r >= 0) v = *(const v4u*)(hglu + (size_t)(t0 - 30 + r) * CONV_CH + c * 8);
            *(LAS v4u*)(tile + r * CONV_CH + c * 8) = v; }
        __syncthreads();
        float acc[8][3];
#pragma unroll
        for (int t = 0; t < 8; ++t)
#pragma unroll
            for (int p = 0; p < 3; ++p) acc[t][p] = bias[p];
#pragma unroll
        for (int r = 0; r < 38; ++r) {
            float x[3];
#pragma unroll
            for (int p = 0; p < 3; ++p) x[p] = bflo((unsigned)tile[(tb * 8 + r) * CONV_CH + p * 256 + L]);
#pragma unroll
            for (int t = 0; t < 8; ++t) { const int j = r - t; if (j >= 0 && j <= 30) {
#pragma unroll
                for (int p = 0; p < 3; ++p) acc[t][p] += x[p] * w[j][p]; } }
        }
        float mean[8], rstd[8];
#pragma unroll
        for (int t = 0; t < 8; ++t) { const float s = wave_sum(acc[t][0] + acc[t][1] + acc[t][2]); if (F.lane == 0) red[(tb * 4 + wv) * 8 + t] = s; }
        __syncthreads();
#pragma unroll
        for (int t = 0; t < 8; ++t) { const LAS float* rp = red + tb * 32 + t; mean[t] = (rp[0] + rp[8] + rp[16] + rp[24]) * (1.0f / CONV_CH); }
#pragma unroll
        for (int t = 0; t < 8; ++t) { const float d0 = acc[t][0] - mean[t], d1 = acc[t][1] - mean[t], d2 = acc[t][2] - mean[t];
            const float s = wave_sum(d0 * d0 + d1 * d1 + d2 * d2); if (F.lane == 0) red[64 + (tb * 4 + wv) * 8 + t] = s; }
        __syncthreads();
#pragma unroll
        for (int t = 0; t < 8; ++t) { const LAS float* rp = red + 64 + tb * 32 + t; rstd[t] = 1.0f / sqrtf((rp[0] + rp[8] + rp[16] + rp[24]) * (1.0f / CONV_CH) + LN_EPS); }
#pragma unroll
        for (int t = 0; t < 8; ++t)
#pragma unroll
            for (int p = 0; p < 3; ++p) { const float y = (acc[t][p] - mean[t]) * rstd[t] * gg[p] + bb[p]; const float o = y * sigmoidf_(y);
                A2[(size_t)(t0 + tb * 8 + t) * D + p * 256 + L] = (bf16)f2bf(o); }
    }
    __syncthreads();
}

constexpr int KPITCH = 144, VSB = 560;
template <int NT, bool MASK>
__device__ __forceinline__ void attn_wave(const LAS unsigned char* Kl, const LAS unsigned char* Vt, int kt0, bf16x8 bq0, bf16x8 bq1, int lane, int qi, bool first, f32x4 (&o)[4], float& lse) {
    const int r = lane & 15, lg = lane >> 4;
    f32x4 s[NT];
#pragma unroll
    for (int t = 0; t < NT; ++t) {
        const LAS unsigned char* kp = Kl + ((kt0 + t) * 16 + r) * KPITCH + lg * 16;
        const bf16x8 a0 = *(const LAS bf16x8*)kp, a1 = *(const LAS bf16x8*)(kp + 64);
        f32x4 z = (f32x4){0.f, 0.f, 0.f, 0.f};
        z = __builtin_amdgcn_mfma_f32_16x16x32_bf16(a0, bq0, z, 0, 0, 0);
        s[t] = __builtin_amdgcn_mfma_f32_16x16x32_bf16(a1, bq1, z, 0, 0, 0);
    }
    float m = -INFINITY;
#pragma unroll
    for (int t = 0; t < NT; ++t)
#pragma unroll
        for (int j = 0; j < 4; ++j) {
            if (MASK) { const int ki = (kt0 + t) * 16 + 4 * lg + j, dist = qi + 128 - ki; const bool valid = (dist >= 0) && (dist <= 128) && (!first || ki >= 128); s[t][j] = valid ? s[t][j] : -INFINITY; }
            m = fmaxf(m, s[t][j]);
        }
    m = fmaxf(m, __shfl_xor(m, 16)); m = fmaxf(m, __shfl_xor(m, 32));
    const float c = 0.125f * 1.4426950408889634f;
    float sum = 0.f;
#pragma unroll
    for (int t = 0; t < NT; ++t)
#pragma unroll
        for (int j = 0; j < 4; ++j) { const float p = __builtin_amdgcn_exp2f((s[t][j] - m) * c); s[t][j] = p; sum += p; }
    sum += __shfl_xor(sum, 16); sum += __shfl_xor(sum, 32);
#pragma unroll
    for (int et = 0; et < 4; ++et) o[et] = (f32x4){0.f, 0.f, 0.f, 0.f};
#pragma unroll
    for (int kk = 0; kk < NT / 2; ++kk) {
        v4u pw; pw.x = cvt_pk_bf16(s[2 * kk][0], s[2 * kk][1]); pw.y = cvt_pk_bf16(s[2 * kk][2], s[2 * kk][3]);
        pw.z = cvt_pk_bf16(s[2 * kk + 1][0], s[2 * kk + 1][1]); pw.w = cvt_pk_bf16(s[2 * kk + 1][2], s[2 * kk + 1][3]);
        const bf16x8 bp = __builtin_bit_cast(bf16x8, pw);
#pragma unroll
        for (int et = 0; et < 4; ++et) {
            const LAS unsigned char* vp = Vt + (16 * et + r) * VSB + ((kt0 + 2 * kk) * 16 + 4 * lg) * 2;
            const v2u lo = *(const LAS v2u*)vp, hi = *(const LAS v2u*)(vp + 32);
            v4u av; av.x = lo.x; av.y = lo.y; av.z = hi.x; av.w = hi.y;
            o[et] = __builtin_amdgcn_mfma_f32_16x16x32_bf16(__builtin_bit_cast(bf16x8, av), bp, o[et], 0, 0, 0);
        }
    }
    const float inv = __builtin_amdgcn_rcpf(sum);
#pragma unroll
    for (int et = 0; et < 4; ++et) o[et] = o[et] * inv;
    lse = m * 0.125f + __logf(sum);
}
__device__ __forceinline__ void vt_store(LAS unsigned char* Vt, int ki, int c, v4u v) {
    LAS unsigned short* p = (LAS unsigned short*)(Vt + (c * 8) * VSB + ki * 2);
    p[0 * (VSB / 2)] = (unsigned short)(v.x & 0xffffu); p[1 * (VSB / 2)] = (unsigned short)(v.x >> 16);
    p[2 * (VSB / 2)] = (unsigned short)(v.y & 0xffffu); p[3 * (VSB / 2)] = (unsigned short)(v.y >> 16);
    p[4 * (VSB / 2)] = (unsigned short)(v.z & 0xffffu); p[5 * (VSB / 2)] = (unsigned short)(v.z >> 16);
    p[6 * (VSB / 2)] = (unsigned short)(v.w & 0xffffu); p[7 * (VSB / 2)] = (unsigned short)(v.w >> 16);
}
constexpr int ATT_K_OFF = 0, ATT_V_OFF = 272 * KPITCH;

__device__ __forceinline__ void phase_memattn(Frame& F, const bf16* q, int qp, int qc0, const bf16* memkv, int l, bf16* out, int op, int oc0) {
    LAS unsigned char* Kl = F.lds + ATT_K_OFF; LAS unsigned char* Vt = F.lds + ATT_V_OFF;
    const int r = F.lane & 15, lg = F.lane >> 4;
    for (int u = blockIdx.x; u < 256; u += F.G) {
        const int b = u >> 7, h = (u >> 5) & 3, qc = u & 31;
        __syncthreads();
#pragma unroll
        for (int k = 0; k < 4; ++k) { const int i = F.tid + NTHR * k, ki = i >> 3, c = i & 7;
            const bf16* src = memkv + (size_t)(b * 256 + ki) * 2048 + l * 512 + h * 64 + c * 8;
            const v4u kv = *(const v4u*)src, vv = *(const v4u*)(src + 256);
            *(LAS v4u*)(Kl + ki * KPITCH + c * 16) = kv; vt_store(Vt, ki, c, vv); }
        __syncthreads();
        for (int pass = 0; pass < 4; ++pass) {
            const int tok = b * SEQ + qc * 512 + pass * 128 + F.wave * 16 + r;
            const bf16* qr = q + (size_t)tok * qp + qc0 + h * 64 + 8 * lg;
            const bf16x8 bq0 = *(const bf16x8*)qr, bq1 = *(const bf16x8*)(qr + 32);
            f32x4 o[4]; float lse;
            attn_wave<16, false>(Kl, Vt, 0, bq0, bq1, F.lane, 0, false, o, lse);
            bf16* orow = out + (size_t)tok * op + oc0 + h * 64 + 4 * lg;
#pragma unroll
            for (int et = 0; et < 4; ++et) { v2u w; w.x = cvt_pk_bf16(o[et][0], o[et][1]); w.y = cvt_pk_bf16(o[et][2], o[et][3]); *(v2u*)(orow + 16 * et) = w; }
        }
    }
    __syncthreads();
}

__device__ __forceinline__ void phase_dilated(Frame& F, const bf16* q  , const bf16* kv  , bf16* og  , float* lseo  ) {
    LAS unsigned char* Kl = F.lds + ATT_K_OFF; LAS unsigned char* Vt = F.lds + ATT_V_OFF;
    const int r16 = F.lane & 15, lg = F.lane >> 4;
    for (int u = blockIdx.x; u < 3072; u += F.G) {
        const int b = u / 1536, rem = u % 1536, grp = rem >> 9, h = (rem >> 7) & 3, blk = rem & 127;
        const int dsh = 2 * grp, d = 1 << dsh, nblk = SEQ >> (7 + dsh), res = blk / nblk, n = blk % nblk;
        __syncthreads();
        for (int i = F.tid; i < 272 * 8; i += NTHR) { const int ki = i >> 3, c = i & 7; const int mk = (n - 1) * 128 + ki;
            v4u kvv = (v4u){0u, 0u, 0u, 0u}, vv = (v4u){0u, 0u, 0u, 0u};
            if (ki < 256 && mk >= 0) { const bf16* src = kv + (size_t)(b * SEQ + mk * d + res) * KVW + grp * 512 + h * 64 + c * 8; kvv = *(const v4u*)src; vv = *(const v4u*)(src + 256); }
            *(LAS v4u*)(Kl + ki * KPITCH + c * 16) = kvv; vt_store(Vt, ki, c, vv); }
        __syncthreads();
        const int qi = F.wave * 16 + r16;
        const int tok = b * SEQ + (n * 128 + qi) * d + res;
        const bf16* qr = q + (size_t)tok * D + grp * 256 + h * 64 + 8 * lg;
        const bf16x8 bq0 = *(const bf16x8*)qr, bq1 = *(const bf16x8*)(qr + 32);
        f32x4 o[4]; float lse;
        attn_wave<10, true>(Kl, Vt, F.wave, bq0, bq1, F.lane, qi, n == 0, o, lse);
        bf16* orow = og + ((size_t)grp * T + tok) * 256 + h * 64 + 4 * lg;
#pragma unroll
        for (int et = 0; et < 4; ++et) { v2u w; w.x = cvt_pk_bf16(o[et][0], o[et][1]); w.y = cvt_pk_bf16(o[et][2], o[et][3]); *(v2u*)(orow + 16 * et) = w; }
        if (lg == 0) lseo[((size_t)grp * T + tok) * 4 + h] = lse;
    }
    __syncthreads();
}
__device__ __forceinline__ void phase_dil_combine(Frame& F, const bf16* og, const float* lse, bf16* A2b  ) {
    const size_t gt = (size_t)blockIdx.x * NTHR + F.tid, NT_ = (size_t)F.G * NTHR;
    for (size_t i = gt; i < (size_t)T * 32; i += NT_) {
        const int t = (int)(i >> 5), h = (int)((i >> 3) & 3), c8 = (int)(i & 7);
        const float l0 = lse[((size_t)0 * T + t) * 4 + h], l1 = lse[((size_t)1 * T + t) * 4 + h], l2 = lse[((size_t)2 * T + t) * 4 + h];
        const float mx = fmaxf(l0, fmaxf(l1, l2)); float w0 = __expf(l0 - mx), w1 = __expf(l1 - mx), w2 = __expf(l2 - mx); const float inv = 1.0f / (w0 + w1 + w2); w0 *= inv; w1 *= inv; w2 *= inv;
        const v4u a = *(const v4u*)(og + ((size_t)0 * T + t) * 256 + h * 64 + c8 * 8), bq = *(const v4u*)(og + ((size_t)1 * T + t) * 256 + h * 64 + c8 * 8), cq = *(const v4u*)(og + ((size_t)2 * T + t) * 256 + h * 64 + c8 * 8);
        v4u o;
        o.x = pk2(w0 * bflo(a.x) + w1 * bflo(bq.x) + w2 * bflo(cq.x), w0 * bfhi(a.x) + w1 * bfhi(bq.x) + w2 * bfhi(cq.x));
        o.y = pk2(w0 * bflo(a.y) + w1 * bflo(bq.y) + w2 * bflo(cq.y), w0 * bfhi(a.y) + w1 * bfhi(bq.y) + w2 * bfhi(cq.y));
        o.z = pk2(w0 * bflo(a.z) + w1 * bflo(bq.z) + w2 * bflo(cq.z), w0 * bfhi(a.z) + w1 * bfhi(bq.z) + w2 * bfhi(cq.z));
        o.w = pk2(w0 * bflo(a.w) + w1 * bflo(bq.w) + w2 * bflo(cq.w), w0 * bfhi(a.w) + w1 * bfhi(bq.w) + w2 * bfhi(cq.w));
        *(v4u*)(A2b + (size_t)t * 512 + h * 64 + c8 * 8) = o;
    }
}

__device__ __forceinline__ void phase_ln_route(Frame& F, const float* z, const float* g, const float* bt, const float* rwT, const float* rb,
                                               float* x1f, bf16* x1b, int* tok_es, float* tok_gate, int* rowtok, unsigned* cnt_g) {
    LAS float* xt = (LAS float*)F.lds;
    LAS float* part = xt + 16 * 1028;
    LAS int* lcnt = (LAS int*)(F.lds + LDS_RT); LAS int* base = lcnt + 32; LAS int* rec = lcnt + 64;
    const int r16 = F.lane & 15, kq = F.lane >> 4, w = F.wave;
    f32x4 Wr[2][8];
#pragma unroll
    for (int nt = 0; nt < 2; ++nt)
#pragma unroll
        for (int q = 0; q < 8; ++q) Wr[nt][q] = *(const f32x4*)(rwT + (size_t)(16 * nt + r16) * D + 128 * w + 16 * q + 4 * kq);
    f32x4 g4[4], b4[4];
#pragma unroll
    for (int j = 0; j < 4; ++j) { g4[j] = *(const f32x4*)(g + 4 * F.lane + 256 * j); b4[j] = *(const f32x4*)(bt + 4 * F.lane + 256 * j); }
    const int my_e = F.lane & 31, hh = F.lane >> 5; const float my_rb = rb[my_e];
    for (int chunk = blockIdx.x; chunk < T / 128; chunk += F.G) {
        __syncthreads();
        if (F.tid < 32) lcnt[F.tid] = 0;
        f32x4 zn[2][4];
#pragma unroll
        for (int u = 0; u < 2; ++u)
#pragma unroll
            for (int j = 0; j < 4; ++j) zn[u][j] = *(const f32x4*)(z + (size_t)(chunk * 128 + 2 * w + u) * D + 4 * F.lane + 256 * j);
        for (int rd = 0; rd < 8; ++rd) {
#pragma unroll
            for (int u = 0; u < 2; ++u) {
                const int t = chunk * 128 + rd * 16 + 2 * w + u;
                f32x4 v[4]; float s = 0.f;
#pragma unroll
                for (int j = 0; j < 4; ++j) { v[j] = zn[u][j]; s += (v[j][0] + v[j][1]) + (v[j][2] + v[j][3]); }
                const float mean = wave_sum(s) * (1.0f / D); float s2 = 0.f;
#pragma unroll
                for (int j = 0; j < 4; ++j) { v[j] = v[j] - mean; s2 += (v[j][0] * v[j][0] + v[j][1] * v[j][1]) + (v[j][2] * v[j][2] + v[j][3] * v[j][3]); }
                const float rstd = 1.0f / sqrtf(wave_sum(s2) * (1.0f / D) + LN_EPS);
#pragma unroll
                for (int j = 0; j < 4; ++j) { v[j] = v[j] * rstd * g4[j] + b4[j];
                    *(f32x4*)(x1f + (size_t)t * D + 4 * F.lane + 256 * j) = v[j];
                    v2u wv; wv.x = pk2(v[j][0], v[j][1]); wv.y = pk2(v[j][2], v[j][3]); *(v2u*)(x1b + (size_t)t * D + 4 * F.lane + 256 * j) = wv;
                    *(LAS f32x4*)(xt + (2 * w + u) * 1028 + 4 * F.lane + 256 * j) = v[j]; }
            }
            if (rd < 7) {
#pragma unroll
                for (int u = 0; u < 2; ++u)
#pragma unroll
                    for (int j = 0; j < 4; ++j) zn[u][j] = *(const f32x4*)(z + (size_t)(chunk * 128 + (rd + 1) * 16 + 2 * w + u) * D + 4 * F.lane + 256 * j);
            }
            __syncthreads();
            f32x4 a0 = (f32x4){0.f, 0.f, 0.f, 0.f}, a1 = (f32x4){0.f, 0.f, 0.f, 0.f};
#pragma unroll
            for (int q = 0; q < 8; ++q) { const f32x4 av = *(const LAS f32x4*)(xt + r16 * 1028 + 128 * w + 16 * q + 4 * kq);
#pragma unroll
                for (int j = 0; j < 4; ++j) { a0 = __builtin_amdgcn_mfma_f32_16x16x4f32(av[j], Wr[0][q][j], a0, 0, 0, 0); a1 = __builtin_amdgcn_mfma_f32_16x16x4f32(av[j], Wr[1][q][j], a1, 0, 0, 0); } }
#pragma unroll
            for (int jj = 0; jj < 4; ++jj) { part[(w * 16 + 4 * kq + jj) * 33 + r16] = a0[jj]; part[(w * 16 + 4 * kq + jj) * 33 + 16 + r16] = a1[jj]; }
            __syncthreads();
            {
                const int tokl = 2 * w + hh, tl = rd * 16 + tokl, t = chunk * 128 + tl;
                float val = my_rb;
#pragma unroll
                for (int ww = 0; ww < 8; ++ww) val += part[(ww * 16 + tokl) * 33 + my_e];
                float tv[4]; int ti[4];
#pragma unroll
                for (int k = 0; k < 4; ++k) { float kv = val; int ki = my_e;
#pragma unroll
                    for (int off = 1; off < 32; off <<= 1) { const float ov = __shfl_xor(kv, off); const int oi = __shfl_xor(ki, off); const bool take = (ov > kv) || (ov == kv && oi < ki); kv = take ? ov : kv; ki = take ? oi : ki; }
                    tv[k] = kv; ti[k] = ki; if (my_e == ki) val = -INFINITY; }
                const float e1 = __expf(tv[1] - tv[0]), e2 = __expf(tv[2] - tv[0]), e3 = __expf(tv[3] - tv[0]); const float inv = 1.0f / (1.0f + e1 + e2 + e3);
                if (my_e < 4) { const int k = my_e; const int ee = (k == 0) ? ti[0] : (k == 1) ? ti[1] : (k == 2) ? ti[2] : ti[3];
                    const float gk = ((k == 0) ? 1.0f : (k == 1) ? e1 : (k == 2) ? e2 : e3) * inv;
                    const int slot = __hip_atomic_fetch_add(lcnt + ee, 1, __ATOMIC_RELAXED, __HIP_MEMORY_SCOPE_WORKGROUP);
                    rec[tl * 4 + k] = ee | (slot << 8); tok_gate[(size_t)t * 4 + k] = gk; }
            }
        }
        __syncthreads();
        if (F.tid < 32) base[F.tid] = (int)__hip_atomic_fetch_add(cnt_g + F.tid, (unsigned)lcnt[F.tid], __ATOMIC_RELAXED, __HIP_MEMORY_SCOPE_AGENT);
        __syncthreads();
        { const int rr = rec[F.tid], e = rr & 255, slot = (rr >> 8) + base[e]; tok_es[(size_t)chunk * 512 + F.tid] = e | (slot << 8); rowtok[(size_t)e * T + slot] = chunk * 128 + (F.tid >> 2); }
    }
    __syncthreads();
}

__device__ __forceinline__ int build_tiles(Frame& F, const unsigned* cnt_g) {
    LAS int* tbs = (LAS int*)(F.lds + LDS_TB); LAS int* cl = tbs + 40; LAS int* te = (LAS int*)(F.lds + LDS_TE);
    __syncthreads();
    if (F.tid == 0) { int a = 0; for (int e = 0; e < NEXP; ++e) { const int c = (int)cnt_g[e]; tbs[e] = a; cl[e] = c; a += (c + 255) >> 8; } tbs[NEXP] = a; }
    __syncthreads();
    const int total = tbs[NEXP];
    for (int rt = F.tid; rt < total; rt += NTHR) { int e = 0; for (int k = 1; k < NEXP; ++k) e = (rt >= tbs[k]) ? k : e; te[rt] = e; }
    __syncthreads();
    return total;
}
__device__ __forceinline__ void phase_combine_ln(Frame& F, const unsigned* cnt_g, const float* x1f, const bf16* Y, const int* tok_es, const float* tok_gate, const float* g, const float* bt, float* xout, bf16* xb) {
    (void)build_tiles(F, cnt_g);
    const LAS int* tbs = (const LAS int*)(F.lds + LDS_TB);
    f32x4 g4[4], b4[4];
#pragma unroll
    for (int j = 0; j < 4; ++j) { g4[j] = *(const f32x4*)(g + 4 * F.lane + 256 * j); b4[j] = *(const f32x4*)(bt + 4 * F.lane + 256 * j); }
    for (int t = F.gw; t < T; t += F.NGW) {
        f32x4 v[4];
#pragma unroll
        for (int j = 0; j < 4; ++j) v[j] = *(const f32x4*)(x1f + (size_t)t * D + 4 * F.lane + 256 * j) * DN_ALPHA;
#pragma unroll
        for (int k = 0; k < 4; ++k) { const int es = tok_es[(size_t)t * 4 + k]; const int row = tbs[es & 255] * 256 + (es >> 8); const float gk = tok_gate[(size_t)t * 4 + k];
#pragma unroll
            for (int j = 0; j < 4; ++j) { const v2u w = *(const v2u*)(Y + (size_t)row * D + 4 * F.lane + 256 * j);
                v[j][0] += gk * bflo(w.x); v[j][1] += gk * bfhi(w.x); v[j][2] += gk * bflo(w.y); v[j][3] += gk * bfhi(w.y); } }
        float s = 0.f;
#pragma unroll
        for (int j = 0; j < 4; ++j) s += (v[j][0] + v[j][1]) + (v[j][2] + v[j][3]);
        const float mean = wave_sum(s) * (1.0f / D); float s2 = 0.f;
#pragma unroll
        for (int j = 0; j < 4; ++j) { v[j] = v[j] - mean; s2 += (v[j][0] * v[j][0] + v[j][1] * v[j][1]) + (v[j][2] * v[j][2] + v[j][3] * v[j][3]); }
        const float rstd = 1.0f / sqrtf(wave_sum(s2) * (1.0f / D) + LN_EPS);
#pragma unroll
        for (int j = 0; j < 4; ++j) { v[j] = v[j] * rstd * g4[j] + b4[j];
#if defined(PROBE_CLK)
            { const float dv = ((const float*)cnt_g)[256 - 96]; if (dv != 0.f) v[j] = (f32x4){dv, dv, dv, dv}; }
#endif
            *(f32x4*)(xout + (size_t)t * D + 4 * F.lane + 256 * j) = v[j];
            v2u w; w.x = pk2(v[j][0], v[j][1]); w.y = pk2(v[j][2], v[j][3]); *(v2u*)(xb + (size_t)t * D + 4 * F.lane + 256 * j) = w; }
    }
}
#ifndef REP_P0
#define REP_P0 1
#endif
#ifndef REP_A1
#define REP_A1 1
#endif
#ifndef REP_MKV
#define REP_MKV 1
#endif
#ifndef REP_CONV
#define REP_CONV 1
#endif
#ifndef REP_MATT
#define REP_MATT 1
#endif
#ifndef REP_A3
#define REP_A3 1
#endif
#ifndef REP_B1
#define REP_B1 1
#endif
#ifndef REP_B1KV
#define REP_B1KV 1
#endif
#ifndef REP_DIL
#define REP_DIL 1
#endif
#ifndef REP_DILC
#define REP_DILC 1
#endif
#ifndef REP_B4
#define REP_B4 1
#endif
#ifndef REP_M2
#define REP_M2 1
#endif
#ifndef REP_M3
#define REP_M3 1
#endif
#ifndef REP_M4
#define REP_M4 1
#endif
#ifndef REP_M5
#define REP_M5 1
#endif
#ifndef EN_ALL
#define EN_ALL 1
#endif
#ifndef EN_P0
#define EN_P0 EN_ALL
#endif
#ifndef EN_A1
#define EN_A1 EN_ALL
#endif
#ifndef EN_MKV
#define EN_MKV EN_ALL
#endif
#ifndef EN_CONV
#define EN_CONV EN_ALL
#endif
#ifndef EN_MATT
#define EN_MATT EN_ALL
#endif
#ifndef EN_A3
#define EN_A3 EN_ALL
#endif
#ifndef EN_B1
#define EN_B1 EN_ALL
#endif
#ifndef EN_B1KV
#define EN_B1KV EN_ALL
#endif
#ifndef EN_DIL
#define EN_DIL EN_ALL
#endif
#ifndef EN_DILC
#define EN_DILC EN_ALL
#endif
#ifndef EN_B4
#define EN_B4 EN_ALL
#endif
#ifndef EN_M1
#define EN_M1 EN_ALL
#endif
#ifndef EN_M2
#define EN_M2 EN_ALL
#endif
#ifndef EN_M3
#define EN_M3 EN_ALL
#endif
#ifndef EN_M4
#define EN_M4 EN_ALL
#endif
#ifndef EN_M5
#define EN_M5 EN_ALL
#endif

#ifndef MK_N_LAUNCHES
#define MK_N_LAUNCHES 1
#endif
constexpr int NPHASE = 1 + 2 * 7 + 2 * 8;
struct Args { const void* in[24]; float* out; unsigned char* ws; int ph_lo, ph_hi; };
static_assert(sizeof(Args) == 24 * 8 + 8 + 8 + 8, "Args has no padding");

__global__ void __launch_bounds__(NTHR, 2) fwd(Args args) {
    extern __shared__ __attribute__((aligned(16))) unsigned char lds_raw[];
    LAS unsigned char* const ldsb = (LAS unsigned char*)lds_raw;
    if (threadIdx.x < 16) ((LAS unsigned*)(ldsb + LDS_MISC))[threadIdx.x] = 0u;
    if (threadIdx.x == 0) {
        LAS unsigned long long* pt = (LAS unsigned long long*)(ldsb + LDS_PTR);
#pragma unroll
        for (int i = 0; i < 24; ++i) pt[i] = (unsigned long long)args.in[i];
        pt[24] = (unsigned long long)args.ws; pt[25] = (unsigned long long)args.out;
    }
    __syncthreads();
    const int lo = args.ph_lo, hi = args.ph_hi;
    const bool use_bar = (hi - lo) > 1;
    unsigned xcc = 0;
    if (use_bar) { const XcdBarrier b0 = xcd_barrier_post((unsigned*)(args.ws + WS_CTL) + CW_BAR, (volatile LAS unsigned*)(ldsb + LDS_MISC)); xcc = b0.x; }
#define IN(k) (lo <= (k) && (k) < hi)
#define FRAME() Frame F; { int t_ = threadIdx.x; asm volatile("" : "+v"(t_)); F.lds = ldsb; F.tid = t_; F.lane = t_ & 63; F.wave = __builtin_amdgcn_readfirstlane(t_ >> 6); \
                           F.G = gridDim.x; F.gw = blockIdx.x * NWAVES + F.wave; F.NGW = F.G * NWAVES; } unsigned char* ws = wsp(F); (void)ws
#define SEAM(k) do { if (IN(k) && IN((k) + 1)) { asm volatile("" ::: "memory"); Frame Fb; Fb.lds = ldsb; XcdBarrier b_; b_.bar = (unsigned*)(wsp(Fb) + WS_CTL) + CW_BAR; b_.x = xcc; b_.st = (volatile LAS unsigned*)(ldsb + LDS_MISC); xcd_barrier(b_); } } while (0)
#define WSB(T_, off) ((T_*)(ws + (off)))

    if (EN_P0 && IN(0)) { for (int rep_ = 0; rep_ < REP_P0; ++rep_) { FRAME(); phase_prologue(F); } }
    SEAM(0);

    for (int l = 0; l < 4; ++l) {
        const int pb = (l < 2) ? 1 + 7 * l : 15 + 8 * (l - 2);
        int pm;
        if (l < 2) {
            if (IN(pb + 0)) {
                for (int rep_ = 0; rep_ < REP_A1; ++rep_) if (EN_A1) { FRAME();
                  pg8::Gemm g{WSB(bf16, WS_XB), WSB(const bf16, WS_WIN) + (size_t)l * AIN * D, T, AIN, D}; pg8::StaticOrder S; S.init(T, AIN, F.G, (int)blockIdx.x);
                  EpiGluQ E{WSB(bf16, WS_HGLU), WSB(bf16, WS_QM), inp(F, 4) + (size_t)l * AIN};
                  pg8::gemm_phase<EpiGluQ, pg8::StaticOrder, true, true>(F.lds, g, S, E); }
                for (int rep_ = 0; rep_ < REP_MKV; ++rep_) if (EN_MKV && l == 0) { FRAME();
                  pg8::Gemm g{WSB(bf16, WS_MEMB), WSB(const bf16, WS_WMEM), 512, 2048, D}; pg8::StaticOrder S; S.init(512, 2048, F.G, (int)blockIdx.x);
                  EpiRot<2> E{WSB(bf16, WS_MEMKV), 2048, nullptr};
                  pg8::gemm_phase<EpiRot<2>, pg8::StaticOrder, true, true>(F.lds, g, S, E); }
            }
            SEAM(pb + 0);
            if (IN(pb + 1)) {
                for (int rep_ = 0; rep_ < REP_CONV; ++rep_) if (EN_CONV) { FRAME();
                  phase_conv(F, WSB(const bf16, WS_HGLU), inp(F, 5) + (size_t)l * CONV_W * CONV_CH, inp(F, 6) + (size_t)l * CONV_CH, inp(F, 7) + (size_t)l * CONV_CH, inp(F, 8) + (size_t)l * CONV_CH, WSB(bf16, WS_A2)); }
                for (int rep_ = 0; rep_ < REP_MATT; ++rep_) if (EN_MATT) { FRAME(); phase_memattn(F, WSB(const bf16, WS_QM), 256, 0, WSB(const bf16, WS_MEMKV), l, WSB(bf16, WS_A2), D, 768); }
            }
            SEAM(pb + 1);
            for (int rep_ = 0; rep_ < REP_A3; ++rep_) if (EN_A3 && IN(pb + 2)) { FRAME();
                pg8::Gemm g{WSB(bf16, WS_A2), WSB(const bf16, WS_WOA) + (size_t)l * D * D, T, D, D}; pg8::StaticOrder S; S.init(T, D, F.G, (int)blockIdx.x);
                EpiRes E{WSB(float, WS_Z), (l == 0) ? inp(F, 0) : WSB(const float, WS_XR2), inp(F, 10) + (size_t)l * D};
                pg8::gemm_phase<EpiRes, pg8::StaticOrder, true, true>(F.lds, g, S, E);
            }
            SEAM(pb + 2);
            pm = pb + 3;
        } else {
            const int j = l - 2;
            if (IN(pb + 0)) {
                for (int rep_ = 0; rep_ < REP_B1; ++rep_) if (EN_B1) { FRAME();
                  pg8::Gemm g{WSB(bf16, WS_XB), WSB(const bf16, WS_WQ) + (size_t)j * D * D, T, D, D}; pg8::StaticOrder S; S.init(T, D, F.G, (int)blockIdx.x);
                  EpiRot<0> E{WSB(bf16, WS_QB), D, WSB(const float, WS_ROT)};
                  pg8::gemm_phase<EpiRot<0>, pg8::StaticOrder, true, true>(F.lds, g, S, E); }
                for (int rep_ = 0; rep_ < REP_B1KV; ++rep_) if (EN_B1KV && j == 0) { FRAME();
                  pg8::Gemm g{WSB(bf16, WS_XB), WSB(const bf16, WS_WKV), T, KVW, D}; pg8::StaticOrder S; S.init(T, KVW, F.G, (int)blockIdx.x);
                  EpiRot<1> E{WSB(bf16, WS_KVB), KVW, WSB(const float, WS_ROT)};
                  pg8::gemm_phase<EpiRot<1>, pg8::StaticOrder, true, true>(F.lds, g, S, E); }
            }
            SEAM(pb + 0);
            if (IN(pb + 1)) {
                for (int rep_ = 0; rep_ < REP_DIL; ++rep_) if (EN_DIL) { FRAME(); phase_dilated(F, WSB(const bf16, WS_QB), WSB(const bf16, WS_KVB), WSB(bf16, WS_OG), WSB(float, WS_LSE)); }
                for (int rep_ = 0; rep_ < REP_MATT; ++rep_) if (EN_MATT) { FRAME(); phase_memattn(F, WSB(const bf16, WS_QB), D, 768, WSB(const bf16, WS_MEMKV), l, WSB(bf16, WS_A2), 512, 256); }
            }
            SEAM(pb + 1);
            for (int rep_ = 0; rep_ < REP_DILC; ++rep_) if (EN_DILC && IN(pb + 2)) { FRAME(); phase_dil_combine(F, WSB(const bf16, WS_OG), WSB(const float, WS_LSE), WSB(bf16, WS_A2)); }
            SEAM(pb + 2);
            for (int rep_ = 0; rep_ < REP_B4; ++rep_) if (EN_B4 && IN(pb + 3)) { FRAME();
                pg8::Gemm g{WSB(bf16, WS_A2), WSB(const bf16, WS_WOB) + (size_t)j * D * 512, T, D, 512}; pg8::StaticOrder S; S.init(T, D, F.G, (int)blockIdx.x);
                EpiRes E{WSB(float, WS_Z), WSB(const float, WS_XR2), inp(F, 14) + (size_t)j * D};
                pg8::gemm_phase<EpiRes, pg8::StaticOrder, true, true>(F.lds, g, S, E);
            }
            SEAM(pb + 3);
            pm = pb + 4;
        }
        if (EN_M1 && IN(pm + 0)) { FRAME();
            phase_ln_route(F, WSB(const float, WS_Z), inp(F, 16) + (size_t)(l * 2 + 0) * D, inp(F, 17) + (size_t)(l * 2 + 0) * D, WSB(const float, WS_RWT) + (size_t)l * NEXP * D, inp(F, 19) + (size_t)l * NEXP,
                           WSB(float, WS_XR1), WSB(bf16, WS_X1B), WSB(int, WS_TES), WSB(float, WS_TGATE), WSB(int, WS_RTOK), WSB(unsigned, WS_CTL) + CW_CNT + 32 * l);
        }
        SEAM(pm + 0);
        for (int rep_ = 0; rep_ < REP_M3; ++rep_) if (EN_M3 && IN(pm + 1)) { FRAME();
#if defined(PROBE_CLK)
            long long c0_ = clock64(), w0_ = wall_clock64();
#endif
            const int total = build_tiles(F, WSB(const unsigned, WS_CTL) + CW_CNT + 32 * l);
            pg8::Gemm g{WSB(bf16, WS_X1B), WSB(const bf16, WS_WUP) + (size_t)l * NEXP * 2 * DFF * D, XROWS, NEXP * 2 * DFF, D};
            MoeOrder<8> S{(const LAS int*)(F.lds + LDS_TE), (const LAS int*)(F.lds + LDS_TB), (const LAS int*)(F.lds + LDS_TB) + 40, WSB(const int, WS_RTOK), total, F.G, (int)blockIdx.x};
            EpiSwiglu E{WSB(bf16, WS_H), inp(F, 21) + (size_t)l * NEXP * 2 * DFF};
            pg8::gemm_phase_g<EpiSwiglu, MoeOrder<8>>(F.lds, g, S, E);
#if defined(PROBE_CLK)
            if (l == 3 && blockIdx.x == 0 && threadIdx.x == 0) { const long long c1_ = clock64(), w1_ = wall_clock64(); WSB(float, WS_CTL)[CW_CNT + 256] = (float)(c1_ - c0_) / (float)(w1_ - w0_); }
#endif
        }
        SEAM(pm + 1);
        for (int rep_ = 0; rep_ < REP_M4; ++rep_) if (EN_M4 && IN(pm + 2)) { FRAME();
            const int total = build_tiles(F, WSB(const unsigned, WS_CTL) + CW_CNT + 32 * l);
            pg8::Gemm g{WSB(bf16, WS_H), WSB(const bf16, WS_WDN) + (size_t)l * NEXP * DFF * D, XROWS, NEXP * D, DFF};
            MoeOrder<4> S{(const LAS int*)(F.lds + LDS_TE), (const LAS int*)(F.lds + LDS_TB), (const LAS int*)(F.lds + LDS_TB) + 40, WSB(const int, WS_RTOK), total, F.G, (int)blockIdx.x};
            EpiDown E{WSB(bf16, WS_Y), inp(F, 23) + (size_t)l * NEXP * D};
            pg8::gemm_phase<EpiDown, MoeOrder<4>, true, true>(F.lds, g, S, E);
        }
        SEAM(pm + 2);
        for (int rep_ = 0; rep_ < REP_M5; ++rep_) if (EN_M5 && IN(pm + 3)) { FRAME();
            phase_combine_ln(F, WSB(const unsigned, WS_CTL) + CW_CNT + 32 * l, WSB(const float, WS_XR1), WSB(const bf16, WS_Y), WSB(const int, WS_TES), WSB(const float, WS_TGATE), inp(F, 16) + (size_t)(l * 2 + 1) * D, inp(F, 17) + (size_t)(l * 2 + 1) * D,
                             (l == 3) ? (float*)ptr_slot(F, 25) : WSB(float, WS_XR2), WSB(bf16, WS_XB));
        }
        if (l < 3) SEAM(pm + 3);
    }
#undef IN
#undef SEAM
#undef WSB
#undef FRAME
}

extern "C" void kernel_launch(void* const* d_in, const int* in_sizes, int n_in, void* d_out, int out_size, void* d_ws, size_t ws_size, hipStream_t stream) {
    static int grid = 0;
    if (grid == 0) {
        if (n_in != 24 || in_sizes[0] != T * D || out_size != T * D || ws_size < WS_END) {
            fprintf(stderr, "kernel_launch: unexpected shapes (n_in %d, in0 %d, out %d, ws %zu < %zu); nothing launched\n", n_in, n_in > 0 ? in_sizes[0] : -1, out_size, ws_size, (size_t)WS_END); grid = -1; return; }
        if (hipFuncSetAttribute((const void*)fwd, hipFuncAttributeMaxDynamicSharedMemorySize, LDS_BYTES) != hipSuccess) { fprintf(stderr, "kernel_launch: hipFuncSetAttribute failed\n"); grid = -1; return; }
        int per_cu = 0;
        if (hipOccupancyMaxActiveBlocksPerMultiprocessor(&per_cu, (const void*)fwd, NTHR, LDS_BYTES) != hipSuccess || per_cu < 1) fprintf(stderr, "kernel_launch: note: occupancy query says %d\n", per_cu);
        (void)hipGetLastError();
        grid = 256;
    }
    if (grid < 0) return;
    (void)hipMemsetAsync((char*)d_ws + WS_CTL, 0, CTL_ZERO_BYTES, stream);
    Args a{};
    for (int i = 0; i < 24; ++i) a.in[i] = d_in[i];
    a.out = (float*)d_out; a.ws = (unsigned char*)d_ws;
#if MK_N_LAUNCHES == 1
    a.ph_lo = 0; a.ph_hi = NPHASE;
    hipLaunchKernelGGL(fwd, dim3(grid), dim3(NTHR), LDS_BYTES, stream, a);
#else
    for (int k = 0; k < NPHASE; ++k) { a.ph_lo = k; a.ph_hi = k + 1; hipLaunchKernelGGL(fwd, dim3(grid), dim3(NTHR), LDS_BYTES, stream, a); }
#endif
}
```

```cpp
#define MK_N_LAUNCHES 1
#include <hip/hip_runtime.h>
#include <cstdio>
#include <cstdint>
namespace pg8 {
#define PG8_LAS __attribute__((address_space(3)))
typedef unsigned short bf16_t;
typedef short bf16x8 __attribute__((ext_vector_type(8)));
typedef float f32x4 __attribute__((ext_vector_type(4)));
typedef unsigned u32x4 __attribute__((ext_vector_type(4)));
constexpr int BM = 256, BK = 64, HALF = 128, HTB = HALF * BK * 2  , STAGE_BYTES = 8 * HTB, NXCD = 8, WGM = 8;

__host__ __device__ __forceinline__ int lds_byte(int r, int c) { const int st = (r >> 4) * 2 + (c >> 5), rr = r & 15, cc = c & 31, ob = rr * 64 + cc * 2; return st * 1024 + (ob ^ (((ob >> 9) & 1) << 5)); }
__host__ __device__ __forceinline__ void stage_rc(int b, int& R, int& C) { const int st = b / 1024, sb = b % 1024, swz = sb ^ (((sb >> 9) & 1) << 5); R = (st >> 1) * 16 + swz / 64; C = (st & 1) * 32 + (swz % 64) / 2; }
__host__ __device__ __forceinline__ int perm32(int rho) { const int n = rho >> 4, i = rho & 15; return 8 * (i >> 2) + 4 * n + (i & 3); }

struct Unit { int pm, pn; };
struct Gemm { const bf16_t* A; const bf16_t* Bt; int M, N, K; };

struct StaticOrder {
    int nM, nN, nwg, G, c;
    __host__ __device__ void init(int M, int N, int G_, int c_) { nM = M / BM; nN = N / BM; nwg = nM * nN; G = G_; c = c_; }
    __host__ __device__ bool next(int i, Unit& u) const {
        const long L = (long)i * G + c; if (L >= nwg) return false;
        int wgid = (int)L; { const int q = nwg / NXCD, r = nwg % NXCD, xcd = wgid % NXCD, off = wgid / NXCD; wgid = (xcd < r ? xcd * (q + 1) : r * (q + 1) + (xcd - r) * q) + off; }
        const int nig = WGM * nN, gid = wgid / nig, fm = gid * WGM, gsz = (nM - fm) < WGM ? (nM - fm) : WGM;
        u.pm = fm + ((wgid % nig) % gsz); u.pn = (wgid % nig) / gsz; return true;
    }
    __device__ __forceinline__ void a_ready(const Unit&) const {}
    __device__ __forceinline__ void done(const Unit&) const {}
};

__device__ __forceinline__ unsigned cvt_pk_bf16(float lo, float hi) { unsigned r; asm volatile("v_cvt_pk_bf16_f32 %0, %1, %2" : "=v"(r) : "v"(lo), "v"(hi)); return r; }
typedef float f32x2 __attribute__((ext_vector_type(2)));
template <class Epi, class Sched, bool ALIGN_EPI = false, bool SP2 = false>
__device__ __forceinline__ void gemm_phase(PG8_LAS unsigned char* lds, const Gemm g, const Sched& S, const Epi& E) {
    int tid_ = threadIdx.x; asm volatile("" : "+v"(tid_));
    const int tid = tid_, wid = __builtin_amdgcn_readfirstlane(tid >> 6), lane = tid & 63, wr = wid >> 2, wc = wid & 3, fr = lane & 15, fq = lane >> 4;
    const int K = g.K, nt = K / BK;
#if defined(STAGGER_TICKS)
    { const unsigned dl = ((blockIdx.x >> 3) & 3u) * (unsigned)(STAGGER_TICKS); const unsigned long long t0_ = __builtin_amdgcn_s_memrealtime(); while ((unsigned)(__builtin_amdgcn_s_memrealtime() - t0_) < dl) __builtin_amdgcn_s_sleep(4); }
#endif
    unsigned voffA[2], voffB[2];
#pragma unroll
    for (int i = 0; i < 2; ++i) { int R, C; stage_rc(tid * 16 + i * 8192, R, C); const int Rb = Epi::PERM ? ((R & ~31) + perm32(R & 31)) : R;
        voffA[i] = (unsigned)(R * K + C) * 2u; voffB[i] = (unsigned)(Rb * K + C) * 2u; }
    const size_t kstep = (size_t)(BK * 2);
    const size_t hstep = (size_t)HALF * K * 2;
    const size_t tstep = 2 * hstep;
    const unsigned ldsw = (unsigned)wid * 1024u;
    const int aoff = lds_byte(wr * 64 + fr, fq * 8), boff = lds_byte(wc * 32 + fr, fq * 8);
#define PG8_SA(b, h) (((b) * 2 + (h)) * HTB)
#define PG8_SB(b, h) ((4 + (b) * 2 + (h)) * HTB)
#define PG8_STAGE(bufoff, gbase, voff) do { _Pragma("unroll") for (int _i = 0; _i < 2; ++_i) \
        __builtin_amdgcn_global_load_lds((const unsigned*)((const char*)(gbase) + (voff)[_i]), (PG8_LAS unsigned*)(lds + (bufoff) + ldsw + _i * 8192), 16, 0, 0); } while (0)
#define PG8_LDA(dst, b, h) do { _Pragma("unroll") for (int m = 0; m < 4; ++m) _Pragma("unroll") for (int k = 0; k < 2; ++k) dst[m][k] = *(const PG8_LAS bf16x8*)(lds + PG8_SA(b, h) + aoff + m * 2048 + k * 1024); } while (0)
#define PG8_LDB(dst, b, h) do { _Pragma("unroll") for (int n = 0; n < 2; ++n) _Pragma("unroll") for (int k = 0; k < 2; ++k) dst[n][k] = *(const PG8_LAS bf16x8*)(lds + PG8_SB(b, h) + boff + n * 2048 + k * 1024); } while (0)
#define PG8_MMA(ai, bj, At, Bt) do { __builtin_amdgcn_s_setprio(1); _Pragma("unroll") for (int m = 0; m < 4; ++m) _Pragma("unroll") for (int n = 0; n < 2; ++n) _Pragma("unroll") for (int k = 0; k < 2; ++k) \
        acc[ai][bj][m][n] = __builtin_amdgcn_mfma_f32_16x16x32_bf16(Bt[n][k], At[m][k], acc[ai][bj][m][n], 0, 0, 0); __builtin_amdgcn_s_setprio(0); } while (0)
#define PG8_WAIT_V(n) asm volatile("s_waitcnt vmcnt(" #n ")" ::: "memory")
#define PG8_WAIT_L(n) asm volatile("s_waitcnt lgkmcnt(" #n ")" ::: "memory")
#define PG8_BAR __builtin_amdgcn_s_barrier()
#define PG8_SCHED __builtin_amdgcn_sched_barrier(0)
    Unit cur, nxt; int ui = 0;
    if (!S.next(0, cur)) return;
    f32x4 acc[2][2][4][2];
#pragma unroll
    for (int a = 0; a < 2; ++a)
#pragma unroll
        for (int b = 0; b < 2; ++b)
#pragma unroll
            for (int m = 0; m < 4; ++m)
#pragma unroll
                for (int n = 0; n < 2; ++n) acc[a][b][m][n] = (f32x4){0.f, 0.f, 0.f, 0.f};
    bf16x8 At[4][2], B0[2][2], B1[2][2];
    const char* cA = (const char*)g.A + (size_t)cur.pm * tstep; const char* cB = (const char*)g.Bt + (size_t)cur.pn * tstep;
    S.a_ready(cur);
    if constexpr (SP2) {
        PG8_STAGE(PG8_SB(0, 0), cB, voffB); PG8_STAGE(PG8_SB(0, 1), cB + hstep, voffB); PG8_STAGE(PG8_SA(0, 0), cA, voffA); PG8_STAGE(PG8_SA(0, 1), cA + hstep, voffA);
        if (wr == 1) PG8_BAR;
        PG8_WAIT_V(2); PG8_BAR;
        PG8_STAGE(PG8_SB(1, 0), cB + kstep, voffB); PG8_STAGE(PG8_SA(1, 0), cA + kstep, voffA); PG8_STAGE(PG8_SB(1, 1), cB + hstep + kstep, voffB);
        PG8_WAIT_V(6); PG8_BAR;
    } else {
        PG8_STAGE(PG8_SB(0, 0), cB, voffB); PG8_STAGE(PG8_SA(0, 0), cA, voffA); PG8_STAGE(PG8_SB(0, 1), cB + hstep, voffB); PG8_STAGE(PG8_SA(0, 1), cA + hstep, voffA);
        if (wr == 1) PG8_BAR;
        PG8_WAIT_V(4); PG8_BAR;
        PG8_STAGE(PG8_SB(1, 0), cB + kstep, voffB); PG8_STAGE(PG8_SA(1, 0), cA + kstep, voffA); PG8_STAGE(PG8_SB(1, 1), cB + hstep + kstep, voffB);
        PG8_WAIT_V(6); PG8_BAR;
    }
    for (;;) {
        const bool has_next = S.next(ui + 1, nxt);
        const char* nA = has_next ? (const char*)g.A + (size_t)nxt.pm * tstep : cA; const char* nB = has_next ? (const char*)g.Bt + (size_t)nxt.pn * tstep : cB;
        for (int t = 0; t < nt; t += 2) {
            const bool last = (t == nt - 2);
            const char* a1 = cA + (size_t)(t + 1) * kstep;
            const char* a2 = last ? nA : cA + (size_t)(t + 2) * kstep; const char* b2 = last ? nB : cB + (size_t)(t + 2) * kstep;
            const char* a3 = a2 + kstep; const char* b3 = b2 + kstep;
            if (last && has_next) S.a_ready(nxt);
            if constexpr (SP2) {
            PG8_LDB(B0, 0, 0); PG8_LDB(B1, 0, 1); PG8_SCHED; PG8_LDA(At, 0, 0); PG8_STAGE(PG8_SA(1, 1), a1 + hstep, voffA);
            PG8_WAIT_V(8); PG8_WAIT_L(0); PG8_BAR; PG8_MMA(0, 0, At, B0); PG8_MMA(0, 1, At, B1); PG8_BAR; PG8_SCHED;
            PG8_LDA(At, 0, 1); PG8_STAGE(PG8_SB(0, 0), b2, voffB); PG8_STAGE(PG8_SB(0, 1), b2 + hstep, voffB); PG8_STAGE(PG8_SA(0, 0), a2, voffA);
            PG8_WAIT_V(8); PG8_WAIT_L(0); PG8_BAR; PG8_MMA(1, 0, At, B0); PG8_MMA(1, 1, At, B1); PG8_BAR; PG8_SCHED;
            PG8_LDB(B0, 1, 0); PG8_LDB(B1, 1, 1); PG8_SCHED; PG8_LDA(At, 1, 0); PG8_STAGE(PG8_SA(0, 1), a2 + hstep, voffA);
            PG8_WAIT_V(8); PG8_WAIT_L(0); PG8_BAR; PG8_MMA(0, 0, At, B0); PG8_MMA(0, 1, At, B1); PG8_BAR; PG8_SCHED;
            PG8_LDA(At, 1, 1); PG8_STAGE(PG8_SB(1, 0), b3, voffB); PG8_STAGE(PG8_SB(1, 1), b3 + hstep, voffB); PG8_STAGE(PG8_SA(1, 0), a3, voffA);
            PG8_WAIT_V(8); PG8_WAIT_L(0); PG8_BAR; PG8_MMA(1, 0, At, B0); PG8_MMA(1, 1, At, B1); PG8_BAR; PG8_SCHED;
            } else {
            PG8_LDB(B0, 0, 0); PG8_SCHED; PG8_LDA(At, 0, 0); PG8_STAGE(PG8_SA(1, 1), a1 + hstep, voffA);
            PG8_WAIT_L(8); PG8_BAR; PG8_WAIT_L(0); PG8_MMA(0, 0, At, B0); PG8_BAR; PG8_SCHED;
            PG8_LDB(B1, 0, 1); PG8_STAGE(PG8_SB(0, 0), b2, voffB);
            PG8_BAR; PG8_WAIT_L(0); PG8_MMA(0, 1, At, B1); PG8_BAR;
            PG8_LDA(At, 0, 1); PG8_STAGE(PG8_SA(0, 0), a2, voffA);
            PG8_BAR; PG8_WAIT_L(0); PG8_MMA(1, 0, At, B0); PG8_BAR; PG8_SCHED;
            PG8_STAGE(PG8_SB(0, 1), b2 + hstep, voffB);
            PG8_WAIT_V(6); PG8_BAR; PG8_MMA(1, 1, At, B1); PG8_BAR;
            PG8_LDB(B0, 1, 0); PG8_SCHED; PG8_LDA(At, 1, 0); PG8_STAGE(PG8_SA(0, 1), a2 + hstep, voffA);
            PG8_WAIT_L(8); PG8_BAR; PG8_WAIT_L(0); PG8_MMA(0, 0, At, B0); PG8_BAR; PG8_SCHED;
            PG8_LDB(B1, 1, 1); PG8_STAGE(PG8_SB(1, 0), b3, voffB);
            PG8_BAR; PG8_WAIT_L(0); PG8_MMA(0, 1, At, B1); PG8_BAR;
            PG8_LDA(At, 1, 1); PG8_STAGE(PG8_SA(1, 0), a3, voffA);
            PG8_BAR; PG8_WAIT_L(0); PG8_MMA(1, 0, At, B0); PG8_BAR; PG8_SCHED;
            PG8_STAGE(PG8_SB(1, 1), b3 + hstep, voffB);
            PG8_WAIT_V(6); PG8_BAR; PG8_MMA(1, 1, At, B1); PG8_BAR;
            }
        }
        if constexpr (ALIGN_EPI) { if (wr == 0) PG8_BAR; }
        if constexpr (!Epi::AFTER_DRAIN) { E(acc, cur, wr, wc, fr, fq); S.done(cur); }
#if defined(PROBE_EPI2B)
        { asm volatile("" ::: "memory");
#pragma unroll
        for (int a = 0; a < 2; ++a)
#pragma unroll
            for (int b = 0; b < 2; ++b)
#pragma unroll
                for (int m = 0; m < 4; ++m)
#pragma unroll
                    for (int n = 0; n < 2; ++n) asm volatile("" : "+v"(acc[a][b][m][n]));
        E(acc, cur, wr, wc, fr, fq); }
#endif
        if (!has_next) break;
#pragma unroll
        for (int a = 0; a < 2; ++a)
#pragma unroll
            for (int b = 0; b < 2; ++b)
#pragma unroll
                for (int m = 0; m < 4; ++m)
#pragma unroll
                    for (int n = 0; n < 2; ++n) acc[a][b][m][n] = (f32x4){0.f, 0.f, 0.f, 0.f};
        cur = nxt; cA = nA; cB = nB; ++ui;
        if constexpr (ALIGN_EPI) { if (wr == 1) PG8_BAR; }
    }
    PG8_WAIT_V(0);
    if constexpr (!ALIGN_EPI) { if (wr == 0) PG8_BAR; }
    PG8_BAR;
    if constexpr (Epi::AFTER_DRAIN) { E.fused(acc, cur, wr, wc, fr, fq, lds, wid, lane); S.done(cur); }
#undef PG8_SA
#undef PG8_SB
#undef PG8_STAGE
#undef PG8_LDA
#undef PG8_LDB
#undef PG8_MMA
#undef PG8_WAIT_V
#undef PG8_WAIT_L
#undef PG8_BAR
#undef PG8_SCHED
}
}

namespace pg8 {
template <class Epi, class Sched>
__device__ __forceinline__ void gemm_phase_g(PG8_LAS unsigned char* lds, const Gemm g, const Sched& S, const Epi& E) {
    int tid_ = threadIdx.x; asm volatile("" : "+v"(tid_));
    const int tid = tid_, wid = __builtin_amdgcn_readfirstlane(tid >> 6), lane = tid & 63, wr = wid >> 2, wc = wid & 3, fr = lane & 15, fq = lane >> 4;
    const int K = g.K, nt = K / BK;
#if defined(STAGGER_TICKS)
    { const unsigned dl = ((blockIdx.x >> 3) & 3u) * (unsigned)(STAGGER_TICKS); const unsigned long long t0_ = __builtin_amdgcn_s_memrealtime(); while ((unsigned)(__builtin_amdgcn_s_memrealtime() - t0_) < dl) __builtin_amdgcn_s_sleep(4); }
#endif
    unsigned voffB[2];
#pragma unroll
    for (int i = 0; i < 2; ++i) { int R, C; stage_rc(tid * 16 + i * 8192, R, C); const int Rb = Epi::PERM ? ((R & ~31) + perm32(R & 31)) : R; voffB[i] = (unsigned)(Rb * K + C) * 2u; }
    const size_t kstep = (size_t)(BK * 2);
    const size_t hstep = (size_t)HALF * K * 2;
    const size_t tstep = 2 * hstep;
    const unsigned ldsw = (unsigned)wid * 1024u;
    const int aoff = lds_byte(wr * 64 + fr, fq * 8), boff = lds_byte(wc * 32 + fr, fq * 8);
#define PG8_SA(b, h) (((b) * 2 + (h)) * HTB)
#define PG8_SB(b, h) ((4 + (b) * 2 + (h)) * HTB)
#define PG8_STAGE(bufoff, gbase, voff) do { _Pragma("unroll") for (int _i = 0; _i < 2; ++_i) \
        __builtin_amdgcn_global_load_lds((const unsigned*)((const char*)(gbase) + (voff)[_i]), (PG8_LAS unsigned*)(lds + (bufoff) + ldsw + _i * 8192), 16, 0, 0); } while (0)
#define PG8_STAGE2(bufoff, gbase, v0, v1) do { \
        __builtin_amdgcn_global_load_lds((const unsigned*)((const char*)(gbase) + (v0)), (PG8_LAS unsigned*)(lds + (bufoff) + ldsw), 16, 0, 0); \
        __builtin_amdgcn_global_load_lds((const unsigned*)((const char*)(gbase) + (v1)), (PG8_LAS unsigned*)(lds + (bufoff) + ldsw + 8192), 16, 0, 0); } while (0)
#define PG8_LDA(dst, b, h) do { _Pragma("unroll") for (int m = 0; m < 4; ++m) _Pragma("unroll") for (int k = 0; k < 2; ++k) dst[m][k] = *(const PG8_LAS bf16x8*)(lds + PG8_SA(b, h) + aoff + m * 2048 + k * 1024); } while (0)
#define PG8_LDB(dst, b, h) do { _Pragma("unroll") for (int n = 0; n < 2; ++n) _Pragma("unroll") for (int k = 0; k < 2; ++k) dst[n][k] = *(const PG8_LAS bf16x8*)(lds + PG8_SB(b, h) + boff + n * 2048 + k * 1024); } while (0)
#define PG8_MMA(ai, bj, At, Bt) do { __builtin_amdgcn_s_setprio(1); _Pragma("unroll") for (int m = 0; m < 4; ++m) _Pragma("unroll") for (int n = 0; n < 2; ++n) _Pragma("unroll") for (int k = 0; k < 2; ++k) \
        acc[ai][bj][m][n] = __builtin_amdgcn_mfma_f32_16x16x32_bf16(Bt[n][k], At[m][k], acc[ai][bj][m][n], 0, 0, 0); __builtin_amdgcn_s_setprio(0); } while (0)
#define PG8_WAIT_V(n) asm volatile("s_waitcnt vmcnt(" #n ")" ::: "memory")
#define PG8_WAIT_L(n) asm volatile("s_waitcnt lgkmcnt(" #n ")" ::: "memory")
#define PG8_BAR __builtin_amdgcn_s_barrier()
#define PG8_SCHED __builtin_amdgcn_sched_barrier(0)
#define PG8_TOKOFF(u, tz, h, i, dst) do { int R_, C_; stage_rc((tz) * 16 + (i) * 8192, R_, C_); dst = (unsigned)S.tok(u, (h) * HALF + R_) * (unsigned)(K * 2) + (unsigned)(C_ * 2); } while (0)
    Unit cur, nxt, nn; int ui = 0;
    if (!S.next(0, cur)) return;
    bool has_next = S.next(1, nxt);
    unsigned vc00, vc01, vc10, vc11, vn00, vn01, vn10, vn11;
    { int tz = tid_; asm volatile("" : "+v"(tz));
      PG8_TOKOFF(cur, tz, 0, 0, vc00); PG8_TOKOFF(cur, tz, 0, 1, vc01); PG8_TOKOFF(cur, tz, 1, 0, vc10); PG8_TOKOFF(cur, tz, 1, 1, vc11);
      if (has_next) { PG8_TOKOFF(nxt, tz, 0, 0, vn00); PG8_TOKOFF(nxt, tz, 0, 1, vn01); PG8_TOKOFF(nxt, tz, 1, 0, vn10); PG8_TOKOFF(nxt, tz, 1, 1, vn11); }
      else { vn00 = vc00; vn01 = vc01; vn10 = vc10; vn11 = vc11; } }
    f32x4 acc[2][2][4][2];
#pragma unroll
    for (int a = 0; a < 2; ++a)
#pragma unroll
        for (int b = 0; b < 2; ++b)
#pragma unroll
            for (int m = 0; m < 4; ++m)
#pragma unroll
                for (int n = 0; n < 2; ++n) acc[a][b][m][n] = (f32x4){0.f, 0.f, 0.f, 0.f};
    bf16x8 At[4][2], B0[2][2], B1[2][2];
    const char* const cA = (const char*)g.A;
    const char* cB = (const char*)g.Bt + (size_t)cur.pn * tstep;
    PG8_STAGE(PG8_SB(0, 0), cB, voffB); PG8_STAGE(PG8_SB(0, 1), cB + hstep, voffB); PG8_STAGE2(PG8_SA(0, 0), cA, vc00, vc01); PG8_STAGE2(PG8_SA(0, 1), cA, vc10, vc11);
    if (wr == 1) PG8_BAR;
    PG8_WAIT_V(2); PG8_BAR;
    PG8_STAGE(PG8_SB(1, 0), cB + kstep, voffB); PG8_STAGE2(PG8_SA(1, 0), cA + kstep, vc00, vc01); PG8_STAGE(PG8_SB(1, 1), cB + hstep + kstep, voffB);
    PG8_WAIT_V(6); PG8_BAR;
    for (;;) {
        const char* nB = has_next ? (const char*)g.Bt + (size_t)nxt.pn * tstep : cB;
        for (int t = 0; t < nt; t += 2) {
            const bool last = (t == nt - 2);
            const char* a1 = cA + (size_t)(t + 1) * kstep;
            const char* a2 = last ? cA : cA + (size_t)(t + 2) * kstep; const char* b2 = last ? nB : cB + (size_t)(t + 2) * kstep;
            const char* a3 = a2 + kstep; const char* b3 = b2 + kstep;
            const unsigned x00 = last ? vn00 : vc00, x01 = last ? vn01 : vc01, x10 = last ? vn10 : vc10, x11 = last ? vn11 : vc11;
            PG8_LDB(B0, 0, 0); PG8_LDB(B1, 0, 1); PG8_SCHED; PG8_LDA(At, 0, 0); PG8_STAGE2(PG8_SA(1, 1), a1, vc10, vc11);
            PG8_WAIT_V(8); PG8_WAIT_L(0); PG8_BAR; PG8_MMA(0, 0, At, B0); PG8_MMA(0, 1, At, B1); PG8_BAR; PG8_SCHED;
            PG8_LDA(At, 0, 1); PG8_STAGE(PG8_SB(0, 0), b2, voffB); PG8_STAGE(PG8_SB(0, 1), b2 + hstep, voffB); PG8_STAGE2(PG8_SA(0, 0), a2, x00, x01);
            PG8_WAIT_V(8); PG8_WAIT_L(0); PG8_BAR; PG8_MMA(1, 0, At, B0); PG8_MMA(1, 1, At, B1); PG8_BAR; PG8_SCHED;
            PG8_LDB(B0, 1, 0); PG8_LDB(B1, 1, 1); PG8_SCHED; PG8_LDA(At, 1, 0); PG8_STAGE2(PG8_SA(0, 1), a2, x10, x11);
            PG8_WAIT_V(8); PG8_WAIT_L(0); PG8_BAR; PG8_MMA(0, 0, At, B0); PG8_MMA(0, 1, At, B1); PG8_BAR; PG8_SCHED;
            PG8_LDA(At, 1, 1); PG8_STAGE(PG8_SB(1, 0), b3, voffB); PG8_STAGE(PG8_SB(1, 1), b3 + hstep, voffB); PG8_STAGE2(PG8_SA(1, 0), a3, x00, x01);
            PG8_WAIT_V(8); PG8_WAIT_L(0); PG8_BAR; PG8_MMA(1, 0, At, B0); PG8_MMA(1, 1, At, B1); PG8_BAR; PG8_SCHED;
        }
        if (wr == 0) PG8_BAR;
        const bool has_nn = has_next && S.next(ui + 2, nn);
        unsigned w00 = 0, w01 = 0, w10 = 0, w11 = 0;
        if (has_nn) { int tz = tid_; asm volatile("" : "+v"(tz)); PG8_TOKOFF(nn, tz, 0, 0, w00); PG8_TOKOFF(nn, tz, 0, 1, w01); PG8_TOKOFF(nn, tz, 1, 0, w10); PG8_TOKOFF(nn, tz, 1, 1, w11); }
        E(acc, cur, wr, wc, fr, fq); S.done(cur);
#if defined(PROBE_EPI2)
        asm volatile("" ::: "memory");
#pragma unroll
        for (int a = 0; a < 2; ++a)
#pragma unroll
            for (int b = 0; b < 2; ++b)
#pragma unroll
                for (int m = 0; m < 4; ++m)
#pragma unroll
                    for (int n = 0; n < 2; ++n) asm volatile("" : "+v"(acc[a][b][m][n]));
        E(acc, cur, wr, wc, fr, fq);
#endif
        if (!has_next) break;
#pragma unroll
        for (int a = 0; a < 2; ++a)
#pragma unroll
            for (int b = 0; b < 2; ++b)
#pragma unroll
                for (int m = 0; m < 4; ++m)
#pragma unroll
                    for (int n = 0; n < 2; ++n) acc[a][b][m][n] = (f32x4){0.f, 0.f, 0.f, 0.f};
        cur = nxt; cB = nB; ++ui;
        vc00 = vn00; vc01 = vn01; vc10 = vn10; vc11 = vn11;
        if (has_nn) { vn00 = w00; vn01 = w01; vn10 = w10; vn11 = w11; nxt = nn; }
        has_next = has_nn;
        if (wr == 1) PG8_BAR;
    }
    PG8_WAIT_V(0);
    PG8_BAR;
#undef PG8_SA
#undef PG8_SB
#undef PG8_STAGE
#undef PG8_STAGE2
#undef PG8_LDA
#undef PG8_LDB
#undef PG8_MMA
#undef PG8_WAIT_V
#undef PG8_WAIT_L
#undef PG8_BAR
#undef PG8_SCHED
#undef PG8_TOKOFF
}
}

#define GAS __attribute__((address_space(1)))
#define LAS __attribute__((address_space(3)))
typedef unsigned short bf16;
typedef unsigned v4u __attribute__((ext_vector_type(4)));
typedef unsigned v2u __attribute__((ext_vector_type(2)));
typedef float f32x4 __attribute__((ext_vector_type(4)));
typedef short bf16x8 __attribute__((ext_vector_type(8)));

constexpr int NWAVES = 8, NTHR = 512;
constexpr int NB = 2, SEQ = 16384, T = NB * SEQ, D = 1024;
constexpr int CONV_CH = 768, CONV_W = 31, AIN = 1792, KVW = 1536, NEXP = 32, DFF = 1024;
constexpr int MAXTILES = (T * 4) / 256 + NEXP;
constexpr int XROWS = MAXTILES * 256;
constexpr float DN_ALPHA = 1.681792830507429f;
constexpr float LN_EPS = 1e-5f;

constexpr size_t MiB = 1u << 20;
constexpr size_t al(size_t x) { return (x + MiB - 1) / MiB * MiB; }
constexpr size_t WS_CTL = 0, CTL_ZERO_BYTES = MiB;
constexpr size_t WS_ROT  = WS_CTL + MiB;
constexpr size_t WS_WIN  = WS_ROT  + al((size_t)T * 16 * 4);
constexpr size_t WS_WOA  = WS_WIN  + al((size_t)2 * AIN * D * 2);
constexpr size_t WS_WKV  = WS_WOA  + al((size_t)2 * D * D * 2);
constexpr size_t WS_WQ   = WS_WKV  + al((size_t)KVW * D * 2);
constexpr size_t WS_WOB  = WS_WQ   + al((size_t)2 * D * D * 2);
constexpr size_t WS_WMEM = WS_WOB  + al((size_t)2 * D * 512 * 2);
constexpr size_t WS_WUP  = WS_WMEM + al((size_t)4 * 512 * D * 2);
constexpr size_t WS_WDN  = WS_WUP  + al((size_t)4 * NEXP * 2 * DFF * D * 2);
constexpr size_t WS_MEMB = WS_WDN  + al((size_t)4 * NEXP * D * DFF * 2);
constexpr size_t WS_MEMKV= WS_MEMB + al((size_t)512 * D * 2);
constexpr size_t WS_XB   = WS_MEMKV+ al((size_t)512 * 2048 * 2);
constexpr size_t WS_X1B  = WS_XB   + al((size_t)T * D * 2);
constexpr size_t WS_XR1  = WS_X1B  + al((size_t)T * D * 2);
constexpr size_t WS_XR2  = WS_XR1  + al((size_t)T * D * 4);
constexpr size_t WS_Z    = WS_XR2  + al((size_t)T * D * 4);
constexpr size_t WS_HGLU = WS_Z    + al((size_t)T * D * 4);
constexpr size_t WS_QM   = WS_HGLU + al((size_t)T * CONV_CH * 2);
constexpr size_t WS_A2   = WS_QM   + al((size_t)T * 256 * 2);
constexpr size_t WS_QB   = WS_A2   + al((size_t)T * D * 2);
constexpr size_t WS_KVB  = WS_QB   + al((size_t)T * D * 2);
constexpr size_t WS_OG   = WS_KVB  + al((size_t)T * KVW * 2);
constexpr size_t WS_LSE  = WS_OG   + al((size_t)3 * T * 256 * 2);
constexpr size_t WS_TES  = WS_LSE  + al((size_t)3 * T * 4 * 4);
constexpr size_t WS_TGATE= WS_TES  + al((size_t)T * 4 * 4);
constexpr size_t WS_TROW = WS_TGATE+ al((size_t)T * 4 * 4);
constexpr size_t WS_RWT  = WS_TROW + al((size_t)T * 4 * 4);
constexpr size_t WS_RTOK = WS_RWT  + al((size_t)4 * NEXP * D * 4);
constexpr size_t WS_H    = WS_RTOK + al((size_t)NEXP * T * 4);
constexpr size_t WS_Y    = WS_H    + al((size_t)XROWS * DFF * 2);
constexpr size_t WS_END  = WS_Y    + al((size_t)XROWS * D * 2);
constexpr int CW_BAR = 4096;
constexpr int CW_CNT = 8192;
constexpr int LDS_SCR = 133120;
constexpr int LDS_MISC = LDS_SCR;
constexpr int LDS_TB = LDS_MISC + 64;
constexpr int LDS_TE = LDS_TB + 320;
constexpr int LDS_RT = LDS_TE + 2304;
constexpr int LDS_PTR = LDS_RT + 2304;
constexpr int LDS_BYTES = 147456;
static_assert(LDS_PTR + 256 <= LDS_BYTES, "LDS map");

#define LDS_WAIT() asm volatile("s_waitcnt lgkmcnt(0)" ::: "memory")
#define VM_WAIT() asm volatile("s_waitcnt vmcnt(0)" ::: "memory")
__device__ __forceinline__ unsigned f2bf(float f) { unsigned u = __builtin_bit_cast(unsigned, f); return (u + 0x7fffu + ((u >> 16) & 1u)) >> 16; }
__device__ __forceinline__ unsigned pk2(float lo, float hi) { return f2bf(lo) | (f2bf(hi) << 16); }
__device__ __forceinline__ float bflo(unsigned w) { return __builtin_bit_cast(float, w << 16); }
__device__ __forceinline__ float bfhi(unsigned w) { return __builtin_bit_cast(float, w & 0xffff0000u); }
__device__ __forceinline__ float wave_sum(float v) {
#pragma unroll
    for (int o = 1; o < 64; o <<= 1) v += __shfl_xor(v, o);
    return v;
}
__device__ __forceinline__ float sigmoidf_(float x) { return __builtin_amdgcn_rcpf(1.0f + __builtin_amdgcn_exp2f(-1.4426950408889634f * x)); }
#define XB_TMO      128
#define XB_XCNT(j)  (256  + 64 * (j))
#define XB_XSUB(j)  (1280 + 64 * (j))
#define XB_XGEN(j)  (2304 + 64 * (j))
#define XB_TOP      3328
#define XB_TOPGEN   3392
#define XCD_BAR_WORDS 3456
#define XB_SPIN_CAP (1u << 18)

__device__ __forceinline__ unsigned xb_ld(unsigned* p)              { return __hip_atomic_load(p, __ATOMIC_RELAXED, __HIP_MEMORY_SCOPE_AGENT); }
__device__ __forceinline__ unsigned xb_add(unsigned* p, unsigned v) { return __hip_atomic_fetch_add(p, v, __ATOMIC_RELAXED, __HIP_MEMORY_SCOPE_AGENT); }
__device__ __forceinline__ unsigned xb_xcc_id() { return (unsigned)__builtin_amdgcn_s_getreg((3 << 11) | 20) & 0xFu; }
#define XB_SPIN(cond, bar) do { unsigned _sp = 0; while (cond) { __builtin_amdgcn_s_sleep(1); \
    if ((++_sp & 255u) == 0u) { if (xb_ld(&(bar)[XB_TMO])) break; if (_sp > XB_SPIN_CAP) { atomicAdd(&(bar)[XB_TMO], 1u); break; } } } } while (0)

struct XcdBarrier {
    unsigned* bar; unsigned x;
    volatile LAS unsigned* st;
};

__device__ __forceinline__ XcdBarrier xcd_barrier_post(unsigned* bar, volatile LAS unsigned* st) {
    XcdBarrier b; b.bar = bar; b.x = xb_xcc_id(); b.st = st;
    if (threadIdx.x == 0) (void)xb_add(&bar[XB_XCNT(b.x)], 1u);
    return b;
}
__device__ __forceinline__ void xcd_barrier_complete(unsigned* bar, unsigned x, unsigned& nloc, unsigned& nx) {
    const unsigned G = gridDim.x * gridDim.y * gridDim.z;
    unsigned sum, cnt, mine, sp = 0u;
    for (;;) {
        sum = 0u; cnt = 0u; mine = 0u;
#pragma unroll
        for (unsigned j = 0; j < 16; ++j) { const unsigned c = xb_ld(&bar[XB_XCNT(j)]); sum += c; cnt += (c > 0u) ? 1u : 0u; mine = (j == x) ? c : mine; }
        if (sum == G) break;
        __builtin_amdgcn_s_sleep(1);
        if ((++sp & 255u) == 0u) { if (xb_ld(&bar[XB_TMO])) break; if (sp > XB_SPIN_CAP) { atomicAdd(&bar[XB_TMO], 1u); break; } }
    }
    nloc = mine > 0u ? mine : 1u; nx = cnt > 0u ? cnt : 1u;
}

__device__ __forceinline__ void xcd_barrier(const XcdBarrier& b) {
    asm volatile("s_waitcnt vmcnt(0)" ::: "memory");
    __syncthreads();
    if (threadIdx.x == 0) {
        unsigned* bar = b.bar;
        __builtin_amdgcn_s_waitcnt(0);
        unsigned nloc = b.st[0], nx = b.st[1];
        if (nloc == 0u) { xcd_barrier_complete(bar, b.x, nloc, nx); b.st[0] = nloc; b.st[1] = nx; }
        const unsigned old = xb_add(&bar[XB_XSUB(b.x)], 1u);
        const unsigned gen = old / nloc;
        if (old + 1u == (gen + 1u) * nloc) {
            __builtin_amdgcn_fence(__ATOMIC_RELEASE, "agent");
            asm volatile("s_waitcnt vmcnt(0)" ::: "memory");
            const unsigned og = xb_add(&bar[XB_TOP], 1u);
            const unsigned tg = og / nx;
            if (og + 1u == (tg + 1u) * nx) xb_add(&bar[XB_TOPGEN], 1u);
            else XB_SPIN(xb_ld(&bar[XB_TOPGEN]) == tg, bar);
            __builtin_amdgcn_fence(__ATOMIC_ACQUIRE, "agent");
            xb_add(&bar[XB_XGEN(b.x)], 1u);
            asm volatile("s_waitcnt vmcnt(0)" ::: "memory");
        } else {
            XB_SPIN(xb_ld(&bar[XB_XGEN(b.x)]) == gen, bar);
            __builtin_amdgcn_fence(__ATOMIC_ACQUIRE, "agent");
            asm volatile("s_waitcnt vmcnt(0)" ::: "memory");
        }
    }
    __syncthreads();
}

using pg8::Unit; using pg8::cvt_pk_bf16; using pg8::BM; using pg8::HALF;
typedef unsigned u32x4 __attribute__((ext_vector_type(4)));
#if defined(EPI_NT)
#define EPI_ST(p, v) __builtin_nontemporal_store((v), (p))
#else
#define EPI_ST(p, v) (*(p) = (v))
#endif

struct EpiGluQ {
    static constexpr bool PERM = true, AFTER_DRAIN = false;
    bf16* hglu; bf16* qm; const float* bias;
    __device__ __forceinline__ void operator()(const f32x4 (&acc)[2][2][4][2], const Unit& u, int wr, int wc, int fr, int fq) const {
        const int row0 = u.pm * BM + wr * 64 + fr, cw = wc * 32 + 8 * fq;
        if (u.pn < 6) {
            f32x4 ba[2], bg[2];
#pragma unroll
            for (int n = 0; n < 2; ++n) { ba[n] = *(const f32x4*)(bias + u.pn * 128 + cw + 4 * n); bg[n] = *(const f32x4*)(bias + 768 + u.pn * 128 + cw + 4 * n); }
#pragma unroll
            for (int ai = 0; ai < 2; ++ai)
#pragma unroll
                for (int m = 0; m < 4; ++m) {
                    float o[8];
#pragma unroll
                    for (int n = 0; n < 2; ++n) { const f32x4 a = acc[ai][0][m][n] + ba[n], g = acc[ai][1][m][n] + bg[n];
#pragma unroll
                        for (int j = 0; j < 4; ++j) o[4 * n + j] = a[j] * sigmoidf_(g[j]); }
                    u32x4 w; w.x = cvt_pk_bf16(o[0], o[1]); w.y = cvt_pk_bf16(o[2], o[3]); w.z = cvt_pk_bf16(o[4], o[5]); w.w = cvt_pk_bf16(o[6], o[7]);
                    EPI_ST((u32x4*)(hglu + (size_t)(row0 + ai * HALF + m * 16) * CONV_CH + u.pn * 128 + cw), w);
                }
        } else {
            f32x4 bv[2][2];
#pragma unroll
            for (int bj = 0; bj < 2; ++bj)
#pragma unroll
                for (int n = 0; n < 2; ++n) bv[bj][n] = *(const f32x4*)(bias + 1536 + bj * HALF + cw + 4 * n);
#pragma unroll
            for (int ai = 0; ai < 2; ++ai)
#pragma unroll
                for (int m = 0; m < 4; ++m)
#pragma unroll
                    for (int bj = 0; bj < 2; ++bj) { const f32x4 v0 = acc[ai][bj][m][0] + bv[bj][0], v1 = acc[ai][bj][m][1] + bv[bj][1];
                        u32x4 w; w.x = cvt_pk_bf16(v0[0], v0[1]); w.y = cvt_pk_bf16(v0[2], v0[3]); w.z = cvt_pk_bf16(v1[0], v1[1]); w.w = cvt_pk_bf16(v1[2], v1[3]);
                        EPI_ST((u32x4*)(qm + (size_t)(row0 + ai * HALF + m * 16) * 256 + bj * HALF + cw), w); }
        }
    }
};

struct EpiRes {
    static constexpr bool PERM = false, AFTER_DRAIN = false;
    float* Z; const float* xres; const float* bias;
    __device__ __forceinline__ void operator()(const f32x4 (&acc)[2][2][4][2], const Unit& u, int wr, int wc, int fr, int fq) const {
        const int row0 = u.pm * BM + wr * 64 + fr, col0 = u.pn * BM + wc * 32 + 4 * fq;
        f32x4 bv[2][2];
#pragma unroll
        for (int bj = 0; bj < 2; ++bj)
#pragma unroll
            for (int n = 0; n < 2; ++n) bv[bj][n] = *(const f32x4*)(bias + col0 + bj * HALF + n * 16);
#pragma unroll
        for (int ai = 0; ai < 2; ++ai)
#pragma unroll
            for (int m = 0; m < 4; ++m) { const size_t off = (size_t)(row0 + ai * HALF + m * 16) * D + col0;
#pragma unroll
                for (int bj = 0; bj < 2; ++bj)
#pragma unroll
                    for (int n = 0; n < 2; ++n) { const f32x4 xr = *(const f32x4*)(xres + off + bj * HALF + n * 16);
                        EPI_ST((f32x4*)(Z + off + bj * HALF + n * 16), xr * DN_ALPHA + acc[ai][bj][m][n] + bv[bj][n]); } }
    }
};

template <int MODE> struct EpiRot {
    static constexpr bool PERM = true, AFTER_DRAIN = false;
    bf16* O; int ldc; const float* rot;
    __device__ __forceinline__ void operator()(const f32x4 (&acc)[2][2][4][2], const Unit& u, int wr, int wc, int fr, int fq) const {
        const int row0 = u.pm * BM + wr * 64 + fr;
#pragma unroll
        for (int bj = 0; bj < 2; ++bj) {
            const int cb = u.pn * BM + bj * HALF;
            bool rotu = false;
            if (MODE == 0) rotu = (cb < 768) && ((wc & 1) == 0);
            if (MODE == 1) rotu = ((cb & 511) < 256) && ((wc & 1) == 0);
#pragma unroll
            for (int ai = 0; ai < 2; ++ai)
#pragma unroll
                for (int m = 0; m < 4; ++m) {
                    const int row = row0 + ai * HALF + m * 16;
                    float v[8];
#pragma unroll
                    for (int j = 0; j < 4; ++j) { v[j] = acc[ai][bj][m][0][j]; v[4 + j] = acc[ai][bj][m][1][j]; }
                    if (rotu) {
                        float pv[8];
#pragma unroll
                        for (int j = 0; j < 8; ++j) pv[j] = __shfl_xor(v[j], 16);
                        if (fq < 2) {
                            const f32x4 c0 = *(const f32x4*)(rot + (size_t)row * 16), c1 = *(const f32x4*)(rot + (size_t)row * 16 + 4);
                            const f32x4 s0 = *(const f32x4*)(rot + (size_t)row * 16 + 8), s1 = *(const f32x4*)(rot + (size_t)row * 16 + 12);
                            const float sg = (fq == 0) ? -1.0f : 1.0f;
#pragma unroll
                            for (int j = 0; j < 4; ++j) { v[j] = v[j] * c0[j] + sg * pv[j] * s0[j]; v[4 + j] = v[4 + j] * c1[j] + sg * pv[4 + j] * s1[j]; }
                        }
                    }
                    u32x4 w; w.x = cvt_pk_bf16(v[0], v[1]); w.y = cvt_pk_bf16(v[2], v[3]); w.z = cvt_pk_bf16(v[4], v[5]); w.w = cvt_pk_bf16(v[6], v[7]);
                    EPI_ST((u32x4*)(O + (size_t)row * ldc + cb + wc * 32 + 8 * fq), w);
                }
        }
    }
};

struct EpiSwiglu {
    static constexpr bool PERM = true, AFTER_DRAIN = false;
    bf16* H; const float* bup;
    __device__ __forceinline__ void operator()(const f32x4 (&acc)[2][2][4][2], const Unit& u, int wr, int wc, int fr, int fq) const {
        const int e = u.pn >> 3, pn = u.pn & 7, row0 = u.pm * BM + wr * 64 + fr, cw = pn * 128 + wc * 32 + 8 * fq;
        f32x4 bg[2], bl[2];
#pragma unroll
        for (int n = 0; n < 2; ++n) { bg[n] = *(const f32x4*)(bup + (size_t)e * 2048 + cw + 4 * n); bl[n] = *(const f32x4*)(bup + (size_t)e * 2048 + 1024 + cw + 4 * n); }
#pragma unroll
        for (int ai = 0; ai < 2; ++ai)
#pragma unroll
            for (int m = 0; m < 4; ++m) {
                float o[8];
#pragma unroll
                for (int n = 0; n < 2; ++n) { const f32x4 g = acc[ai][0][m][n] + bg[n], li = acc[ai][1][m][n] + bl[n];
#pragma unroll
                    for (int j = 0; j < 4; ++j) { const float gg = fminf(g[j], 7.0f), ll = fminf(fmaxf(li[j], -7.0f), 7.0f); o[4 * n + j] = gg * sigmoidf_(1.702f * gg) * (ll + 1.0f); } }
                u32x4 w; w.x = cvt_pk_bf16(o[0], o[1]); w.y = cvt_pk_bf16(o[2], o[3]); w.z = cvt_pk_bf16(o[4], o[5]); w.w = cvt_pk_bf16(o[6], o[7]);
                EPI_ST((u32x4*)(H + (size_t)(row0 + ai * HALF + m * 16) * DFF + cw), w);
            }
    }
};

struct EpiDown {
    static constexpr bool PERM = true, AFTER_DRAIN = false;
    bf16* Y; const float* bdn;
    __device__ __forceinline__ void operator()(const f32x4 (&acc)[2][2][4][2], const Unit& u, int wr, int wc, int fr, int fq) const {
        const int e = u.pn >> 2, pn = u.pn & 3, row0 = u.pm * BM + wr * 64 + fr, cw = pn * BM + wc * 32 + 8 * fq;
        f32x4 bv[2][2];
#pragma unroll
        for (int bj = 0; bj < 2; ++bj)
#pragma unroll
            for (int n = 0; n < 2; ++n) bv[bj][n] = *(const f32x4*)(bdn + (size_t)e * D + cw + bj * HALF + 4 * n);
#pragma unroll
        for (int ai = 0; ai < 2; ++ai)
#pragma unroll
            for (int m = 0; m < 4; ++m)
#pragma unroll
                for (int bj = 0; bj < 2; ++bj) { const f32x4 v0 = acc[ai][bj][m][0] + bv[bj][0], v1 = acc[ai][bj][m][1] + bv[bj][1];
                    u32x4 w; w.x = cvt_pk_bf16(v0[0], v0[1]); w.y = cvt_pk_bf16(v0[2], v0[3]); w.z = cvt_pk_bf16(v1[0], v1[1]); w.w = cvt_pk_bf16(v1[2], v1[3]);
                    EPI_ST((u32x4*)(Y + (size_t)(row0 + ai * HALF + m * 16) * D + cw + bj * HALF), w); }
    }
};

template <int NTN> struct MoeOrder {
    const LAS int* tile_e; const LAS int* tbs; const LAS int* cntl; const int* rowtok; int total, G, c;
    __device__ __forceinline__ bool next(int i, Unit& u) const {
        const int L = i * G + c, grp = L / (8 * NTN), w = L % (8 * NTN), rt = grp * 8 + (w & 7), pn = w >> 3;
        if (rt >= total) return false;
        const int e = __builtin_amdgcn_readfirstlane(tile_e[rt]);
        u.pm = rt; u.pn = e * NTN + pn; return true;
    }
    __device__ __forceinline__ int tok(const Unit& u, int r) const {
        const int e = u.pn / NTN, slot = (u.pm - tbs[e]) * 256 + r; int t = 0;
        if (slot < cntl[e]) t = rowtok[(size_t)e * T + slot];
        return t;
    }
    __device__ __forceinline__ void a_ready(const Unit&) const {}
    __device__ __forceinline__ void done(const Unit&) const {}
};

struct Frame {
    LAS unsigned char* lds;
    int tid, lane, wave, G, gw, NGW;
};
__device__ __forceinline__ unsigned char* ptr_slot(const Frame& F, int k) {
    const unsigned long long v = *(const LAS unsigned long long*)(F.lds + LDS_PTR + 8 * k);
    const unsigned lo = __builtin_amdgcn_readfirstlane((unsigned)v), hi = __builtin_amdgcn_readfirstlane((unsigned)(v >> 32));
    return (unsigned char*)(GAS unsigned char*)(((unsigned long long)hi << 32) | lo);
}
__device__ __forceinline__ const float* inp(const Frame& F, int k) { return (const float*)ptr_slot(F, k); }
__device__ __forceinline__ unsigned char* wsp(const Frame& F) { return ptr_slot(F, 24); }

__device__ __forceinline__ void tr_item(const float* W, int N, bf16* WT, int K, int k0, int n0, int orow0, LAS float* scr, int lane) {
#if defined(P0_V2)
    { float tv_[64];
#pragma unroll
      for (int i = 0; i < 64; ++i) tv_[i] = __builtin_nontemporal_load(W + (size_t)(k0 + i) * N + n0 + lane);
#pragma unroll
      for (int i = 0; i < 64; ++i) scr[i * 65 + lane] = tv_[i]; }
#else
#pragma unroll 16
    for (int i = 0; i < 64; ++i) scr[i * 65 + lane] = W[(size_t)(k0 + i) * N + n0 + lane];
#endif
    LDS_WAIT(); asm volatile("" ::: "memory");
    const int c = lane & 7;
#pragma unroll
    for (int j = 0; j < 8; ++j) { const int n = (lane >> 3) + 8 * j; const LAS float* s = scr + (8 * c) * 65 + n;
        v4u o; o.x = pk2(s[0 * 65], s[1 * 65]); o.y = pk2(s[2 * 65], s[3 * 65]); o.z = pk2(s[4 * 65], s[5 * 65]); o.w = pk2(s[6 * 65], s[7 * 65]);
        *(v4u*)(WT + (size_t)(orow0 + n) * K + k0 + 8 * c) = o; }
    LDS_WAIT(); asm volatile("" ::: "memory");
}
template <int PERMT> __device__ __forceinline__ int perm_row(int n0) {
    if (PERMT == 1) { if (n0 >= 1536) return n0; const int bj = n0 / 768, r = n0 % 768; return (r / 128) * 256 + bj * 128 + (r % 128); }
    if (PERMT == 2) { const int bj = n0 / 1024, r = n0 % 1024; return (r / 128) * 256 + bj * 128 + (r % 128); }
    return n0;
}
template <int PERMT> __device__ __forceinline__ void conv_group(Frame& F, const float* src, bf16* dst, int K, int N, int nmat) {
    LAS float* scr = (LAS float*)(F.lds + F.wave * 16640);
    const int nkb = K / 64, nnb = N / 64, per = nkb * nnb, total = per * nmat;
    for (int it = F.gw; it < total; it += F.NGW) {
        const int mat = it / per, r = it % per, kb = r / nnb, nb = r % nnb;
        tr_item(src + (size_t)mat * K * N, N, dst + (size_t)mat * K * N, K, kb * 64, nb * 64, perm_row<PERMT>(nb * 64), scr, F.lane);
    }
}
__device__ __forceinline__ void phase_prologue(Frame& F) {
    unsigned char* ws = wsp(F);
    conv_group<1>(F, inp(F, 3),  (bf16*)(ws + WS_WIN),  D, AIN, 2);
    conv_group<0>(F, inp(F, 9),  (bf16*)(ws + WS_WOA),  D, D, 2);
    conv_group<0>(F, inp(F, 11), (bf16*)(ws + WS_WKV),  D, KVW, 1);
    conv_group<0>(F, inp(F, 12), (bf16*)(ws + WS_WQ),   D, D, 2);
    conv_group<0>(F, inp(F, 13), (bf16*)(ws + WS_WOB),  512, D, 2);
    conv_group<0>(F, inp(F, 15), (bf16*)(ws + WS_WMEM), D, 512, 4);
    conv_group<2>(F, inp(F, 20), (bf16*)(ws + WS_WUP),  D, 2 * DFF, 4 * NEXP);
    conv_group<0>(F, inp(F, 22), (bf16*)(ws + WS_WDN),  DFF, D, 4 * NEXP);
    {
        const size_t gt = (size_t)blockIdx.x * NTHR + F.tid, NT_ = (size_t)F.G * NTHR;
        const float* x = inp(F, 0); bf16* xb = (bf16*)(ws + WS_XB);
        for (size_t i = gt; i < (size_t)T * D / 8; i += NT_) { const f32x4 a = *(const f32x4*)(x + i * 8), b = *(const f32x4*)(x + i * 8 + 4);
            v4u o; o.x = pk2(a[0], a[1]); o.y = pk2(a[2], a[3]); o.z = pk2(b[0], b[1]); o.w = pk2(b[2], b[3]); *(v4u*)(xb + i * 8) = o; }
        const float* mem = inp(F, 1); bf16* mb = (bf16*)(ws + WS_MEMB);
        for (size_t i = gt; i < (size_t)512 * D / 8; i += NT_) { const f32x4 a = *(const f32x4*)(mem + i * 8), b = *(const f32x4*)(mem + i * 8 + 4);
            v4u o; o.x = pk2(a[0], a[1]); o.y = pk2(a[2], a[3]); o.z = pk2(b[0], b[1]); o.w = pk2(b[2], b[3]); *(v4u*)(mb + i * 8) = o; }
        { const float* rw = inp(F, 18); float* rwT = (float*)(ws + WS_RWT);
          for (size_t i = gt; i < (size_t)4 * NEXP * D; i += NT_) { const int l = (int)(i >> 15), e = (int)((i >> 10) & 31), c = (int)(i & 1023); rwT[i] = rw[((size_t)l * D + c) * NEXP + e]; } }
        const int* pos = (const int*)inp(F, 2); float* rot = (float*)(ws + WS_ROT);
        for (size_t i = gt; i < (size_t)T * 8; i += NT_) { const int t = (int)(i >> 3), k = (int)(i & 7);
            double f = 1.0;
            f = (k == 1) ? 0.19392274474868576 : f; f = (k == 2) ? 0.03760603093086393 : f; f = (k == 3) ? 0.007292664737217109 : f; f = (k == 4) ? 0.001414213562373095 : f;
            f = (k == 5) ? 0.0002742481756762073 : f; f = (k == 6) ? 5.318295896944988e-05 : f; f = (k == 7) ? 1.031338537721246e-05 : f;
            const double a = (double)pos[t] * f; const double rv = a * 0.15915494309189535; const double fr = rv - floor(rv);
            const float ang = (float)(fr * 6.283185307179586);
            rot[(size_t)t * 16 + k] = cosf(ang); rot[(size_t)t * 16 + 8 + k] = sinf(ang); }
    }
}

__device__ __forceinline__ void phase_conv(Frame& F, const bf16* hglu, const float* dw, const float* dwb, const float* cg, const float* cb, bf16* A2) {
    LAS bf16* tile = (LAS bf16*)F.lds;
    LAS float* red = (LAS float*)(F.lds + 46 * 768 * 2);
    const int L = F.tid & 255, tb = F.tid >> 8, wv = F.wave & 3;
    float w[31][3], bias[3], gg[3], bb[3];
#pragma unroll
    for (int p = 0; p < 3; ++p) { bias[p] = dwb[p * 256 + L]; gg[p] = cg[p * 256 + L]; bb[p] = cb[p * 256 + L];
#pragma unroll
        for (int j = 0; j < 31; ++j) w[j][p] = dw[j * CONV_CH + p * 256 + L]; }
    for (int ti = blockIdx.x; ti < T / 16; ti += F.G) {
        const int t0 = ti * 16, s0 = t0 & (SEQ - 1);
        __syncthreads();
        for (int i = F.tid; i < 46 * 96; i += NTHR) { const int r = i / 96, c = i % 96; v4u v = (v4u){0u, 0u, 0u, 0u};
            if (s0 - 30 + r >= 0) v = *(const v4u*)(hglu + (size_t)(t0 - 30 + r) * CONV_CH + c * 8);
            *(LAS v4u*)(tile + r * CONV_CH + c * 8) = v; }
        __syncthreads();
        float acc[8][3];
#pragma unroll
        for (int t = 0; t < 8; ++t)
#pragma unroll
            for (int p = 0; p < 3; ++p) acc[t][p] = bias[p];
#pragma unroll
        for (int r = 0; r < 38; ++r) {
            float x[3];
#pragma unroll
            for (int p = 0; p < 3; ++p) x[p] = bflo((unsigned)tile[(tb * 8 + r) * CONV_CH + p * 256 + L]);
#pragma unroll
            for (int t = 0; t < 8; ++t) { const int j = r - t; if (j >= 0 && j <= 30) {
#pragma unroll
                for (int p = 0; p < 3; ++p) acc[t][p] += x[p] * w[j][p]; } }
        }
        float mean[8], rstd[8];
#pragma unroll
        for (int t = 0; t < 8; ++t) { const float s = wave_sum(acc[t][0] + acc[t][1] + acc[t][2]); if (F.lane == 0) red[(tb * 4 + wv) * 8 + t] = s; }
        __syncthreads();
#pragma unroll
        for (int t = 0; t < 8; ++t) { const LAS float* rp = red + tb * 32 + t; mean[t] = (rp[0] + rp[8] + rp[16] + rp[24]) * (1.0f / CONV_CH); }
#pragma unroll
        for (int t = 0; t < 8; ++t) { const float d0 = acc[t][0] - mean[t], d1 = acc[t][1] - mean[t], d2 = acc[t][2] - mean[t];
            const float s = wave_sum(d0 * d0 + d1 * d1 + d2 * d2); if (F.lane == 0) red[64 + (tb * 4 + wv) * 8 + t] = s; }
        __syncthreads();
#pragma unroll
        for (int t = 0; t < 8; ++t) { const LAS float* rp = red + 64 + tb * 32 + t; rstd[t] = 1.0f / sqrtf((rp[0] + rp[8] + rp[16] + rp[24]) * (1.0f / CONV_CH) + LN_EPS); }
#pragma unroll
        for (int t = 0; t < 8; ++t)
#pragma unroll
            for (int p = 0; p < 3; ++p) { const float y = (acc[t][p] - mean[t]) * rstd[t] * gg[p] + bb[p]; const float o = y * sigmoidf_(y);
                A2[(size_t)(t0 + tb * 8 + t) * D + p * 256 + L] = (bf16)f2bf(o); }
    }
    __syncthreads();
}

constexpr int KPITCH = 144;
typedef short v4i16_t __attribute__((ext_vector_type(4)));
template <int NT, bool MASK>
__device__ __forceinline__ void attn_wave(const LAS unsigned char* Kl, const LAS unsigned char* Vl, int kt0, bf16x8 bq0, bf16x8 bq1, int lane, int qi, bool first, f32x4 (&o)[4], float& lse) {
    const int r = lane & 15, lg = lane >> 4;
    f32x4 s[NT];
#pragma unroll
    for (int t = 0; t < NT; ++t) {
        const LAS unsigned char* kp = Kl + ((kt0 + t) * 16 + r) * KPITCH + lg * 16;
        const bf16x8 a0 = *(const LAS bf16x8*)kp, a1 = *(const LAS bf16x8*)(kp + 64);
        f32x4 z = (f32x4){0.f, 0.f, 0.f, 0.f};
        z = __builtin_amdgcn_mfma_f32_16x16x32_bf16(a0, bq0, z, 0, 0, 0);
        s[t] = __builtin_amdgcn_mfma_f32_16x16x32_bf16(a1, bq1, z, 0, 0, 0);
    }
    float m = -INFINITY;
#pragma unroll
    for (int t = 0; t < NT; ++t)
#pragma unroll
        for (int j = 0; j < 4; ++j) {
            if (MASK) { const int ki = (kt0 + t) * 16 + 4 * lg + j, dist = qi + 128 - ki; const bool valid = (dist >= 0) && (dist <= 128) && (!first || ki >= 128); s[t][j] = valid ? s[t][j] : -INFINITY; }
            m = fmaxf(m, s[t][j]);
        }
    m = fmaxf(m, __shfl_xor(m, 16)); m = fmaxf(m, __shfl_xor(m, 32));
    const float c = 0.125f * 1.4426950408889634f;
    float sum = 0.f;
#pragma unroll
    for (int t = 0; t < NT; ++t)
#pragma unroll
        for (int j = 0; j < 4; ++j) { const float p = __builtin_amdgcn_exp2f((s[t][j] - m) * c); s[t][j] = p; sum += p; }
    sum += __shfl_xor(sum, 16); sum += __shfl_xor(sum, 32);
#pragma unroll
    for (int et = 0; et < 4; ++et) o[et] = (f32x4){0.f, 0.f, 0.f, 0.f};
    const LAS unsigned char* vbase = Vl + (kt0 * 16 + 4 * lg + ((lane & 15) >> 2)) * KPITCH + (lane & 3) * 8;
#pragma unroll
    for (int kk = 0; kk < NT / 2; ++kk) {
        v4u pw; pw.x = cvt_pk_bf16(s[2 * kk][0], s[2 * kk][1]); pw.y = cvt_pk_bf16(s[2 * kk][2], s[2 * kk][3]);
        pw.z = cvt_pk_bf16(s[2 * kk + 1][0], s[2 * kk + 1][1]); pw.w = cvt_pk_bf16(s[2 * kk + 1][2], s[2 * kk + 1][3]);
        const bf16x8 bp = __builtin_bit_cast(bf16x8, pw);
#pragma unroll
        for (int et = 0; et < 4; ++et) {
            const LAS unsigned char* vp = vbase + (32 * kk) * KPITCH + et * 32;
            const v4i16_t lo = __builtin_amdgcn_ds_read_tr16_b64_v4i16((LAS v4i16_t*)vp);
            const v4i16_t hi = __builtin_amdgcn_ds_read_tr16_b64_v4i16((LAS v4i16_t*)(vp + 16 * KPITCH));
            bf16x8 av; av[0] = lo[0]; av[1] = lo[1]; av[2] = lo[2]; av[3] = lo[3]; av[4] = hi[0]; av[5] = hi[1]; av[6] = hi[2]; av[7] = hi[3];
            o[et] = __builtin_amdgcn_mfma_f32_16x16x32_bf16(av, bp, o[et], 0, 0, 0);
        }
    }
    const float inv = __builtin_amdgcn_rcpf(sum);
#pragma unroll
    for (int et = 0; et < 4; ++et) o[et] = o[et] * inv;
    lse = m * 0.125f + __logf(sum);
}
constexpr int ATT_K_OFF = 0, ATT_V_OFF = 272 * KPITCH;

__device__ __forceinline__ void phase_memattn(Frame& F, const bf16* q, int qp, int qc0, const bf16* memkv, int l, bf16* out, int op, int oc0) {
    LAS unsigned char* Kl = F.lds + ATT_K_OFF; LAS unsigned char* Vl = F.lds + ATT_V_OFF;
    const int r = F.lane & 15, lg = F.lane >> 4;
    for (int u = blockIdx.x; u < 256; u += F.G) {
        const int b = u >> 7, h = (u >> 5) & 3, qc = u & 31;
        __syncthreads();
#pragma unroll
        for (int k = 0; k < 4; ++k) { const int i = F.tid + NTHR * k, ki = i >> 3, c = i & 7;
            const bf16* src = memkv + (size_t)(b * 256 + ki) * 2048 + l * 512 + h * 64 + c * 8;
            const v4u kv = *(const v4u*)src, vv = *(const v4u*)(src + 256);
            *(LAS v4u*)(Kl + ki * KPITCH + c * 16) = kv; *(LAS v4u*)(Vl + ki * KPITCH + c * 16) = vv; }
        bf16x8 nq0, nq1;
        { const bf16* qr = q + (size_t)(b * SEQ + qc * 512 + F.wave * 16 + r) * qp + qc0 + h * 64 + 8 * lg; nq0 = *(const bf16x8*)qr; nq1 = *(const bf16x8*)(qr + 32); }
        __syncthreads();
        for (int pass = 0; pass < 4; ++pass) {
            const int tok = b * SEQ + qc * 512 + pass * 128 + F.wave * 16 + r;
            const bf16x8 bq0 = nq0, bq1 = nq1;
            if (pass < 3) { const bf16* qr = q + (size_t)(tok + 128) * qp + qc0 + h * 64 + 8 * lg; nq0 = *(const bf16x8*)qr; nq1 = *(const bf16x8*)(qr + 32); }
            f32x4 o[4]; float lse;
            attn_wave<16, false>(Kl, Vl, 0, bq0, bq1, F.lane, 0, false, o, lse);
            bf16* orow = out + (size_t)tok * op + oc0 + h * 64 + 4 * lg;
#pragma unroll
            for (int et = 0; et < 4; ++et) { v2u w; w.x = cvt_pk_bf16(o[et][0], o[et][1]); w.y = cvt_pk_bf16(o[et][2], o[et][3]); *(v2u*)(orow + 16 * et) = w; }
        }
    }
    __syncthreads();
}

struct DilUnit { int b, grp, h, d, res, n; };
__device__ __forceinline__ DilUnit dil_unit(int u) {
    DilUnit x; x.b = u / 1536; const int rem = u % 1536; x.grp = rem >> 9; x.h = (rem >> 7) & 3; const int blk = rem & 127;
    const int dsh = 2 * x.grp; x.d = 1 << dsh; const int nblk = SEQ >> (7 + dsh); x.res = blk / nblk; x.n = blk % nblk; return x;
}
__device__ __forceinline__ void phase_dilated(Frame& F, const bf16* q  , const bf16* kv  , bf16* og  , float* lseo  ) {
    LAS unsigned char* Kl = F.lds + ATT_K_OFF; LAS unsigned char* Vl = F.lds + ATT_V_OFF;
    const int r16 = F.lane & 15, lg = F.lane >> 4;
    v4u kr[5], vr[5]; bf16x8 nq0, nq1; int ntok = 0;
#define DIL_PREFETCH(uu) do { const DilUnit x_ = dil_unit(uu); \
        _Pragma("unroll") for (int k_ = 0; k_ < 5; ++k_) { const int i_ = F.tid + NTHR * k_, ki_ = i_ >> 3, c_ = i_ & 7, mk_ = (x_.n - 1) * 128 + ki_; \
            kr[k_] = (v4u){0u, 0u, 0u, 0u}; vr[k_] = (v4u){0u, 0u, 0u, 0u}; \
            if (ki_ < 256 && mk_ >= 0) { const bf16* src_ = kv + (size_t)(x_.b * SEQ + mk_ * x_.d + x_.res) * KVW + x_.grp * 512 + x_.h * 64 + c_ * 8; kr[k_] = *(const v4u*)src_; vr[k_] = *(const v4u*)(src_ + 256); } } \
        ntok = x_.b * SEQ + (x_.n * 128 + F.wave * 16 + r16) * x_.d + x_.res; \
        { const bf16* qr_ = q + (size_t)ntok * D + x_.grp * 256 + x_.h * 64 + 8 * lg; nq0 = *(const bf16x8*)qr_; nq1 = *(const bf16x8*)(qr_ + 32); } } while (0)
    int u = blockIdx.x;
    if (u < 3072) DIL_PREFETCH(u);
    for (; u < 3072; u += F.G) {
        const DilUnit x = dil_unit(u);
        __syncthreads();
#pragma unroll
        for (int k = 0; k < 5; ++k) { const int i = F.tid + NTHR * k, ki = i >> 3, c = i & 7;
            if (ki < 272) { *(LAS v4u*)(Kl + ki * KPITCH + c * 16) = kr[k]; *(LAS v4u*)(Vl + ki * KPITCH + c * 16) = vr[k]; } }
        const bf16x8 bq0 = nq0, bq1 = nq1; const int tok = ntok;
        __syncthreads();
        if (u + F.G < 3072) DIL_PREFETCH(u + F.G);
        f32x4 o[4]; float lse;
        attn_wave<10, true>(Kl, Vl, F.wave, bq0, bq1, F.lane, F.wave * 16 + r16, x.n == 0, o, lse);
        bf16* orow = og + ((size_t)x.grp * T + tok) * 256 + x.h * 64 + 4 * lg;
#pragma unroll
        for (int et = 0; et < 4; ++et) { v2u w; w.x = cvt_pk_bf16(o[et][0], o[et][1]); w.y = cvt_pk_bf16(o[et][2], o[et][3]); *(v2u*)(orow + 16 * et) = w; }
        if (lg == 0) lseo[((size_t)x.grp * T + tok) * 4 + x.h] = lse;
    }
#undef DIL_PREFETCH
    __syncthreads();
}
__device__ __forceinline__ void phase_dil_combine(Frame& F, const bf16* og, const float* lse, bf16* A2b  ) {
    const size_t gt = (size_t)blockIdx.x * NTHR + F.tid, NT_ = (size_t)F.G * NTHR;
    for (size_t i = gt; i < (size_t)T * 32; i += NT_) {
        const int t = (int)(i >> 5), h = (int)((i >> 3) & 3), c8 = (int)(i & 7);
        const float l0 = lse[((size_t)0 * T + t) * 4 + h], l1 = lse[((size_t)1 * T + t) * 4 + h], l2 = lse[((size_t)2 * T + t) * 4 + h];
        const float mx = fmaxf(l0, fmaxf(l1, l2)); float w0 = __expf(l0 - mx), w1 = __expf(l1 - mx), w2 = __expf(l2 - mx); const float inv = 1.0f / (w0 + w1 + w2); w0 *= inv; w1 *= inv; w2 *= inv;
        const v4u a = *(const v4u*)(og + ((size_t)0 * T + t) * 256 + h * 64 + c8 * 8), bq = *(const v4u*)(og + ((size_t)1 * T + t) * 256 + h * 64 + c8 * 8), cq = *(const v4u*)(og + ((size_t)2 * T + t) * 256 + h * 64 + c8 * 8);
        v4u o;
        o.x = pk2(w0 * bflo(a.x) + w1 * bflo(bq.x) + w2 * bflo(cq.x), w0 * bfhi(a.x) + w1 * bfhi(bq.x) + w2 * bfhi(cq.x));
        o.y = pk2(w0 * bflo(a.y) + w1 * bflo(bq.y) + w2 * bflo(cq.y), w0 * bfhi(a.y) + w1 * bfhi(bq.y) + w2 * bfhi(cq.y));
        o.z = pk2(w0 * bflo(a.z) + w1 * bflo(bq.z) + w2 * bflo(cq.z), w0 * bfhi(a.z) + w1 * bfhi(bq.z) + w2 * bfhi(cq.z));
        o.w = pk2(w0 * bflo(a.w) + w1 * bflo(bq.w) + w2 * bflo(cq.w), w0 * bfhi(a.w) + w1 * bfhi(bq.w) + w2 * bfhi(cq.w));
        *(v4u*)(A2b + (size_t)t * 512 + h * 64 + c8 * 8) = o;
    }
}

__device__ __forceinline__ void phase_ln_route(Frame& F, const float* z, const float* g, const float* bt, const float* rwT, const float* rb,
                                               float* x1f, bf16* x1b, int* tok_es, float* tok_gate, int* rowtok, unsigned* cnt_g) {
    LAS float* xt = (LAS float*)F.lds;
    LAS float* part = xt + 16 * 1028;
    LAS int* lcnt = (LAS int*)(F.lds + LDS_RT); LAS int* base = lcnt + 32; LAS int* rec = lcnt + 64;
    const int r16 = F.lane & 15, kq = F.lane >> 4, w = F.wave;
    f32x4 Wr[2][8];
#pragma unroll
    for (int nt = 0; nt < 2; ++nt)
#pragma unroll
        for (int q = 0; q < 8; ++q) Wr[nt][q] = *(const f32x4*)(rwT + (size_t)(16 * nt + r16) * D + 128 * w + 16 * q + 4 * kq);
    f32x4 g4[4], b4[4];
#pragma unroll
    for (int j = 0; j < 4; ++j) { g4[j] = *(const f32x4*)(g + 4 * F.lane + 256 * j); b4[j] = *(const f32x4*)(bt + 4 * F.lane + 256 * j); }
    const int my_e = F.lane & 31, hh = F.lane >> 5; const float my_rb = rb[my_e];
    for (int chunk = blockIdx.x; chunk < T / 128; chunk += F.G) {
        __syncthreads();
        if (F.tid < 32) lcnt[F.tid] = 0;
        f32x4 zn[2][4];
#pragma unroll
        for (int u = 0; u < 2; ++u)
#pragma unroll
            for (int j = 0; j < 4; ++j) zn[u][j] = *(const f32x4*)(z + (size_t)(chunk * 128 + 2 * w + u) * D + 4 * F.lane + 256 * j);
        for (int rd = 0; rd < 8; ++rd) {
#pragma unroll
            for (int u = 0; u < 2; ++u) {
                const int t = chunk * 128 + rd * 16 + 2 * w + u;
                f32x4 v[4]; float s = 0.f;
#pragma unroll
                for (int j = 0; j < 4; ++j) { v[j] = zn[u][j]; s += (v[j][0] + v[j][1]) + (v[j][2] + v[j][3]); }
                const float mean = wave_sum(s) * (1.0f / D); float s2 = 0.f;
#pragma unroll
                for (int j = 0; j < 4; ++j) { v[j] = v[j] - mean; s2 += (v[j][0] * v[j][0] + v[j][1] * v[j][1]) + (v[j][2] * v[j][2] + v[j][3] * v[j][3]); }
                const float rstd = 1.0f / sqrtf(wave_sum(s2) * (1.0f / D) + LN_EPS);
#pragma unroll
                for (int j = 0; j < 4; ++j) { v[j] = v[j] * rstd * g4[j] + b4[j];
                    *(f32x4*)(x1f + (size_t)t * D + 4 * F.lane + 256 * j) = v[j];
                    v2u wv; wv.x = pk2(v[j][0], v[j][1]); wv.y = pk2(v[j][2], v[j][3]); *(v2u*)(x1b + (size_t)t * D + 4 * F.lane + 256 * j) = wv;
                    *(LAS f32x4*)(xt + (2 * w + u) * 1028 + 4 * F.lane + 256 * j) = v[j]; }
            }
            if (rd < 7) {
#pragma unroll
                for (int u = 0; u < 2; ++u)
#pragma unroll
                    for (int j = 0; j < 4; ++j) zn[u][j] = *(const f32x4*)(z + (size_t)(chunk * 128 + (rd + 1) * 16 + 2 * w + u) * D + 4 * F.lane + 256 * j);
            }
            __syncthreads();
            f32x4 a0 = (f32x4){0.f, 0.f, 0.f, 0.f}, a1 = (f32x4){0.f, 0.f, 0.f, 0.f};
#pragma unroll
            for (int q = 0; q < 8; ++q) { const f32x4 av = *(const LAS f32x4*)(xt + r16 * 1028 + 128 * w + 16 * q + 4 * kq);
#pragma unroll
                for (int j = 0; j < 4; ++j) { a0 = __builtin_amdgcn_mfma_f32_16x16x4f32(av[j], Wr[0][q][j], a0, 0, 0, 0); a1 = __builtin_amdgcn_mfma_f32_16x16x4f32(av[j], Wr[1][q][j], a1, 0, 0, 0); } }
#pragma unroll
            for (int jj = 0; jj < 4; ++jj) { part[(w * 16 + 4 * kq + jj) * 33 + r16] = a0[jj]; part[(w * 16 + 4 * kq + jj) * 33 + 16 + r16] = a1[jj]; }
            __syncthreads();
            {
                const int tokl = 2 * w + hh, tl = rd * 16 + tokl, t = chunk * 128 + tl;
                float val = my_rb;
#pragma unroll
                for (int ww = 0; ww < 8; ++ww) val += part[(ww * 16 + tokl) * 33 + my_e];
                float tv[4]; int ti[4];
#pragma unroll
                for (int k = 0; k < 4; ++k) { float kv = val; int ki = my_e;
#pragma unroll
                    for (int off = 1; off < 32; off <<= 1) { const float ov = __shfl_xor(kv, off); const int oi = __shfl_xor(ki, off); const bool take = (ov > kv) || (ov == kv && oi < ki); kv = take ? ov : kv; ki = take ? oi : ki; }
                    tv[k] = kv; ti[k] = ki; if (my_e == ki) val = -INFINITY; }
                const float e1 = __expf(tv[1] - tv[0]), e2 = __expf(tv[2] - tv[0]), e3 = __expf(tv[3] - tv[0]); const float inv = 1.0f / (1.0f + e1 + e2 + e3);
                if (my_e < 4) { const int k = my_e; const int ee = (k == 0) ? ti[0] : (k == 1) ? ti[1] : (k == 2) ? ti[2] : ti[3];
                    const float gk = ((k == 0) ? 1.0f : (k == 1) ? e1 : (k == 2) ? e2 : e3) * inv;
                    const int slot = __hip_atomic_fetch_add(lcnt + ee, 1, __ATOMIC_RELAXED, __HIP_MEMORY_SCOPE_WORKGROUP);
                    rec[tl * 4 + k] = ee | (slot << 8); tok_gate[(size_t)t * 4 + k] = gk; }
            }
        }
        __syncthreads();
        if (F.tid < 32) base[F.tid] = (int)__hip_atomic_fetch_add(cnt_g + F.tid, (unsigned)lcnt[F.tid], __ATOMIC_RELAXED, __HIP_MEMORY_SCOPE_AGENT);
        __syncthreads();
        { const int rr = rec[F.tid], e = rr & 255, slot = (rr >> 8) + base[e]; tok_es[(size_t)chunk * 512 + F.tid] = e | (slot << 8); rowtok[(size_t)e * T + slot] = chunk * 128 + (F.tid >> 2); }
    }
    __syncthreads();
}

__device__ __forceinline__ int build_tiles(Frame& F, const unsigned* cnt_g) {
    LAS int* tbs = (LAS int*)(F.lds + LDS_TB); LAS int* cl = tbs + 40; LAS int* te = (LAS int*)(F.lds + LDS_TE);
    __syncthreads();
    if (F.tid == 0) { int a = 0; for (int e = 0; e < NEXP; ++e) { const int c = (int)cnt_g[e]; tbs[e] = a; cl[e] = c; a += (c + 255) >> 8; } tbs[NEXP] = a; }
    __syncthreads();
    const int total = tbs[NEXP];
    for (int rt = F.tid; rt < total; rt += NTHR) { int e = 0; for (int k = 1; k < NEXP; ++k) e = (rt >= tbs[k]) ? k : e; te[rt] = e; }
    __syncthreads();
    return total;
}
__device__ __forceinline__ void phase_combine_ln(Frame& F, const unsigned* cnt_g, const float* x1f, const bf16* Y, const int* tok_es, const float* tok_gate, const float* g, const float* bt, float* xout, bf16* xb) {
    (void)build_tiles(F, cnt_g);
    const LAS int* tbs = (const LAS int*)(F.lds + LDS_TB);
    f32x4 g4[4], b4[4];
#pragma unroll
    for (int j = 0; j < 4; ++j) { g4[j] = *(const f32x4*)(g + 4 * F.lane + 256 * j); b4[j] = *(const f32x4*)(bt + 4 * F.lane + 256 * j); }
    for (int t = F.gw; t < T; t += F.NGW) {
        f32x4 v[4];
#pragma unroll
        for (int j = 0; j < 4; ++j) v[j] = *(const f32x4*)(x1f + (size_t)t * D + 4 * F.lane + 256 * j) * DN_ALPHA;
#pragma unroll
        for (int k = 0; k < 4; ++k) { const int es = tok_es[(size_t)t * 4 + k]; const int row = tbs[es & 255] * 256 + (es >> 8); const float gk = tok_gate[(size_t)t * 4 + k];
#pragma unroll
            for (int j = 0; j < 4; ++j) { const v2u w = *(const v2u*)(Y + (size_t)row * D + 4 * F.lane + 256 * j);
                v[j][0] += gk * bflo(w.x); v[j][1] += gk * bfhi(w.x); v[j][2] += gk * bflo(w.y); v[j][3] += gk * bfhi(w.y); } }
        float s = 0.f;
#pragma unroll
        for (int j = 0; j < 4; ++j) s += (v[j][0] + v[j][1]) + (v[j][2] + v[j][3]);
        const float mean = wave_sum(s) * (1.0f / D); float s2 = 0.f;
#pragma unroll
        for (int j = 0; j < 4; ++j) { v[j] = v[j] - mean; s2 += (v[j][0] * v[j][0] + v[j][1] * v[j][1]) + (v[j][2] * v[j][2] + v[j][3] * v[j][3]); }
        const float rstd = 1.0f / sqrtf(wave_sum(s2) * (1.0f / D) + LN_EPS);
#pragma unroll
        for (int j = 0; j < 4; ++j) { v[j] = v[j] * rstd * g4[j] + b4[j];
#if defined(PROBE_CLK)
            { const float dv = ((const float*)cnt_g)[256 - 96]; if (dv != 0.f) v[j] = (f32x4){dv, dv, dv, dv}; }
#endif
            *(f32x4*)(xout + (size_t)t * D + 4 * F.lane + 256 * j) = v[j];
            v2u w; w.x = pk2(v[j][0], v[j][1]); w.y = pk2(v[j][2], v[j][3]); *(v2u*)(xb + (size_t)t * D + 4 * F.lane + 256 * j) = w; }
    }
}
#ifndef REP_P0
#define REP_P0 1
#endif
#ifndef REP_A1
#define REP_A1 1
#endif
#ifndef REP_MKV
#define REP_MKV 1
#endif
#ifndef REP_CONV
#define REP_CONV 1
#endif
#ifndef REP_MATT
#define REP_MATT 1
#endif
#ifndef REP_A3
#define REP_A3 1
#endif
#ifndef REP_B1
#define REP_B1 1
#endif
#ifndef REP_B1KV
#define REP_B1KV 1
#endif
#ifndef REP_DIL
#define REP_DIL 1
#endif
#ifndef REP_DILC
#define REP_DILC 1
#endif
#ifndef REP_B4
#define REP_B4 1
#endif
#ifndef REP_M2
#define REP_M2 1
#endif
#ifndef REP_M3
#define REP_M3 1
#endif
#ifndef REP_M4
#define REP_M4 1
#endif
#ifndef REP_M5
#define REP_M5 1
#endif
#ifndef EN_ALL
#define EN_ALL 1
#endif
#ifndef EN_P0
#define EN_P0 EN_ALL
#endif
#ifndef EN_A1
#define EN_A1 EN_ALL
#endif
#ifndef EN_MKV
#define EN_MKV EN_ALL
#endif
#ifndef EN_CONV
#define EN_CONV EN_ALL
#endif
#ifndef EN_MATT
#define EN_MATT EN_ALL
#endif
#ifndef EN_A3
#define EN_A3 EN_ALL
#endif
#ifndef EN_B1
#define EN_B1 EN_ALL
#endif
#ifndef EN_B1KV
#define EN_B1KV EN_ALL
#endif
#ifndef EN_DIL
#define EN_DIL EN_ALL
#endif
#ifndef EN_DILC
#define EN_DILC EN_ALL
#endif
#ifndef EN_B4
#define EN_B4 EN_ALL
#endif
#ifndef EN_M1
#define EN_M1 EN_ALL
#endif
#ifndef EN_M2
#define EN_M2 EN_ALL
#endif
#ifndef EN_M3
#define EN_M3 EN_ALL
#endif
#ifndef EN_M4
#define EN_M4 EN_ALL
#endif
#ifndef EN_M5
#define EN_M5 EN_ALL
#endif

#ifndef MK_N_LAUNCHES
#define MK_N_LAUNCHES 1
#endif
constexpr int NPHASE = 1 + 2 * 7 + 2 * 8;
struct Args { const void* in[24]; float* out; unsigned char* ws; int ph_lo, ph_hi; };
static_assert(sizeof(Args) == 24 * 8 + 8 + 8 + 8, "Args has no padding");

__global__ void __launch_bounds__(NTHR, 2) fwd(Args args) {
    extern __shared__ __attribute__((aligned(16))) unsigned char lds_raw[];
    LAS unsigned char* const ldsb = (LAS unsigned char*)lds_raw;
    if (threadIdx.x < 16) ((LAS unsigned*)(ldsb + LDS_MISC))[threadIdx.x] = 0u;
    if (threadIdx.x == 0) {
        LAS unsigned long long* pt = (LAS unsigned long long*)(ldsb + LDS_PTR);
#pragma unroll
        for (int i = 0; i < 24; ++i) pt[i] = (unsigned long long)args.in[i];
        pt[24] = (unsigned long long)args.ws; pt[25] = (unsigned long long)args.out;
    }
    __syncthreads();
    const int lo = args.ph_lo, hi = args.ph_hi;
    const bool use_bar = (hi - lo) > 1;
    unsigned xcc = 0;
    if (use_bar) { const XcdBarrier b0 = xcd_barrier_post((unsigned*)(args.ws + WS_CTL) + CW_BAR, (volatile LAS unsigned*)(ldsb + LDS_MISC)); xcc = b0.x; }
#define IN(k) (lo <= (k) && (k) < hi)
#define FRAME() Frame F; { int t_ = threadIdx.x; asm volatile("" : "+v"(t_)); F.lds = ldsb; F.tid = t_; F.lane = t_ & 63; F.wave = __builtin_amdgcn_readfirstlane(t_ >> 6); \
                           F.G = gridDim.x; F.gw = blockIdx.x * NWAVES + F.wave; F.NGW = F.G * NWAVES; } unsigned char* ws = wsp(F); (void)ws
#define SEAM(k) do { if (IN(k) && IN((k) + 1)) { asm volatile("" ::: "memory"); Frame Fb; Fb.lds = ldsb; XcdBarrier b_; b_.bar = (unsigned*)(wsp(Fb) + WS_CTL) + CW_BAR; b_.x = xcc; b_.st = (volatile LAS unsigned*)(ldsb + LDS_MISC); xcd_barrier(b_); } } while (0)
#define WSB(T_, off) ((T_*)(ws + (off)))

    if (EN_P0 && IN(0)) { for (int rep_ = 0; rep_ < REP_P0; ++rep_) { FRAME(); phase_prologue(F); } }
    SEAM(0);

    for (int l = 0; l < 4; ++l) {
        const int pb = (l < 2) ? 1 + 7 * l : 15 + 8 * (l - 2);
        int pm;
        if (l < 2) {
            if (IN(pb + 0)) {
                for (int rep_ = 0; rep_ < REP_A1; ++rep_) if (EN_A1) { FRAME();
                  pg8::Gemm g{WSB(bf16, WS_XB), WSB(const bf16, WS_WIN) + (size_t)l * AIN * D, T, AIN, D}; pg8::StaticOrder S; S.init(T, AIN, F.G, (int)blockIdx.x);
                  EpiGluQ E{WSB(bf16, WS_HGLU), WSB(bf16, WS_QM), inp(F, 4) + (size_t)l * AIN};
                  pg8::gemm_phase<EpiGluQ, pg8::StaticOrder, true, true>(F.lds, g, S, E); }
                for (int rep_ = 0; rep_ < REP_MKV; ++rep_) if (EN_MKV && l == 0) { FRAME();
                  pg8::Gemm g{WSB(bf16, WS_MEMB), WSB(const bf16, WS_WMEM), 512, 2048, D}; pg8::StaticOrder S; S.init(512, 2048, F.G, (int)blockIdx.x);
                  EpiRot<2> E{WSB(bf16, WS_MEMKV), 2048, nullptr};
                  pg8::gemm_phase<EpiRot<2>, pg8::StaticOrder, true, true>(F.lds, g, S, E); }
            }
            SEAM(pb + 0);
            if (IN(pb + 1)) {
                for (int rep_ = 0; rep_ < REP_CONV; ++rep_) if (EN_CONV) { FRAME();
                  phase_conv(F, WSB(const bf16, WS_HGLU), inp(F, 5) + (size_t)l * CONV_W * CONV_CH, inp(F, 6) + (size_t)l * CONV_CH, inp(F, 7) + (size_t)l * CONV_CH, inp(F, 8) + (size_t)l * CONV_CH, WSB(bf16, WS_A2)); }
                for (int rep_ = 0; rep_ < REP_MATT; ++rep_) if (EN_MATT) { FRAME(); phase_memattn(F, WSB(const bf16, WS_QM), 256, 0, WSB(const bf16, WS_MEMKV), l, WSB(bf16, WS_A2), D, 768); }
            }
            SEAM(pb + 1);
            for (int rep_ = 0; rep_ < REP_A3; ++rep_) if (EN_A3 && IN(pb + 2)) { FRAME();
                pg8::Gemm g{WSB(bf16, WS_A2), WSB(const bf16, WS_WOA) + (size_t)l * D * D, T, D, D}; pg8::StaticOrder S; S.init(T, D, F.G, (int)blockIdx.x);
                EpiRes E{WSB(float, WS_Z), (l == 0) ? inp(F, 0) : WSB(const float, WS_XR2), inp(F, 10) + (size_t)l * D};
                pg8::gemm_phase<EpiRes, pg8::StaticOrder, true, true>(F.lds, g, S, E);
            }
            SEAM(pb + 2);
            pm = pb + 3;
        } else {
            const int j = l - 2;
            if (IN(pb + 0)) {
                for (int rep_ = 0; rep_ < REP_B1; ++rep_) if (EN_B1) { FRAME();
                  pg8::Gemm g{WSB(bf16, WS_XB), WSB(const bf16, WS_WQ) + (size_t)j * D * D, T, D, D}; pg8::StaticOrder S; S.init(T, D, F.G, (int)blockIdx.x);
                  EpiRot<0> E{WSB(bf16, WS_QB), D, WSB(const float, WS_ROT)};
                  pg8::gemm_phase<EpiRot<0>, pg8::StaticOrder, true, true>(F.lds, g, S, E); }
                for (int rep_ = 0; rep_ < REP_B1KV; ++rep_) if (EN_B1KV && j == 0) { FRAME();
                  pg8::Gemm g{WSB(bf16, WS_XB), WSB(const bf16, WS_WKV), T, KVW, D}; pg8::StaticOrder S; S.init(T, KVW, F.G, (int)blockIdx.x);
                  EpiRot<1> E{WSB(bf16, WS_KVB), KVW, WSB(const float, WS_ROT)};
                  pg8::gemm_phase<EpiRot<1>, pg8::StaticOrder, true, true>(F.lds, g, S, E); }
            }
            SEAM(pb + 0);
            if (IN(pb + 1)) {
                for (int rep_ = 0; rep_ < REP_DIL; ++rep_) if (EN_DIL) { FRAME(); phase_dilated(F, WSB(const bf16, WS_QB), WSB(const bf16, WS_KVB), WSB(bf16, WS_OG), WSB(float, WS_LSE)); }
                for (int rep_ = 0; rep_ < REP_MATT; ++rep_) if (EN_MATT) { FRAME(); phase_memattn(F, WSB(const bf16, WS_QB), D, 768, WSB(const bf16, WS_MEMKV), l, WSB(bf16, WS_A2), 512, 256); }
            }
            SEAM(pb + 1);
            for (int rep_ = 0; rep_ < REP_DILC; ++rep_) if (EN_DILC && IN(pb + 2)) { FRAME(); phase_dil_combine(F, WSB(const bf16, WS_OG), WSB(const float, WS_LSE), WSB(bf16, WS_A2)); }
            SEAM(pb + 2);
            for (int rep_ = 0; rep_ < REP_B4; ++rep_) if (EN_B4 && IN(pb + 3)) { FRAME();
                pg8::Gemm g{WSB(bf16, WS_A2), WSB(const bf16, WS_WOB) + (size_t)j * D * 512, T, D, 512}; pg8::StaticOrder S; S.init(T, D, F.G, (int)blockIdx.x);
                EpiRes E{WSB(float, WS_Z), WSB(const float, WS_XR2), inp(F, 14) + (size_t)j * D};
                pg8::gemm_phase<EpiRes, pg8::StaticOrder, true, true>(F.lds, g, S, E);
            }
            SEAM(pb + 3);
            pm = pb + 4;
        }
        if (EN_M1 && IN(pm + 0)) { FRAME();
            phase_ln_route(F, WSB(const float, WS_Z), inp(F, 16) + (size_t)(l * 2 + 0) * D, inp(F, 17) + (size_t)(l * 2 + 0) * D, WSB(const float, WS_RWT) + (size_t)l * NEXP * D, inp(F, 19) + (size_t)l * NEXP,
                           WSB(float, WS_XR1), WSB(bf16, WS_X1B), WSB(int, WS_TES), WSB(float, WS_TGATE), WSB(int, WS_RTOK), WSB(unsigned, WS_CTL) + CW_CNT + 32 * l);
        }
        SEAM(pm + 0);
        for (int rep_ = 0; rep_ < REP_M3; ++rep_) if (EN_M3 && IN(pm + 1)) { FRAME();
#if defined(PROBE_CLK)
            long long c0_ = clock64(), w0_ = wall_clock64();
#endif
            const int total = build_tiles(F, WSB(const unsigned, WS_CTL) + CW_CNT + 32 * l);
            pg8::Gemm g{WSB(bf16, WS_X1B), WSB(const bf16, WS_WUP) + (size_t)l * NEXP * 2 * DFF * D, XROWS, NEXP * 2 * DFF, D};
            MoeOrder<8> S{(const LAS int*)(F.lds + LDS_TE), (const LAS int*)(F.lds + LDS_TB), (const LAS int*)(F.lds + LDS_TB) + 40, WSB(const int, WS_RTOK), total, F.G, (int)blockIdx.x};
            EpiSwiglu E{WSB(bf16, WS_H), inp(F, 21) + (size_t)l * NEXP * 2 * DFF};
            pg8::gemm_phase_g<EpiSwiglu, MoeOrder<8>>(F.lds, g, S, E);
#if defined(PROBE_CLK)
            if (l == 3 && blockIdx.x == 0 && threadIdx.x == 0) { const long long c1_ = clock64(), w1_ = wall_clock64(); WSB(float, WS_CTL)[CW_CNT + 256] = (float)(c1_ - c0_) / (float)(w1_ - w0_); }
#endif
        }
        SEAM(pm + 1);
        for (int rep_ = 0; rep_ < REP_M4; ++rep_) if (EN_M4 && IN(pm + 2)) { FRAME();
            const int total = build_tiles(F, WSB(const unsigned, WS_CTL) + CW_CNT + 32 * l);
            pg8::Gemm g{WSB(bf16, WS_H), WSB(const bf16, WS_WDN) + (size_t)l * NEXP * DFF * D, XROWS, NEXP * D, DFF};
            MoeOrder<4> S{(const LAS int*)(F.lds + LDS_TE), (const LAS int*)(F.lds + LDS_TB), (const LAS int*)(F.lds + LDS_TB) + 40, WSB(const int, WS_RTOK), total, F.G, (int)blockIdx.x};
            EpiDown E{WSB(bf16, WS_Y), inp(F, 23) + (size_t)l * NEXP * D};
            pg8::gemm_phase<EpiDown, MoeOrder<4>, true, true>(F.lds, g, S, E);
        }
        SEAM(pm + 2);
        for (int rep_ = 0; rep_ < REP_M5; ++rep_) if (EN_M5 && IN(pm + 3)) { FRAME();
            phase_combine_ln(F, WSB(const unsigned, WS_CTL) + CW_CNT + 32 * l, WSB(const float, WS_XR1), WSB(const bf16, WS_Y), WSB(const int, WS_TES), WSB(const float, WS_TGATE), inp(F, 16) + (size_t)(l * 2 + 1) * D, inp(F, 17) + (size_t)(l * 2 + 1) * D,
                             (l == 3) ? (float*)ptr_slot(F, 25) : WSB(float, WS_XR2), WSB(bf16, WS_XB));
        }
        if (l < 3) SEAM(pm + 3);
    }
#undef IN
#undef SEAM
#undef WSB
#undef FRAME
}

extern "C" void kernel_launch(void* const* d_in, const int* in_sizes, int n_in, void* d_out, int out_size, void* d_ws, size_t ws_size, hipStream_t stream) {
    static int grid = 0;
    if (grid == 0) {
        if (n_in != 24 || in_sizes[0] != T * D || out_size != T * D || ws_size < WS_END) {
            fprintf(stderr, "kernel_launch: unexpected shapes (n_in %d, in0 %d, out %d, ws %zu < %zu); nothing launched\n", n_in, n_in > 0 ? in_sizes[0] : -1, out_size, ws_size, (size_t)WS_END); grid = -1; return; }
        if (hipFuncSetAttribute((const void*)fwd, hipFuncAttributeMaxDynamicSharedMemorySize, LDS_BYTES) != hipSuccess) { fprintf(stderr, "kernel_launch: hipFuncSetAttribute failed\n"); grid = -1; return; }
        int per_cu = 0;
        if (hipOccupancyMaxActiveBlocksPerMultiprocessor(&per_cu, (const void*)fwd, NTHR, LDS_BYTES) != hipSuccess || per_cu < 1) fprintf(stderr, "kernel_launch: note: occupancy query says %d\n", per_cu);
        (void)hipGetLastError();
        grid = 256;
    }
    if (grid < 0) return;
    (void)hipMemsetAsync((char*)d_ws + WS_CTL, 0, CTL_ZERO_BYTES, stream);
    Args a{};
    for (int i = 0; i < 24; ++i) a.in[i] = d_in[i];
    a.out = (float*)d_out; a.ws = (unsigned char*)d_ws;
#if MK_N_LAUNCHES == 1
    a.ph_lo = 0; a.ph_hi = NPHASE;
    hipLaunchKernelGGL(fwd, dim3(grid), dim3(NTHR), LDS_BYTES, stream, a);
#else
    for (int k = 0; k < NPHASE; ++k) { a.ph_lo = k; a.ph_hi = k + 1; hipLaunchKernelGGL(fwd, dim3(grid), dim3(NTHR), LDS_BYTES, stream, a); }
#endif
}
```

```cpp
#define MK_N_LAUNCHES 1
#include <hip/hip_runtime.h>
#include <cstdio>
#include <cstdint>
namespace pg8 {
#define PG8_LAS __attribute__((address_space(3)))
typedef unsigned short bf16_t;
typedef short bf16x8 __attribute__((ext_vector_type(8)));
typedef float f32x4 __attribute__((ext_vector_type(4)));
typedef unsigned u32x4 __attribute__((ext_vector_type(4)));
constexpr int BM = 256, BK = 64, HALF = 128, HTB = HALF * BK * 2  , STAGE_BYTES = 8 * HTB, NXCD = 8, WGM = 8;

__host__ __device__ __forceinline__ int lds_byte(int r, int c) { const int st = (r >> 4) * 2 + (c >> 5), rr = r & 15, cc = c & 31, ob = rr * 64 + cc * 2; return st * 1024 + (ob ^ (((ob >> 9) & 1) << 5)); }
__host__ __device__ __forceinline__ void stage_rc(int b, int& R, int& C) { const int st = b / 1024, sb = b % 1024, swz = sb ^ (((sb >> 9) & 1) << 5); R = (st >> 1) * 16 + swz / 64; C = (st & 1) * 32 + (swz % 64) / 2; }
__host__ __device__ __forceinline__ int perm32(int rho) { const int n = rho >> 4, i = rho & 15; return 8 * (i >> 2) + 4 * n + (i & 3); }

struct Unit { int pm, pn; };
struct Gemm { const bf16_t* A; const bf16_t* Bt; int M, N, K; };

struct StaticOrder {
    int nM, nN, nwg, G, c;
    __host__ __device__ void init(int M, int N, int G_, int c_) { nM = M / BM; nN = N / BM; nwg = nM * nN; G = G_; c = c_; }
    __host__ __device__ bool next(int i, Unit& u) const {
        const long L = (long)i * G + c; if (L >= nwg) return false;
        int wgid = (int)L; { const int q = nwg / NXCD, r = nwg % NXCD, xcd = wgid % NXCD, off = wgid / NXCD; wgid = (xcd < r ? xcd * (q + 1) : r * (q + 1) + (xcd - r) * q) + off; }
        const int nig = WGM * nN, gid = wgid / nig, fm = gid * WGM, gsz = (nM - fm) < WGM ? (nM - fm) : WGM;
        u.pm = fm + ((wgid % nig) % gsz); u.pn = (wgid % nig) / gsz; return true;
    }
    __device__ __forceinline__ void a_ready(const Unit&) const {}
    __device__ __forceinline__ void done(const Unit&) const {}
};

__device__ __forceinline__ unsigned cvt_pk_bf16(float lo, float hi) { unsigned r; asm volatile("v_cvt_pk_bf16_f32 %0, %1, %2" : "=v"(r) : "v"(lo), "v"(hi)); return r; }
typedef float f32x2 __attribute__((ext_vector_type(2)));
template <class Epi, class Sched, bool ALIGN_EPI = false, bool SP2 = false>
__device__ __forceinline__ void gemm_phase(PG8_LAS unsigned char* lds, const Gemm g, const Sched& S, const Epi& E) {
    int tid_ = threadIdx.x; asm volatile("" : "+v"(tid_));
    const int tid = tid_, wid = __builtin_amdgcn_readfirstlane(tid >> 6), lane = tid & 63, wr = wid >> 2, wc = wid & 3, fr = lane & 15, fq = lane >> 4;
    const int K = g.K, nt = K / BK;
#if defined(STAGGER_TICKS)
    { const unsigned dl = ((blockIdx.x >> 3) & 3u) * (unsigned)(STAGGER_TICKS); const unsigned long long t0_ = __builtin_amdgcn_s_memrealtime(); while ((unsigned)(__builtin_amdgcn_s_memrealtime() - t0_) < dl) __builtin_amdgcn_s_sleep(4); }
#endif
    unsigned voffA[2], voffB[2];
#pragma unroll
    for (int i = 0; i < 2; ++i) { int R, C; stage_rc(tid * 16 + i * 8192, R, C); const int Rb = Epi::PERM ? ((R & ~31) + perm32(R & 31)) : R;
        voffA[i] = (unsigned)(R * K + C) * 2u; voffB[i] = (unsigned)(Rb * K + C) * 2u; }
    const size_t kstep = (size_t)(BK * 2);
    const size_t hstep = (size_t)HALF * K * 2;
    const size_t tstep = 2 * hstep;
    const unsigned ldsw = (unsigned)wid * 1024u;
    const int aoff = lds_byte(wr * 64 + fr, fq * 8), boff = lds_byte(wc * 32 + fr, fq * 8);
#define PG8_SA(b, h) (((b) * 2 + (h)) * HTB)
#define PG8_SB(b, h) ((4 + (b) * 2 + (h)) * HTB)
#define PG8_STAGE(bufoff, gbase, voff) do { _Pragma("unroll") for (int _i = 0; _i < 2; ++_i) \
        __builtin_amdgcn_global_load_lds((const unsigned*)((const char*)(gbase) + (voff)[_i]), (PG8_LAS unsigned*)(lds + (bufoff) + ldsw + _i * 8192), 16, 0, 0); } while (0)
#define PG8_LDA(dst, b, h) do { _Pragma("unroll") for (int m = 0; m < 4; ++m) _Pragma("unroll") for (int k = 0; k < 2; ++k) dst[m][k] = *(const PG8_LAS bf16x8*)(lds + PG8_SA(b, h) + aoff + m * 2048 + k * 1024); } while (0)
#define PG8_LDB(dst, b, h) do { _Pragma("unroll") for (int n = 0; n < 2; ++n) _Pragma("unroll") for (int k = 0; k < 2; ++k) dst[n][k] = *(const PG8_LAS bf16x8*)(lds + PG8_SB(b, h) + boff + n * 2048 + k * 1024); } while (0)
#define PG8_MMA(ai, bj, At, Bt) do { __builtin_amdgcn_s_setprio(1); _Pragma("unroll") for (int m = 0; m < 4; ++m) _Pragma("unroll") for (int n = 0; n < 2; ++n) _Pragma("unroll") for (int k = 0; k < 2; ++k) \
        acc[ai][bj][m][n] = __builtin_amdgcn_mfma_f32_16x16x32_bf16(Bt[n][k], At[m][k], acc[ai][bj][m][n], 0, 0, 0); __builtin_amdgcn_s_setprio(0); } while (0)
#define PG8_WAIT_V(n) asm volatile("s_waitcnt vmcnt(" #n ")" ::: "memory")
#define PG8_WAIT_L(n) asm volatile("s_waitcnt lgkmcnt(" #n ")" ::: "memory")
#define PG8_BAR __builtin_amdgcn_s_barrier()
#define PG8_SCHED __builtin_amdgcn_sched_barrier(0)
    Unit cur, nxt; int ui = 0;
    if (!S.next(0, cur)) return;
    f32x4 acc[2][2][4][2];
#pragma unroll
    for (int a = 0; a < 2; ++a)
#pragma unroll
        for (int b = 0; b < 2; ++b)
#pragma unroll
            for (int m = 0; m < 4; ++m)
#pragma unroll
                for (int n = 0; n < 2; ++n) acc[a][b][m][n] = (f32x4){0.f, 0.f, 0.f, 0.f};
    bf16x8 At[4][2], B0[2][2], B1[2][2];
    const char* cA = (const char*)g.A + (size_t)cur.pm * tstep; const char* cB = (const char*)g.Bt + (size_t)cur.pn * tstep;
    S.a_ready(cur);
    if constexpr (SP2) {
        PG8_STAGE(PG8_SB(0, 0), cB, voffB); PG8_STAGE(PG8_SB(0, 1), cB + hstep, voffB); PG8_STAGE(PG8_SA(0, 0), cA, voffA); PG8_STAGE(PG8_SA(0, 1), cA + hstep, voffA);
        if (wr == 1) PG8_BAR;
        PG8_WAIT_V(2); PG8_BAR;
        PG8_STAGE(PG8_SB(1, 0), cB + kstep, voffB); PG8_STAGE(PG8_SA(1, 0), cA + kstep, voffA); PG8_STAGE(PG8_SB(1, 1), cB + hstep + kstep, voffB);
        PG8_WAIT_V(6); PG8_BAR;
    } else {
        PG8_STAGE(PG8_SB(0, 0), cB, voffB); PG8_STAGE(PG8_SA(0, 0), cA, voffA); PG8_STAGE(PG8_SB(0, 1), cB + hstep, voffB); PG8_STAGE(PG8_SA(0, 1), cA + hstep, voffA);
        if (wr == 1) PG8_BAR;
        PG8_WAIT_V(4); PG8_BAR;
        PG8_STAGE(PG8_SB(1, 0), cB + kstep, voffB); PG8_STAGE(PG8_SA(1, 0), cA + kstep, voffA); PG8_STAGE(PG8_SB(1, 1), cB + hstep + kstep, voffB);
        PG8_WAIT_V(6); PG8_BAR;
    }
    for (;;) {
        const bool has_next = S.next(ui + 1, nxt);
        const char* nA = has_next ? (const char*)g.A + (size_t)nxt.pm * tstep : cA; const char* nB = has_next ? (const char*)g.Bt + (size_t)nxt.pn * tstep : cB;
        for (int t = 0; t < nt; t += 2) {
            const bool last = (t == nt - 2);
            const char* a1 = cA + (size_t)(t + 1) * kstep;
            const char* a2 = last ? nA : cA + (size_t)(t + 2) * kstep; const char* b2 = last ? nB : cB + (size_t)(t + 2) * kstep;
            const char* a3 = a2 + kstep; const char* b3 = b2 + kstep;
            if (last && has_next) S.a_ready(nxt);
            if constexpr (SP2) {
            PG8_LDB(B0, 0, 0); PG8_LDB(B1, 0, 1); PG8_SCHED; PG8_LDA(At, 0, 0); PG8_STAGE(PG8_SA(1, 1), a1 + hstep, voffA);
            PG8_WAIT_V(8); PG8_WAIT_L(0); PG8_BAR; PG8_MMA(0, 0, At, B0); PG8_MMA(0, 1, At, B1); PG8_BAR; PG8_SCHED;
            PG8_LDA(At, 0, 1); PG8_STAGE(PG8_SB(0, 0), b2, voffB); PG8_STAGE(PG8_SB(0, 1), b2 + hstep, voffB); PG8_STAGE(PG8_SA(0, 0), a2, voffA);
            PG8_WAIT_V(8); PG8_WAIT_L(0); PG8_BAR; PG8_MMA(1, 0, At, B0); PG8_MMA(1, 1, At, B1); PG8_BAR; PG8_SCHED;
            PG8_LDB(B0, 1, 0); PG8_LDB(B1, 1, 1); PG8_SCHED; PG8_LDA(At, 1, 0); PG8_STAGE(PG8_SA(0, 1), a2 + hstep, voffA);
            PG8_WAIT_V(8); PG8_WAIT_L(0); PG8_BAR; PG8_MMA(0, 0, At, B0); PG8_MMA(0, 1, At, B1); PG8_BAR; PG8_SCHED;
            PG8_LDA(At, 1, 1); PG8_STAGE(PG8_SB(1, 0), b3, voffB); PG8_STAGE(PG8_SB(1, 1), b3 + hstep, voffB); PG8_STAGE(PG8_SA(1, 0), a3, voffA);
            PG8_WAIT_V(8); PG8_WAIT_L(0); PG8_BAR; PG8_MMA(1, 0, At, B0); PG8_MMA(1, 1, At, B1); PG8_BAR; PG8_SCHED;
            } else {
            PG8_LDB(B0, 0, 0); PG8_SCHED; PG8_LDA(At, 0, 0); PG8_STAGE(PG8_SA(1, 1), a1 + hstep, voffA);
            PG8_WAIT_L(8); PG8_BAR; PG8_WAIT_L(0); PG8_MMA(0, 0, At, B0); PG8_BAR; PG8_SCHED;
            PG8_LDB(B1, 0, 1); PG8_STAGE(PG8_SB(0, 0), b2, voffB);
            PG8_BAR; PG8_WAIT_L(0); PG8_MMA(0, 1, At, B1); PG8_BAR;
            PG8_LDA(At, 0, 1); PG8_STAGE(PG8_SA(0, 0), a2, voffA);
            PG8_BAR; PG8_WAIT_L(0); PG8_MMA(1, 0, At, B0); PG8_BAR; PG8_SCHED;
            PG8_STAGE(PG8_SB(0, 1), b2 + hstep, voffB);
            PG8_WAIT_V(6); PG8_BAR; PG8_MMA(1, 1, At, B1); PG8_BAR;
            PG8_LDB(B0, 1, 0); PG8_SCHED; PG8_LDA(At, 1, 0); PG8_STAGE(PG8_SA(0, 1), a2 + hstep, voffA);
            PG8_WAIT_L(8); PG8_BAR; PG8_WAIT_L(0); PG8_MMA(0, 0, At, B0); PG8_BAR; PG8_SCHED;
            PG8_LDB(B1, 1, 1); PG8_STAGE(PG8_SB(1, 0), b3, voffB);
            PG8_BAR; PG8_WAIT_L(0); PG8_MMA(0, 1, At, B1); PG8_BAR;
            PG8_LDA(At, 1, 1); PG8_STAGE(PG8_SA(1, 0), a3, voffA);
            PG8_BAR; PG8_WAIT_L(0); PG8_MMA(1, 0, At, B0); PG8_BAR; PG8_SCHED;
            PG8_STAGE(PG8_SB(1, 1), b3 + hstep, voffB);
            PG8_WAIT_V(6); PG8_BAR; PG8_MMA(1, 1, At, B1); PG8_BAR;
            }
        }
        if constexpr (ALIGN_EPI) { if (wr == 0) PG8_BAR; }
        if constexpr (!Epi::AFTER_DRAIN) { E(acc, cur, wr, wc, fr, fq); S.done(cur); }
#if defined(PROBE_EPI2B)
        { asm volatile("" ::: "memory");
#pragma unroll
        for (int a = 0; a < 2; ++a)
#pragma unroll
            for (int b = 0; b < 2; ++b)
#pragma unroll
                for (int m = 0; m < 4; ++m)
#pragma unroll
                    for (int n = 0; n < 2; ++n) asm volatile("" : "+v"(acc[a][b][m][n]));
        E(acc, cur, wr, wc, fr, fq); }
#endif
        if (!has_next) break;
#pragma unroll
        for (int a = 0; a < 2; ++a)
#pragma unroll
            for (int b = 0; b < 2; ++b)
#pragma unroll
                for (int m = 0; m < 4; ++m)
#pragma unroll
                    for (int n = 0; n < 2; ++n) acc[a][b][m][n] = (f32x4){0.f, 0.f, 0.f, 0.f};
        cur = nxt; cA = nA; cB = nB; ++ui;
        if constexpr (ALIGN_EPI) { if (wr == 1) PG8_BAR; }
    }
    PG8_WAIT_V(0);
    if constexpr (!ALIGN_EPI) { if (wr == 0) PG8_BAR; }
    PG8_BAR;
    if constexpr (Epi::AFTER_DRAIN) { E.fused(acc, cur, wr, wc, fr, fq, lds, wid, lane); S.done(cur); }
#undef PG8_SA
#undef PG8_SB
#undef PG8_STAGE
#undef PG8_LDA
#undef PG8_LDB
#undef PG8_MMA
#undef PG8_WAIT_V
#undef PG8_WAIT_L
#undef PG8_BAR
#undef PG8_SCHED
}
}

namespace pg8 {
typedef int i32x4 __attribute__((ext_vector_type(4)));
template <class Epi, class Sched, bool I8 = false>
__device__ __forceinline__ void gemm_phase_g(PG8_LAS unsigned char* lds, const Gemm g, const Sched& S, const Epi& E) {
    int tid_ = threadIdx.x; asm volatile("" : "+v"(tid_));
    const int tid = tid_, wid = __builtin_amdgcn_readfirstlane(tid >> 6), lane = tid & 63, wr = wid >> 2, wc = wid & 3, fr = lane & 15, fq = lane >> 4;
    const int K = g.K, nt = K / BK;
#if defined(STAGGER_TICKS)
    { const unsigned dl = ((blockIdx.x >> 3) & 3u) * (unsigned)(STAGGER_TICKS); const unsigned long long t0_ = __builtin_amdgcn_s_memrealtime(); while ((unsigned)(__builtin_amdgcn_s_memrealtime() - t0_) < dl) __builtin_amdgcn_s_sleep(4); }
#endif
    unsigned voffB[2];
#pragma unroll
    for (int i = 0; i < 2; ++i) { int R, C; stage_rc(tid * 16 + i * 8192, R, C); const int Rb = Epi::PERM ? ((R & ~31) + perm32(R & 31)) : R; voffB[i] = (unsigned)(Rb * K + C) * 2u; }
    const size_t kstep = (size_t)(BK * 2);
    const size_t hstep = (size_t)HALF * K * 2;
    const size_t tstep = 2 * hstep;
    const unsigned ldsw = (unsigned)wid * 1024u;
    const int aoff = lds_byte(wr * 64 + fr, fq * 8), boff = lds_byte(wc * 32 + fr, fq * 8);
#define PG8_SA(b, h) (((b) * 2 + (h)) * HTB)
#define PG8_SB(b, h) ((4 + (b) * 2 + (h)) * HTB)
#define PG8_STAGE(bufoff, gbase, voff) do { _Pragma("unroll") for (int _i = 0; _i < 2; ++_i) \
        __builtin_amdgcn_global_load_lds((const unsigned*)((const char*)(gbase) + (voff)[_i]), (PG8_LAS unsigned*)(lds + (bufoff) + ldsw + _i * 8192), 16, 0, 0); } while (0)
#define PG8_STAGE2(bufoff, gbase, v0, v1) do { \
        __builtin_amdgcn_global_load_lds((const unsigned*)((const char*)(gbase) + (v0)), (PG8_LAS unsigned*)(lds + (bufoff) + ldsw), 16, 0, 0); \
        __builtin_amdgcn_global_load_lds((const unsigned*)((const char*)(gbase) + (v1)), (PG8_LAS unsigned*)(lds + (bufoff) + ldsw + 8192), 16, 0, 0); } while (0)
#define PG8_LDA(dst, b, h) do { _Pragma("unroll") for (int m = 0; m < 4; ++m) _Pragma("unroll") for (int k = 0; k < 2; ++k) dst[m][k] = *(const PG8_LAS bf16x8*)(lds + PG8_SA(b, h) + aoff + m * 2048 + k * 1024); } while (0)
#define PG8_LDB(dst, b, h) do { _Pragma("unroll") for (int n = 0; n < 2; ++n) _Pragma("unroll") for (int k = 0; k < 2; ++k) dst[n][k] = *(const PG8_LAS bf16x8*)(lds + PG8_SB(b, h) + boff + n * 2048 + k * 1024); } while (0)
#define PG8_MMA(ai, bj, At, Bt) do { __builtin_amdgcn_s_setprio(1); _Pragma("unroll") for (int m = 0; m < 4; ++m) _Pragma("unroll") for (int n = 0; n < 2; ++n) _Pragma("unroll") for (int k = 0; k < 2; ++k) \
        { if constexpr (I8) acc[ai][bj][m][n] = __builtin_bit_cast(f32x4, __builtin_amdgcn_mfma_i32_16x16x64_i8(__builtin_bit_cast(i32x4, Bt[n][k]), __builtin_bit_cast(i32x4, At[m][k]), __builtin_bit_cast(i32x4, acc[ai][bj][m][n]), 0, 0, 0)); \
          else acc[ai][bj][m][n] = __builtin_amdgcn_mfma_f32_16x16x32_bf16(Bt[n][k], At[m][k], acc[ai][bj][m][n], 0, 0, 0); } __builtin_amdgcn_s_setprio(0); } while (0)
#define PG8_WAIT_V(n) asm volatile("s_waitcnt vmcnt(" #n ")" ::: "memory")
#define PG8_WAIT_L(n) asm volatile("s_waitcnt lgkmcnt(" #n ")" ::: "memory")
#define PG8_BAR __builtin_amdgcn_s_barrier()
#define PG8_SCHED __builtin_amdgcn_sched_barrier(0)
#define PG8_TOKOFF(u, tz, h, i, dst) do { int R_, C_; stage_rc((tz) * 16 + (i) * 8192, R_, C_); dst = (unsigned)S.tok(u, (h) * HALF + R_) * (unsigned)(K * 2) + (unsigned)(C_ * 2); } while (0)
    Unit cur, nxt, nn; int ui = 0;
    if (!S.next(0, cur)) return;
    bool has_next = S.next(1, nxt);
    unsigned vc00, vc01, vc10, vc11, vn00, vn01, vn10, vn11;
    { int tz = tid_; asm volatile("" : "+v"(tz));
      PG8_TOKOFF(cur, tz, 0, 0, vc00); PG8_TOKOFF(cur, tz, 0, 1, vc01); PG8_TOKOFF(cur, tz, 1, 0, vc10); PG8_TOKOFF(cur, tz, 1, 1, vc11);
      if (has_next) { PG8_TOKOFF(nxt, tz, 0, 0, vn00); PG8_TOKOFF(nxt, tz, 0, 1, vn01); PG8_TOKOFF(nxt, tz, 1, 0, vn10); PG8_TOKOFF(nxt, tz, 1, 1, vn11); }
      else { vn00 = vc00; vn01 = vc01; vn10 = vc10; vn11 = vc11; } }
    f32x4 acc[2][2][4][2];
#pragma unroll
    for (int a = 0; a < 2; ++a)
#pragma unroll
        for (int b = 0; b < 2; ++b)
#pragma unroll
            for (int m = 0; m < 4; ++m)
#pragma unroll
                for (int n = 0; n < 2; ++n) acc[a][b][m][n] = (f32x4){0.f, 0.f, 0.f, 0.f};
    bf16x8 At[4][2], B0[2][2], B1[2][2];
    const char* const cA = (const char*)g.A;
    const char* cB = (const char*)g.Bt + (size_t)cur.pn * tstep;
    PG8_STAGE(PG8_SB(0, 0), cB, voffB); PG8_STAGE(PG8_SB(0, 1), cB + hstep, voffB); PG8_STAGE2(PG8_SA(0, 0), cA, vc00, vc01); PG8_STAGE2(PG8_SA(0, 1), cA, vc10, vc11);
    if (wr == 1) PG8_BAR;
    PG8_WAIT_V(2); PG8_BAR;
    PG8_STAGE(PG8_SB(1, 0), cB + kstep, voffB); PG8_STAGE2(PG8_SA(1, 0), cA + kstep, vc00, vc01); PG8_STAGE(PG8_SB(1, 1), cB + hstep + kstep, voffB);
    PG8_WAIT_V(6); PG8_BAR;
    for (;;) {
        const char* nB = has_next ? (const char*)g.Bt + (size_t)nxt.pn * tstep : cB;
        for (int t = 0; t < nt; t += 2) {
            const bool last = (t == nt - 2);
            const char* a1 = cA + (size_t)(t + 1) * kstep;
            const char* a2 = last ? cA : cA + (size_t)(t + 2) * kstep; const char* b2 = last ? nB : cB + (size_t)(t + 2) * kstep;
            const char* a3 = a2 + kstep; const char* b3 = b2 + kstep;
            const unsigned x00 = last ? vn00 : vc00, x01 = last ? vn01 : vc01, x10 = last ? vn10 : vc10, x11 = last ? vn11 : vc11;
            PG8_LDB(B0, 0, 0); PG8_LDB(B1, 0, 1); PG8_SCHED; PG8_LDA(At, 0, 0); PG8_STAGE2(PG8_SA(1, 1), a1, vc10, vc11);
            PG8_WAIT_V(8); PG8_WAIT_L(0); PG8_BAR; PG8_MMA(0, 0, At, B0); PG8_MMA(0, 1, At, B1); PG8_BAR; PG8_SCHED;
            PG8_LDA(At, 0, 1); PG8_STAGE(PG8_SB(0, 0), b2, voffB); PG8_STAGE(PG8_SB(0, 1), b2 + hstep, voffB); PG8_STAGE2(PG8_SA(0, 0), a2, x00, x01);
            PG8_WAIT_V(8); PG8_WAIT_L(0); PG8_BAR; PG8_MMA(1, 0, At, B0); PG8_MMA(1, 1, At, B1); PG8_BAR; PG8_SCHED;
            PG8_LDB(B0, 1, 0); PG8_LDB(B1, 1, 1); PG8_SCHED; PG8_LDA(At, 1, 0); PG8_STAGE2(PG8_SA(0, 1), a2, x10, x11);
            PG8_WAIT_V(8); PG8_WAIT_L(0); PG8_BAR; PG8_MMA(0, 0, At, B0); PG8_MMA(0, 1, At, B1); PG8_BAR; PG8_SCHED;
            PG8_LDA(At, 1, 1); PG8_STAGE(PG8_SB(1, 0), b3, voffB); PG8_STAGE(PG8_SB(1, 1), b3 + hstep, voffB); PG8_STAGE2(PG8_SA(1, 0), a3, x00, x01);
            PG8_WAIT_V(8); PG8_WAIT_L(0); PG8_BAR; PG8_MMA(1, 0, At, B0); PG8_MMA(1, 1, At, B1); PG8_BAR; PG8_SCHED;
        }
        if (wr == 0) PG8_BAR;
        const bool has_nn = has_next && S.next(ui + 2, nn);
        unsigned w00 = 0, w01 = 0, w10 = 0, w11 = 0;
        if (has_nn) { int tz = tid_; asm volatile("" : "+v"(tz)); PG8_TOKOFF(nn, tz, 0, 0, w00); PG8_TOKOFF(nn, tz, 0, 1, w01); PG8_TOKOFF(nn, tz, 1, 0, w10); PG8_TOKOFF(nn, tz, 1, 1, w11); }
        E(acc, cur, wr, wc, fr, fq); S.done(cur);
#if defined(PROBE_EPI2)
        asm volatile("" ::: "memory");
#pragma unroll
        for (int a = 0; a < 2; ++a)
#pragma unroll
            for (int b = 0; b < 2; ++b)
#pragma unroll
                for (int m = 0; m < 4; ++m)
#pragma unroll
                    for (int n = 0; n < 2; ++n) asm volatile("" : "+v"(acc[a][b][m][n]));
        E(acc, cur, wr, wc, fr, fq);
#endif
        if (!has_next) break;
#pragma unroll
        for (int a = 0; a < 2; ++a)
#pragma unroll
            for (int b = 0; b < 2; ++b)
#pragma unroll
                for (int m = 0; m < 4; ++m)
#pragma unroll
                    for (int n = 0; n < 2; ++n) acc[a][b][m][n] = (f32x4){0.f, 0.f, 0.f, 0.f};
        cur = nxt; cB = nB; ++ui;
        vc00 = vn00; vc01 = vn01; vc10 = vn10; vc11 = vn11;
        if (has_nn) { vn00 = w00; vn01 = w01; vn10 = w10; vn11 = w11; nxt = nn; }
        has_next = has_nn;
        if (wr == 1) PG8_BAR;
    }
    PG8_WAIT_V(0);
    PG8_BAR;
#undef PG8_SA
#undef PG8_SB
#undef PG8_STAGE
#undef PG8_STAGE2
#undef PG8_LDA
#undef PG8_LDB
#undef PG8_MMA
#undef PG8_WAIT_V
#undef PG8_WAIT_L
#undef PG8_BAR
#undef PG8_SCHED
#undef PG8_TOKOFF
}
}

#define GAS __attribute__((address_space(1)))
#define LAS __attribute__((address_space(3)))
typedef unsigned short bf16;
typedef unsigned v4u __attribute__((ext_vector_type(4)));
typedef unsigned v2u __attribute__((ext_vector_type(2)));
typedef float f32x4 __attribute__((ext_vector_type(4)));
typedef short bf16x8 __attribute__((ext_vector_type(8)));

constexpr int NWAVES = 8, NTHR = 512;
constexpr int NB = 2, SEQ = 16384, T = NB * SEQ, D = 1024;
constexpr int CONV_CH = 768, CONV_W = 31, AIN = 1792, KVW = 1536, NEXP = 32, DFF = 1024;
constexpr int MAXTILES = (T * 4) / 256 + NEXP;
constexpr int XROWS = MAXTILES * 256;
constexpr float DN_ALPHA = 1.681792830507429f;
constexpr float LN_EPS = 1e-5f;

constexpr size_t MiB = 1u << 20;
constexpr size_t al(size_t x) { return (x + MiB - 1) / MiB * MiB; }
constexpr size_t WS_CTL = 0, CTL_ZERO_BYTES = MiB;
constexpr size_t WS_ROT  = WS_CTL + MiB;
constexpr size_t WS_WIN  = WS_ROT  + al((size_t)T * 16 * 4);
constexpr size_t WS_WOA  = WS_WIN  + al((size_t)2 * AIN * D * 2);
constexpr size_t WS_WKV  = WS_WOA  + al((size_t)2 * D * D * 2);
constexpr size_t WS_WQ   = WS_WKV  + al((size_t)KVW * D * 2);
constexpr size_t WS_WOB  = WS_WQ   + al((size_t)2 * D * D * 2);
constexpr size_t WS_WMEM = WS_WOB  + al((size_t)2 * D * 512 * 2);
constexpr size_t WS_WUP  = WS_WMEM + al((size_t)4 * 512 * D * 2);
constexpr size_t WS_SBW  = WS_WUP  + al((size_t)4 * NEXP * 2 * DFF * D);
constexpr size_t WS_WDN  = WS_SBW  + al((size_t)4 * NEXP * 2 * DFF * 4);
constexpr size_t WS_MEMB = WS_WDN  + al((size_t)4 * NEXP * D * DFF * 2);
constexpr size_t WS_MEMKV= WS_MEMB + al((size_t)512 * D * 2);
constexpr size_t WS_XB   = WS_MEMKV+ al((size_t)512 * 2048 * 2);
constexpr size_t WS_X1B  = WS_XB   + al((size_t)T * D * 2);
constexpr size_t WS_XR1  = WS_X1B  + al((size_t)T * D * 2);
constexpr size_t WS_XR2  = WS_XR1  + al((size_t)T * D * 4);
constexpr size_t WS_Z    = WS_XR2  + al((size_t)T * D * 4);
constexpr size_t WS_HGLU = WS_Z    + al((size_t)T * D * 4);
constexpr size_t WS_QM   = WS_HGLU + al((size_t)T * CONV_CH * 2);
constexpr size_t WS_A2   = WS_QM   + al((size_t)T * 256 * 2);
constexpr size_t WS_QB   = WS_A2   + al((size_t)T * D * 2);
constexpr size_t WS_KVB  = WS_QB   + al((size_t)T * D * 2);
constexpr size_t WS_OG   = WS_KVB  + al((size_t)T * KVW * 2);
constexpr size_t WS_LSE  = WS_OG   + al((size_t)3 * T * 256 * 2);
constexpr size_t WS_TES  = WS_LSE  + al((size_t)3 * T * 4 * 4);
constexpr size_t WS_TGATE= WS_TES  + al((size_t)T * 4 * 4);
constexpr size_t WS_TROW = WS_TGATE+ al((size_t)T * 4 * 4);
constexpr size_t WS_RWT  = WS_TROW + al((size_t)T * 4 * 4);
constexpr size_t WS_RTOK = WS_RWT  + al((size_t)4 * NEXP * D * 4);
constexpr size_t WS_RSC  = WS_RTOK + al((size_t)NEXP * T * 4);
constexpr size_t WS_H    = WS_RSC  + al((size_t)NEXP * T * 4);
constexpr size_t WS_Y    = WS_H    + al((size_t)XROWS * DFF * 2);
constexpr size_t WS_END  = WS_Y    + al((size_t)XROWS * D * 2);
constexpr int CW_BAR = 4096;
constexpr int CW_CNT = 8192;
constexpr int LDS_SCR = 133120;
constexpr int LDS_MISC = LDS_SCR;
constexpr int LDS_TB = LDS_MISC + 64;
constexpr int LDS_TE = LDS_TB + 320;
constexpr int LDS_RT = LDS_TE + 2304;
constexpr int LDS_PTR = LDS_RT + 2304;
constexpr int LDS_SA = LDS_PTR + 256;
constexpr int LDS_BYTES = 147456;
static_assert(LDS_SA + 512 <= LDS_BYTES, "LDS map");

#define LDS_WAIT() asm volatile("s_waitcnt lgkmcnt(0)" ::: "memory")
#define VM_WAIT() asm volatile("s_waitcnt vmcnt(0)" ::: "memory")
__device__ __forceinline__ unsigned f2bf(float f) { unsigned u = __builtin_bit_cast(unsigned, f); return (u + 0x7fffu + ((u >> 16) & 1u)) >> 16; }
__device__ __forceinline__ unsigned pk2(float lo, float hi) { return f2bf(lo) | (f2bf(hi) << 16); }
__device__ __forceinline__ float bflo(unsigned w) { return __builtin_bit_cast(float, w << 16); }
__device__ __forceinline__ float bfhi(unsigned w) { return __builtin_bit_cast(float, w & 0xffff0000u); }
__device__ __forceinline__ float wave_sum(float v) {
#pragma unroll
    for (int o = 1; o < 64; o <<= 1) v += __shfl_xor(v, o);
    return v;
}
__device__ __forceinline__ float sigmoidf_(float x) { return __builtin_amdgcn_rcpf(1.0f + __builtin_amdgcn_exp2f(-1.4426950408889634f * x)); }
#define XB_TMO      128
#define XB_XCNT(j)  (256  + 64 * (j))
#define XB_XSUB(j)  (1280 + 64 * (j))
#define XB_XGEN(j)  (2304 + 64 * (j))
#define XB_TOP      3328
#define XB_TOPGEN   3392
#define XCD_BAR_WORDS 3456
#define XB_SPIN_CAP (1u << 18)

__device__ __forceinline__ unsigned xb_ld(unsigned* p)              { return __hip_atomic_load(p, __ATOMIC_RELAXED, __HIP_MEMORY_SCOPE_AGENT); }
__device__ __forceinline__ unsigned xb_add(unsigned* p, unsigned v) { return __hip_atomic_fetch_add(p, v, __ATOMIC_RELAXED, __HIP_MEMORY_SCOPE_AGENT); }
__device__ __forceinline__ unsigned xb_xcc_id() { return (unsigned)__builtin_amdgcn_s_getreg((3 << 11) | 20) & 0xFu; }
#define XB_SPIN(cond, bar) do { unsigned _sp = 0; while (cond) { __builtin_amdgcn_s_sleep(1); \
    if ((++_sp & 255u) == 0u) { if (xb_ld(&(bar)[XB_TMO])) break; if (_sp > XB_SPIN_CAP) { atomicAdd(&(bar)[XB_TMO], 1u); break; } } } } while (0)

struct XcdBarrier {
    unsigned* bar; unsigned x;
    volatile LAS unsigned* st;
};

__device__ __forceinline__ XcdBarrier xcd_barrier_post(unsigned* bar, volatile LAS unsigned* st) {
    XcdBarrier b; b.bar = bar; b.x = xb_xcc_id(); b.st = st;
    if (threadIdx.x == 0) (void)xb_add(&bar[XB_XCNT(b.x)], 1u);
    return b;
}
__device__ __forceinline__ void xcd_barrier_complete(unsigned* bar, unsigned x, unsigned& nloc, unsigned& nx) {
    const unsigned G = gridDim.x * gridDim.y * gridDim.z;
    unsigned sum, cnt, mine, sp = 0u;
    for (;;) {
        sum = 0u; cnt = 0u; mine = 0u;
#pragma unroll
        for (unsigned j = 0; j < 16; ++j) { const unsigned c = xb_ld(&bar[XB_XCNT(j)]); sum += c; cnt += (c > 0u) ? 1u : 0u; mine = (j == x) ? c : mine; }
        if (sum == G) break;
        __builtin_amdgcn_s_sleep(1);
        if ((++sp & 255u) == 0u) { if (xb_ld(&bar[XB_TMO])) break; if (sp > XB_SPIN_CAP) { atomicAdd(&bar[XB_TMO], 1u); break; } }
    }
    nloc = mine > 0u ? mine : 1u; nx = cnt > 0u ? cnt : 1u;
}

__device__ __forceinline__ void xcd_barrier(const XcdBarrier& b) {
    asm volatile("s_waitcnt vmcnt(0)" ::: "memory");
    __syncthreads();
    if (threadIdx.x == 0) {
        unsigned* bar = b.bar;
        __builtin_amdgcn_s_waitcnt(0);
        unsigned nloc = b.st[0], nx = b.st[1];
        if (nloc == 0u) { xcd_barrier_complete(bar, b.x, nloc, nx); b.st[0] = nloc; b.st[1] = nx; }
        const unsigned old = xb_add(&bar[XB_XSUB(b.x)], 1u);
        const unsigned gen = old / nloc;
        if (old + 1u == (gen + 1u) * nloc) {
            __builtin_amdgcn_fence(__ATOMIC_RELEASE, "agent");
            asm volatile("s_waitcnt vmcnt(0)" ::: "memory");
            const unsigned og = xb_add(&bar[XB_TOP], 1u);
            const unsigned tg = og / nx;
            if (og + 1u == (tg + 1u) * nx) xb_add(&bar[XB_TOPGEN], 1u);
            else XB_SPIN(xb_ld(&bar[XB_TOPGEN]) == tg, bar);
            __builtin_amdgcn_fence(__ATOMIC_ACQUIRE, "agent");
            xb_add(&bar[XB_XGEN(b.x)], 1u);
            asm volatile("s_waitcnt vmcnt(0)" ::: "memory");
        } else {
            XB_SPIN(xb_ld(&bar[XB_XGEN(b.x)]) == gen, bar);
            __builtin_amdgcn_fence(__ATOMIC_ACQUIRE, "agent");
            asm volatile("s_waitcnt vmcnt(0)" ::: "memory");
        }
    }
    __syncthreads();
}

using pg8::Unit; using pg8::cvt_pk_bf16; using pg8::BM; using pg8::HALF;
typedef unsigned u32x4 __attribute__((ext_vector_type(4)));
#if defined(EPI_NT)
#define EPI_ST(p, v) __builtin_nontemporal_store((v), (p))
#else
#define EPI_ST(p, v) (*(p) = (v))
#endif

struct EpiGluQ {
    static constexpr bool PERM = true, AFTER_DRAIN = false;
    bf16* hglu; bf16* qm; const float* bias;
    __device__ __forceinline__ void operator()(const f32x4 (&acc)[2][2][4][2], const Unit& u, int wr, int wc, int fr, int fq) const {
        const int row0 = u.pm * BM + wr * 64 + fr, cw = wc * 32 + 8 * fq;
        if (u.pn < 6) {
            f32x4 ba[2], bg[2];
#pragma unroll
            for (int n = 0; n < 2; ++n) { ba[n] = *(const f32x4*)(bias + u.pn * 128 + cw + 4 * n); bg[n] = *(const f32x4*)(bias + 768 + u.pn * 128 + cw + 4 * n); }
#pragma unroll
            for (int ai = 0; ai < 2; ++ai)
#pragma unroll
                for (int m = 0; m < 4; ++m) {
                    float o[8];
#pragma unroll
                    for (int n = 0; n < 2; ++n) { const f32x4 a = acc[ai][0][m][n] + ba[n], g = acc[ai][1][m][n] + bg[n];
#pragma unroll
                        for (int j = 0; j < 4; ++j) o[4 * n + j] = a[j] * sigmoidf_(g[j]); }
                    u32x4 w; w.x = cvt_pk_bf16(o[0], o[1]); w.y = cvt_pk_bf16(o[2], o[3]); w.z = cvt_pk_bf16(o[4], o[5]); w.w = cvt_pk_bf16(o[6], o[7]);
                    EPI_ST((u32x4*)(hglu + (size_t)(row0 + ai * HALF + m * 16) * CONV_CH + u.pn * 128 + cw), w);
                }
        } else {
            f32x4 bv[2][2];
#pragma unroll
            for (int bj = 0; bj < 2; ++bj)
#pragma unroll
                for (int n = 0; n < 2; ++n) bv[bj][n] = *(const f32x4*)(bias + 1536 + bj * HALF + cw + 4 * n);
#pragma unroll
            for (int ai = 0; ai < 2; ++ai)
#pragma unroll
                for (int m = 0; m < 4; ++m)
#pragma unroll
                    for (int bj = 0; bj < 2; ++bj) { const f32x4 v0 = acc[ai][bj][m][0] + bv[bj][0], v1 = acc[ai][bj][m][1] + bv[bj][1];
                        u32x4 w; w.x = cvt_pk_bf16(v0[0], v0[1]); w.y = cvt_pk_bf16(v0[2], v0[3]); w.z = cvt_pk_bf16(v1[0], v1[1]); w.w = cvt_pk_bf16(v1[2], v1[3]);
                        EPI_ST((u32x4*)(qm + (size_t)(row0 + ai * HALF + m * 16) * 256 + bj * HALF + cw), w); }
        }
    }
};

struct EpiRes {
    static constexpr bool PERM = false, AFTER_DRAIN = false;
    float* Z; const float* xres; const float* bias;
    __device__ __forceinline__ void operator()(const f32x4 (&acc)[2][2][4][2], const Unit& u, int wr, int wc, int fr, int fq) const {
        const int row0 = u.pm * BM + wr * 64 + fr, col0 = u.pn * BM + wc * 32 + 4 * fq;
        f32x4 bv[2][2];
#pragma unroll
        for (int bj = 0; bj < 2; ++bj)
#pragma unroll
            for (int n = 0; n < 2; ++n) bv[bj][n] = *(const f32x4*)(bias + col0 + bj * HALF + n * 16);
#pragma unroll
        for (int ai = 0; ai < 2; ++ai)
#pragma unroll
            for (int m = 0; m < 4; ++m) { const size_t off = (size_t)(row0 + ai * HALF + m * 16) * D + col0;
#pragma unroll
                for (int bj = 0; bj < 2; ++bj)
#pragma unroll
                    for (int n = 0; n < 2; ++n) { const f32x4 xr = *(const f32x4*)(xres + off + bj * HALF + n * 16);
                        EPI_ST((f32x4*)(Z + off + bj * HALF + n * 16), xr * DN_ALPHA + acc[ai][bj][m][n] + bv[bj][n]); } }
    }
};

template <int MODE> struct EpiRot {
    static constexpr bool PERM = true, AFTER_DRAIN = false;
    bf16* O; int ldc; const float* rot;
    __device__ __forceinline__ void operator()(const f32x4 (&acc)[2][2][4][2], const Unit& u, int wr, int wc, int fr, int fq) const {
        const int row0 = u.pm * BM + wr * 64 + fr;
#pragma unroll
        for (int bj = 0; bj < 2; ++bj) {
            const int cb = u.pn * BM + bj * HALF;
            bool rotu = false;
            if (MODE == 0) rotu = (cb < 768) && ((wc & 1) == 0);
            if (MODE == 1) rotu = ((cb & 511) < 256) && ((wc & 1) == 0);
#pragma unroll
            for (int ai = 0; ai < 2; ++ai)
#pragma unroll
                for (int m = 0; m < 4; ++m) {
                    const int row = row0 + ai * HALF + m * 16;
                    float v[8];
#pragma unroll
                    for (int j = 0; j < 4; ++j) { v[j] = acc[ai][bj][m][0][j]; v[4 + j] = acc[ai][bj][m][1][j]; }
                    if (rotu) {
                        float pv[8];
#pragma unroll
                        for (int j = 0; j < 8; ++j) pv[j] = __shfl_xor(v[j], 16);
                        if (fq < 2) {
                            const f32x4 c0 = *(const f32x4*)(rot + (size_t)row * 16), c1 = *(const f32x4*)(rot + (size_t)row * 16 + 4);
                            const f32x4 s0 = *(const f32x4*)(rot + (size_t)row * 16 + 8), s1 = *(const f32x4*)(rot + (size_t)row * 16 + 12);
                            const float sg = (fq == 0) ? -1.0f : 1.0f;
#pragma unroll
                            for (int j = 0; j < 4; ++j) { v[j] = v[j] * c0[j] + sg * pv[j] * s0[j]; v[4 + j] = v[4 + j] * c1[j] + sg * pv[4 + j] * s1[j]; }
                        }
                    }
                    u32x4 w; w.x = cvt_pk_bf16(v[0], v[1]); w.y = cvt_pk_bf16(v[2], v[3]); w.z = cvt_pk_bf16(v[4], v[5]); w.w = cvt_pk_bf16(v[6], v[7]);
                    EPI_ST((u32x4*)(O + (size_t)row * ldc + cb + wc * 32 + 8 * fq), w);
                }
        }
    }
};

struct EpiSwiglu {
    static constexpr bool PERM = true, AFTER_DRAIN = false;
    bf16* H; const float* bup;
    __device__ __forceinline__ void operator()(const f32x4 (&acc)[2][2][4][2], const Unit& u, int wr, int wc, int fr, int fq) const {
        const int e = u.pn >> 3, pn = u.pn & 7, row0 = u.pm * BM + wr * 64 + fr, cw = pn * 128 + wc * 32 + 8 * fq;
        f32x4 bg[2], bl[2];
#pragma unroll
        for (int n = 0; n < 2; ++n) { bg[n] = *(const f32x4*)(bup + (size_t)e * 2048 + cw + 4 * n); bl[n] = *(const f32x4*)(bup + (size_t)e * 2048 + 1024 + cw + 4 * n); }
#pragma unroll
        for (int ai = 0; ai < 2; ++ai)
#pragma unroll
            for (int m = 0; m < 4; ++m) {
                float o[8];
#pragma unroll
                for (int n = 0; n < 2; ++n) { const f32x4 g = acc[ai][0][m][n] + bg[n], li = acc[ai][1][m][n] + bl[n];
#pragma unroll
                    for (int j = 0; j < 4; ++j) { const float gg = fminf(g[j], 7.0f), ll = fminf(fmaxf(li[j], -7.0f), 7.0f); o[4 * n + j] = gg * sigmoidf_(1.702f * gg) * (ll + 1.0f); } }
                u32x4 w; w.x = cvt_pk_bf16(o[0], o[1]); w.y = cvt_pk_bf16(o[2], o[3]); w.z = cvt_pk_bf16(o[4], o[5]); w.w = cvt_pk_bf16(o[6], o[7]);
                EPI_ST((u32x4*)(H + (size_t)(row0 + ai * HALF + m * 16) * DFF + cw), w);
            }
    }
};

struct EpiSwigluI8 {
    static constexpr bool PERM = true, AFTER_DRAIN = false;
    bf16* H; const float* bup; const float* sbw; const float* rowsc; const LAS int* tbs;
    __device__ __forceinline__ void operator()(const f32x4 (&acc)[2][2][4][2], const Unit& u, int wr, int wc, int fr, int fq) const {
        const int e = u.pn >> 3, pn = u.pn & 7, row0 = u.pm * BM + wr * 64 + fr, cw = pn * 128 + wc * 32 + 8 * fq;
        const int slot0 = (u.pm - tbs[e]) * 256 + wr * 64 + fr;
        f32x4 bg[2], bl[2], sg[2], sl[2];
#pragma unroll
        for (int n = 0; n < 2; ++n) { bg[n] = *(const f32x4*)(bup + (size_t)e * 2048 + cw + 4 * n); bl[n] = *(const f32x4*)(bup + (size_t)e * 2048 + 1024 + cw + 4 * n);
            sg[n] = *(const f32x4*)(sbw + (size_t)e * 2048 + pn * 256 + wc * 32 + 8 * fq + 4 * n); sl[n] = *(const f32x4*)(sbw + (size_t)e * 2048 + pn * 256 + 128 + wc * 32 + 8 * fq + 4 * n); }
#pragma unroll
        for (int ai = 0; ai < 2; ++ai)
#pragma unroll
            for (int m = 0; m < 4; ++m) {
                const float sa = rowsc[(size_t)e * T + slot0 + ai * HALF + m * 16];
                float o[8];
#pragma unroll
                for (int n = 0; n < 2; ++n) {
#pragma unroll
                    for (int j = 0; j < 4; ++j) {
                        const float g = (float)__float_as_int(acc[ai][0][m][n][j]) * (sa * sg[n][j]) + bg[n][j], li = (float)__float_as_int(acc[ai][1][m][n][j]) * (sa * sl[n][j]) + bl[n][j];
                        const float gg = fminf(g, 7.0f), ll = fminf(fmaxf(li, -7.0f), 7.0f); o[4 * n + j] = gg * sigmoidf_(1.702f * gg) * (ll + 1.0f);
#if defined(PROBE_H) && (PROBE_H == 3 || PROBE_H >= 7)
                        o[4 * n + j] = (float)__float_as_int(acc[ai][0][m][n][j]);
#endif
                    } }
                u32x4 w; w.x = cvt_pk_bf16(o[0], o[1]); w.y = cvt_pk_bf16(o[2], o[3]); w.z = cvt_pk_bf16(o[4], o[5]); w.w = cvt_pk_bf16(o[6], o[7]);
                EPI_ST((u32x4*)(H + (size_t)(row0 + ai * HALF + m * 16) * DFF + cw), w);
            }
    }
};

struct EpiDown {
    static constexpr bool PERM = true, AFTER_DRAIN = false;
    bf16* Y; const float* bdn;
    __device__ __forceinline__ void operator()(const f32x4 (&acc)[2][2][4][2], const Unit& u, int wr, int wc, int fr, int fq) const {
        const int e = u.pn >> 2, pn = u.pn & 3, row0 = u.pm * BM + wr * 64 + fr, cw = pn * BM + wc * 32 + 8 * fq;
        f32x4 bv[2][2];
#pragma unroll
        for (int bj = 0; bj < 2; ++bj)
#pragma unroll
            for (int n = 0; n < 2; ++n) bv[bj][n] = *(const f32x4*)(bdn + (size_t)e * D + cw + bj * HALF + 4 * n);
#pragma unroll
        for (int ai = 0; ai < 2; ++ai)
#pragma unroll
            for (int m = 0; m < 4; ++m)
#pragma unroll
                for (int bj = 0; bj < 2; ++bj) { const f32x4 v0 = acc[ai][bj][m][0] + bv[bj][0], v1 = acc[ai][bj][m][1] + bv[bj][1];
                    u32x4 w; w.x = cvt_pk_bf16(v0[0], v0[1]); w.y = cvt_pk_bf16(v0[2], v0[3]); w.z = cvt_pk_bf16(v1[0], v1[1]); w.w = cvt_pk_bf16(v1[2], v1[3]);
                    EPI_ST((u32x4*)(Y + (size_t)(row0 + ai * HALF + m * 16) * D + cw + bj * HALF), w); }
    }
};

template <int NTN> struct MoeOrder {
    const LAS int* tile_e; const LAS int* tbs; const LAS int* cntl; const int* rowtok; int total, G, c;
    __device__ __forceinline__ bool next(int i, Unit& u) const {
#if defined(MOE_ORDER_B)
        const int L = i * G + c, grp = L / (8 * NTN), w = L % (8 * NTN), rt = grp * 8 + (w / NTN), pn = w % NTN;
#else
        const int L = i * G + c, grp = L / (8 * NTN), w = L % (8 * NTN), rt = grp * 8 + (w & 7), pn = w >> 3;
#endif
        if (rt >= total) return false;
        const int e = __builtin_amdgcn_readfirstlane(tile_e[rt]);
        u.pm = rt; u.pn = e * NTN + pn; return true;
    }
    __device__ __forceinline__ int tok(const Unit& u, int r) const {
        const int e = u.pn / NTN, slot = (u.pm - tbs[e]) * 256 + r; int t = 0;
        if (slot < cntl[e]) t = rowtok[(size_t)e * T + slot];
        return t;
    }
    __device__ __forceinline__ void a_ready(const Unit&) const {}
    __device__ __forceinline__ void done(const Unit&) const {}
};

struct Frame {
    LAS unsigned char* lds;
    int tid, lane, wave, G, gw, NGW;
};
__device__ __forceinline__ unsigned char* ptr_slot(const Frame& F, int k) {
    const unsigned long long v = *(const LAS unsigned long long*)(F.lds + LDS_PTR + 8 * k);
    const unsigned lo = __builtin_amdgcn_readfirstlane((unsigned)v), hi = __builtin_amdgcn_readfirstlane((unsigned)(v >> 32));
    return (unsigned char*)(GAS unsigned char*)(((unsigned long long)hi << 32) | lo);
}
__device__ __forceinline__ const float* inp(const Frame& F, int k) { return (const float*)ptr_slot(F, k); }
__device__ __forceinline__ unsigned char* wsp(const Frame& F) { return ptr_slot(F, 24); }

__device__ __forceinline__ void tr_item(const float* W, int N, bf16* WT, int K, int k0, int n0, int orow0, LAS float* scr, int lane) {
#if defined(P0_V2)
    { float tv_[64];
#pragma unroll
      for (int i = 0; i < 64; ++i) tv_[i] = __builtin_nontemporal_load(W + (size_t)(k0 + i) * N + n0 + lane);
#pragma unroll
      for (int i = 0; i < 64; ++i) scr[i * 65 + lane] = tv_[i]; }
#else
#pragma unroll 16
    for (int i = 0; i < 64; ++i) scr[i * 65 + lane] = W[(size_t)(k0 + i) * N + n0 + lane];
#endif
    LDS_WAIT(); asm volatile("" ::: "memory");
    const int c = lane & 7;
#pragma unroll
    for (int j = 0; j < 8; ++j) { const int n = (lane >> 3) + 8 * j; const LAS float* s = scr + (8 * c) * 65 + n;
        v4u o; o.x = pk2(s[0 * 65], s[1 * 65]); o.y = pk2(s[2 * 65], s[3 * 65]); o.z = pk2(s[4 * 65], s[5 * 65]); o.w = pk2(s[6 * 65], s[7 * 65]);
        *(v4u*)(WT + (size_t)(orow0 + n) * K + k0 + 8 * c) = o; }
    LDS_WAIT(); asm volatile("" ::: "memory");
}
template <int PERMT> __device__ __forceinline__ int perm_row(int n0) {
    if (PERMT == 1) { if (n0 >= 1536) return n0; const int bj = n0 / 768, r = n0 % 768; return (r / 128) * 256 + bj * 128 + (r % 128); }
    if (PERMT == 2) { const int bj = n0 / 1024, r = n0 % 1024; return (r / 128) * 256 + bj * 128 + (r % 128); }
    return n0;
}
template <int PERMT> __device__ __forceinline__ void conv_group(Frame& F, const float* src, bf16* dst, int K, int N, int nmat) {
    LAS float* scr = (LAS float*)(F.lds + F.wave * 16640);
    const int nkb = K / 64, nnb = N / 64, per = nkb * nnb, total = per * nmat;
    for (int it = F.gw; it < total; it += F.NGW) {
        const int mat = it / per, r = it % per, kb = r / nnb, nb = r % nnb;
        tr_item(src + (size_t)mat * K * N, N, dst + (size_t)mat * K * N, K, kb * 64, nb * 64, perm_row<PERMT>(nb * 64), scr, F.lane);
    }
}
__device__ __forceinline__ void conv_up_i8(Frame& F, const float* src, unsigned char* dst, float* sbw) {
    constexpr int K = D, N = 2 * DFF, NSTRIP = N / 64, TOTAL = 4 * NEXP * NSTRIP;
    for (int it = F.gw; it < TOTAL; it += F.NGW) {
        const int mat = it / NSTRIP, n0 = (it % NSTRIP) * 64;
        const float* W = src + (size_t)mat * K * N + n0 + F.lane;
        float mx = 0.f;
        for (int k0 = 0; k0 < K; k0 += 32) {
            float t[32];
#pragma unroll
            for (int i = 0; i < 32; ++i) t[i] = W[(size_t)(k0 + i) * N];
#pragma unroll
            for (int i = 0; i < 32; ++i) mx = fmaxf(mx, fabsf(t[i]));
        }
        mx = fmaxf(mx, 1e-30f);
        const float inv = 127.0f / mx;
        const int orow = perm_row<2>(n0) + F.lane;
        sbw[(size_t)mat * N + orow] = mx * (1.0f / 127.0f);
        unsigned char* out = dst + ((size_t)mat * N + orow) * K;
        for (int k0 = 0; k0 < K; k0 += 32) {
            float t[32];
#pragma unroll
            for (int i = 0; i < 32; ++i) t[i] = W[(size_t)(k0 + i) * N];
            unsigned pk[8];
#pragma unroll
            for (int i = 0; i < 8; ++i) { const int q0 = (int)rintf(t[4 * i] * inv), q1 = (int)rintf(t[4 * i + 1] * inv), q2 = (int)rintf(t[4 * i + 2] * inv), q3 = (int)rintf(t[4 * i + 3] * inv);
                pk[i] = (unsigned)(q0 & 255) | ((unsigned)(q1 & 255) << 8) | ((unsigned)(q2 & 255) << 16) | ((unsigned)(q3 & 255) << 24); }
#if defined(PROBE_H) && PROBE_H == 7
#pragma unroll
            for (int i = 0; i < 8; ++i) pk[i] = 0x01010101u;
#endif
#if defined(PROBE_H) && (PROBE_H == 9 || PROBE_H == 10)
#pragma unroll
            for (int i = 0; i < 8; ++i) pk[i] = 0x01010101u * (unsigned)((PROBE_H == 9) ? (orow & 127) : (orow >> 4));
#endif
            *(v4u*)(out + k0) = (v4u){pk[0], pk[1], pk[2], pk[3]}; *(v4u*)(out + k0 + 16) = (v4u){pk[4], pk[5], pk[6], pk[7]};
        }
    }
}
__device__ __forceinline__ void phase_prologue(Frame& F) {
    unsigned char* ws = wsp(F);
#if defined(PROBE_I8)
    if (blockIdx.x == 0 && F.wave == 0) {
        typedef int i32x4_ __attribute__((ext_vector_type(4)));
        const int i = F.lane & 15, g = F.lane >> 4;
        unsigned aw[4], bw[4];
        for (int w = 0; w < 4; ++w) { unsigned a = 0, b = 0; for (int t = 0; t < 4; ++t) { const int k = 16 * g + 4 * w + t; const int av = ((i * 7 + k * 3) % 11) - 5, bv = ((k * 5 + i * 2) % 13) - 6; a |= (unsigned)(av & 255) << (8 * t); b |= (unsigned)(bv & 255) << (8 * t); } aw[w] = a; bw[w] = b; }
        i32x4_ A = {(int)aw[0], (int)aw[1], (int)aw[2], (int)aw[3]}, B = {(int)bw[0], (int)bw[1], (int)bw[2], (int)bw[3]}, C = {0, 0, 0, 0};
        C = __builtin_amdgcn_mfma_i32_16x16x64_i8(A, B, C, 0, 0, 0);
        int bad = 0;
        for (int jj = 0; jj < 4; ++jj) { const int row = 4 * g + jj, col = i; int ref = 0; for (int k = 0; k < 64; ++k) ref += (((row * 7 + k * 3) % 11) - 5) * (((k * 5 + col * 2) % 13) - 6); if (ref != C[jj]) bad = 1; }
        const unsigned long long bm = __ballot(bad);
        if (F.lane == 0) ((float*)(ws + WS_CTL))[CW_CNT + 256] = bm ? 3.0f : 1.0f;
    }
#endif
    conv_group<1>(F, inp(F, 3),  (bf16*)(ws + WS_WIN),  D, AIN, 2);
    conv_group<0>(F, inp(F, 9),  (bf16*)(ws + WS_WOA),  D, D, 2);
    conv_group<0>(F, inp(F, 11), (bf16*)(ws + WS_WKV),  D, KVW, 1);
    conv_group<0>(F, inp(F, 12), (bf16*)(ws + WS_WQ),   D, D, 2);
    conv_group<0>(F, inp(F, 13), (bf16*)(ws + WS_WOB),  512, D, 2);
    conv_group<0>(F, inp(F, 15), (bf16*)(ws + WS_WMEM), D, 512, 4);
    conv_up_i8(F, inp(F, 20), (unsigned char*)(ws + WS_WUP), (float*)(ws + WS_SBW));
    conv_group<0>(F, inp(F, 22), (bf16*)(ws + WS_WDN),  DFF, D, 4 * NEXP);
    {
        const size_t gt = (size_t)blockIdx.x * NTHR + F.tid, NT_ = (size_t)F.G * NTHR;
        const float* x = inp(F, 0); bf16* xb = (bf16*)(ws + WS_XB);
        for (size_t i = gt; i < (size_t)T * D / 8; i += NT_) { const f32x4 a = *(const f32x4*)(x + i * 8), b = *(const f32x4*)(x + i * 8 + 4);
            v4u o; o.x = pk2(a[0], a[1]); o.y = pk2(a[2], a[3]); o.z = pk2(b[0], b[1]); o.w = pk2(b[2], b[3]); *(v4u*)(xb + i * 8) = o; }
        const float* mem = inp(F, 1); bf16* mb = (bf16*)(ws + WS_MEMB);
        for (size_t i = gt; i < (size_t)512 * D / 8; i += NT_) { const f32x4 a = *(const f32x4*)(mem + i * 8), b = *(const f32x4*)(mem + i * 8 + 4);
            v4u o; o.x = pk2(a[0], a[1]); o.y = pk2(a[2], a[3]); o.z = pk2(b[0], b[1]); o.w = pk2(b[2], b[3]); *(v4u*)(mb + i * 8) = o; }
        { const float* rw = inp(F, 18); float* rwT = (float*)(ws + WS_RWT);
          for (size_t i = gt; i < (size_t)4 * NEXP * D; i += NT_) { const int l = (int)(i >> 15), e = (int)((i >> 10) & 31), c = (int)(i & 1023); rwT[i] = rw[((size_t)l * D + c) * NEXP + e]; } }
        const int* pos = (const int*)inp(F, 2); float* rot = (float*)(ws + WS_ROT);
        for (size_t i = gt; i < (size_t)T * 8; i += NT_) { const int t = (int)(i >> 3), k = (int)(i & 7);
            double f = 1.0;
            f = (k == 1) ? 0.19392274474868576 : f; f = (k == 2) ? 0.03760603093086393 : f; f = (k == 3) ? 0.007292664737217109 : f; f = (k == 4) ? 0.001414213562373095 : f;
            f = (k == 5) ? 0.0002742481756762073 : f; f = (k == 6) ? 5.318295896944988e-05 : f; f = (k == 7) ? 1.031338537721246e-05 : f;
            const double a = (double)pos[t] * f; const double rv = a * 0.15915494309189535; const double fr = rv - floor(rv);
            const float ang = (float)(fr * 6.283185307179586);
            rot[(size_t)t * 16 + k] = cosf(ang); rot[(size_t)t * 16 + 8 + k] = sinf(ang); }
    }
}

__device__ __forceinline__ void phase_conv(Frame& F, const bf16* hglu, const float* dw, const float* dwb, const float* cg, const float* cb, bf16* A2) {
    LAS bf16* tile = (LAS bf16*)F.lds;
    LAS float* red = (LAS float*)(F.lds + 46 * 768 * 2);
    const int L = F.tid & 255, tb = F.tid >> 8, wv = F.wave & 3;
    float w[31][3], bias[3], gg[3], bb[3];
#pragma unroll
    for (int p = 0; p < 3; ++p) { bias[p] = dwb[p * 256 + L]; gg[p] = cg[p * 256 + L]; bb[p] = cb[p * 256 + L];
#pragma unroll
        for (int j = 0; j < 31; ++j) w[j][p] = dw[j * CONV_CH + p * 256 + L]; }
    for (int ti = blockIdx.x; ti < T / 16; ti += F.G) {
        const int t0 = ti * 16, s0 = t0 & (SEQ - 1);
        __syncthreads();
        for (int i = F.tid; i < 46 * 96; i += NTHR) { const int r = i / 96, c = i % 96; v4u v = (v4u){0u, 0u, 0u, 0u};
            if (s0 - 30 + r >= 0) v = *(const v4u*)(hglu + (size_t)(t0 - 30 + r) * CONV_CH + c * 8);
            *(LAS v4u*)(tile + r * CONV_CH + c * 8) = v; }
        __syncthreads();
        float acc[8][3];
#pragma unroll
        for (int t = 0; t < 8; ++t)
#pragma unroll
            for (int p = 0; p < 3; ++p) acc[t][p] = bias[p];
#pragma unroll
        for (int r = 0; r < 38; ++r) {
            float x[3];
#pragma unroll
            for (int p = 0; p < 3; ++p) x[p] = bflo((unsigned)tile[(tb * 8 + r) * CONV_CH + p * 256 + L]);
#pragma unroll
            for (int t = 0; t < 8; ++t) { const int j = r - t; if (j >= 0 && j <= 30) {
#pragma unroll
                for (int p = 0; p < 3; ++p) acc[t][p] += x[p] * w[j][p]; } }
        }
        float mean[8], rstd[8];
#pragma unroll
        for (int t = 0; t < 8; ++t) { const float s = wave_sum(acc[t][0] + acc[t][1] + acc[t][2]); if (F.lane == 0) red[(tb * 4 + wv) * 8 + t] = s; }
        __syncthreads();
#pragma unroll
        for (int t = 0; t < 8; ++t) { const LAS float* rp = red + tb * 32 + t; mean[t] = (rp[0] + rp[8] + rp[16] + rp[24]) * (1.0f / CONV_CH); }
#pragma unroll
        for (int t = 0; t < 8; ++t) { const float d0 = acc[t][0] - mean[t], d1 = acc[t][1] - mean[t], d2 = acc[t][2] - mean[t];
            const float s = wave_sum(d0 * d0 + d1 * d1 + d2 * d2); if (F.lane == 0) red[64 + (tb * 4 + wv) * 8 + t] = s; }
        __syncthreads();
#pragma unroll
        for (int t = 0; t < 8; ++t) { const LAS float* rp = red + 64 + tb * 32 + t; rstd[t] = 1.0f / sqrtf((rp[0] + rp[8] + rp[16] + rp[24]) * (1.0f / CONV_CH) + LN_EPS); }
#pragma unroll
        for (int t = 0; t < 8; ++t)
#pragma unroll
            for (int p = 0; p < 3; ++p) { const float y = (acc[t][p] - mean[t]) * rstd[t] * gg[p] + bb[p]; const float o = y * sigmoidf_(y);
                A2[(size_t)(t0 + tb * 8 + t) * D + p * 256 + L] = (bf16)f2bf(o); }
    }
    __syncthreads();
}

constexpr int KPITCH = 144;
typedef short v4i16_t __attribute__((ext_vector_type(4)));
template <int NT, bool MASK>
__device__ __forceinline__ void attn_wave(const LAS unsigned char* Kl, const LAS unsigned char* Vl, int kt0, bf16x8 bq0, bf16x8 bq1, int lane, int qi, bool first, f32x4 (&o)[4], float& lse) {
    const int r = lane & 15, lg = lane >> 4;
    f32x4 s[NT];
#pragma unroll
    for (int t = 0; t < NT; ++t) {
        const LAS unsigned char* kp = Kl + ((kt0 + t) * 16 + r) * KPITCH + lg * 16;
        const bf16x8 a0 = *(const LAS bf16x8*)kp, a1 = *(const LAS bf16x8*)(kp + 64);
        f32x4 z = (f32x4){0.f, 0.f, 0.f, 0.f};
        z = __builtin_amdgcn_mfma_f32_16x16x32_bf16(a0, bq0, z, 0, 0, 0);
        s[t] = __builtin_amdgcn_mfma_f32_16x16x32_bf16(a1, bq1, z, 0, 0, 0);
    }
    float m = -INFINITY;
#pragma unroll
    for (int t = 0; t < NT; ++t)
#pragma unroll
        for (int j = 0; j < 4; ++j) {
            if (MASK) { const int ki = (kt0 + t) * 16 + 4 * lg + j, dist = qi + 128 - ki; const bool valid = (dist >= 0) && (dist <= 128) && (!first || ki >= 128); s[t][j] = valid ? s[t][j] : -INFINITY; }
            m = fmaxf(m, s[t][j]);
        }
    m = fmaxf(m, __shfl_xor(m, 16)); m = fmaxf(m, __shfl_xor(m, 32));
    const float c = 0.125f * 1.4426950408889634f;
    float sum = 0.f;
#pragma unroll
    for (int t = 0; t < NT; ++t)
#pragma unroll
        for (int j = 0; j < 4; ++j) { const float p = __builtin_amdgcn_exp2f((s[t][j] - m) * c); s[t][j] = p; sum += p; }
    sum += __shfl_xor(sum, 16); sum += __shfl_xor(sum, 32);
#pragma unroll
    for (int et = 0; et < 4; ++et) o[et] = (f32x4){0.f, 0.f, 0.f, 0.f};
    const LAS unsigned char* vbase = Vl + (kt0 * 16 + 4 * lg + ((lane & 15) >> 2)) * KPITCH + (lane & 3) * 8;
#pragma unroll
    for (int kk = 0; kk < NT / 2; ++kk) {
        v4u pw; pw.x = cvt_pk_bf16(s[2 * kk][0], s[2 * kk][1]); pw.y = cvt_pk_bf16(s[2 * kk][2], s[2 * kk][3]);
        pw.z = cvt_pk_bf16(s[2 * kk + 1][0], s[2 * kk + 1][1]); pw.w = cvt_pk_bf16(s[2 * kk + 1][2], s[2 * kk + 1][3]);
        const bf16x8 bp = __builtin_bit_cast(bf16x8, pw);
#pragma unroll
        for (int et = 0; et < 4; ++et) {
            const LAS unsigned char* vp = vbase + (32 * kk) * KPITCH + et * 32;
            const v4i16_t lo = __builtin_amdgcn_ds_read_tr16_b64_v4i16((LAS v4i16_t*)vp);
            const v4i16_t hi = __builtin_amdgcn_ds_read_tr16_b64_v4i16((LAS v4i16_t*)(vp + 16 * KPITCH));
            bf16x8 av; av[0] = lo[0]; av[1] = lo[1]; av[2] = lo[2]; av[3] = lo[3]; av[4] = hi[0]; av[5] = hi[1]; av[6] = hi[2]; av[7] = hi[3];
            o[et] = __builtin_amdgcn_mfma_f32_16x16x32_bf16(av, bp, o[et], 0, 0, 0);
        }
    }
    const float inv = __builtin_amdgcn_rcpf(sum);
#pragma unroll
    for (int et = 0; et < 4; ++et) o[et] = o[et] * inv;
    lse = m * 0.125f + __logf(sum);
}
constexpr int ATT_K_OFF = 0, ATT_V_OFF = 272 * KPITCH;

__device__ __forceinline__ void phase_memattn(Frame& F, const bf16* q, int qp, int qc0, const bf16* memkv, int l, bf16* out, int op, int oc0) {
    LAS unsigned char* Kl = F.lds + ATT_K_OFF; LAS unsigned char* Vl = F.lds + ATT_V_OFF;
    const int r = F.lane & 15, lg = F.lane >> 4;
    for (int u = blockIdx.x; u < 256; u += F.G) {
        const int b = u >> 7, h = (u >> 5) & 3, qc = u & 31;
        __syncthreads();
#pragma unroll
        for (int k = 0; k < 4; ++k) { const int i = F.tid + NTHR * k, ki = i >> 3, c = i & 7;
            const bf16* src = memkv + (size_t)(b * 256 + ki) * 2048 + l * 512 + h * 64 + c * 8;
            const v4u kv = *(const v4u*)src, vv = *(const v4u*)(src + 256);
            *(LAS v4u*)(Kl + ki * KPITCH + c * 16) = kv; *(LAS v4u*)(Vl + ki * KPITCH + c * 16) = vv; }
        bf16x8 nq0, nq1;
        { const bf16* qr = q + (size_t)(b * SEQ + qc * 512 + F.wave * 16 + r) * qp + qc0 + h * 64 + 8 * lg; nq0 = *(const bf16x8*)qr; nq1 = *(const bf16x8*)(qr + 32); }
        __syncthreads();
        for (int pass = 0; pass < 4; ++pass) {
            const int tok = b * SEQ + qc * 512 + pass * 128 + F.wave * 16 + r;
            const bf16x8 bq0 = nq0, bq1 = nq1;
            if (pass < 3) { const bf16* qr = q + (size_t)(tok + 128) * qp + qc0 + h * 64 + 8 * lg; nq0 = *(const bf16x8*)qr; nq1 = *(const bf16x8*)(qr + 32); }
            f32x4 o[4]; float lse;
            attn_wave<16, false>(Kl, Vl, 0, bq0, bq1, F.lane, 0, false, o, lse);
            bf16* orow = out + (size_t)tok * op + oc0 + h * 64 + 4 * lg;
#pragma unroll
            for (int et = 0; et < 4; ++et) { v2u w; w.x = cvt_pk_bf16(o[et][0], o[et][1]); w.y = cvt_pk_bf16(o[et][2], o[et][3]); *(v2u*)(orow + 16 * et) = w; }
        }
    }
    __syncthreads();
}

struct DilUnit { int b, grp, h, d, res, n; };
__device__ __forceinline__ DilUnit dil_unit(int u) {
    DilUnit x; x.b = u / 1536; const int rem = u % 1536; x.grp = rem >> 9; x.h = (rem >> 7) & 3; const int blk = rem & 127;
    const int dsh = 2 * x.grp; x.d = 1 << dsh; const int nblk = SEQ >> (7 + dsh); x.res = blk / nblk; x.n = blk % nblk; return x;
}
__device__ __forceinline__ void phase_dilated(Frame& F, const bf16* q  , const bf16* kv  , bf16* og  , float* lseo  ) {
    LAS unsigned char* Kl = F.lds + ATT_K_OFF; LAS unsigned char* Vl = F.lds + ATT_V_OFF;
    const int r16 = F.lane & 15, lg = F.lane >> 4;
    v4u kr[5], vr[5]; bf16x8 nq0, nq1; int ntok = 0;
#define DIL_PREFETCH(uu) do { const DilUnit x_ = dil_unit(uu); \
        _Pragma("unroll") for (int k_ = 0; k_ < 5; ++k_) { const int i_ = F.tid + NTHR * k_, ki_ = i_ >> 3, c_ = i_ & 7, mk_ = (x_.n - 1) * 128 + ki_; \
            kr[k_] = (v4u){0u, 0u, 0u, 0u}; vr[k_] = (v4u){0u, 0u, 0u, 0u}; \
            if (ki_ < 256 && mk_ >= 0) { const bf16* src_ = kv + (size_t)(x_.b * SEQ + mk_ * x_.d + x_.res) * KVW + x_.grp * 512 + x_.h * 64 + c_ * 8; kr[k_] = *(const v4u*)src_; vr[k_] = *(const v4u*)(src_ + 256); } } \
        ntok = x_.b * SEQ + (x_.n * 128 + F.wave * 16 + r16) * x_.d + x_.res; \
        { const bf16* qr_ = q + (size_t)ntok * D + x_.grp * 256 + x_.h * 64 + 8 * lg; nq0 = *(const bf16x8*)qr_; nq1 = *(const bf16x8*)(qr_ + 32); } } while (0)
    int u = blockIdx.x;
    if (u < 3072) DIL_PREFETCH(u);
    for (; u < 3072; u += F.G) {
        const DilUnit x = dil_unit(u);
        __syncthreads();
#pragma unroll
        for (int k = 0; k < 5; ++k) { const int i = F.tid + NTHR * k, ki = i >> 3, c = i & 7;
            if (ki < 272) { *(LAS v4u*)(Kl + ki * KPITCH + c * 16) = kr[k]; *(LAS v4u*)(Vl + ki * KPITCH + c * 16) = vr[k]; } }
        const bf16x8 bq0 = nq0, bq1 = nq1; const int tok = ntok;
        __syncthreads();
        if (u + F.G < 3072) DIL_PREFETCH(u + F.G);
        f32x4 o[4]; float lse;
        attn_wave<10, true>(Kl, Vl, F.wave, bq0, bq1, F.lane, F.wave * 16 + r16, x.n == 0, o, lse);
        bf16* orow = og + ((size_t)x.grp * T + tok) * 256 + x.h * 64 + 4 * lg;
#pragma unroll
        for (int et = 0; et < 4; ++et) { v2u w; w.x = cvt_pk_bf16(o[et][0], o[et][1]); w.y = cvt_pk_bf16(o[et][2], o[et][3]); *(v2u*)(orow + 16 * et) = w; }
        if (lg == 0) lseo[((size_t)x.grp * T + tok) * 4 + x.h] = lse;
    }
#undef DIL_PREFETCH
    __syncthreads();
}
__device__ __forceinline__ void phase_dil_combine(Frame& F, const bf16* og, const float* lse, bf16* A2b  ) {
    const size_t gt = (size_t)blockIdx.x * NTHR + F.tid, NT_ = (size_t)F.G * NTHR;
    for (size_t i = gt; i < (size_t)T * 32; i += NT_) {
        const int t = (int)(i >> 5), h = (int)((i >> 3) & 3), c8 = (int)(i & 7);
        const float l0 = lse[((size_t)0 * T + t) * 4 + h], l1 = lse[((size_t)1 * T + t) * 4 + h], l2 = lse[((size_t)2 * T + t) * 4 + h];
        const float mx = fmaxf(l0, fmaxf(l1, l2)); float w0 = __expf(l0 - mx), w1 = __expf(l1 - mx), w2 = __expf(l2 - mx); const float inv = 1.0f / (w0 + w1 + w2); w0 *= inv; w1 *= inv; w2 *= inv;
        const v4u a = *(const v4u*)(og + ((size_t)0 * T + t) * 256 + h * 64 + c8 * 8), bq = *(const v4u*)(og + ((size_t)1 * T + t) * 256 + h * 64 + c8 * 8), cq = *(const v4u*)(og + ((size_t)2 * T + t) * 256 + h * 64 + c8 * 8);
        v4u o;
        o.x = pk2(w0 * bflo(a.x) + w1 * bflo(bq.x) + w2 * bflo(cq.x), w0 * bfhi(a.x) + w1 * bfhi(bq.x) + w2 * bfhi(cq.x));
        o.y = pk2(w0 * bflo(a.y) + w1 * bflo(bq.y) + w2 * bflo(cq.y), w0 * bfhi(a.y) + w1 * bfhi(bq.y) + w2 * bfhi(cq.y));
        o.z = pk2(w0 * bflo(a.z) + w1 * bflo(bq.z) + w2 * bflo(cq.z), w0 * bfhi(a.z) + w1 * bfhi(bq.z) + w2 * bfhi(cq.z));
        o.w = pk2(w0 * bflo(a.w) + w1 * bflo(bq.w) + w2 * bflo(cq.w), w0 * bfhi(a.w) + w1 * bfhi(bq.w) + w2 * bfhi(cq.w));
        *(v4u*)(A2b + (size_t)t * 512 + h * 64 + c8 * 8) = o;
    }
}

__device__ __forceinline__ void phase_ln_route(Frame& F, const float* z, const float* g, const float* bt, const float* rwT, const float* rb,
                                               float* x1f, unsigned char* x1q, int* tok_es, float* tok_gate, int* rowtok, float* rowsc, unsigned* cnt_g) {
    LAS float* xt = (LAS float*)F.lds;
    LAS float* part = xt + 16 * 1028;
    LAS int* lcnt = (LAS int*)(F.lds + LDS_RT); LAS int* base = lcnt + 32; LAS int* rec = lcnt + 64;
    LAS float* lsa = (LAS float*)(F.lds + LDS_SA);
    const int r16 = F.lane & 15, kq = F.lane >> 4, w = F.wave;
    f32x4 Wr[2][8];
#pragma unroll
    for (int nt = 0; nt < 2; ++nt)
#pragma unroll
        for (int q = 0; q < 8; ++q) Wr[nt][q] = *(const f32x4*)(rwT + (size_t)(16 * nt + r16) * D + 128 * w + 16 * q + 4 * kq);
    f32x4 g4[4], b4[4];
#pragma unroll
    for (int j = 0; j < 4; ++j) { g4[j] = *(const f32x4*)(g + 4 * F.lane + 256 * j); b4[j] = *(const f32x4*)(bt + 4 * F.lane + 256 * j); }
    const int my_e = F.lane & 31, hh = F.lane >> 5; const float my_rb = rb[my_e];
    for (int chunk = blockIdx.x; chunk < T / 128; chunk += F.G) {
        __syncthreads();
        if (F.tid < 32) lcnt[F.tid] = 0;
        f32x4 zn[2][4];
#pragma unroll
        for (int u = 0; u < 2; ++u)
#pragma unroll
            for (int j = 0; j < 4; ++j) zn[u][j] = *(const f32x4*)(z + (size_t)(chunk * 128 + 2 * w + u) * D + 4 * F.lane + 256 * j);
        for (int rd = 0; rd < 8; ++rd) {
#pragma unroll
            for (int u = 0; u < 2; ++u) {
                const int t = chunk * 128 + rd * 16 + 2 * w + u;
                f32x4 v[4]; float s = 0.f;
#pragma unroll
                for (int j = 0; j < 4; ++j) { v[j] = zn[u][j]; s += (v[j][0] + v[j][1]) + (v[j][2] + v[j][3]); }
                const float mean = wave_sum(s) * (1.0f / D); float s2 = 0.f;
#pragma unroll
                for (int j = 0; j < 4; ++j) { v[j] = v[j] - mean; s2 += (v[j][0] * v[j][0] + v[j][1] * v[j][1]) + (v[j][2] * v[j][2] + v[j][3] * v[j][3]); }
                const float rstd = 1.0f / sqrtf(wave_sum(s2) * (1.0f / D) + LN_EPS);
                float amax = 0.f;
#pragma unroll
                for (int j = 0; j < 4; ++j) { v[j] = v[j] * rstd * g4[j] + b4[j];
                    *(f32x4*)(x1f + (size_t)t * D + 4 * F.lane + 256 * j) = v[j];
                    *(LAS f32x4*)(xt + (2 * w + u) * 1028 + 4 * F.lane + 256 * j) = v[j];
                    amax = fmaxf(amax, fmaxf(fmaxf(fabsf(v[j][0]), fabsf(v[j][1])), fmaxf(fabsf(v[j][2]), fabsf(v[j][3])))); }
#pragma unroll
                for (int o = 1; o < 64; o <<= 1) amax = fmaxf(amax, __shfl_xor(amax, o));
                amax = fmaxf(amax, 1e-30f);
                const float qinv = 127.0f / amax;
                if (F.lane == 0) lsa[rd * 16 + 2 * w + u] = amax * (1.0f / 127.0f);
#pragma unroll
                for (int j = 0; j < 4; ++j) { const int q0 = (int)rintf(v[j][0] * qinv), q1 = (int)rintf(v[j][1] * qinv), q2 = (int)rintf(v[j][2] * qinv), q3 = (int)rintf(v[j][3] * qinv);
                    unsigned pq = (unsigned)(q0 & 255) | ((unsigned)(q1 & 255) << 8) | ((unsigned)(q2 & 255) << 16) | ((unsigned)(q3 & 255) << 24);
#if defined(PROBE_H) && (PROBE_H >= 7)
                    pq = 0x01010101u;
#endif
                    *(unsigned*)(x1q + (size_t)t * D + 4 * F.lane + 256 * j) = pq; }
            }
            if (rd < 7) {
#pragma unroll
                for (int u = 0; u < 2; ++u)
#pragma unroll
                    for (int j = 0; j < 4; ++j) zn[u][j] = *(const f32x4*)(z + (size_t)(chunk * 128 + (rd + 1) * 16 + 2 * w + u) * D + 4 * F.lane + 256 * j);
            }
            __syncthreads();
            f32x4 a0 = (f32x4){0.f, 0.f, 0.f, 0.f}, a1 = (f32x4){0.f, 0.f, 0.f, 0.f};
#pragma unroll
            for (int q = 0; q < 8; ++q) { const f32x4 av = *(const LAS f32x4*)(xt + r16 * 1028 + 128 * w + 16 * q + 4 * kq);
#pragma unroll
                for (int j = 0; j < 4; ++j) { a0 = __builtin_amdgcn_mfma_f32_16x16x4f32(av[j], Wr[0][q][j], a0, 0, 0, 0); a1 = __builtin_amdgcn_mfma_f32_16x16x4f32(av[j], Wr[1][q][j], a1, 0, 0, 0); } }
#pragma unroll
            for (int jj = 0; jj < 4; ++jj) { part[(w * 16 + 4 * kq + jj) * 33 + r16] = a0[jj]; part[(w * 16 + 4 * kq + jj) * 33 + 16 + r16] = a1[jj]; }
            __syncthreads();
            {
                const int tokl = 2 * w + hh, tl = rd * 16 + tokl, t = chunk * 128 + tl;
                float val = my_rb;
#pragma unroll
                for (int ww = 0; ww < 8; ++ww) val += part[(ww * 16 + tokl) * 33 + my_e];
                float tv[4]; int ti[4];
#pragma unroll
                for (int k = 0; k < 4; ++k) { float kv = val; int ki = my_e;
#pragma unroll
                    for (int off = 1; off < 32; off <<= 1) { const float ov = __shfl_xor(kv, off); const int oi = __shfl_xor(ki, off); const bool take = (ov > kv) || (ov == kv && oi < ki); kv = take ? ov : kv; ki = take ? oi : ki; }
                    tv[k] = kv; ti[k] = ki; if (my_e == ki) val = -INFINITY; }
                const float e1 = __expf(tv[1] - tv[0]), e2 = __expf(tv[2] - tv[0]), e3 = __expf(tv[3] - tv[0]); const float inv = 1.0f / (1.0f + e1 + e2 + e3);
                if (my_e < 4) { const int k = my_e; const int ee = (k == 0) ? ti[0] : (k == 1) ? ti[1] : (k == 2) ? ti[2] : ti[3];
                    const float gk = ((k == 0) ? 1.0f : (k == 1) ? e1 : (k == 2) ? e2 : e3) * inv;
                    const int slot = __hip_atomic_fetch_add(lcnt + ee, 1, __ATOMIC_RELAXED, __HIP_MEMORY_SCOPE_WORKGROUP);
                    rec[tl * 4 + k] = ee | (slot << 8); tok_gate[(size_t)t * 4 + k] = gk; }
            }
        }
        __syncthreads();
        if (F.tid < 32) base[F.tid] = (int)__hip_atomic_fetch_add(cnt_g + F.tid, (unsigned)lcnt[F.tid], __ATOMIC_RELAXED, __HIP_MEMORY_SCOPE_AGENT);
        __syncthreads();
        { const int rr = rec[F.tid], e = rr & 255, slot = (rr >> 8) + base[e]; tok_es[(size_t)chunk * 512 + F.tid] = e | (slot << 8); rowtok[(size_t)e * T + slot] = chunk * 128 + (F.tid >> 2); rowsc[(size_t)e * T + slot] = lsa[F.tid >> 2]; }
    }
    __syncthreads();
}

__device__ __forceinline__ int build_tiles(Frame& F, const unsigned* cnt_g) {
    LAS int* tbs = (LAS int*)(F.lds + LDS_TB); LAS int* cl = tbs + 40; LAS int* te = (LAS int*)(F.lds + LDS_TE);
    __syncthreads();
    if (F.tid == 0) { int a = 0; for (int e = 0; e < NEXP; ++e) { const int c = (int)cnt_g[e]; tbs[e] = a; cl[e] = c; a += (c + 255) >> 8; } tbs[NEXP] = a; }
    __syncthreads();
    const int total = tbs[NEXP];
    for (int rt = F.tid; rt < total; rt += NTHR) { int e = 0; for (int k = 1; k < NEXP; ++k) e = (rt >= tbs[k]) ? k : e; te[rt] = e; }
    __syncthreads();
    return total;
}
__device__ __forceinline__ void phase_combine_ln(Frame& F, const unsigned* cnt_g, const float* x1f, const bf16* Y, const int* tok_es, const float* tok_gate, const float* g, const float* bt, float* xout, bf16* xb) {
    (void)build_tiles(F, cnt_g);
    const LAS int* tbs = (const LAS int*)(F.lds + LDS_TB);
    f32x4 g4[4], b4[4];
#pragma unroll
    for (int j = 0; j < 4; ++j) { g4[j] = *(const f32x4*)(g + 4 * F.lane + 256 * j); b4[j] = *(const f32x4*)(bt + 4 * F.lane + 256 * j); }
    for (int t = F.gw; t < T; t += F.NGW) {
        f32x4 v[4];
#pragma unroll
        for (int j = 0; j < 4; ++j) v[j] = *(const f32x4*)(x1f + (size_t)t * D + 4 * F.lane + 256 * j) * DN_ALPHA;
#pragma unroll
        for (int k = 0; k < 4; ++k) { const int es = tok_es[(size_t)t * 4 + k]; const int row = tbs[es & 255] * 256 + (es >> 8); const float gk = tok_gate[(size_t)t * 4 + k];
#pragma unroll
            for (int j = 0; j < 4; ++j) { const v2u w = *(const v2u*)(Y + (size_t)row * D + 4 * F.lane + 256 * j);
                v[j][0] += gk * bflo(w.x); v[j][1] += gk * bfhi(w.x); v[j][2] += gk * bflo(w.y); v[j][3] += gk * bfhi(w.y); } }
        float s = 0.f;
#pragma unroll
        for (int j = 0; j < 4; ++j) s += (v[j][0] + v[j][1]) + (v[j][2] + v[j][3]);
        const float mean = wave_sum(s) * (1.0f / D); float s2 = 0.f;
#pragma unroll
        for (int j = 0; j < 4; ++j) { v[j] = v[j] - mean; s2 += (v[j][0] * v[j][0] + v[j][1] * v[j][1]) + (v[j][2] * v[j][2] + v[j][3] * v[j][3]); }
        const float rstd = 1.0f / sqrtf(wave_sum(s2) * (1.0f / D) + LN_EPS);
#pragma unroll
        for (int j = 0; j < 4; ++j) { v[j] = v[j] * rstd * g4[j] + b4[j];
#if defined(PROBE_CLK) || defined(PROBE_I8) || defined(PROBE_H)
            { const float dv = ((const float*)cnt_g)[256 - 96]; if (dv != 0.f) v[j] = (f32x4){dv, dv, dv, dv}; }
#endif
            *(f32x4*)(xout + (size_t)t * D + 4 * F.lane + 256 * j) = v[j];
            v2u w; w.x = pk2(v[j][0], v[j][1]); w.y = pk2(v[j][2], v[j][3]); *(v2u*)(xb + (size_t)t * D + 4 * F.lane + 256 * j) = w; }
    }
}
#ifndef REP_P0
#define REP_P0 1
#endif
#ifndef REP_A1
#define REP_A1 1
#endif
#ifndef REP_MKV
#define REP_MKV 1
#endif
#ifndef REP_CONV
#define REP_CONV 1
#endif
#ifndef REP_MATT
#define REP_MATT 1
#endif
#ifndef REP_A3
#define REP_A3 1
#endif
#ifndef REP_B1
#define REP_B1 1
#endif
#ifndef REP_B1KV
#define REP_B1KV 1
#endif
#ifndef REP_DIL
#define REP_DIL 1
#endif
#ifndef REP_DILC
#define REP_DILC 1
#endif
#ifndef REP_B4
#define REP_B4 1
#endif
#ifndef REP_M2
#define REP_M2 1
#endif
#ifndef REP_M3
#define REP_M3 1
#endif
#ifndef REP_M4
#define REP_M4 1
#endif
#ifndef REP_M5
#define REP_M5 1
#endif
#ifndef EN_ALL
#define EN_ALL 1
#endif
#ifndef EN_P0
#define EN_P0 EN_ALL
#endif
#ifndef EN_A1
#define EN_A1 EN_ALL
#endif
#ifndef EN_MKV
#define EN_MKV EN_ALL
#endif
#ifndef EN_CONV
#define EN_CONV EN_ALL
#endif
#ifndef EN_MATT
#define EN_MATT EN_ALL
#endif
#ifndef EN_A3
#define EN_A3 EN_ALL
#endif
#ifndef EN_B1
#define EN_B1 EN_ALL
#endif
#ifndef EN_B1KV
#define EN_B1KV EN_ALL
#endif
#ifndef EN_DIL
#define EN_DIL EN_ALL
#endif
#ifndef EN_DILC
#define EN_DILC EN_ALL
#endif
#ifndef EN_B4
#define EN_B4 EN_ALL
#endif
#ifndef EN_M1
#define EN_M1 EN_ALL
#endif
#ifndef EN_M2
#define EN_M2 EN_ALL
#endif
#ifndef EN_M3
#define EN_M3 EN_ALL
#endif
#ifndef EN_M4
#define EN_M4 EN_ALL
#endif
#ifndef EN_M5
#define EN_M5 EN_ALL
#endif

#ifndef MK_N_LAUNCHES
#define MK_N_LAUNCHES 1
#endif
constexpr int NPHASE = 1 + 2 * 7 + 2 * 8;
struct Args { const void* in[24]; float* out; unsigned char* ws; int ph_lo, ph_hi; };
static_assert(sizeof(Args) == 24 * 8 + 8 + 8 + 8, "Args has no padding");

__global__ void __launch_bounds__(NTHR, 2) fwd(Args args) {
    extern __shared__ __attribute__((aligned(16))) unsigned char lds_raw[];
    LAS unsigned char* const ldsb = (LAS unsigned char*)lds_raw;
    if (threadIdx.x < 16) ((LAS unsigned*)(ldsb + LDS_MISC))[threadIdx.x] = 0u;
    if (threadIdx.x == 0) {
        LAS unsigned long long* pt = (LAS unsigned long long*)(ldsb + LDS_PTR);
#pragma unroll
        for (int i = 0; i < 24; ++i) pt[i] = (unsigned long long)args.in[i];
        pt[24] = (unsigned long long)args.ws; pt[25] = (unsigned long long)args.out;
    }
    __syncthreads();
    const int lo = args.ph_lo, hi = args.ph_hi;
    const bool use_bar = (hi - lo) > 1;
    unsigned xcc = 0;
    if (use_bar) { const XcdBarrier b0 = xcd_barrier_post((unsigned*)(args.ws + WS_CTL) + CW_BAR, (volatile LAS unsigned*)(ldsb + LDS_MISC)); xcc = b0.x; }
#define IN(k) (lo <= (k) && (k) < hi)
#define FRAME() Frame F; { int t_ = threadIdx.x; asm volatile("" : "+v"(t_)); F.lds = ldsb; F.tid = t_; F.lane = t_ & 63; F.wave = __builtin_amdgcn_readfirstlane(t_ >> 6); \
                           F.G = gridDim.x; F.gw = blockIdx.x * NWAVES + F.wave; F.NGW = F.G * NWAVES; } unsigned char* ws = wsp(F); (void)ws
#define SEAM(k) do { if (IN(k) && IN((k) + 1)) { asm volatile("" ::: "memory"); Frame Fb; Fb.lds = ldsb; XcdBarrier b_; b_.bar = (unsigned*)(wsp(Fb) + WS_CTL) + CW_BAR; b_.x = xcc; b_.st = (volatile LAS unsigned*)(ldsb + LDS_MISC); xcd_barrier(b_); } } while (0)
#define WSB(T_, off) ((T_*)(ws + (off)))

    if (EN_P0 && IN(0)) { for (int rep_ = 0; rep_ < REP_P0; ++rep_) { FRAME(); phase_prologue(F); } }
    SEAM(0);

    for (int l = 0; l < 4; ++l) {
        const int pb = (l < 2) ? 1 + 7 * l : 15 + 8 * (l - 2);
        int pm;
        if (l < 2) {
            if (IN(pb + 0)) {
                for (int rep_ = 0; rep_ < REP_A1; ++rep_) if (EN_A1) { FRAME();
                  pg8::Gemm g{WSB(bf16, WS_XB), WSB(const bf16, WS_WIN) + (size_t)l * AIN * D, T, AIN, D}; pg8::StaticOrder S; S.init(T, AIN, F.G, (int)blockIdx.x);
                  EpiGluQ E{WSB(bf16, WS_HGLU), WSB(bf16, WS_QM), inp(F, 4) + (size_t)l * AIN};
                  pg8::gemm_phase<EpiGluQ, pg8::StaticOrder, true, true>(F.lds, g, S, E); }
                for (int rep_ = 0; rep_ < REP_MKV; ++rep_) if (EN_MKV && l == 0) { FRAME();
                  pg8::Gemm g{WSB(bf16, WS_MEMB), WSB(const bf16, WS_WMEM), 512, 2048, D}; pg8::StaticOrder S; S.init(512, 2048, F.G, (int)blockIdx.x);
                  EpiRot<2> E{WSB(bf16, WS_MEMKV), 2048, nullptr};
                  pg8::gemm_phase<EpiRot<2>, pg8::StaticOrder, true, true>(F.lds, g, S, E); }
            }
            SEAM(pb + 0);
            if (IN(pb + 1)) {
                for (int rep_ = 0; rep_ < REP_CONV; ++rep_) if (EN_CONV) { FRAME();
                  phase_conv(F, WSB(const bf16, WS_HGLU), inp(F, 5) + (size_t)l * CONV_W * CONV_CH, inp(F, 6) + (size_t)l * CONV_CH, inp(F, 7) + (size_t)l * CONV_CH, inp(F, 8) + (size_t)l * CONV_CH, WSB(bf16, WS_A2)); }
                for (int rep_ = 0; rep_ < REP_MATT; ++rep_) if (EN_MATT) { FRAME(); phase_memattn(F, WSB(const bf16, WS_QM), 256, 0, WSB(const bf16, WS_MEMKV), l, WSB(bf16, WS_A2), D, 768); }
            }
            SEAM(pb + 1);
            for (int rep_ = 0; rep_ < REP_A3; ++rep_) if (EN_A3 && IN(pb + 2)) { FRAME();
                pg8::Gemm g{WSB(bf16, WS_A2), WSB(const bf16, WS_WOA) + (size_t)l * D * D, T, D, D}; pg8::StaticOrder S; S.init(T, D, F.G, (int)blockIdx.x);
                EpiRes E{WSB(float, WS_Z), (l == 0) ? inp(F, 0) : WSB(const float, WS_XR2), inp(F, 10) + (size_t)l * D};
                pg8::gemm_phase<EpiRes, pg8::StaticOrder, true, true>(F.lds, g, S, E);
            }
            SEAM(pb + 2);
            pm = pb + 3;
        } else {
            const int j = l - 2;
            if (IN(pb + 0)) {
                for (int rep_ = 0; rep_ < REP_B1; ++rep_) if (EN_B1) { FRAME();
                  pg8::Gemm g{WSB(bf16, WS_XB), WSB(const bf16, WS_WQ) + (size_t)j * D * D, T, D, D}; pg8::StaticOrder S; S.init(T, D, F.G, (int)blockIdx.x);
                  EpiRot<0> E{WSB(bf16, WS_QB), D, WSB(const float, WS_ROT)};
                  pg8::gemm_phase<EpiRot<0>, pg8::StaticOrder, true, true>(F.lds, g, S, E); }
                for (int rep_ = 0; rep_ < REP_B1KV; ++rep_) if (EN_B1KV && j == 0) { FRAME();
                  pg8::Gemm g{WSB(bf16, WS_XB), WSB(const bf16, WS_WKV), T, KVW, D}; pg8::StaticOrder S; S.init(T, KVW, F.G, (int)blockIdx.x);
                  EpiRot<1> E{WSB(bf16, WS_KVB), KVW, WSB(const float, WS_ROT)};
                  pg8::gemm_phase<EpiRot<1>, pg8::StaticOrder, true, true>(F.lds, g, S, E); }
            }
            SEAM(pb + 0);
            if (IN(pb + 1)) {
                for (int rep_ = 0; rep_ < REP_DIL; ++rep_) if (EN_DIL) { FRAME(); phase_dilated(F, WSB(const bf16, WS_QB), WSB(const bf16, WS_KVB), WSB(bf16, WS_OG), WSB(float, WS_LSE)); }
                for (int rep_ = 0; rep_ < REP_MATT; ++rep_) if (EN_MATT) { FRAME(); phase_memattn(F, WSB(const bf16, WS_QB), D, 768, WSB(const bf16, WS_MEMKV), l, WSB(bf16, WS_A2), 512, 256); }
            }
            SEAM(pb + 1);
            for (int rep_ = 0; rep_ < REP_DILC; ++rep_) if (EN_DILC && IN(pb + 2)) { FRAME(); phase_dil_combine(F, WSB(const bf16, WS_OG), WSB(const float, WS_LSE), WSB(bf16, WS_A2)); }
            SEAM(pb + 2);
            for (int rep_ = 0; rep_ < REP_B4; ++rep_) if (EN_B4 && IN(pb + 3)) { FRAME();
                pg8::Gemm g{WSB(bf16, WS_A2), WSB(const bf16, WS_WOB) + (size_t)j * D * 512, T, D, 512}; pg8::StaticOrder S; S.init(T, D, F.G, (int)blockIdx.x);
                EpiRes E{WSB(float, WS_Z), WSB(const float, WS_XR2), inp(F, 14) + (size_t)j * D};
                pg8::gemm_phase<EpiRes, pg8::StaticOrder, true, true>(F.lds, g, S, E);
            }
            SEAM(pb + 3);
            pm = pb + 4;
        }
        if (EN_M1 && IN(pm + 0)) { FRAME();
            phase_ln_route(F, WSB(const float, WS_Z), inp(F, 16) + (size_t)(l * 2 + 0) * D, inp(F, 17) + (size_t)(l * 2 + 0) * D, WSB(const float, WS_RWT) + (size_t)l * NEXP * D, inp(F, 19) + (size_t)l * NEXP,
                           WSB(float, WS_XR1), WSB(unsigned char, WS_X1B), WSB(int, WS_TES), WSB(float, WS_TGATE), WSB(int, WS_RTOK), WSB(float, WS_RSC), WSB(unsigned, WS_CTL) + CW_CNT + 32 * l);
        }
        SEAM(pm + 0);
        for (int rep_ = 0; rep_ < REP_M3; ++rep_) if (EN_M3 && IN(pm + 1)) { FRAME();
#if defined(PROBE_CLK)
            long long c0_ = clock64(), w0_ = wall_clock64();
#endif
            const int total = build_tiles(F, WSB(const unsigned, WS_CTL) + CW_CNT + 32 * l);
            pg8::Gemm g{WSB(bf16, WS_X1B), (const bf16*)(WSB(const unsigned char, WS_WUP) + (size_t)l * NEXP * 2 * DFF * D), XROWS, NEXP * 2 * DFF, D / 2};
            MoeOrder<8> S{(const LAS int*)(F.lds + LDS_TE), (const LAS int*)(F.lds + LDS_TB), (const LAS int*)(F.lds + LDS_TB) + 40, WSB(const int, WS_RTOK), total, F.G, (int)blockIdx.x};
            EpiSwigluI8 E{WSB(bf16, WS_H), inp(F, 21) + (size_t)l * NEXP * 2 * DFF, WSB(const float, WS_SBW) + (size_t)l * NEXP * 2 * DFF, WSB(const float, WS_RSC), (const LAS int*)(F.lds + LDS_TB)};
            pg8::gemm_phase_g<EpiSwigluI8, MoeOrder<8>, true>(F.lds, g, S, E);
#if defined(PROBE_CLK)
            if (l == 3 && blockIdx.x == 0 && threadIdx.x == 0) { const long long c1_ = clock64(), w1_ = wall_clock64(); WSB(float, WS_CTL)[CW_CNT + 256] = (float)(c1_ - c0_) / (float)(w1_ - w0_); }
#endif
        }
        SEAM(pm + 1);
        for (int rep_ = 0; rep_ < REP_M4; ++rep_) if (EN_M4 && IN(pm + 2)) { FRAME();
            const int total = build_tiles(F, WSB(const unsigned, WS_CTL) + CW_CNT + 32 * l);
#if defined(PROBE_H)
            if (l == 0) { __syncthreads(); asm volatile("s_waitcnt vmcnt(0)" ::: "memory");
              if (blockIdx.x == 0 && F.wave == 0) {
                const LAS int* tb_ = (const LAS int*)(F.lds + LDS_TB);
                const int tok_ = 1000 + (F.lane >> 3), c_ = ((F.lane & 7) * 137 + 5) & 1023;
                const int es_ = WSB(const int, WS_TES)[(size_t)tok_ * 4]; const int e_ = es_ & 255; const int r_ = tb_[e_] * 256 + (es_ >> 8);
                const float* x_ = WSB(const float, WS_XR1) + (size_t)tok_ * D; const float* wu_ = inp(F, 20) + (size_t)e_ * D * 2 * DFF; const float* bu_ = inp(F, 21) + (size_t)e_ * 2 * DFF;
                float g_ = bu_[c_], li_ = bu_[1024 + c_];
#if PROBE_H == 2
                { const signed char* xq_ = (const signed char*)WSB(const unsigned char, WS_X1B) + (size_t)tok_ * D; const int ng_ = (c_ >> 7) * 256 + (c_ & 127), nl_ = ng_ + 128;
                  const signed char* wg_ = (const signed char*)WSB(const unsigned char, WS_WUP) + ((size_t)e_ * 2048 + ng_) * D; const signed char* wl_ = (const signed char*)WSB(const unsigned char, WS_WUP) + ((size_t)e_ * 2048 + nl_) * D;
                  int ag_ = 0, al_ = 0; for (int k = 0; k < D; ++k) { ag_ += (int)xq_[k] * (int)wg_[k]; al_ += (int)xq_[k] * (int)wl_[k]; }
                  const float sa_ = WSB(const float, WS_RSC)[(size_t)e_ * T + (es_ >> 8)]; const float* sb_ = WSB(const float, WS_SBW) + (size_t)e_ * 2048;
                  g_ += (float)ag_ * sa_ * sb_[ng_]; li_ += (float)al_ * sa_ * sb_[nl_]; (void)x_; (void)wu_; }
#else
                for (int k = 0; k < D; ++k) { const float xv = x_[k]; g_ += xv * wu_[(size_t)k * 2048 + c_]; li_ += xv * wu_[(size_t)k * 2048 + 1024 + c_]; }
#endif
                const float gg = fminf(g_, 7.0f), ll = fminf(fmaxf(li_, -7.0f), 7.0f); float href = gg * (1.0f / (1.0f + __expf(-1.702f * gg))) * (ll + 1.0f);
#if PROBE_H == 3 || PROBE_H == 8
                { const signed char* xq_ = (const signed char*)WSB(const unsigned char, WS_X1B) + (size_t)tok_ * D; const int ng_ = (c_ >> 7) * 256 + (c_ & 127);
                  const signed char* wg_ = (const signed char*)WSB(const unsigned char, WS_WUP) + ((size_t)e_ * 2048 + ng_) * D;
                  int ag_ = 0; for (int k = 0; k < D; ++k) ag_ += (int)xq_[k] * (int)wg_[k]; href = (float)ag_; }
#endif
                const float hgot = bflo((unsigned)WSB(const bf16, WS_H)[(size_t)r_ * DFF + c_]);
                float df = fabsf(href - hgot);
#if PROBE_H == 9 || PROBE_H == 10
                { const int ng_ = (c_ >> 7) * 256 + (c_ & 127); const int expv = (PROBE_H == 9) ? (ng_ & 127) : (ng_ >> 4); const int gotv = (int)(hgot * (1.0f / 1024.0f) + 0.5f);
                  int dl = (gotv ^ expv) & 127; int dor = dl;
#pragma unroll
                  for (int o = 1; o < 64; o <<= 1) { dor |= __shfl_xor(dor, o); }
#if defined(PROBE_S)
                  if (F.lane == PROBE_S) WSB(float, WS_CTL)[CW_CNT + 256] = 1.0f + (float)((gotv & 3) * 4 + (expv & 3)); (void)dor; }
#else
                  if (F.lane == 0) WSB(float, WS_CTL)[CW_CNT + 256] = 1.0f + (float)dor; }
#endif
#endif
#if PROBE_H == 7
                { float hm = hgot;
#pragma unroll
                  for (int o = 1; o < 64; o <<= 1) hm = fmaxf(hm, __shfl_xor(hm, o));
                  float hn = hgot;
#pragma unroll
                  for (int o = 1; o < 64; o <<= 1) hn = fminf(hn, __shfl_xor(hn, o));
                  if (F.lane == 0) WSB(float, WS_CTL)[CW_CNT + 256] = 1.0f + hm * (1.0f / 128.0f) + ((hn != hm) ? 0.5f : 0.0f); }
#endif
#if PROBE_H == 5
                { const signed char* xq_ = (const signed char*)WSB(const unsigned char, WS_X1B) + (size_t)tok_ * D; const float sa_ = WSB(const float, WS_RSC)[(size_t)e_ * T + (es_ >> 8)];
                  df = 0.f; for (int k = 0; k < D; ++k) df = fmaxf(df, fabsf((float)xq_[k] * sa_ - x_[k])); df *= 10.0f; }
#endif
#if PROBE_H == 6
                { const int ng_ = (c_ >> 7) * 256 + (c_ & 127); const signed char* wg_ = (const signed char*)WSB(const unsigned char, WS_WUP) + ((size_t)e_ * 2048 + ng_) * D; const float sb_ = WSB(const float, WS_SBW)[(size_t)e_ * 2048 + ng_];
                  df = 0.f; for (int k = 0; k < D; ++k) df = fmaxf(df, fabsf((float)wg_[k] * sb_ - wu_[(size_t)k * 2048 + c_])); df *= 1000.0f; }
#endif
#if PROBE_H == 3 || PROBE_H == 8
                df = df / (fabsf(href) + 100.0f) * 10.0f;
#endif
#pragma unroll
                for (int o = 1; o < 64; o <<= 1) df = fmaxf(df, __shfl_xor(df, o));
                if (PROBE_H < 7 && F.lane == 0) WSB(float, WS_CTL)[CW_CNT + 256] = (df < 0.15f) ? 2.0f : (df < 0.5f) ? 3.0f : (df < 2.0f) ? 4.0f : (df < 10.0f) ? 5.0f : 6.0f;
              } }
#endif
            pg8::Gemm g{WSB(bf16, WS_H), WSB(const bf16, WS_WDN) + (size_t)l * NEXP * DFF * D, XROWS, NEXP * D, DFF};
            MoeOrder<4> S{(const LAS int*)(F.lds + LDS_TE), (const LAS int*)(F.lds + LDS_TB), (const LAS int*)(F.lds + LDS_TB) + 40, WSB(const int, WS_RTOK), total, F.G, (int)blockIdx.x};
            EpiDown E{WSB(bf16, WS_Y), inp(F, 23) + (size_t)l * NEXP * D};
            pg8::gemm_phase<EpiDown, MoeOrder<4>, true, true>(F.lds, g, S, E);
        }
        SEAM(pm + 2);
        for (int rep_ = 0; rep_ < REP_M5; ++rep_) if (EN_M5 && IN(pm + 3)) { FRAME();
            phase_combine_ln(F, WSB(const unsigned, WS_CTL) + CW_CNT + 32 * l, WSB(const float, WS_XR1), WSB(const bf16, WS_Y), WSB(const int, WS_TES), WSB(const float, WS_TGATE), inp(F, 16) + (size_t)(l * 2 + 1) * D, inp(F, 17) + (size_t)(l * 2 + 1) * D,
                             (l == 3) ? (float*)ptr_slot(F, 25) : WSB(float, WS_XR2), WSB(bf16, WS_XB));
        }
        if (l < 3) SEAM(pm + 3);
    }
#undef IN
#undef SEAM
#undef WSB
#undef FRAME
}

extern "C" void kernel_launch(void* const* d_in, const int* in_sizes, int n_in, void* d_out, int out_size, void* d_ws, size_t ws_size, hipStream_t stream) {
    static int grid = 0;
    if (grid == 0) {
        if (n_in != 24 || in_sizes[0] != T * D || out_size != T * D || ws_size < WS_END) {
            fprintf(stderr, "kernel_launch: unexpected shapes (n_in %d, in0 %d, out %d, ws %zu < %zu); nothing launched\n", n_in, n_in > 0 ? in_sizes[0] : -1, out_size, ws_size, (size_t)WS_END); grid = -1; return; }
        if (hipFuncSetAttribute((const void*)fwd, hipFuncAttributeMaxDynamicSharedMemorySize, LDS_BYTES) != hipSuccess) { fprintf(stderr, "kernel_launch: hipFuncSetAttribute failed\n"); grid = -1; return; }
        int per_cu = 0;
        if (hipOccupancyMaxActiveBlocksPerMultiprocessor(&per_cu, (const void*)fwd, NTHR, LDS_BYTES) != hipSuccess || per_cu < 1) fprintf(stderr, "kernel_launch: note: occupancy query says %d\n", per_cu);
        (void)hipGetLastError();
        grid = 256;
    }
    if (grid < 0) return;
    (void)hipMemsetAsync((char*)d_ws + WS_CTL, 0, CTL_ZERO_BYTES, stream);
    Args a{};
    for (int i = 0; i < 24; ++i) a.in[i] = d_in[i];
    a.out = (float*)d_out; a.ws = (unsigned char*)d_ws;
#if MK_N_LAUNCHES == 1
    a.ph_lo = 0; a.ph_hi = NPHASE;
    hipLaunchKernelGGL(fwd, dim3(grid), dim3(NTHR), LDS_BYTES, stream, a);
#else
    for (int k = 0; k < NPHASE; ++k) { a.ph_lo = k; a.ph_hi = k + 1; hipLaunchKernelGGL(fwd, dim3(grid), dim3(NTHR), LDS_BYTES, stream, a); }
#endif
}
```

```cpp
#define MK_N_LAUNCHES 1
#include <hip/hip_runtime.h>
#include <cstdio>
#include <cstdint>
namespace pg8 {
#define PG8_LAS __attribute__((address_space(3)))
typedef unsigned short bf16_t;
typedef short bf16x8 __attribute__((ext_vector_type(8)));
typedef float f32x4 __attribute__((ext_vector_type(4)));
typedef unsigned u32x4 __attribute__((ext_vector_type(4)));
constexpr int BM = 256, BK = 64, HALF = 128, HTB = HALF * BK * 2  , STAGE_BYTES = 8 * HTB, NXCD = 8, WGM = 8;

__host__ __device__ __forceinline__ int lds_byte(int r, int c) { const int st = (r >> 4) * 2 + (c >> 5), rr = r & 15, cc = c & 31, ob = rr * 64 + cc * 2; return st * 1024 + (ob ^ (((ob >> 9) & 1) << 5)); }
__host__ __device__ __forceinline__ void stage_rc(int b, int& R, int& C) { const int st = b / 1024, sb = b % 1024, swz = sb ^ (((sb >> 9) & 1) << 5); R = (st >> 1) * 16 + swz / 64; C = (st & 1) * 32 + (swz % 64) / 2; }
__host__ __device__ __forceinline__ int perm32(int rho) { const int n = rho >> 4, i = rho & 15; return 8 * (i >> 2) + 4 * n + (i & 3); }

struct Unit { int pm, pn; };
struct Gemm { const bf16_t* A; const bf16_t* Bt; int M, N, K; };

struct StaticOrder {
    int nM, nN, nwg, G, c;
    __host__ __device__ void init(int M, int N, int G_, int c_) { nM = M / BM; nN = N / BM; nwg = nM * nN; G = G_; c = c_; }
    __host__ __device__ bool next(int i, Unit& u) const {
        const long L = (long)i * G + c; if (L >= nwg) return false;
        int wgid = (int)L; { const int q = nwg / NXCD, r = nwg % NXCD, xcd = wgid % NXCD, off = wgid / NXCD; wgid = (xcd < r ? xcd * (q + 1) : r * (q + 1) + (xcd - r) * q) + off; }
        const int nig = WGM * nN, gid = wgid / nig, fm = gid * WGM, gsz = (nM - fm) < WGM ? (nM - fm) : WGM;
        u.pm = fm + ((wgid % nig) % gsz); u.pn = (wgid % nig) / gsz; return true;
    }
    __device__ __forceinline__ void a_ready(const Unit&) const {}
    __device__ __forceinline__ void done(const Unit&) const {}
};

__device__ __forceinline__ unsigned cvt_pk_bf16(float lo, float hi) { unsigned r; asm volatile("v_cvt_pk_bf16_f32 %0, %1, %2" : "=v"(r) : "v"(lo), "v"(hi)); return r; }
typedef float f32x2 __attribute__((ext_vector_type(2)));
template <class Epi, class Sched, bool ALIGN_EPI = false, bool SP2 = false>
__device__ __forceinline__ void gemm_phase(PG8_LAS unsigned char* lds, const Gemm g, const Sched& S, const Epi& E) {
    int tid_ = threadIdx.x; asm volatile("" : "+v"(tid_));
    const int tid = tid_, wid = __builtin_amdgcn_readfirstlane(tid >> 6), lane = tid & 63, wr = wid >> 2, wc = wid & 3, fr = lane & 15, fq = lane >> 4;
    const int K = g.K, nt = K / BK;
#if defined(STAGGER_TICKS)
    { const unsigned dl = ((blockIdx.x >> 3) & 3u) * (unsigned)(STAGGER_TICKS); const unsigned long long t0_ = __builtin_amdgcn_s_memrealtime(); while ((unsigned)(__builtin_amdgcn_s_memrealtime() - t0_) < dl) __builtin_amdgcn_s_sleep(4); }
#endif
    unsigned voffA[2], voffB[2];
#pragma unroll
    for (int i = 0; i < 2; ++i) { int R, C; stage_rc(tid * 16 + i * 8192, R, C); const int Rb = Epi::PERM ? ((R & ~31) + perm32(R & 31)) : R;
        voffA[i] = (unsigned)(R * K + C) * 2u; voffB[i] = (unsigned)(Rb * K + C) * 2u; }
    const size_t kstep = (size_t)(BK * 2);
    const size_t hstep = (size_t)HALF * K * 2;
    const size_t tstep = 2 * hstep;
    const unsigned ldsw = (unsigned)wid * 1024u;
    const int aoff = lds_byte(wr * 64 + fr, fq * 8), boff = lds_byte(wc * 32 + fr, fq * 8);
#define PG8_SA(b, h) (((b) * 2 + (h)) * HTB)
#define PG8_SB(b, h) ((4 + (b) * 2 + (h)) * HTB)
#define PG8_STAGE(bufoff, gbase, voff) do { _Pragma("unroll") for (int _i = 0; _i < 2; ++_i) \
        __builtin_amdgcn_global_load_lds((const unsigned*)((const char*)(gbase) + (voff)[_i]), (PG8_LAS unsigned*)(lds + (bufoff) + ldsw + _i * 8192), 16, 0, 0); } while (0)
#define PG8_LDA(dst, b, h) do { _Pragma("unroll") for (int m = 0; m < 4; ++m) _Pragma("unroll") for (int k = 0; k < 2; ++k) dst[m][k] = *(const PG8_LAS bf16x8*)(lds + PG8_SA(b, h) + aoff + m * 2048 + k * 1024); } while (0)
#define PG8_LDB(dst, b, h) do { _Pragma("unroll") for (int n = 0; n < 2; ++n) _Pragma("unroll") for (int k = 0; k < 2; ++k) dst[n][k] = *(const PG8_LAS bf16x8*)(lds + PG8_SB(b, h) + boff + n * 2048 + k * 1024); } while (0)
#define PG8_MMA(ai, bj, At, Bt) do { __builtin_amdgcn_s_setprio(1); _Pragma("unroll") for (int m = 0; m < 4; ++m) _Pragma("unroll") for (int n = 0; n < 2; ++n) _Pragma("unroll") for (int k = 0; k < 2; ++k) \
        acc[ai][bj][m][n] = __builtin_amdgcn_mfma_f32_16x16x32_bf16(Bt[n][k], At[m][k], acc[ai][bj][m][n], 0, 0, 0); __builtin_amdgcn_s_setprio(0); } while (0)
#define PG8_WAIT_V(n) asm volatile("s_waitcnt vmcnt(" #n ")" ::: "memory")
#define PG8_WAIT_L(n) asm volatile("s_waitcnt lgkmcnt(" #n ")" ::: "memory")
#define PG8_BAR __builtin_amdgcn_s_barrier()
#define PG8_SCHED __builtin_amdgcn_sched_barrier(0)
    Unit cur, nxt; int ui = 0;
    if (!S.next(0, cur)) return;
    f32x4 acc[2][2][4][2];
#pragma unroll
    for (int a = 0; a < 2; ++a)
#pragma unroll
        for (int b = 0; b < 2; ++b)
#pragma unroll
            for (int m = 0; m < 4; ++m)
#pragma unroll
                for (int n = 0; n < 2; ++n) acc[a][b][m][n] = (f32x4){0.f, 0.f, 0.f, 0.f};
    bf16x8 At[4][2], B0[2][2], B1[2][2];
    const char* cA = (const char*)g.A + (size_t)cur.pm * tstep; const char* cB = (const char*)g.Bt + (size_t)cur.pn * tstep;
    S.a_ready(cur);
    if constexpr (SP2) {
        PG8_STAGE(PG8_SB(0, 0), cB, voffB); PG8_STAGE(PG8_SB(0, 1), cB + hstep, voffB); PG8_STAGE(PG8_SA(0, 0), cA, voffA); PG8_STAGE(PG8_SA(0, 1), cA + hstep, voffA);
        if (wr == 1) PG8_BAR;
        PG8_WAIT_V(2); PG8_BAR;
        PG8_STAGE(PG8_SB(1, 0), cB + kstep, voffB); PG8_STAGE(PG8_SA(1, 0), cA + kstep, voffA); PG8_STAGE(PG8_SB(1, 1), cB + hstep + kstep, voffB);
        PG8_WAIT_V(6); PG8_BAR;
    } else {
        PG8_STAGE(PG8_SB(0, 0), cB, voffB); PG8_STAGE(PG8_SA(0, 0), cA, voffA); PG8_STAGE(PG8_SB(0, 1), cB + hstep, voffB); PG8_STAGE(PG8_SA(0, 1), cA + hstep, voffA);
        if (wr == 1) PG8_BAR;
        PG8_WAIT_V(4); PG8_BAR;
        PG8_STAGE(PG8_SB(1, 0), cB + kstep, voffB); PG8_STAGE(PG8_SA(1, 0), cA + kstep, voffA); PG8_STAGE(PG8_SB(1, 1), cB + hstep + kstep, voffB);
        PG8_WAIT_V(6); PG8_BAR;
    }
    for (;;) {
        const bool has_next = S.next(ui + 1, nxt);
        const char* nA = has_next ? (const char*)g.A + (size_t)nxt.pm * tstep : cA; const char* nB = has_next ? (const char*)g.Bt + (size_t)nxt.pn * tstep : cB;
        for (int t = 0; t < nt; t += 2) {
            const bool last = (t == nt - 2);
            const char* a1 = cA + (size_t)(t + 1) * kstep;
            const char* a2 = last ? nA : cA + (size_t)(t + 2) * kstep; const char* b2 = last ? nB : cB + (size_t)(t + 2) * kstep;
            const char* a3 = a2 + kstep; const char* b3 = b2 + kstep;
            if (last && has_next) S.a_ready(nxt);
            if constexpr (SP2) {
            PG8_LDB(B0, 0, 0); PG8_LDB(B1, 0, 1); PG8_SCHED; PG8_LDA(At, 0, 0); PG8_STAGE(PG8_SA(1, 1), a1 + hstep, voffA);
            PG8_WAIT_V(8); PG8_WAIT_L(0); PG8_BAR; PG8_MMA(0, 0, At, B0); PG8_MMA(0, 1, At, B1); PG8_BAR; PG8_SCHED;
            PG8_LDA(At, 0, 1); PG8_STAGE(PG8_SB(0, 0), b2, voffB); PG8_STAGE(PG8_SB(0, 1), b2 + hstep, voffB); PG8_STAGE(PG8_SA(0, 0), a2, voffA);
            PG8_WAIT_V(8); PG8_WAIT_L(0); PG8_BAR; PG8_MMA(1, 0, At, B0); PG8_MMA(1, 1, At, B1); PG8_BAR; PG8_SCHED;
            PG8_LDB(B0, 1, 0); PG8_LDB(B1, 1, 1); PG8_SCHED; PG8_LDA(At, 1, 0); PG8_STAGE(PG8_SA(0, 1), a2 + hstep, voffA);
            PG8_WAIT_V(8); PG8_WAIT_L(0); PG8_BAR; PG8_MMA(0, 0, At, B0); PG8_MMA(0, 1, At, B1); PG8_BAR; PG8_SCHED;
            PG8_LDA(At, 1, 1); PG8_STAGE(PG8_SB(1, 0), b3, voffB); PG8_STAGE(PG8_SB(1, 1), b3 + hstep, voffB); PG8_STAGE(PG8_SA(1, 0), a3, voffA);
            PG8_WAIT_V(8); PG8_WAIT_L(0); PG8_BAR; PG8_MMA(1, 0, At, B0); PG8_MMA(1, 1, At, B1); PG8_BAR; PG8_SCHED;
            } else {
            PG8_LDB(B0, 0, 0); PG8_SCHED; PG8_LDA(At, 0, 0); PG8_STAGE(PG8_SA(1, 1), a1 + hstep, voffA);
            PG8_WAIT_L(8); PG8_BAR; PG8_WAIT_L(0); PG8_MMA(0, 0, At, B0); PG8_BAR; PG8_SCHED;
            PG8_LDB(B1, 0, 1); PG8_STAGE(PG8_SB(0, 0), b2, voffB);
            PG8_BAR; PG8_WAIT_L(0); PG8_MMA(0, 1, At, B1); PG8_BAR;
            PG8_LDA(At, 0, 1); PG8_STAGE(PG8_SA(0, 0), a2, voffA);
            PG8_BAR; PG8_WAIT_L(0); PG8_MMA(1, 0, At, B0); PG8_BAR; PG8_SCHED;
            PG8_STAGE(PG8_SB(0, 1), b2 + hstep, voffB);
            PG8_WAIT_V(6); PG8_BAR; PG8_MMA(1, 1, At, B1); PG8_BAR;
            PG8_LDB(B0, 1, 0); PG8_SCHED; PG8_LDA(At, 1, 0); PG8_STAGE(PG8_SA(0, 1), a2 + hstep, voffA);
            PG8_WAIT_L(8); PG8_BAR; PG8_WAIT_L(0); PG8_MMA(0, 0, At, B0); PG8_BAR; PG8_SCHED;
            PG8_LDB(B1, 1, 1); PG8_STAGE(PG8_SB(1, 0), b3, voffB);
            PG8_BAR; PG8_WAIT_L(0); PG8_MMA(0, 1, At, B1); PG8_BAR;
            PG8_LDA(At, 1, 1); PG8_STAGE(PG8_SA(1, 0), a3, voffA);
            PG8_BAR; PG8_WAIT_L(0); PG8_MMA(1, 0, At, B0); PG8_BAR; PG8_SCHED;
            PG8_STAGE(PG8_SB(1, 1), b3 + hstep, voffB);
            PG8_WAIT_V(6); PG8_BAR; PG8_MMA(1, 1, At, B1); PG8_BAR;
            }
        }
        if constexpr (ALIGN_EPI) { if (wr == 0) PG8_BAR; }
        if constexpr (!Epi::AFTER_DRAIN) { E(acc, cur, wr, wc, fr, fq); S.done(cur); }
#if defined(PROBE_EPI2B)
        { asm volatile("" ::: "memory");
#pragma unroll
        for (int a = 0; a < 2; ++a)
#pragma unroll
            for (int b = 0; b < 2; ++b)
#pragma unroll
                for (int m = 0; m < 4; ++m)
#pragma unroll
                    for (int n = 0; n < 2; ++n) asm volatile("" : "+v"(acc[a][b][m][n]));
        E(acc, cur, wr, wc, fr, fq); }
#endif
        if (!has_next) break;
#pragma unroll
        for (int a = 0; a < 2; ++a)
#pragma unroll
            for (int b = 0; b < 2; ++b)
#pragma unroll
                for (int m = 0; m < 4; ++m)
#pragma unroll
                    for (int n = 0; n < 2; ++n) acc[a][b][m][n] = (f32x4){0.f, 0.f, 0.f, 0.f};
        cur = nxt; cA = nA; cB = nB; ++ui;
        if constexpr (ALIGN_EPI) { if (wr == 1) PG8_BAR; }
    }
    PG8_WAIT_V(0);
    if constexpr (!ALIGN_EPI) { if (wr == 0) PG8_BAR; }
    PG8_BAR;
    if constexpr (Epi::AFTER_DRAIN) { E.fused(acc, cur, wr, wc, fr, fq, lds, wid, lane); S.done(cur); }
#undef PG8_SA
#undef PG8_SB
#undef PG8_STAGE
#undef PG8_LDA
#undef PG8_LDB
#undef PG8_MMA
#undef PG8_WAIT_V
#undef PG8_WAIT_L
#undef PG8_BAR
#undef PG8_SCHED
}
}

namespace pg8 {
typedef int i32x4 __attribute__((ext_vector_type(4)));
template <class Epi, class Sched, bool I8 = false>
__device__ __forceinline__ void gemm_phase_g(PG8_LAS unsigned char* lds, const Gemm g, const Sched& S, const Epi& E) {
    int tid_ = threadIdx.x; asm volatile("" : "+v"(tid_));
    const int tid = tid_, wid = __builtin_amdgcn_readfirstlane(tid >> 6), lane = tid & 63, wr = wid >> 2, wc = wid & 3, fr = lane & 15, fq = lane >> 4;
    const int K = g.K, nt = K / BK;
#if defined(STAGGER_TICKS)
    { const unsigned dl = ((blockIdx.x >> 3) & 3u) * (unsigned)(STAGGER_TICKS); const unsigned long long t0_ = __builtin_amdgcn_s_memrealtime(); while ((unsigned)(__builtin_amdgcn_s_memrealtime() - t0_) < dl) __builtin_amdgcn_s_sleep(4); }
#endif
    unsigned voffB[2];
#pragma unroll
    for (int i = 0; i < 2; ++i) { int R, C; stage_rc(tid * 16 + i * 8192, R, C); const int Rb = Epi::PERM ? ((R & ~31) + perm32(R & 31)) : R; voffB[i] = (unsigned)(Rb * K + C) * 2u; }
    const size_t kstep = (size_t)(BK * 2);
    const size_t hstep = (size_t)HALF * K * 2;
    const size_t tstep = 2 * hstep;
    const unsigned ldsw = (unsigned)wid * 1024u;
    const int aoff = lds_byte(wr * 64 + fr, fq * 8), boff = lds_byte(wc * 32 + fr, fq * 8);
#define PG8_SA(b, h) (((b) * 2 + (h)) * HTB)
#define PG8_SB(b, h) ((4 + (b) * 2 + (h)) * HTB)
#define PG8_STAGE(bufoff, gbase, voff) do { _Pragma("unroll") for (int _i = 0; _i < 2; ++_i) \
        __builtin_amdgcn_global_load_lds((const unsigned*)((const char*)(gbase) + (voff)[_i]), (PG8_LAS unsigned*)(lds + (bufoff) + ldsw + _i * 8192), 16, 0, 0); } while (0)
#define PG8_STAGE2(bufoff, gbase, v0, v1) do { \
        __builtin_amdgcn_global_load_lds((const unsigned*)((const char*)(gbase) + (v0)), (PG8_LAS unsigned*)(lds + (bufoff) + ldsw), 16, 0, 0); \
        __builtin_amdgcn_global_load_lds((const unsigned*)((const char*)(gbase) + (v1)), (PG8_LAS unsigned*)(lds + (bufoff) + ldsw + 8192), 16, 0, 0); } while (0)
#define PG8_LDA(dst, b, h) do { _Pragma("unroll") for (int m = 0; m < 4; ++m) _Pragma("unroll") for (int k = 0; k < 2; ++k) dst[m][k] = *(const PG8_LAS bf16x8*)(lds + PG8_SA(b, h) + aoff + m * 2048 + k * 1024); } while (0)
#define PG8_LDB(dst, b, h) do { _Pragma("unroll") for (int n = 0; n < 2; ++n) _Pragma("unroll") for (int k = 0; k < 2; ++k) dst[n][k] = *(const PG8_LAS bf16x8*)(lds + PG8_SB(b, h) + boff + n * 2048 + k * 1024); } while (0)
#define PG8_MMA(ai, bj, At, Bt) do { __builtin_amdgcn_s_setprio(1); _Pragma("unroll") for (int m = 0; m < 4; ++m) _Pragma("unroll") for (int n = 0; n < 2; ++n) _Pragma("unroll") for (int k = 0; k < 2; ++k) \
        { if constexpr (I8) acc[ai][bj][m][n] = __builtin_bit_cast(f32x4, __builtin_amdgcn_mfma_i32_16x16x64_i8(__builtin_bit_cast(i32x4, Bt[n][k]), __builtin_bit_cast(i32x4, At[m][k]), __builtin_bit_cast(i32x4, acc[ai][bj][m][n]), 0, 0, 0)); \
          else acc[ai][bj][m][n] = __builtin_amdgcn_mfma_f32_16x16x32_bf16(Bt[n][k], At[m][k], acc[ai][bj][m][n], 0, 0, 0); } __builtin_amdgcn_s_setprio(0); } while (0)
#define PG8_WAIT_V(n) asm volatile("s_waitcnt vmcnt(" #n ")" ::: "memory")
#define PG8_WAIT_L(n) asm volatile("s_waitcnt lgkmcnt(" #n ")" ::: "memory")
#define PG8_BAR __builtin_amdgcn_s_barrier()
#define PG8_SCHED __builtin_amdgcn_sched_barrier(0)
#define PG8_TOKOFF(u, tz, h, i, dst) do { int R_, C_; stage_rc((tz) * 16 + (i) * 8192, R_, C_); dst = (unsigned)S.tok(u, (h) * HALF + R_) * (unsigned)(K * 2) + (unsigned)(C_ * 2); } while (0)
    Unit cur, nxt, nn; int ui = 0;
    if (!S.next(0, cur)) return;
    bool has_next = S.next(1, nxt);
    unsigned vc00, vc01, vc10, vc11, vn00, vn01, vn10, vn11;
    { int tz = tid_; asm volatile("" : "+v"(tz));
      PG8_TOKOFF(cur, tz, 0, 0, vc00); PG8_TOKOFF(cur, tz, 0, 1, vc01); PG8_TOKOFF(cur, tz, 1, 0, vc10); PG8_TOKOFF(cur, tz, 1, 1, vc11);
      if (has_next) { PG8_TOKOFF(nxt, tz, 0, 0, vn00); PG8_TOKOFF(nxt, tz, 0, 1, vn01); PG8_TOKOFF(nxt, tz, 1, 0, vn10); PG8_TOKOFF(nxt, tz, 1, 1, vn11); }
      else { vn00 = vc00; vn01 = vc01; vn10 = vc10; vn11 = vc11; } }
    f32x4 acc[2][2][4][2];
#pragma unroll
    for (int a = 0; a < 2; ++a)
#pragma unroll
        for (int b = 0; b < 2; ++b)
#pragma unroll
            for (int m = 0; m < 4; ++m)
#pragma unroll
                for (int n = 0; n < 2; ++n) acc[a][b][m][n] = (f32x4){0.f, 0.f, 0.f, 0.f};
    bf16x8 At[4][2], B0[2][2], B1[2][2];
    const char* const cA = (const char*)g.A;
    const char* cB = (const char*)g.Bt + (size_t)cur.pn * tstep;
    PG8_STAGE(PG8_SB(0, 0), cB, voffB); PG8_STAGE(PG8_SB(0, 1), cB + hstep, voffB); PG8_STAGE2(PG8_SA(0, 0), cA, vc00, vc01); PG8_STAGE2(PG8_SA(0, 1), cA, vc10, vc11);
    if (wr == 1) PG8_BAR;
    PG8_WAIT_V(2); PG8_BAR;
    PG8_STAGE(PG8_SB(1, 0), cB + kstep, voffB); PG8_STAGE2(PG8_SA(1, 0), cA + kstep, vc00, vc01); PG8_STAGE(PG8_SB(1, 1), cB + hstep + kstep, voffB);
    PG8_WAIT_V(6); PG8_BAR;
    for (;;) {
        const char* nB = has_next ? (const char*)g.Bt + (size_t)nxt.pn * tstep : cB;
        for (int t = 0; t < nt; t += 2) {
            const bool last = (t == nt - 2);
            const char* a1 = cA + (size_t)(t + 1) * kstep;
            const char* a2 = last ? cA : cA + (size_t)(t + 2) * kstep; const char* b2 = last ? nB : cB + (size_t)(t + 2) * kstep;
            const char* a3 = a2 + kstep; const char* b3 = b2 + kstep;
            const unsigned x00 = last ? vn00 : vc00, x01 = last ? vn01 : vc01, x10 = last ? vn10 : vc10, x11 = last ? vn11 : vc11;
            PG8_LDB(B0, 0, 0); PG8_LDB(B1, 0, 1); PG8_SCHED; PG8_LDA(At, 0, 0); PG8_STAGE2(PG8_SA(1, 1), a1, vc10, vc11);
            PG8_WAIT_V(8); PG8_WAIT_L(0); PG8_BAR; PG8_MMA(0, 0, At, B0); PG8_MMA(0, 1, At, B1); PG8_BAR; PG8_SCHED;
            PG8_LDA(At, 0, 1); PG8_STAGE(PG8_SB(0, 0), b2, voffB); PG8_STAGE(PG8_SB(0, 1), b2 + hstep, voffB); PG8_STAGE2(PG8_SA(0, 0), a2, x00, x01);
            PG8_WAIT_V(8); PG8_WAIT_L(0); PG8_BAR; PG8_MMA(1, 0, At, B0); PG8_MMA(1, 1, At, B1); PG8_BAR; PG8_SCHED;
            PG8_LDB(B0, 1, 0); PG8_LDB(B1, 1, 1); PG8_SCHED; PG8_LDA(At, 1, 0); PG8_STAGE2(PG8_SA(0, 1), a2, x10, x11);
            PG8_WAIT_V(8); PG8_WAIT_L(0); PG8_BAR; PG8_MMA(0, 0, At, B0); PG8_MMA(0, 1, At, B1); PG8_BAR; PG8_SCHED;
            PG8_LDA(At, 1, 1); PG8_STAGE(PG8_SB(1, 0), b3, voffB); PG8_STAGE(PG8_SB(1, 1), b3 + hstep, voffB); PG8_STAGE2(PG8_SA(1, 0), a3, x00, x01);
            PG8_WAIT_V(8); PG8_WAIT_L(0); PG8_BAR; PG8_MMA(1, 0, At, B0); PG8_MMA(1, 1, At, B1); PG8_BAR; PG8_SCHED;
        }
        if (wr == 0) PG8_BAR;
        const bool has_nn = has_next && S.next(ui + 2, nn);
        unsigned w00 = 0, w01 = 0, w10 = 0, w11 = 0;
        if (has_nn) { int tz = tid_; asm volatile("" : "+v"(tz)); PG8_TOKOFF(nn, tz, 0, 0, w00); PG8_TOKOFF(nn, tz, 0, 1, w01); PG8_TOKOFF(nn, tz, 1, 0, w10); PG8_TOKOFF(nn, tz, 1, 1, w11); }
        E(acc, cur, wr, wc, fr, fq); S.done(cur);
#if defined(PROBE_EPI2)
        asm volatile("" ::: "memory");
#pragma unroll
        for (int a = 0; a < 2; ++a)
#pragma unroll
            for (int b = 0; b < 2; ++b)
#pragma unroll
                for (int m = 0; m < 4; ++m)
#pragma unroll
                    for (int n = 0; n < 2; ++n) asm volatile("" : "+v"(acc[a][b][m][n]));
        E(acc, cur, wr, wc, fr, fq);
#endif
        if (!has_next) break;
#pragma unroll
        for (int a = 0; a < 2; ++a)
#pragma unroll
            for (int b = 0; b < 2; ++b)
#pragma unroll
                for (int m = 0; m < 4; ++m)
#pragma unroll
                    for (int n = 0; n < 2; ++n) acc[a][b][m][n] = (f32x4){0.f, 0.f, 0.f, 0.f};
        cur = nxt; cB = nB; ++ui;
        vc00 = vn00; vc01 = vn01; vc10 = vn10; vc11 = vn11;
        if (has_nn) { vn00 = w00; vn01 = w01; vn10 = w10; vn11 = w11; nxt = nn; }
        has_next = has_nn;
        if (wr == 1) PG8_BAR;
    }
    PG8_WAIT_V(0);
    PG8_BAR;
#undef PG8_SA
#undef PG8_SB
#undef PG8_STAGE
#undef PG8_STAGE2
#undef PG8_LDA
#undef PG8_LDB
#undef PG8_MMA
#undef PG8_WAIT_V
#undef PG8_WAIT_L
#undef PG8_BAR
#undef PG8_SCHED
#undef PG8_TOKOFF
}
}

#define GAS __attribute__((address_space(1)))
#define LAS __attribute__((address_space(3)))
typedef unsigned short bf16;
typedef unsigned v4u __attribute__((ext_vector_type(4)));
typedef unsigned v2u __attribute__((ext_vector_type(2)));
typedef float f32x4 __attribute__((ext_vector_type(4)));
typedef short bf16x8 __attribute__((ext_vector_type(8)));

constexpr int NWAVES = 8, NTHR = 512;
constexpr int NB = 2, SEQ = 16384, T = NB * SEQ, D = 1024;
constexpr int CONV_CH = 768, CONV_W = 31, AIN = 1792, KVW = 1536, NEXP = 32, DFF = 1024;
constexpr int MAXTILES = (T * 4) / 256 + NEXP;
constexpr int XROWS = MAXTILES * 256;
constexpr float DN_ALPHA = 1.681792830507429f;
constexpr float LN_EPS = 1e-5f;

constexpr size_t MiB = 1u << 20;
constexpr size_t al(size_t x) { return (x + MiB - 1) / MiB * MiB; }
constexpr size_t WS_CTL = 0, CTL_ZERO_BYTES = MiB;
constexpr size_t WS_ROT  = WS_CTL + MiB;
constexpr size_t WS_WIN  = WS_ROT  + al((size_t)T * 16 * 4);
constexpr size_t WS_WOA  = WS_WIN  + al((size_t)2 * AIN * D * 2);
constexpr size_t WS_WKV  = WS_WOA  + al((size_t)2 * D * D * 2);
constexpr size_t WS_WQ   = WS_WKV  + al((size_t)KVW * D * 2);
constexpr size_t WS_WOB  = WS_WQ   + al((size_t)2 * D * D * 2);
constexpr size_t WS_WMEM = WS_WOB  + al((size_t)2 * D * 512 * 2);
constexpr size_t WS_WUP  = WS_WMEM + al((size_t)4 * 512 * D * 2);
constexpr size_t WS_SBW  = WS_WUP  + al((size_t)4 * NEXP * 2 * DFF * D);
constexpr size_t WS_WDN  = WS_SBW  + al((size_t)4 * NEXP * 2 * DFF * 4);
constexpr size_t WS_MEMB = WS_WDN  + al((size_t)4 * NEXP * D * DFF * 2);
constexpr size_t WS_MEMKV= WS_MEMB + al((size_t)512 * D * 2);
constexpr size_t WS_XB   = WS_MEMKV+ al((size_t)512 * 2048 * 2);
constexpr size_t WS_X1B  = WS_XB   + al((size_t)T * D * 2);
constexpr size_t WS_XR1  = WS_X1B  + al((size_t)T * D * 2);
constexpr size_t WS_XR2  = WS_XR1  + al((size_t)T * D * 4);
constexpr size_t WS_Z    = WS_XR2  + al((size_t)T * D * 4);
constexpr size_t WS_HGLU = WS_Z    + al((size_t)T * D * 4);
constexpr size_t WS_QM   = WS_HGLU + al((size_t)T * CONV_CH * 2);
constexpr size_t WS_A2   = WS_QM   + al((size_t)T * 256 * 2);
constexpr size_t WS_QB   = WS_A2   + al((size_t)T * D * 2);
constexpr size_t WS_KVB  = WS_QB   + al((size_t)T * D * 2);
constexpr size_t WS_OG   = WS_KVB  + al((size_t)T * KVW * 2);
constexpr size_t WS_LSE  = WS_OG   + al((size_t)3 * T * 256 * 2);
constexpr size_t WS_TES  = WS_LSE  + al((size_t)3 * T * 4 * 4);
constexpr size_t WS_TGATE= WS_TES  + al((size_t)T * 4 * 4);
constexpr size_t WS_TROW = WS_TGATE+ al((size_t)T * 4 * 4);
constexpr size_t WS_RWT  = WS_TROW + al((size_t)T * 4 * 4);
constexpr size_t WS_RTOK = WS_RWT  + al((size_t)4 * NEXP * D * 4);
constexpr size_t WS_RSC  = WS_RTOK + al((size_t)NEXP * T * 4);
constexpr size_t WS_H    = WS_RSC  + al((size_t)NEXP * T * 4);
constexpr size_t WS_Y    = WS_H    + al((size_t)XROWS * DFF * 2);
constexpr size_t WS_END  = WS_Y    + al((size_t)XROWS * D * 2);
constexpr int CW_BAR = 4096;
constexpr int CW_CNT = 8192;
constexpr int LDS_SCR = 133120;
constexpr int LDS_MISC = LDS_SCR;
constexpr int LDS_TB = LDS_MISC + 64;
constexpr int LDS_TE = LDS_TB + 320;
constexpr int LDS_RT = LDS_TE + 2304;
constexpr int LDS_PTR = LDS_RT + 2304;
constexpr int LDS_SA = LDS_PTR + 256;
constexpr int LDS_BYTES = 147456;
static_assert(LDS_SA + 512 <= LDS_BYTES, "LDS map");

#define LDS_WAIT() asm volatile("s_waitcnt lgkmcnt(0)" ::: "memory")
#define VM_WAIT() asm volatile("s_waitcnt vmcnt(0)" ::: "memory")
__device__ __forceinline__ unsigned f2bf(float f) { unsigned u = __builtin_bit_cast(unsigned, f); return (u + 0x7fffu + ((u >> 16) & 1u)) >> 16; }
__device__ __forceinline__ unsigned pk2(float lo, float hi) { return f2bf(lo) | (f2bf(hi) << 16); }
__device__ __forceinline__ float bflo(unsigned w) { return __builtin_bit_cast(float, w << 16); }
__device__ __forceinline__ float bfhi(unsigned w) { return __builtin_bit_cast(float, w & 0xffff0000u); }
__device__ __forceinline__ float wave_sum(float v) {
#pragma unroll
    for (int o = 1; o < 64; o <<= 1) v += __shfl_xor(v, o);
    return v;
}
__device__ __forceinline__ float sigmoidf_(float x) { return __builtin_amdgcn_rcpf(1.0f + __builtin_amdgcn_exp2f(-1.4426950408889634f * x)); }
#define XB_TMO      128
#define XB_XCNT(j)  (256  + 64 * (j))
#define XB_XSUB(j)  (1280 + 64 * (j))
#define XB_XGEN(j)  (2304 + 64 * (j))
#define XB_TOP      3328
#define XB_TOPGEN   3392
#define XCD_BAR_WORDS 3456
#define XB_SPIN_CAP (1u << 18)

__device__ __forceinline__ unsigned xb_ld(unsigned* p)              { return __hip_atomic_load(p, __ATOMIC_RELAXED, __HIP_MEMORY_SCOPE_AGENT); }
__device__ __forceinline__ unsigned xb_add(unsigned* p, unsigned v) { return __hip_atomic_fetch_add(p, v, __ATOMIC_RELAXED, __HIP_MEMORY_SCOPE_AGENT); }
__device__ __forceinline__ unsigned xb_xcc_id() { return (unsigned)__builtin_amdgcn_s_getreg((3 << 11) | 20) & 0xFu; }
#define XB_SPIN(cond, bar) do { unsigned _sp = 0; while (cond) { __builtin_amdgcn_s_sleep(1); \
    if ((++_sp & 255u) == 0u) { if (xb_ld(&(bar)[XB_TMO])) break; if (_sp > XB_SPIN_CAP) { atomicAdd(&(bar)[XB_TMO], 1u); break; } } } } while (0)

struct XcdBarrier {
    unsigned* bar; unsigned x;
    volatile LAS unsigned* st;
};

__device__ __forceinline__ XcdBarrier xcd_barrier_post(unsigned* bar, volatile LAS unsigned* st) {
    XcdBarrier b; b.bar = bar; b.x = xb_xcc_id(); b.st = st;
    if (threadIdx.x == 0) (void)xb_add(&bar[XB_XCNT(b.x)], 1u);
    return b;
}
__device__ __forceinline__ void xcd_barrier_complete(unsigned* bar, unsigned x, unsigned& nloc, unsigned& nx) {
    const unsigned G = gridDim.x * gridDim.y * gridDim.z;
    unsigned sum, cnt, mine, sp = 0u;
    for (;;) {
        sum = 0u; cnt = 0u; mine = 0u;
#pragma unroll
        for (unsigned j = 0; j < 16; ++j) { const unsigned c = xb_ld(&bar[XB_XCNT(j)]); sum += c; cnt += (c > 0u) ? 1u : 0u; mine = (j == x) ? c : mine; }
        if (sum == G) break;
        __builtin_amdgcn_s_sleep(1);
        if ((++sp & 255u) == 0u) { if (xb_ld(&bar[XB_TMO])) break; if (sp > XB_SPIN_CAP) { atomicAdd(&bar[XB_TMO], 1u); break; } }
    }
    nloc = mine > 0u ? mine : 1u; nx = cnt > 0u ? cnt : 1u;
}

__device__ __forceinline__ void xcd_barrier(const XcdBarrier& b) {
    asm volatile("s_waitcnt vmcnt(0)" ::: "memory");
    __syncthreads();
    if (threadIdx.x == 0) {
        unsigned* bar = b.bar;
        __builtin_amdgcn_s_waitcnt(0);
        unsigned nloc = b.st[0], nx = b.st[1];
        if (nloc == 0u) { xcd_barrier_complete(bar, b.x, nloc, nx); b.st[0] = nloc; b.st[1] = nx; }
        const unsigned old = xb_add(&bar[XB_XSUB(b.x)], 1u);
        const unsigned gen = old / nloc;
        if (old + 1u == (gen + 1u) * nloc) {
            __builtin_amdgcn_fence(__ATOMIC_RELEASE, "agent");
            asm volatile("s_waitcnt vmcnt(0)" ::: "memory");
            const unsigned og = xb_add(&bar[XB_TOP], 1u);
            const unsigned tg = og / nx;
            if (og + 1u == (tg + 1u) * nx) xb_add(&bar[XB_TOPGEN], 1u);
            else XB_SPIN(xb_ld(&bar[XB_TOPGEN]) == tg, bar);
            __builtin_amdgcn_fence(__ATOMIC_ACQUIRE, "agent");
            xb_add(&bar[XB_XGEN(b.x)], 1u);
            asm volatile("s_waitcnt vmcnt(0)" ::: "memory");
        } else {
            XB_SPIN(xb_ld(&bar[XB_XGEN(b.x)]) == gen, bar);
            __builtin_amdgcn_fence(__ATOMIC_ACQUIRE, "agent");
            asm volatile("s_waitcnt vmcnt(0)" ::: "memory");
        }
    }
    __syncthreads();
}

using pg8::Unit; using pg8::cvt_pk_bf16; using pg8::BM; using pg8::HALF;
typedef unsigned u32x4 __attribute__((ext_vector_type(4)));
#if defined(EPI_NT)
#define EPI_ST(p, v) __builtin_nontemporal_store((v), (p))
#else
#define EPI_ST(p, v) (*(p) = (v))
#endif

struct EpiGluQ {
    static constexpr bool PERM = true, AFTER_DRAIN = false;
    bf16* hglu; bf16* qm; const float* bias;
    __device__ __forceinline__ void operator()(const f32x4 (&acc)[2][2][4][2], const Unit& u, int wr, int wc, int fr, int fq) const {
        const int row0 = u.pm * BM + wr * 64 + fr, cw = wc * 32 + 8 * fq;
        if (u.pn < 6) {
            f32x4 ba[2], bg[2];
#pragma unroll
            for (int n = 0; n < 2; ++n) { ba[n] = *(const f32x4*)(bias + u.pn * 128 + cw + 4 * n); bg[n] = *(const f32x4*)(bias + 768 + u.pn * 128 + cw + 4 * n); }
#pragma unroll
            for (int ai = 0; ai < 2; ++ai)
#pragma unroll
                for (int m = 0; m < 4; ++m) {
                    float o[8];
#pragma unroll
                    for (int n = 0; n < 2; ++n) { const f32x4 a = acc[ai][0][m][n] + ba[n], g = acc[ai][1][m][n] + bg[n];
#pragma unroll
                        for (int j = 0; j < 4; ++j) o[4 * n + j] = a[j] * sigmoidf_(g[j]); }
                    u32x4 w; w.x = cvt_pk_bf16(o[0], o[1]); w.y = cvt_pk_bf16(o[2], o[3]); w.z = cvt_pk_bf16(o[4], o[5]); w.w = cvt_pk_bf16(o[6], o[7]);
                    EPI_ST((u32x4*)(hglu + (size_t)(row0 + ai * HALF + m * 16) * CONV_CH + u.pn * 128 + cw), w);
                }
        } else {
            f32x4 bv[2][2];
#pragma unroll
            for (int bj = 0; bj < 2; ++bj)
#pragma unroll
                for (int n = 0; n < 2; ++n) bv[bj][n] = *(const f32x4*)(bias + 1536 + bj * HALF + cw + 4 * n);
#pragma unroll
            for (int ai = 0; ai < 2; ++ai)
#pragma unroll
                for (int m = 0; m < 4; ++m)
#pragma unroll
                    for (int bj = 0; bj < 2; ++bj) { const f32x4 v0 = acc[ai][bj][m][0] + bv[bj][0], v1 = acc[ai][bj][m][1] + bv[bj][1];
                        u32x4 w; w.x = cvt_pk_bf16(v0[0], v0[1]); w.y = cvt_pk_bf16(v0[2], v0[3]); w.z = cvt_pk_bf16(v1[0], v1[1]); w.w = cvt_pk_bf16(v1[2], v1[3]);
                        EPI_ST((u32x4*)(qm + (size_t)(row0 + ai * HALF + m * 16) * 256 + bj * HALF + cw), w); }
        }
    }
};

struct EpiRes {
    static constexpr bool PERM = false, AFTER_DRAIN = false;
    float* Z; const float* xres; const float* bias;
    __device__ __forceinline__ void operator()(const f32x4 (&acc)[2][2][4][2], const Unit& u, int wr, int wc, int fr, int fq) const {
        const int row0 = u.pm * BM + wr * 64 + fr, col0 = u.pn * BM + wc * 32 + 4 * fq;
        f32x4 bv[2][2];
#pragma unroll
        for (int bj = 0; bj < 2; ++bj)
#pragma unroll
            for (int n = 0; n < 2; ++n) bv[bj][n] = *(const f32x4*)(bias + col0 + bj * HALF + n * 16);
#pragma unroll
        for (int ai = 0; ai < 2; ++ai)
#pragma unroll
            for (int m = 0; m < 4; ++m) { const size_t off = (size_t)(row0 + ai * HALF + m * 16) * D + col0;
#pragma unroll
                for (int bj = 0; bj < 2; ++bj)
#pragma unroll
                    for (int n = 0; n < 2; ++n) { const f32x4 xr = *(const f32x4*)(xres + off + bj * HALF + n * 16);
                        EPI_ST((f32x4*)(Z + off + bj * HALF + n * 16), xr * DN_ALPHA + acc[ai][bj][m][n] + bv[bj][n]); } }
    }
};

template <int MODE> struct EpiRot {
    static constexpr bool PERM = true, AFTER_DRAIN = false;
    bf16* O; int ldc; const float* rot;
    __device__ __forceinline__ void operator()(const f32x4 (&acc)[2][2][4][2], const Unit& u, int wr, int wc, int fr, int fq) const {
        const int row0 = u.pm * BM + wr * 64 + fr;
#pragma unroll
        for (int bj = 0; bj < 2; ++bj) {
            const int cb = u.pn * BM + bj * HALF;
            bool rotu = false;
            if (MODE == 0) rotu = (cb < 768) && ((wc & 1) == 0);
            if (MODE == 1) rotu = ((cb & 511) < 256) && ((wc & 1) == 0);
#pragma unroll
            for (int ai = 0; ai < 2; ++ai)
#pragma unroll
                for (int m = 0; m < 4; ++m) {
                    const int row = row0 + ai * HALF + m * 16;
                    float v[8];
#pragma unroll
                    for (int j = 0; j < 4; ++j) { v[j] = acc[ai][bj][m][0][j]; v[4 + j] = acc[ai][bj][m][1][j]; }
                    if (rotu) {
                        float pv[8];
#pragma unroll
                        for (int j = 0; j < 8; ++j) pv[j] = __shfl_xor(v[j], 16);
                        if (fq < 2) {
                            const f32x4 c0 = *(const f32x4*)(rot + (size_t)row * 16), c1 = *(const f32x4*)(rot + (size_t)row * 16 + 4);
                            const f32x4 s0 = *(const f32x4*)(rot + (size_t)row * 16 + 8), s1 = *(const f32x4*)(rot + (size_t)row * 16 + 12);
                            const float sg = (fq == 0) ? -1.0f : 1.0f;
#pragma unroll
                            for (int j = 0; j < 4; ++j) { v[j] = v[j] * c0[j] + sg * pv[j] * s0[j]; v[4 + j] = v[4 + j] * c1[j] + sg * pv[4 + j] * s1[j]; }
                        }
                    }
                    u32x4 w; w.x = cvt_pk_bf16(v[0], v[1]); w.y = cvt_pk_bf16(v[2], v[3]); w.z = cvt_pk_bf16(v[4], v[5]); w.w = cvt_pk_bf16(v[6], v[7]);
                    EPI_ST((u32x4*)(O + (size_t)row * ldc + cb + wc * 32 + 8 * fq), w);
                }
        }
    }
};

struct EpiSwiglu {
    static constexpr bool PERM = true, AFTER_DRAIN = false;
    bf16* H; const float* bup;
    __device__ __forceinline__ void operator()(const f32x4 (&acc)[2][2][4][2], const Unit& u, int wr, int wc, int fr, int fq) const {
        const int e = u.pn >> 3, pn = u.pn & 7, row0 = u.pm * BM + wr * 64 + fr, cw = pn * 128 + wc * 32 + 8 * fq;
        f32x4 bg[2], bl[2];
#pragma unroll
        for (int n = 0; n < 2; ++n) { bg[n] = *(const f32x4*)(bup + (size_t)e * 2048 + cw + 4 * n); bl[n] = *(const f32x4*)(bup + (size_t)e * 2048 + 1024 + cw + 4 * n); }
#pragma unroll
        for (int ai = 0; ai < 2; ++ai)
#pragma unroll
            for (int m = 0; m < 4; ++m) {
                float o[8];
#pragma unroll
                for (int n = 0; n < 2; ++n) { const f32x4 g = acc[ai][0][m][n] + bg[n], li = acc[ai][1][m][n] + bl[n];
#pragma unroll
                    for (int j = 0; j < 4; ++j) { const float gg = fminf(g[j], 7.0f), ll = fminf(fmaxf(li[j], -7.0f), 7.0f); o[4 * n + j] = gg * sigmoidf_(1.702f * gg) * (ll + 1.0f); } }
                u32x4 w; w.x = cvt_pk_bf16(o[0], o[1]); w.y = cvt_pk_bf16(o[2], o[3]); w.z = cvt_pk_bf16(o[4], o[5]); w.w = cvt_pk_bf16(o[6], o[7]);
                EPI_ST((u32x4*)(H + (size_t)(row0 + ai * HALF + m * 16) * DFF + cw), w);
            }
    }
};

struct EpiSwigluI8 {
    static constexpr bool PERM = true, AFTER_DRAIN = false;
    bf16* H; const float* bup; const float* sbw; const float* rowsc; const LAS int* tbs;
    __device__ __forceinline__ void operator()(const f32x4 (&acc)[2][2][4][2], const Unit& u, int wr, int wc, int fr, int fq) const {
        const int e = u.pn >> 3, pn = u.pn & 7, row0 = u.pm * BM + wr * 64 + fr, cw = pn * 128 + wc * 32 + 8 * fq;
        const int slot0 = (u.pm - tbs[e]) * 256 + wr * 64 + fr;
        f32x4 bg[2], bl[2], sg[2], sl[2];
#pragma unroll
        for (int n = 0; n < 2; ++n) { bg[n] = *(const f32x4*)(bup + (size_t)e * 2048 + cw + 4 * n); bl[n] = *(const f32x4*)(bup + (size_t)e * 2048 + 1024 + cw + 4 * n);
            sg[n] = *(const f32x4*)(sbw + (size_t)e * 2048 + pn * 256 + wc * 32 + 8 * fq + 4 * n); sl[n] = *(const f32x4*)(sbw + (size_t)e * 2048 + pn * 256 + 128 + wc * 32 + 8 * fq + 4 * n); }
#pragma unroll
        for (int ai = 0; ai < 2; ++ai)
#pragma unroll
            for (int m = 0; m < 4; ++m) {
                const float sa = rowsc[(size_t)e * T + slot0 + ai * HALF + m * 16];
                float o[8];
#pragma unroll
                for (int n = 0; n < 2; ++n) {
#pragma unroll
                    for (int j = 0; j < 4; ++j) {
                        const float g = (float)__float_as_int(acc[ai][0][m][n][j]) * (sa * sg[n][j]) + bg[n][j], li = (float)__float_as_int(acc[ai][1][m][n][j]) * (sa * sl[n][j]) + bl[n][j];
                        const float gg = fminf(g, 7.0f), ll = fminf(fmaxf(li, -7.0f), 7.0f); o[4 * n + j] = gg * sigmoidf_(1.702f * gg) * (ll + 1.0f);
#if defined(PROBE_H) && (PROBE_H == 3 || PROBE_H >= 7)
                        o[4 * n + j] = (float)__float_as_int(acc[ai][0][m][n][j]);
#endif
                    } }
                u32x4 w; w.x = cvt_pk_bf16(o[0], o[1]); w.y = cvt_pk_bf16(o[2], o[3]); w.z = cvt_pk_bf16(o[4], o[5]); w.w = cvt_pk_bf16(o[6], o[7]);
                EPI_ST((u32x4*)(H + (size_t)(row0 + ai * HALF + m * 16) * DFF + cw), w);
            }
    }
};

struct EpiDown {
    static constexpr bool PERM = true, AFTER_DRAIN = false;
    bf16* Y; const float* bdn;
    __device__ __forceinline__ void operator()(const f32x4 (&acc)[2][2][4][2], const Unit& u, int wr, int wc, int fr, int fq) const {
        const int e = u.pn >> 2, pn = u.pn & 3, row0 = u.pm * BM + wr * 64 + fr, cw = pn * BM + wc * 32 + 8 * fq;
        f32x4 bv[2][2];
#pragma unroll
        for (int bj = 0; bj < 2; ++bj)
#pragma unroll
            for (int n = 0; n < 2; ++n) bv[bj][n] = *(const f32x4*)(bdn + (size_t)e * D + cw + bj * HALF + 4 * n);
#pragma unroll
        for (int ai = 0; ai < 2; ++ai)
#pragma unroll
            for (int m = 0; m < 4; ++m)
#pragma unroll
                for (int bj = 0; bj < 2; ++bj) { const f32x4 v0 = acc[ai][bj][m][0] + bv[bj][0], v1 = acc[ai][bj][m][1] + bv[bj][1];
                    u32x4 w; w.x = cvt_pk_bf16(v0[0], v0[1]); w.y = cvt_pk_bf16(v0[2], v0[3]); w.z = cvt_pk_bf16(v1[0], v1[1]); w.w = cvt_pk_bf16(v1[2], v1[3]);
                    EPI_ST((u32x4*)(Y + (size_t)(row0 + ai * HALF + m * 16) * D + cw + bj * HALF), w); }
    }
};

template <int NTN> struct MoeOrder {
    const LAS int* tile_e; const LAS int* tbs; const LAS int* cntl; const int* rowtok; int total, G, c;
    __device__ __forceinline__ bool next(int i, Unit& u) const {
#if defined(MOE_ORDER_B)
        const int L = i * G + c, grp = L / (8 * NTN), w = L % (8 * NTN), rt = grp * 8 + (w / NTN), pn = w % NTN;
#else
        const int L = i * G + c, grp = L / (8 * NTN), w = L % (8 * NTN), rt = grp * 8 + (w & 7), pn = w >> 3;
#endif
        if (rt >= total) return false;
        const int e = __builtin_amdgcn_readfirstlane(tile_e[rt]);
        u.pm = rt; u.pn = e * NTN + pn; return true;
    }
    __device__ __forceinline__ int tok(const Unit& u, int r) const {
        const int e = u.pn / NTN, slot = (u.pm - tbs[e]) * 256 + r; int t = 0;
        if (slot < cntl[e]) t = rowtok[(size_t)e * T + slot];
        return t;
    }
    __device__ __forceinline__ void a_ready(const Unit&) const {}
    __device__ __forceinline__ void done(const Unit&) const {}
};

struct Frame {
    LAS unsigned char* lds;
    int tid, lane, wave, G, gw, NGW;
};
__device__ __forceinline__ unsigned char* ptr_slot(const Frame& F, int k) {
    const unsigned long long v = *(const LAS unsigned long long*)(F.lds + LDS_PTR + 8 * k);
    const unsigned lo = __builtin_amdgcn_readfirstlane((unsigned)v), hi = __builtin_amdgcn_readfirstlane((unsigned)(v >> 32));
    return (unsigned char*)(GAS unsigned char*)(((unsigned long long)hi << 32) | lo);
}
__device__ __forceinline__ const float* inp(const Frame& F, int k) { return (const float*)ptr_slot(F, k); }
__device__ __forceinline__ unsigned char* wsp(const Frame& F) { return ptr_slot(F, 24); }

__device__ __forceinline__ void tr_item(const float* W, int N, bf16* WT, int K, int k0, int n0, int orow0, LAS float* scr, int lane) {
#if defined(P0_V2)
    { float tv_[64];
#pragma unroll
      for (int i = 0; i < 64; ++i) tv_[i] = __builtin_nontemporal_load(W + (size_t)(k0 + i) * N + n0 + lane);
#pragma unroll
      for (int i = 0; i < 64; ++i) scr[i * 65 + lane] = tv_[i]; }
#else
#pragma unroll 16
    for (int i = 0; i < 64; ++i) scr[i * 65 + lane] = W[(size_t)(k0 + i) * N + n0 + lane];
#endif
    LDS_WAIT(); asm volatile("" ::: "memory");
    const int c = lane & 7;
#pragma unroll
    for (int j = 0; j < 8; ++j) { const int n = (lane >> 3) + 8 * j; const LAS float* s = scr + (8 * c) * 65 + n;
        v4u o; o.x = pk2(s[0 * 65], s[1 * 65]); o.y = pk2(s[2 * 65], s[3 * 65]); o.z = pk2(s[4 * 65], s[5 * 65]); o.w = pk2(s[6 * 65], s[7 * 65]);
        *(v4u*)(WT + (size_t)(orow0 + n) * K + k0 + 8 * c) = o; }
    LDS_WAIT(); asm volatile("" ::: "memory");
}
template <int PERMT> __device__ __forceinline__ int perm_row(int n0) {
    if (PERMT == 1) { if (n0 >= 1536) return n0; const int bj = n0 / 768, r = n0 % 768; return (r / 128) * 256 + bj * 128 + (r % 128); }
    if (PERMT == 2) { const int bj = n0 / 1024, r = n0 % 1024; return (r / 128) * 256 + bj * 128 + (r % 128); }
    return n0;
}
template <int PERMT> __device__ __forceinline__ void conv_group(Frame& F, const float* src, bf16* dst, int K, int N, int nmat) {
    LAS float* scr = (LAS float*)(F.lds + F.wave * 16640);
    const int nkb = K / 64, nnb = N / 64, per = nkb * nnb, total = per * nmat;
    for (int it = F.gw; it < total; it += F.NGW) {
        const int mat = it / per, r = it % per, kb = r / nnb, nb = r % nnb;
        tr_item(src + (size_t)mat * K * N, N, dst + (size_t)mat * K * N, K, kb * 64, nb * 64, perm_row<PERMT>(nb * 64), scr, F.lane);
    }
}
__device__ __forceinline__ void conv_up_i8(Frame& F, const float* src, unsigned char* dst, float* sbw) {
    constexpr int K = D, N = 2 * DFF, NSTRIP = N / 64, TOTAL = 4 * NEXP * NSTRIP;
    LAS float* red = (LAS float*)F.lds;
    for (int it = blockIdx.x; it < TOTAL; it += F.G) {
        const int mat = it / NSTRIP, n0 = (it % NSTRIP) * 64;
        const float* W = src + (size_t)mat * K * N + (size_t)(128 * F.wave) * N + n0 + F.lane;
        float t[128];
#pragma unroll
        for (int i = 0; i < 128; ++i) t[i] = __builtin_nontemporal_load(W + (size_t)i * N);
        float mx = 0.f;
#pragma unroll
        for (int i = 0; i < 128; ++i) mx = fmaxf(mx, fabsf(t[i]));
        __syncthreads();
        red[F.wave * 64 + F.lane] = mx;
        __syncthreads();
#pragma unroll
        for (int w = 0; w < 8; ++w) mx = fmaxf(mx, red[w * 64 + F.lane]);
        mx = fmaxf(mx, 1e-30f);
        const float inv = 127.0f / mx;
        const int orow = perm_row<2>(n0) + F.lane;
        if (F.wave == 0) sbw[(size_t)mat * N + orow] = mx * (1.0f / 127.0f);
        unsigned char* out = dst + ((size_t)mat * N + orow) * K + 128 * F.wave;
#pragma unroll
        for (int c = 0; c < 8; ++c) { unsigned pk[4];
#pragma unroll
            for (int i = 0; i < 4; ++i) { const int b = 16 * c + 4 * i; const int q0 = (int)rintf(t[b] * inv), q1 = (int)rintf(t[b + 1] * inv), q2 = (int)rintf(t[b + 2] * inv), q3 = (int)rintf(t[b + 3] * inv);
                pk[i] = (unsigned)(q0 & 255) | ((unsigned)(q1 & 255) << 8) | ((unsigned)(q2 & 255) << 16) | ((unsigned)(q3 & 255) << 24); }
            *(v4u*)(out + 16 * c) = (v4u){pk[0], pk[1], pk[2], pk[3]}; }
    }
    __syncthreads();
}
__device__ __forceinline__ void phase_prologue(Frame& F) {
    unsigned char* ws = wsp(F);
#if defined(PROBE_I8)
    if (blockIdx.x == 0 && F.wave == 0) {
        typedef int i32x4_ __attribute__((ext_vector_type(4)));
        const int i = F.lane & 15, g = F.lane >> 4;
        unsigned aw[4], bw[4];
        for (int w = 0; w < 4; ++w) { unsigned a = 0, b = 0; for (int t = 0; t < 4; ++t) { const int k = 16 * g + 4 * w + t; const int av = ((i * 7 + k * 3) % 11) - 5, bv = ((k * 5 + i * 2) % 13) - 6; a |= (unsigned)(av & 255) << (8 * t); b |= (unsigned)(bv & 255) << (8 * t); } aw[w] = a; bw[w] = b; }
        i32x4_ A = {(int)aw[0], (int)aw[1], (int)aw[2], (int)aw[3]}, B = {(int)bw[0], (int)bw[1], (int)bw[2], (int)bw[3]}, C = {0, 0, 0, 0};
        C = __builtin_amdgcn_mfma_i32_16x16x64_i8(A, B, C, 0, 0, 0);
        int bad = 0;
        for (int jj = 0; jj < 4; ++jj) { const int row = 4 * g + jj, col = i; int ref = 0; for (int k = 0; k < 64; ++k) ref += (((row * 7 + k * 3) % 11) - 5) * (((k * 5 + col * 2) % 13) - 6); if (ref != C[jj]) bad = 1; }
        const unsigned long long bm = __ballot(bad);
        if (F.lane == 0) ((float*)(ws + WS_CTL))[CW_CNT + 256] = bm ? 3.0f : 1.0f;
    }
#endif
    conv_group<1>(F, inp(F, 3),  (bf16*)(ws + WS_WIN),  D, AIN, 2);
    conv_group<0>(F, inp(F, 9),  (bf16*)(ws + WS_WOA),  D, D, 2);
    conv_group<0>(F, inp(F, 11), (bf16*)(ws + WS_WKV),  D, KVW, 1);
    conv_group<0>(F, inp(F, 12), (bf16*)(ws + WS_WQ),   D, D, 2);
    conv_group<0>(F, inp(F, 13), (bf16*)(ws + WS_WOB),  512, D, 2);
    conv_group<0>(F, inp(F, 15), (bf16*)(ws + WS_WMEM), D, 512, 4);
    conv_up_i8(F, inp(F, 20), (unsigned char*)(ws + WS_WUP), (float*)(ws + WS_SBW));
    conv_group<0>(F, inp(F, 22), (bf16*)(ws + WS_WDN),  DFF, D, 4 * NEXP);
    {
        const size_t gt = (size_t)blockIdx.x * NTHR + F.tid, NT_ = (size_t)F.G * NTHR;
        const float* x = inp(F, 0); bf16* xb = (bf16*)(ws + WS_XB);
        for (size_t i = gt; i < (size_t)T * D / 8; i += NT_) { const f32x4 a = *(const f32x4*)(x + i * 8), b = *(const f32x4*)(x + i * 8 + 4);
            v4u o; o.x = pk2(a[0], a[1]); o.y = pk2(a[2], a[3]); o.z = pk2(b[0], b[1]); o.w = pk2(b[2], b[3]); *(v4u*)(xb + i * 8) = o; }
        const float* mem = inp(F, 1); bf16* mb = (bf16*)(ws + WS_MEMB);
        for (size_t i = gt; i < (size_t)512 * D / 8; i += NT_) { const f32x4 a = *(const f32x4*)(mem + i * 8), b = *(const f32x4*)(mem + i * 8 + 4);
            v4u o; o.x = pk2(a[0], a[1]); o.y = pk2(a[2], a[3]); o.z = pk2(b[0], b[1]); o.w = pk2(b[2], b[3]); *(v4u*)(mb + i * 8) = o; }
        { const float* rw = inp(F, 18); float* rwT = (float*)(ws + WS_RWT);
          for (size_t i = gt; i < (size_t)4 * NEXP * D; i += NT_) { const int l = (int)(i >> 15), e = (int)((i >> 10) & 31), c = (int)(i & 1023); rwT[i] = rw[((size_t)l * D + c) * NEXP + e]; } }
        const int* pos = (const int*)inp(F, 2); float* rot = (float*)(ws + WS_ROT);
        for (size_t i = gt; i < (size_t)T * 8; i += NT_) { const int t = (int)(i >> 3), k = (int)(i & 7);
            double f = 1.0;
            f = (k == 1) ? 0.19392274474868576 : f; f = (k == 2) ? 0.03760603093086393 : f; f = (k == 3) ? 0.007292664737217109 : f; f = (k == 4) ? 0.001414213562373095 : f;
            f = (k == 5) ? 0.0002742481756762073 : f; f = (k == 6) ? 5.318295896944988e-05 : f; f = (k == 7) ? 1.031338537721246e-05 : f;
            const double a = (double)pos[t] * f; const double rv = a * 0.15915494309189535; const double fr = rv - floor(rv);
            const float ang = (float)(fr * 6.283185307179586);
            rot[(size_t)t * 16 + k] = cosf(ang); rot[(size_t)t * 16 + 8 + k] = sinf(ang); }
    }
}

__device__ __forceinline__ void phase_conv(Frame& F, const bf16* hglu, const float* dw, const float* dwb, const float* cg, const float* cb, bf16* A2) {
    LAS bf16* tile = (LAS bf16*)F.lds;
    LAS float* red = (LAS float*)(F.lds + 46 * 768 * 2);
    const int L = F.tid & 255, tb = F.tid >> 8, wv = F.wave & 3;
    float w[31][3], bias[3], gg[3], bb[3];
#pragma unroll
    for (int p = 0; p < 3; ++p) { bias[p] = dwb[p * 256 + L]; gg[p] = cg[p * 256 + L]; bb[p] = cb[p * 256 + L];
#pragma unroll
        for (int j = 0; j < 31; ++j) w[j][p] = dw[j * CONV_CH + p * 256 + L]; }
    for (int ti = blockIdx.x; ti < T / 16; ti += F.G) {
        const int t0 = ti * 16, s0 = t0 & (SEQ - 1);
        __syncthreads();
        for (int i = F.tid; i < 46 * 96; i += NTHR) { const int r = i / 96, c = i % 96; v4u v = (v4u){0u, 0u, 0u, 0u};
            if (s0 - 30 + r >= 0) v = *(const v4u*)(hglu + (size_t)(t0 - 30 + r) * CONV_CH + c * 8);
            *(LAS v4u*)(tile + r * CONV_CH + c * 8) = v; }
        __syncthreads();
        float acc[8][3];
#pragma unroll
        for (int t = 0; t < 8; ++t)
#pragma unroll
            for (int p = 0; p < 3; ++p) acc[t][p] = bias[p];
#pragma unroll
        for (int r = 0; r < 38; ++r) {
            float x[3];
#pragma unroll
            for (int p = 0; p < 3; ++p) x[p] = bflo((unsigned)tile[(tb * 8 + r) * CONV_CH + p * 256 + L]);
#pragma unroll
            for (int t = 0; t < 8; ++t) { const int j = r - t; if (j >= 0 && j <= 30) {
#pragma unroll
                for (int p = 0; p < 3; ++p) acc[t][p] += x[p] * w[j][p]; } }
        }
        float mean[8], rstd[8];
#pragma unroll
        for (int t = 0; t < 8; ++t) { const float s = wave_sum(acc[t][0] + acc[t][1] + acc[t][2]); if (F.lane == 0) red[(tb * 4 + wv) * 8 + t] = s; }
        __syncthreads();
#pragma unroll
        for (int t = 0; t < 8; ++t) { const LAS float* rp = red + tb * 32 + t; mean[t] = (rp[0] + rp[8] + rp[16] + rp[24]) * (1.0f / CONV_CH); }
#pragma unroll
        for (int t = 0; t < 8; ++t) { const float d0 = acc[t][0] - mean[t], d1 = acc[t][1] - mean[t], d2 = acc[t][2] - mean[t];
            const float s = wave_sum(d0 * d0 + d1 * d1 + d2 * d2); if (F.lane == 0) red[64 + (tb * 4 + wv) * 8 + t] = s; }
        __syncthreads();
#pragma unroll
        for (int t = 0; t < 8; ++t) { const LAS float* rp = red + 64 + tb * 32 + t; rstd[t] = 1.0f / sqrtf((rp[0] + rp[8] + rp[16] + rp[24]) * (1.0f / CONV_CH) + LN_EPS); }
#pragma unroll
        for (int t = 0; t < 8; ++t)
#pragma unroll
            for (int p = 0; p < 3; ++p) { const float y = (acc[t][p] - mean[t]) * rstd[t] * gg[p] + bb[p]; const float o = y * sigmoidf_(y);
                A2[(size_t)(t0 + tb * 8 + t) * D + p * 256 + L] = (bf16)f2bf(o); }
    }
    __syncthreads();
}

constexpr int KPITCH = 144;
typedef short v4i16_t __attribute__((ext_vector_type(4)));
template <int NT, bool MASK>
__device__ __forceinline__ void attn_wave(const LAS unsigned char* Kl, const LAS unsigned char* Vl, int kt0, bf16x8 bq0, bf16x8 bq1, int lane, int qi, bool first, f32x4 (&o)[4], float& lse) {
    const int r = lane & 15, lg = lane >> 4;
    f32x4 s[NT];
#pragma unroll
    for (int t = 0; t < NT; ++t) {
        const LAS unsigned char* kp = Kl + ((kt0 + t) * 16 + r) * KPITCH + lg * 16;
        const bf16x8 a0 = *(const LAS bf16x8*)kp, a1 = *(const LAS bf16x8*)(kp + 64);
        f32x4 z = (f32x4){0.f, 0.f, 0.f, 0.f};
        z = __builtin_amdgcn_mfma_f32_16x16x32_bf16(a0, bq0, z, 0, 0, 0);
        s[t] = __builtin_amdgcn_mfma_f32_16x16x32_bf16(a1, bq1, z, 0, 0, 0);
    }
    float m = -INFINITY;
#pragma unroll
    for (int t = 0; t < NT; ++t)
#pragma unroll
        for (int j = 0; j < 4; ++j) {
            if (MASK) { const int ki = (kt0 + t) * 16 + 4 * lg + j, dist = qi + 128 - ki; const bool valid = (dist >= 0) && (dist <= 128) && (!first || ki >= 128); s[t][j] = valid ? s[t][j] : -INFINITY; }
            m = fmaxf(m, s[t][j]);
        }
    m = fmaxf(m, __shfl_xor(m, 16)); m = fmaxf(m, __shfl_xor(m, 32));
    const float c = 0.125f * 1.4426950408889634f;
    float sum = 0.f;
#pragma unroll
    for (int t = 0; t < NT; ++t)
#pragma unroll
        for (int j = 0; j < 4; ++j) { const float p = __builtin_amdgcn_exp2f((s[t][j] - m) * c); s[t][j] = p; sum += p; }
    sum += __shfl_xor(sum, 16); sum += __shfl_xor(sum, 32);
#pragma unroll
    for (int et = 0; et < 4; ++et) o[et] = (f32x4){0.f, 0.f, 0.f, 0.f};
    const LAS unsigned char* vbase = Vl + (kt0 * 16 + 4 * lg + ((lane & 15) >> 2)) * KPITCH + (lane & 3) * 8;
#pragma unroll
    for (int kk = 0; kk < NT / 2; ++kk) {
        v4u pw; pw.x = cvt_pk_bf16(s[2 * kk][0], s[2 * kk][1]); pw.y = cvt_pk_bf16(s[2 * kk][2], s[2 * kk][3]);
        pw.z = cvt_pk_bf16(s[2 * kk + 1][0], s[2 * kk + 1][1]); pw.w = cvt_pk_bf16(s[2 * kk + 1][2], s[2 * kk + 1][3]);
        const bf16x8 bp = __builtin_bit_cast(bf16x8, pw);
#pragma unroll
        for (int et = 0; et < 4; ++et) {
            const LAS unsigned char* vp = vbase + (32 * kk) * KPITCH + et * 32;
            const v4i16_t lo = __builtin_amdgcn_ds_read_tr16_b64_v4i16((LAS v4i16_t*)vp);
            const v4i16_t hi = __builtin_amdgcn_ds_read_tr16_b64_v4i16((LAS v4i16_t*)(vp + 16 * KPITCH));
            bf16x8 av; av[0] = lo[0]; av[1] = lo[1]; av[2] = lo[2]; av[3] = lo[3]; av[4] = hi[0]; av[5] = hi[1]; av[6] = hi[2]; av[7] = hi[3];
            o[et] = __builtin_amdgcn_mfma_f32_16x16x32_bf16(av, bp, o[et], 0, 0, 0);
        }
    }
    const float inv = __builtin_amdgcn_rcpf(sum);
#pragma unroll
    for (int et = 0; et < 4; ++et) o[et] = o[et] * inv;
    lse = m * 0.125f + __logf(sum);
}
constexpr int ATT_K_OFF = 0, ATT_V_OFF = 272 * KPITCH;

__device__ __forceinline__ void phase_memattn(Frame& F, const bf16* q, int qp, int qc0, const bf16* memkv, int l, bf16* out, int op, int oc0) {
    LAS unsigned char* Kl = F.lds + ATT_K_OFF; LAS unsigned char* Vl = F.lds + ATT_V_OFF;
    const int r = F.lane & 15, lg = F.lane >> 4;
    for (int u = blockIdx.x; u < 256; u += F.G) {
        const int b = u >> 7, h = (u >> 5) & 3, qc = u & 31;
        __syncthreads();
#pragma unroll
        for (int k = 0; k < 4; ++k) { const int i = F.tid + NTHR * k, ki = i >> 3, c = i & 7;
            const bf16* src = memkv + (size_t)(b * 256 + ki) * 2048 + l * 512 + h * 64 + c * 8;
            const v4u kv = *(const v4u*)src, vv = *(const v4u*)(src + 256);
            *(LAS v4u*)(Kl + ki * KPITCH + c * 16) = kv; *(LAS v4u*)(Vl + ki * KPITCH + c * 16) = vv; }
        bf16x8 nq0, nq1;
        { const bf16* qr = q + (size_t)(b * SEQ + qc * 512 + F.wave * 16 + r) * qp + qc0 + h * 64 + 8 * lg; nq0 = *(const bf16x8*)qr; nq1 = *(const bf16x8*)(qr + 32); }
        __syncthreads();
        for (int pass = 0; pass < 4; ++pass) {
            const int tok = b * SEQ + qc * 512 + pass * 128 + F.wave * 16 + r;
            const bf16x8 bq0 = nq0, bq1 = nq1;
            if (pass < 3) { const bf16* qr = q + (size_t)(tok + 128) * qp + qc0 + h * 64 + 8 * lg; nq0 = *(const bf16x8*)qr; nq1 = *(const bf16x8*)(qr + 32); }
            f32x4 o[4]; float lse;
            attn_wave<16, false>(Kl, Vl, 0, bq0, bq1, F.lane, 0, false, o, lse);
            bf16* orow = out + (size_t)tok * op + oc0 + h * 64 + 4 * lg;
#pragma unroll
            for (int et = 0; et < 4; ++et) { v2u w; w.x = cvt_pk_bf16(o[et][0], o[et][1]); w.y = cvt_pk_bf16(o[et][2], o[et][3]); *(v2u*)(orow + 16 * et) = w; }
        }
    }
    __syncthreads();
}

struct DilUnit { int b, grp, h, d, res, n; };
__device__ __forceinline__ DilUnit dil_unit(int u) {
    DilUnit x; x.b = u / 1536; const int rem = u % 1536; x.grp = rem >> 9; x.h = (rem >> 7) & 3; const int blk = rem & 127;
    const int dsh = 2 * x.grp; x.d = 1 << dsh; const int nblk = SEQ >> (7 + dsh); x.res = blk / nblk; x.n = blk % nblk; return x;
}
__device__ __forceinline__ void phase_dilated(Frame& F, const bf16* q  , const bf16* kv  , bf16* og  , float* lseo  ) {
    LAS unsigned char* Kl = F.lds + ATT_K_OFF; LAS unsigned char* Vl = F.lds + ATT_V_OFF;
    const int r16 = F.lane & 15, lg = F.lane >> 4;
    v4u kr[5], vr[5]; bf16x8 nq0, nq1; int ntok = 0;
#define DIL_PREFETCH(uu) do { const DilUnit x_ = dil_unit(uu); \
        _Pragma("unroll") for (int k_ = 0; k_ < 5; ++k_) { const int i_ = F.tid + NTHR * k_, ki_ = i_ >> 3, c_ = i_ & 7, mk_ = (x_.n - 1) * 128 + ki_; \
            kr[k_] = (v4u){0u, 0u, 0u, 0u}; vr[k_] = (v4u){0u, 0u, 0u, 0u}; \
            if (ki_ < 256 && mk_ >= 0) { const bf16* src_ = kv + (size_t)(x_.b * SEQ + mk_ * x_.d + x_.res) * KVW + x_.grp * 512 + x_.h * 64 + c_ * 8; kr[k_] = *(const v4u*)src_; vr[k_] = *(const v4u*)(src_ + 256); } } \
        ntok = x_.b * SEQ + (x_.n * 128 + F.wave * 16 + r16) * x_.d + x_.res; \
        { const bf16* qr_ = q + (size_t)ntok * D + x_.grp * 256 + x_.h * 64 + 8 * lg; nq0 = *(const bf16x8*)qr_; nq1 = *(const bf16x8*)(qr_ + 32); } } while (0)
    int u = blockIdx.x;
    if (u < 3072) DIL_PREFETCH(u);
    for (; u < 3072; u += F.G) {
        const DilUnit x = dil_unit(u);
        __syncthreads();
#pragma unroll
        for (int k = 0; k < 5; ++k) { const int i = F.tid + NTHR * k, ki = i >> 3, c = i & 7;
            if (ki < 272) { *(LAS v4u*)(Kl + ki * KPITCH + c * 16) = kr[k]; *(LAS v4u*)(Vl + ki * KPITCH + c * 16) = vr[k]; } }
        const bf16x8 bq0 = nq0, bq1 = nq1; const int tok = ntok;
        __syncthreads();
        if (u + F.G < 3072) DIL_PREFETCH(u + F.G);
        f32x4 o[4]; float lse;
        attn_wave<10, true>(Kl, Vl, F.wave, bq0, bq1, F.lane, F.wave * 16 + r16, x.n == 0, o, lse);
        bf16* orow = og + ((size_t)x.grp * T + tok) * 256 + x.h * 64 + 4 * lg;
#pragma unroll
        for (int et = 0; et < 4; ++et) { v2u w; w.x = cvt_pk_bf16(o[et][0], o[et][1]); w.y = cvt_pk_bf16(o[et][2], o[et][3]); *(v2u*)(orow + 16 * et) = w; }
        if (lg == 0) lseo[((size_t)x.grp * T + tok) * 4 + x.h] = lse;
    }
#undef DIL_PREFETCH
    __syncthreads();
}
__device__ __forceinline__ void phase_dil_combine(Frame& F, const bf16* og, const float* lse, bf16* A2b  ) {
    const size_t gt = (size_t)blockIdx.x * NTHR + F.tid, NT_ = (size_t)F.G * NTHR;
    for (size_t i = gt; i < (size_t)T * 32; i += NT_) {
        const int t = (int)(i >> 5), h = (int)((i >> 3) & 3), c8 = (int)(i & 7);
        const float l0 = lse[((size_t)0 * T + t) * 4 + h], l1 = lse[((size_t)1 * T + t) * 4 + h], l2 = lse[((size_t)2 * T + t) * 4 + h];
        const float mx = fmaxf(l0, fmaxf(l1, l2)); float w0 = __expf(l0 - mx), w1 = __expf(l1 - mx), w2 = __expf(l2 - mx); const float inv = 1.0f / (w0 + w1 + w2); w0 *= inv; w1 *= inv; w2 *= inv;
        const v4u a = *(const v4u*)(og + ((size_t)0 * T + t) * 256 + h * 64 + c8 * 8), bq = *(const v4u*)(og + ((size_t)1 * T + t) * 256 + h * 64 + c8 * 8), cq = *(const v4u*)(og + ((size_t)2 * T + t) * 256 + h * 64 + c8 * 8);
        v4u o;
        o.x = pk2(w0 * bflo(a.x) + w1 * bflo(bq.x) + w2 * bflo(cq.x), w0 * bfhi(a.x) + w1 * bfhi(bq.x) + w2 * bfhi(cq.x));
        o.y = pk2(w0 * bflo(a.y) + w1 * bflo(bq.y) + w2 * bflo(cq.y), w0 * bfhi(a.y) + w1 * bfhi(bq.y) + w2 * bfhi(cq.y));
        o.z = pk2(w0 * bflo(a.z) + w1 * bflo(bq.z) + w2 * bflo(cq.z), w0 * bfhi(a.z) + w1 * bfhi(bq.z) + w2 * bfhi(cq.z));
        o.w = pk2(w0 * bflo(a.w) + w1 * bflo(bq.w) + w2 * bflo(cq.w), w0 * bfhi(a.w) + w1 * bfhi(bq.w) + w2 * bfhi(cq.w));
        *(v4u*)(A2b + (size_t)t * 512 + h * 64 + c8 * 8) = o;
    }
}

__device__ __forceinline__ void phase_ln_route(Frame& F, const float* z, const float* g, const float* bt, const float* rwT, const float* rb,
                                               float* x1f, unsigned char* x1q, int* tok_es, float* tok_gate, int* rowtok, float* rowsc, unsigned* cnt_g) {
    LAS float* xt = (LAS float*)F.lds;
    LAS float* part = xt + 16 * 1028;
    LAS int* lcnt = (LAS int*)(F.lds + LDS_RT); LAS int* base = lcnt + 32; LAS int* rec = lcnt + 64;
    LAS float* lsa = (LAS float*)(F.lds + LDS_SA);
    const int r16 = F.lane & 15, kq = F.lane >> 4, w = F.wave;
    f32x4 Wr[2][8];
#pragma unroll
    for (int nt = 0; nt < 2; ++nt)
#pragma unroll
        for (int q = 0; q < 8; ++q) Wr[nt][q] = *(const f32x4*)(rwT + (size_t)(16 * nt + r16) * D + 128 * w + 16 * q + 4 * kq);
    f32x4 g4[4], b4[4];
#pragma unroll
    for (int j = 0; j < 4; ++j) { g4[j] = *(const f32x4*)(g + 4 * F.lane + 256 * j); b4[j] = *(const f32x4*)(bt + 4 * F.lane + 256 * j); }
    const int my_e = F.lane & 31, hh = F.lane >> 5; const float my_rb = rb[my_e];
    for (int chunk = blockIdx.x; chunk < T / 128; chunk += F.G) {
        __syncthreads();
        if (F.tid < 32) lcnt[F.tid] = 0;
        f32x4 zn[2][4];
#pragma unroll
        for (int u = 0; u < 2; ++u)
#pragma unroll
            for (int j = 0; j < 4; ++j) zn[u][j] = *(const f32x4*)(z + (size_t)(chunk * 128 + 2 * w + u) * D + 4 * F.lane + 256 * j);
        for (int rd = 0; rd < 8; ++rd) {
#pragma unroll
            for (int u = 0; u < 2; ++u) {
                const int t = chunk * 128 + rd * 16 + 2 * w + u;
                f32x4 v[4]; float s = 0.f;
#pragma unroll
                for (int j = 0; j < 4; ++j) { v[j] = zn[u][j]; s += (v[j][0] + v[j][1]) + (v[j][2] + v[j][3]); }
                const float mean = wave_sum(s) * (1.0f / D); float s2 = 0.f;
#pragma unroll
                for (int j = 0; j < 4; ++j) { v[j] = v[j] - mean; s2 += (v[j][0] * v[j][0] + v[j][1] * v[j][1]) + (v[j][2] * v[j][2] + v[j][3] * v[j][3]); }
                const float rstd = 1.0f / sqrtf(wave_sum(s2) * (1.0f / D) + LN_EPS);
                float amax = 0.f;
#pragma unroll
                for (int j = 0; j < 4; ++j) { v[j] = v[j] * rstd * g4[j] + b4[j];
                    *(f32x4*)(x1f + (size_t)t * D + 4 * F.lane + 256 * j) = v[j];
                    *(LAS f32x4*)(xt + (2 * w + u) * 1028 + 4 * F.lane + 256 * j) = v[j];
                    amax = fmaxf(amax, fmaxf(fmaxf(fabsf(v[j][0]), fabsf(v[j][1])), fmaxf(fabsf(v[j][2]), fabsf(v[j][3])))); }
#pragma unroll
                for (int o = 1; o < 64; o <<= 1) amax = fmaxf(amax, __shfl_xor(amax, o));
                amax = fmaxf(amax, 1e-30f);
                const float qinv = 127.0f / amax;
                if (F.lane == 0) lsa[rd * 16 + 2 * w + u] = amax * (1.0f / 127.0f);
#pragma unroll
                for (int j = 0; j < 4; ++j) { const int q0 = (int)rintf(v[j][0] * qinv), q1 = (int)rintf(v[j][1] * qinv), q2 = (int)rintf(v[j][2] * qinv), q3 = (int)rintf(v[j][3] * qinv);
                    unsigned pq = (unsigned)(q0 & 255) | ((unsigned)(q1 & 255) << 8) | ((unsigned)(q2 & 255) << 16) | ((unsigned)(q3 & 255) << 24);
#if defined(PROBE_H) && (PROBE_H >= 7)
                    pq = 0x01010101u;
#endif
                    *(unsigned*)(x1q + (size_t)t * D + 4 * F.lane + 256 * j) = pq; }
            }
            if (rd < 7) {
#pragma unroll
                for (int u = 0; u < 2; ++u)
#pragma unroll
                    for (int j = 0; j < 4; ++j) zn[u][j] = *(const f32x4*)(z + (size_t)(chunk * 128 + (rd + 1) * 16 + 2 * w + u) * D + 4 * F.lane + 256 * j);
            }
            __syncthreads();
            f32x4 a0 = (f32x4){0.f, 0.f, 0.f, 0.f}, a1 = (f32x4){0.f, 0.f, 0.f, 0.f};
#pragma unroll
            for (int q = 0; q < 8; ++q) { const f32x4 av = *(const LAS f32x4*)(xt + r16 * 1028 + 128 * w + 16 * q + 4 * kq);
#pragma unroll
                for (int j = 0; j < 4; ++j) { a0 = __builtin_amdgcn_mfma_f32_16x16x4f32(av[j], Wr[0][q][j], a0, 0, 0, 0); a1 = __builtin_amdgcn_mfma_f32_16x16x4f32(av[j], Wr[1][q][j], a1, 0, 0, 0); } }
#pragma unroll
            for (int jj = 0; jj < 4; ++jj) { part[(w * 16 + 4 * kq + jj) * 33 + r16] = a0[jj]; part[(w * 16 + 4 * kq + jj) * 33 + 16 + r16] = a1[jj]; }
            __syncthreads();
            {
                const int tokl = 2 * w + hh, tl = rd * 16 + tokl, t = chunk * 128 + tl;
                float val = my_rb;
#pragma unroll
                for (int ww = 0; ww < 8; ++ww) val += part[(ww * 16 + tokl) * 33 + my_e];
                float tv[4]; int ti[4];
#pragma unroll
                for (int k = 0; k < 4; ++k) { float kv = val; int ki = my_e;
#pragma unroll
                    for (int off = 1; off < 32; off <<= 1) { const float ov = __shfl_xor(kv, off); const int oi = __shfl_xor(ki, off); const bool take = (ov > kv) || (ov == kv && oi < ki); kv = take ? ov : kv; ki = take ? oi : ki; }
                    tv[k] = kv; ti[k] = ki; if (my_e == ki) val = -INFINITY; }
                const float e1 = __expf(tv[1] - tv[0]), e2 = __expf(tv[2] - tv[0]), e3 = __expf(tv[3] - tv[0]); const float inv = 1.0f / (1.0f + e1 + e2 + e3);
                if (my_e < 4) { const int k = my_e; const int ee = (k == 0) ? ti[0] : (k == 1) ? ti[1] : (k == 2) ? ti[2] : ti[3];
                    const float gk = ((k == 0) ? 1.0f : (k == 1) ? e1 : (k == 2) ? e2 : e3) * inv;
                    const int slot = __hip_atomic_fetch_add(lcnt + ee, 1, __ATOMIC_RELAXED, __HIP_MEMORY_SCOPE_WORKGROUP);
                    rec[tl * 4 + k] = ee | (slot << 8); tok_gate[(size_t)t * 4 + k] = gk; }
            }
        }
        __syncthreads();
        if (F.tid < 32) base[F.tid] = (int)__hip_atomic_fetch_add(cnt_g + F.tid, (unsigned)lcnt[F.tid], __ATOMIC_RELAXED, __HIP_MEMORY_SCOPE_AGENT);
        __syncthreads();
        { const int rr = rec[F.tid], e = rr & 255, slot = (rr >> 8) + base[e]; tok_es[(size_t)chunk * 512 + F.tid] = e | (slot << 8); rowtok[(size_t)e * T + slot] = chunk * 128 + (F.tid >> 2); rowsc[(size_t)e * T + slot] = lsa[F.tid >> 2]; }
    }
    __syncthreads();
}

__device__ __forceinline__ int build_tiles(Frame& F, const unsigned* cnt_g) {
    LAS int* tbs = (LAS int*)(F.lds + LDS_TB); LAS int* cl = tbs + 40; LAS int* te = (LAS int*)(F.lds + LDS_TE);
    __syncthreads();
    if (F.tid == 0) { int a = 0; for (int e = 0; e < NEXP; ++e) { const int c = (int)cnt_g[e]; tbs[e] = a; cl[e] = c; a += (c + 255) >> 8; } tbs[NEXP] = a; }
    __syncthreads();
    const int total = tbs[NEXP];
    for (int rt = F.tid; rt < total; rt += NTHR) { int e = 0; for (int k = 1; k < NEXP; ++k) e = (rt >= tbs[k]) ? k : e; te[rt] = e; }
    __syncthreads();
    return total;
}
__device__ __forceinline__ void phase_combine_ln(Frame& F, const unsigned* cnt_g, const float* x1f, const bf16* Y, const int* tok_es, const float* tok_gate, const float* g, const float* bt, float* xout, bf16* xb) {
    (void)build_tiles(F, cnt_g);
    const LAS int* tbs = (const LAS int*)(F.lds + LDS_TB);
    f32x4 g4[4], b4[4];
#pragma unroll
    for (int j = 0; j < 4; ++j) { g4[j] = *(const f32x4*)(g + 4 * F.lane + 256 * j); b4[j] = *(const f32x4*)(bt + 4 * F.lane + 256 * j); }
    for (int t = F.gw; t < T; t += F.NGW) {
        f32x4 v[4];
#pragma unroll
        for (int j = 0; j < 4; ++j) v[j] = *(const f32x4*)(x1f + (size_t)t * D + 4 * F.lane + 256 * j) * DN_ALPHA;
#pragma unroll
        for (int k = 0; k < 4; ++k) { const int es = tok_es[(size_t)t * 4 + k]; const int row = tbs[es & 255] * 256 + (es >> 8); const float gk = tok_gate[(size_t)t * 4 + k];
#pragma unroll
            for (int j = 0; j < 4; ++j) { const v2u w = *(const v2u*)(Y + (size_t)row * D + 4 * F.lane + 256 * j);
                v[j][0] += gk * bflo(w.x); v[j][1] += gk * bfhi(w.x); v[j][2] += gk * bflo(w.y); v[j][3] += gk * bfhi(w.y); } }
        float s = 0.f;
#pragma unroll
        for (int j = 0; j < 4; ++j) s += (v[j][0] + v[j][1]) + (v[j][2] + v[j][3]);
        const float mean = wave_sum(s) * (1.0f / D); float s2 = 0.f;
#pragma unroll
        for (int j = 0; j < 4; ++j) { v[j] = v[j] - mean; s2 += (v[j][0] * v[j][0] + v[j][1] * v[j][1]) + (v[j][2] * v[j][2] + v[j][3] * v[j][3]); }
        const float rstd = 1.0f / sqrtf(wave_sum(s2) * (1.0f / D) + LN_EPS);
#pragma unroll
        for (int j = 0; j < 4; ++j) { v[j] = v[j] * rstd * g4[j] + b4[j];
#if defined(PROBE_CLK) || defined(PROBE_I8) || defined(PROBE_H)
            { const float dv = ((const float*)cnt_g)[256 - 96]; if (dv != 0.f) v[j] = (f32x4){dv, dv, dv, dv}; }
#endif
            *(f32x4*)(xout + (size_t)t * D + 4 * F.lane + 256 * j) = v[j];
            v2u w; w.x = pk2(v[j][0], v[j][1]); w.y = pk2(v[j][2], v[j][3]); *(v2u*)(xb + (size_t)t * D + 4 * F.lane + 256 * j) = w; }
    }
}
#ifndef REP_P0
#define REP_P0 1
#endif
#ifndef REP_A1
#define REP_A1 1
#endif
#ifndef REP_MKV
#define REP_MKV 1
#endif
#ifndef REP_CONV
#define REP_CONV 1
#endif
#ifndef REP_MATT
#define REP_MATT 1
#endif
#ifndef REP_A3
#define REP_A3 1
#endif
#ifndef REP_B1
#define REP_B1 1
#endif
#ifndef REP_B1KV
#define REP_B1KV 1
#endif
#ifndef REP_DIL
#define REP_DIL 1
#endif
#ifndef REP_DILC
#define REP_DILC 1
#endif
#ifndef REP_B4
#define REP_B4 1
#endif
#ifndef REP_M2
#define REP_M2 1
#endif
#ifndef REP_M3
#define REP_M3 1
#endif
#ifndef REP_M4
#define REP_M4 1
#endif
#ifndef REP_M5
#define REP_M5 1
#endif
#ifndef EN_ALL
#define EN_ALL 1
#endif
#ifndef EN_P0
#define EN_P0 EN_ALL
#endif
#ifndef EN_A1
#define EN_A1 EN_ALL
#endif
#ifndef EN_MKV
#define EN_MKV EN_ALL
#endif
#ifndef EN_CONV
#define EN_CONV EN_ALL
#endif
#ifndef EN_MATT
#define EN_MATT EN_ALL
#endif
#ifndef EN_A3
#define EN_A3 EN_ALL
#endif
#ifndef EN_B1
#define EN_B1 EN_ALL
#endif
#ifndef EN_B1KV
#define EN_B1KV EN_ALL
#endif
#ifndef EN_DIL
#define EN_DIL EN_ALL
#endif
#ifndef EN_DILC
#define EN_DILC EN_ALL
#endif
#ifndef EN_B4
#define EN_B4 EN_ALL
#endif
#ifndef EN_M1
#define EN_M1 EN_ALL
#endif
#ifndef EN_M2
#define EN_M2 EN_ALL
#endif
#ifndef EN_M3
#define EN_M3 EN_ALL
#endif
#ifndef EN_M4
#define EN_M4 EN_ALL
#endif
#ifndef EN_M5
#define EN_M5 EN_ALL
#endif

#ifndef MK_N_LAUNCHES
#define MK_N_LAUNCHES 1
#endif
constexpr int NPHASE = 1 + 2 * 7 + 2 * 8;
struct Args { const void* in[24]; float* out; unsigned char* ws; int ph_lo, ph_hi; };
static_assert(sizeof(Args) == 24 * 8 + 8 + 8 + 8, "Args has no padding");

__global__ void __launch_bounds__(NTHR, 2) fwd(Args args) {
    extern __shared__ __attribute__((aligned(16))) unsigned char lds_raw[];
    LAS unsigned char* const ldsb = (LAS unsigned char*)lds_raw;
    if (threadIdx.x < 16) ((LAS unsigned*)(ldsb + LDS_MISC))[threadIdx.x] = 0u;
    if (threadIdx.x == 0) {
        LAS unsigned long long* pt = (LAS unsigned long long*)(ldsb + LDS_PTR);
#pragma unroll
        for (int i = 0; i < 24; ++i) pt[i] = (unsigned long long)args.in[i];
        pt[24] = (unsigned long long)args.ws; pt[25] = (unsigned long long)args.out;
    }
    __syncthreads();
    const int lo = args.ph_lo, hi = args.ph_hi;
    const bool use_bar = (hi - lo) > 1;
    unsigned xcc = 0;
    if (use_bar) { const XcdBarrier b0 = xcd_barrier_post((unsigned*)(args.ws + WS_CTL) + CW_BAR, (volatile LAS unsigned*)(ldsb + LDS_MISC)); xcc = b0.x; }
#define IN(k) (lo <= (k) && (k) < hi)
#define FRAME() Frame F; { int t_ = threadIdx.x; asm volatile("" : "+v"(t_)); F.lds = ldsb; F.tid = t_; F.lane = t_ & 63; F.wave = __builtin_amdgcn_readfirstlane(t_ >> 6); \
                           F.G = gridDim.x; F.gw = blockIdx.x * NWAVES + F.wave; F.NGW = F.G * NWAVES; } unsigned char* ws = wsp(F); (void)ws
#define SEAM(k) do { if (IN(k) && IN((k) + 1)) { asm volatile("" ::: "memory"); Frame Fb; Fb.lds = ldsb; XcdBarrier b_; b_.bar = (unsigned*)(wsp(Fb) + WS_CTL) + CW_BAR; b_.x = xcc; b_.st = (volatile LAS unsigned*)(ldsb + LDS_MISC); xcd_barrier(b_); } } while (0)
#define WSB(T_, off) ((T_*)(ws + (off)))

    if (EN_P0 && IN(0)) { for (int rep_ = 0; rep_ < REP_P0; ++rep_) { FRAME(); phase_prologue(F); } }
    SEAM(0);

    for (int l = 0; l < 4; ++l) {
        const int pb = (l < 2) ? 1 + 7 * l : 15 + 8 * (l - 2);
        int pm;
        if (l < 2) {
            if (IN(pb + 0)) {
                for (int rep_ = 0; rep_ < REP_A1; ++rep_) if (EN_A1) { FRAME();
                  pg8::Gemm g{WSB(bf16, WS_XB), WSB(const bf16, WS_WIN) + (size_t)l * AIN * D, T, AIN, D}; pg8::StaticOrder S; S.init(T, AIN, F.G, (int)blockIdx.x);
                  EpiGluQ E{WSB(bf16, WS_HGLU), WSB(bf16, WS_QM), inp(F, 4) + (size_t)l * AIN};
                  pg8::gemm_phase<EpiGluQ, pg8::StaticOrder, true, true>(F.lds, g, S, E); }
                for (int rep_ = 0; rep_ < REP_MKV; ++rep_) if (EN_MKV && l == 0) { FRAME();
                  pg8::Gemm g{WSB(bf16, WS_MEMB), WSB(const bf16, WS_WMEM), 512, 2048, D}; pg8::StaticOrder S; S.init(512, 2048, F.G, (int)blockIdx.x);
                  EpiRot<2> E{WSB(bf16, WS_MEMKV), 2048, nullptr};
                  pg8::gemm_phase<EpiRot<2>, pg8::StaticOrder, true, true>(F.lds, g, S, E); }
            }
            SEAM(pb + 0);
            if (IN(pb + 1)) {
                for (int rep_ = 0; rep_ < REP_CONV; ++rep_) if (EN_CONV) { FRAME();
                  phase_conv(F, WSB(const bf16, WS_HGLU), inp(F, 5) + (size_t)l * CONV_W * CONV_CH, inp(F, 6) + (size_t)l * CONV_CH, inp(F, 7) + (size_t)l * CONV_CH, inp(F, 8) + (size_t)l * CONV_CH, WSB(bf16, WS_A2)); }
                for (int rep_ = 0; rep_ < REP_MATT; ++rep_) if (EN_MATT) { FRAME(); phase_memattn(F, WSB(const bf16, WS_QM), 256, 0, WSB(const bf16, WS_MEMKV), l, WSB(bf16, WS_A2), D, 768); }
            }
            SEAM(pb + 1);
            for (int rep_ = 0; rep_ < REP_A3; ++rep_) if (EN_A3 && IN(pb + 2)) { FRAME();
                pg8::Gemm g{WSB(bf16, WS_A2), WSB(const bf16, WS_WOA) + (size_t)l * D * D, T, D, D}; pg8::StaticOrder S; S.init(T, D, F.G, (int)blockIdx.x);
                EpiRes E{WSB(float, WS_Z), (l == 0) ? inp(F, 0) : WSB(const float, WS_XR2), inp(F, 10) + (size_t)l * D};
                pg8::gemm_phase<EpiRes, pg8::StaticOrder, true, true>(F.lds, g, S, E);
            }
            SEAM(pb + 2);
            pm = pb + 3;
        } else {
            const int j = l - 2;
            if (IN(pb + 0)) {
                for (int rep_ = 0; rep_ < REP_B1; ++rep_) if (EN_B1) { FRAME();
                  pg8::Gemm g{WSB(bf16, WS_XB), WSB(const bf16, WS_WQ) + (size_t)j * D * D, T, D, D}; pg8::StaticOrder S; S.init(T, D, F.G, (int)blockIdx.x);
                  EpiRot<0> E{WSB(bf16, WS_QB), D, WSB(const float, WS_ROT)};
                  pg8::gemm_phase<EpiRot<0>, pg8::StaticOrder, true, true>(F.lds, g, S, E); }
                for (int rep_ = 0; rep_ < REP_B1KV; ++rep_) if (EN_B1KV && j == 0) { FRAME();
                  pg8::Gemm g{WSB(bf16, WS_XB), WSB(const bf16, WS_WKV), T, KVW, D}; pg8::StaticOrder S; S.init(T, KVW, F.G, (int)blockIdx.x);
                  EpiRot<1> E{WSB(bf16, WS_KVB), KVW, WSB(const float, WS_ROT)};
                  pg8::gemm_phase<EpiRot<1>, pg8::StaticOrder, true, true>(F.lds, g, S, E); }
            }
            SEAM(pb + 0);
            if (IN(pb + 1)) {
                for (int rep_ = 0; rep_ < REP_DIL; ++rep_) if (EN_DIL) { FRAME(); phase_dilated(F, WSB(const bf16, WS_QB), WSB(const bf16, WS_KVB), WSB(bf16, WS_OG), WSB(float, WS_LSE)); }
                for (int rep_ = 0; rep_ < REP_MATT; ++rep_) if (EN_MATT) { FRAME(); phase_memattn(F, WSB(const bf16, WS_QB), D, 768, WSB(const bf16, WS_MEMKV), l, WSB(bf16, WS_A2), 512, 256); }
            }
            SEAM(pb + 1);
            for (int rep_ = 0; rep_ < REP_DILC; ++rep_) if (EN_DILC && IN(pb + 2)) { FRAME(); phase_dil_combine(F, WSB(const bf16, WS_OG), WSB(const float, WS_LSE), WSB(bf16, WS_A2)); }
            SEAM(pb + 2);
            for (int rep_ = 0; rep_ < REP_B4; ++rep_) if (EN_B4 && IN(pb + 3)) { FRAME();
                pg8::Gemm g{WSB(bf16, WS_A2), WSB(const bf16, WS_WOB) + (size_t)j * D * 512, T, D, 512}; pg8::StaticOrder S; S.init(T, D, F.G, (int)blockIdx.x);
                EpiRes E{WSB(float, WS_Z), WSB(const float, WS_XR2), inp(F, 14) + (size_t)j * D};
                pg8::gemm_phase<EpiRes, pg8::StaticOrder, true, true>(F.lds, g, S, E);
            }
            SEAM(pb + 3);
            pm = pb + 4;
        }
        if (EN_M1 && IN(pm + 0)) { FRAME();
            phase_ln_route(F, WSB(const float, WS_Z), inp(F, 16) + (size_t)(l * 2 + 0) * D, inp(F, 17) + (size_t)(l * 2 + 0) * D, WSB(const float, WS_RWT) + (size_t)l * NEXP * D, inp(F, 19) + (size_t)l * NEXP,
                           WSB(float, WS_XR1), WSB(unsigned char, WS_X1B), WSB(int, WS_TES), WSB(float, WS_TGATE), WSB(int, WS_RTOK), WSB(float, WS_RSC), WSB(unsigned, WS_CTL) + CW_CNT + 32 * l);
        }
        SEAM(pm + 0);
        for (int rep_ = 0; rep_ < REP_M3; ++rep_) if (EN_M3 && IN(pm + 1)) { FRAME();
#if defined(PROBE_CLK)
            long long c0_ = clock64(), w0_ = wall_clock64();
#endif
            const int total = build_tiles(F, WSB(const unsigned, WS_CTL) + CW_CNT + 32 * l);
            pg8::Gemm g{WSB(bf16, WS_X1B), (const bf16*)(WSB(const unsigned char, WS_WUP) + (size_t)l * NEXP * 2 * DFF * D), XROWS, NEXP * 2 * DFF, D / 2};
            MoeOrder<8> S{(const LAS int*)(F.lds + LDS_TE), (const LAS int*)(F.lds + LDS_TB), (const LAS int*)(F.lds + LDS_TB) + 40, WSB(const int, WS_RTOK), total, F.G, (int)blockIdx.x};
            EpiSwigluI8 E{WSB(bf16, WS_H), inp(F, 21) + (size_t)l * NEXP * 2 * DFF, WSB(const float, WS_SBW) + (size_t)l * NEXP * 2 * DFF, WSB(const float, WS_RSC), (const LAS int*)(F.lds + LDS_TB)};
            pg8::gemm_phase_g<EpiSwigluI8, MoeOrder<8>, true>(F.lds, g, S, E);
#if defined(PROBE_CLK)
            if (l == 3 && blockIdx.x == 0 && threadIdx.x == 0) { const long long c1_ = clock64(), w1_ = wall_clock64(); WSB(float, WS_CTL)[CW_CNT + 256] = (float)(c1_ - c0_) / (float)(w1_ - w0_); }
#endif
        }
        SEAM(pm + 1);
        for (int rep_ = 0; rep_ < REP_M4; ++rep_) if (EN_M4 && IN(pm + 2)) { FRAME();
            const int total = build_tiles(F, WSB(const unsigned, WS_CTL) + CW_CNT + 32 * l);
#if defined(PROBE_H)
            if (l == 0) { __syncthreads(); asm volatile("s_waitcnt vmcnt(0)" ::: "memory");
              if (blockIdx.x == 0 && F.wave == 0) {
                const LAS int* tb_ = (const LAS int*)(F.lds + LDS_TB);
                const int tok_ = 1000 + (F.lane >> 3), c_ = ((F.lane & 7) * 137 + 5) & 1023;
                const int es_ = WSB(const int, WS_TES)[(size_t)tok_ * 4]; const int e_ = es_ & 255; const int r_ = tb_[e_] * 256 + (es_ >> 8);
                const float* x_ = WSB(const float, WS_XR1) + (size_t)tok_ * D; const float* wu_ = inp(F, 20) + (size_t)e_ * D * 2 * DFF; const float* bu_ = inp(F, 21) + (size_t)e_ * 2 * DFF;
                float g_ = bu_[c_], li_ = bu_[1024 + c_];
#if PROBE_H == 2
                { const signed char* xq_ = (const signed char*)WSB(const unsigned char, WS_X1B) + (size_t)tok_ * D; const int ng_ = (c_ >> 7) * 256 + (c_ & 127), nl_ = ng_ + 128;
                  const signed char* wg_ = (const signed char*)WSB(const unsigned char, WS_WUP) + ((size_t)e_ * 2048 + ng_) * D; const signed char* wl_ = (const signed char*)WSB(const unsigned char, WS_WUP) + ((size_t)e_ * 2048 + nl_) * D;
                  int ag_ = 0, al_ = 0; for (int k = 0; k < D; ++k) { ag_ += (int)xq_[k] * (int)wg_[k]; al_ += (int)xq_[k] * (int)wl_[k]; }
                  const float sa_ = WSB(const float, WS_RSC)[(size_t)e_ * T + (es_ >> 8)]; const float* sb_ = WSB(const float, WS_SBW) + (size_t)e_ * 2048;
                  g_ += (float)ag_ * sa_ * sb_[ng_]; li_ += (float)al_ * sa_ * sb_[nl_]; (void)x_; (void)wu_; }
#else
                for (int k = 0; k < D; ++k) { const float xv = x_[k]; g_ += xv * wu_[(size_t)k * 2048 + c_]; li_ += xv * wu_[(size_t)k * 2048 + 1024 + c_]; }
#endif
                const float gg = fminf(g_, 7.0f), ll = fminf(fmaxf(li_, -7.0f), 7.0f); float href = gg * (1.0f / (1.0f + __expf(-1.702f * gg))) * (ll + 1.0f);
#if PROBE_H == 3 || PROBE_H == 8
                { const signed char* xq_ = (const signed char*)WSB(const unsigned char, WS_X1B) + (size_t)tok_ * D; const int ng_ = (c_ >> 7) * 256 + (c_ & 127);
                  const signed char* wg_ = (const signed char*)WSB(const unsigned char, WS_WUP) + ((size_t)e_ * 2048 + ng_) * D;
                  int ag_ = 0; for (int k = 0; k < D; ++k) ag_ += (int)xq_[k] * (int)wg_[k]; href = (float)ag_; }
#endif
                const float hgot = bflo((unsigned)WSB(const bf16, WS_H)[(size_t)r_ * DFF + c_]);
                float df = fabsf(href - hgot);
#if PROBE_H == 9 || PROBE_H == 10
                { const int ng_ = (c_ >> 7) * 256 + (c_ & 127); const int expv = (PROBE_H == 9) ? (ng_ & 127) : (ng_ >> 4); const int gotv = (int)(hgot * (1.0f / 1024.0f) + 0.5f);
                  int dl = (gotv ^ expv) & 127; int dor = dl;
#pragma unroll
                  for (int o = 1; o < 64; o <<= 1) { dor |= __shfl_xor(dor, o); }
#if defined(PROBE_S)
                  if (F.lane == PROBE_S) WSB(float, WS_CTL)[CW_CNT + 256] = 1.0f + (float)((gotv & 3) * 4 + (expv & 3)); (void)dor; }
#else
                  if (F.lane == 0) WSB(float, WS_CTL)[CW_CNT + 256] = 1.0f + (float)dor; }
#endif
#endif
#if PROBE_H == 7
                { float hm = hgot;
#pragma unroll
                  for (int o = 1; o < 64; o <<= 1) hm = fmaxf(hm, __shfl_xor(hm, o));
                  float hn = hgot;
#pragma unroll
                  for (int o = 1; o < 64; o <<= 1) hn = fminf(hn, __shfl_xor(hn, o));
                  if (F.lane == 0) WSB(float, WS_CTL)[CW_CNT + 256] = 1.0f + hm * (1.0f / 128.0f) + ((hn != hm) ? 0.5f : 0.0f); }
#endif
#if PROBE_H == 5
                { const signed char* xq_ = (const signed char*)WSB(const unsigned char, WS_X1B) + (size_t)tok_ * D; const float sa_ = WSB(const float, WS_RSC)[(size_t)e_ * T + (es_ >> 8)];
                  df = 0.f; for (int k = 0; k < D; ++k) df = fmaxf(df, fabsf((float)xq_[k] * sa_ - x_[k])); df *= 10.0f; }
#endif
#if PROBE_H == 6
                { const int ng_ = (c_ >> 7) * 256 + (c_ & 127); const signed char* wg_ = (const signed char*)WSB(const unsigned char, WS_WUP) + ((size_t)e_ * 2048 + ng_) * D; const float sb_ = WSB(const float, WS_SBW)[(size_t)e_ * 2048 + ng_];
                  df = 0.f; for (int k = 0; k < D; ++k) df = fmaxf(df, fabsf((float)wg_[k] * sb_ - wu_[(size_t)k * 2048 + c_])); df *= 1000.0f; }
#endif
#if PROBE_H == 3 || PROBE_H == 8
                df = df / (fabsf(href) + 100.0f) * 10.0f;
#endif
#pragma unroll
                for (int o = 1; o < 64; o <<= 1) df = fmaxf(df, __shfl_xor(df, o));
                if (PROBE_H < 7 && F.lane == 0) WSB(float, WS_CTL)[CW_CNT + 256] = (df < 0.15f) ? 2.0f : (df < 0.5f) ? 3.0f : (df < 2.0f) ? 4.0f : (df < 10.0f) ? 5.0f : 6.0f;
              } }
#endif
            pg8::Gemm g{WSB(bf16, WS_H), WSB(const bf16, WS_WDN) + (size_t)l * NEXP * DFF * D, XROWS, NEXP * D, DFF};
            MoeOrder<4> S{(const LAS int*)(F.lds + LDS_TE), (const LAS int*)(F.lds + LDS_TB), (const LAS int*)(F.lds + LDS_TB) + 40, WSB(const int, WS_RTOK), total, F.G, (int)blockIdx.x};
            EpiDown E{WSB(bf16, WS_Y), inp(F, 23) + (size_t)l * NEXP * D};
            pg8::gemm_phase<EpiDown, MoeOrder<4>, true, true>(F.lds, g, S, E);
        }
        SEAM(pm + 2);
        for (int rep_ = 0; rep_ < REP_M5; ++rep_) if (EN_M5 && IN(pm + 3)) { FRAME();
            phase_combine_ln(F, WSB(const unsigned, WS_CTL) + CW_CNT + 32 * l, WSB(const float, WS_XR1), WSB(const bf16, WS_Y), WSB(const int, WS_TES), WSB(const float, WS_TGATE), inp(F, 16) + (size_t)(l * 2 + 1) * D, inp(F, 17) + (size_t)(l * 2 + 1) * D,
                             (l == 3) ? (float*)ptr_slot(F, 25) : WSB(float, WS_XR2), WSB(bf16, WS_XB));
        }
        if (l < 3) SEAM(pm + 3);
    }
#undef IN
#undef SEAM
#undef WSB
#undef FRAME
}

extern "C" void kernel_launch(void* const* d_in, const int* in_sizes, int n_in, void* d_out, int out_size, void* d_ws, size_t ws_size, hipStream_t stream) {
    static int grid = 0;
    if (grid == 0) {
        if (n_in != 24 || in_sizes[0] != T * D || out_size != T * D || ws_size < WS_END) {
            fprintf(stderr, "kernel_launch: unexpected shapes (n_in %d, in0 %d, out %d, ws %zu < %zu); nothing launched\n", n_in, n_in > 0 ? in_sizes[0] : -1, out_size, ws_size, (size_t)WS_END); grid = -1; return; }
        if (hipFuncSetAttribute((const void*)fwd, hipFuncAttributeMaxDynamicSharedMemorySize, LDS_BYTES) != hipSuccess) { fprintf(stderr, "kernel_launch: hipFuncSetAttribute failed\n"); grid = -1; return; }
        int per_cu = 0;
        if (hipOccupancyMaxActiveBlocksPerMultiprocessor(&per_cu, (const void*)fwd, NTHR, LDS_BYTES) != hipSuccess || per_cu < 1) fprintf(stderr, "kernel_launch: note: occupancy query says %d\n", per_cu);
        (void)hipGetLastError();
        grid = 256;
    }
    if (grid < 0) return;
    (void)hipMemsetAsync((char*)d_ws + WS_CTL, 0, CTL_ZERO_BYTES, stream);
    Args a{};
    for (int i = 0; i < 24; ++i) a.in[i] = d_in[i];
    a.out = (float*)d_out; a.ws = (unsigned char*)d_ws;
#if MK_N_LAUNCHES == 1
    a.ph_lo = 0; a.ph_hi = NPHASE;
    hipLaunchKernelGGL(fwd, dim3(grid), dim3(NTHR), LDS_BYTES, stream, a);
#else
    for (int k = 0; k < NPHASE; ++k) { a.ph_lo = k; a.ph_hi = k + 1; hipLaunchKernelGGL(fwd, dim3(grid), dim3(NTHR), LDS_BYTES, stream, a); }
#endif
}
```

```cpp
#define MK_N_LAUNCHES 1
#include <hip/hip_runtime.h>
#include <cstdio>
#include <cstdint>
namespace pg8 {
#define PG8_LAS __attribute__((address_space(3)))
typedef unsigned short bf16_t;
typedef short bf16x8 __attribute__((ext_vector_type(8)));
typedef float f32x4 __attribute__((ext_vector_type(4)));
typedef unsigned u32x4 __attribute__((ext_vector_type(4)));
constexpr int BM = 256, BK = 64, HALF = 128, HTB = HALF * BK * 2  , STAGE_BYTES = 8 * HTB, NXCD = 8, WGM = 8;

__host__ __device__ __forceinline__ int lds_byte(int r, int c) { const int st = (r >> 4) * 2 + (c >> 5), rr = r & 15, cc = c & 31, ob = rr * 64 + cc * 2; return st * 1024 + (ob ^ (((ob >> 9) & 1) << 5)); }
__host__ __device__ __forceinline__ void stage_rc(int b, int& R, int& C) { const int st = b / 1024, sb = b % 1024, swz = sb ^ (((sb >> 9) & 1) << 5); R = (st >> 1) * 16 + swz / 64; C = (st & 1) * 32 + (swz % 64) / 2; }
__host__ __device__ __forceinline__ int perm32(int rho) { const int n = rho >> 4, i = rho & 15; return 8 * (i >> 2) + 4 * n + (i & 3); }

struct Unit { int pm, pn; };
struct Gemm { const bf16_t* A; const bf16_t* Bt; int M, N, K; };

struct StaticOrder {
    int nM, nN, nwg, G, c;
    __host__ __device__ void init(int M, int N, int G_, int c_) { nM = M / BM; nN = N / BM; nwg = nM * nN; G = G_; c = c_; }
    __host__ __device__ bool next(int i, Unit& u) const {
        const long L = (long)i * G + c; if (L >= nwg) return false;
        int wgid = (int)L; { const int q = nwg / NXCD, r = nwg % NXCD, xcd = wgid % NXCD, off = wgid / NXCD; wgid = (xcd < r ? xcd * (q + 1) : r * (q + 1) + (xcd - r) * q) + off; }
        const int nig = WGM * nN, gid = wgid / nig, fm = gid * WGM, gsz = (nM - fm) < WGM ? (nM - fm) : WGM;
        u.pm = fm + ((wgid % nig) % gsz); u.pn = (wgid % nig) / gsz; return true;
    }
    __device__ __forceinline__ void a_ready(const Unit&) const {}
    __device__ __forceinline__ void done(const Unit&) const {}
};

__device__ __forceinline__ unsigned cvt_pk_bf16(float lo, float hi) { unsigned r; asm volatile("v_cvt_pk_bf16_f32 %0, %1, %2" : "=v"(r) : "v"(lo), "v"(hi)); return r; }
typedef float f32x2 __attribute__((ext_vector_type(2)));
typedef int i32x4 __attribute__((ext_vector_type(4)));
template <class Epi, class Sched, bool ALIGN_EPI = false, bool SP2 = false, bool I8 = false>
__device__ __forceinline__ void gemm_phase(PG8_LAS unsigned char* lds, const Gemm g, const Sched& S, const Epi& E) {
    int tid_ = threadIdx.x; asm volatile("" : "+v"(tid_));
    const int tid = tid_, wid = __builtin_amdgcn_readfirstlane(tid >> 6), lane = tid & 63, wr = wid >> 2, wc = wid & 3, fr = lane & 15, fq = lane >> 4;
    const int K = g.K, nt = K / BK;
#if defined(STAGGER_TICKS)
    { const unsigned dl = ((blockIdx.x >> 3) & 3u) * (unsigned)(STAGGER_TICKS); const unsigned long long t0_ = __builtin_amdgcn_s_memrealtime(); while ((unsigned)(__builtin_amdgcn_s_memrealtime() - t0_) < dl) __builtin_amdgcn_s_sleep(4); }
#endif
    unsigned voffA[2], voffB[2];
#pragma unroll
    for (int i = 0; i < 2; ++i) { int R, C; stage_rc(tid * 16 + i * 8192, R, C); const int Rb = Epi::PERM ? ((R & ~31) + perm32(R & 31)) : R;
        voffA[i] = (unsigned)(R * K + C) * 2u; voffB[i] = (unsigned)(Rb * K + C) * 2u; }
    const size_t kstep = (size_t)(BK * 2);
    const size_t hstep = (size_t)HALF * K * 2;
    const size_t tstep = 2 * hstep;
    const unsigned ldsw = (unsigned)wid * 1024u;
    const int aoff = lds_byte(wr * 64 + fr, fq * 8), boff = lds_byte(wc * 32 + fr, fq * 8);
#define PG8_SA(b, h) (((b) * 2 + (h)) * HTB)
#define PG8_SB(b, h) ((4 + (b) * 2 + (h)) * HTB)
#define PG8_STAGE(bufoff, gbase, voff) do { _Pragma("unroll") for (int _i = 0; _i < 2; ++_i) \
        __builtin_amdgcn_global_load_lds((const unsigned*)((const char*)(gbase) + (voff)[_i]), (PG8_LAS unsigned*)(lds + (bufoff) + ldsw + _i * 8192), 16, 0, 0); } while (0)
#define PG8_LDA(dst, b, h) do { _Pragma("unroll") for (int m = 0; m < 4; ++m) _Pragma("unroll") for (int k = 0; k < 2; ++k) dst[m][k] = *(const PG8_LAS bf16x8*)(lds + PG8_SA(b, h) + aoff + m * 2048 + k * 1024); } while (0)
#define PG8_LDB(dst, b, h) do { _Pragma("unroll") for (int n = 0; n < 2; ++n) _Pragma("unroll") for (int k = 0; k < 2; ++k) dst[n][k] = *(const PG8_LAS bf16x8*)(lds + PG8_SB(b, h) + boff + n * 2048 + k * 1024); } while (0)
#define PG8_MMA(ai, bj, At, Bt) do { __builtin_amdgcn_s_setprio(1); _Pragma("unroll") for (int m = 0; m < 4; ++m) _Pragma("unroll") for (int n = 0; n < 2; ++n) _Pragma("unroll") for (int k = 0; k < 2; ++k) \
        { if constexpr (I8) acc[ai][bj][m][n] = __builtin_bit_cast(f32x4, __builtin_amdgcn_mfma_i32_16x16x64_i8(__builtin_bit_cast(i32x4, Bt[n][k]), __builtin_bit_cast(i32x4, At[m][k]), __builtin_bit_cast(i32x4, acc[ai][bj][m][n]), 0, 0, 0)); \
          else acc[ai][bj][m][n] = __builtin_amdgcn_mfma_f32_16x16x32_bf16(Bt[n][k], At[m][k], acc[ai][bj][m][n], 0, 0, 0); } __builtin_amdgcn_s_setprio(0); } while (0)
#define PG8_WAIT_V(n) asm volatile("s_waitcnt vmcnt(" #n ")" ::: "memory")
#define PG8_WAIT_L(n) asm volatile("s_waitcnt lgkmcnt(" #n ")" ::: "memory")
#define PG8_BAR __builtin_amdgcn_s_barrier()
#define PG8_SCHED __builtin_amdgcn_sched_barrier(0)
    Unit cur, nxt; int ui = 0;
    if (!S.next(0, cur)) return;
    f32x4 acc[2][2][4][2];
#pragma unroll
    for (int a = 0; a < 2; ++a)
#pragma unroll
        for (int b = 0; b < 2; ++b)
#pragma unroll
            for (int m = 0; m < 4; ++m)
#pragma unroll
                for (int n = 0; n < 2; ++n) acc[a][b][m][n] = (f32x4){0.f, 0.f, 0.f, 0.f};
    bf16x8 At[4][2], B0[2][2], B1[2][2];
    const char* cA = (const char*)g.A + (size_t)cur.pm * tstep; const char* cB = (const char*)g.Bt + (size_t)cur.pn * tstep;
    S.a_ready(cur);
    if constexpr (SP2) {
        PG8_STAGE(PG8_SB(0, 0), cB, voffB); PG8_STAGE(PG8_SB(0, 1), cB + hstep, voffB); PG8_STAGE(PG8_SA(0, 0), cA, voffA); PG8_STAGE(PG8_SA(0, 1), cA + hstep, voffA);
        if (wr == 1) PG8_BAR;
        PG8_WAIT_V(2); PG8_BAR;
        PG8_STAGE(PG8_SB(1, 0), cB + kstep, voffB); PG8_STAGE(PG8_SA(1, 0), cA + kstep, voffA); PG8_STAGE(PG8_SB(1, 1), cB + hstep + kstep, voffB);
        PG8_WAIT_V(6); PG8_BAR;
    } else {
        PG8_STAGE(PG8_SB(0, 0), cB, voffB); PG8_STAGE(PG8_SA(0, 0), cA, voffA); PG8_STAGE(PG8_SB(0, 1), cB + hstep, voffB); PG8_STAGE(PG8_SA(0, 1), cA + hstep, voffA);
        if (wr == 1) PG8_BAR;
        PG8_WAIT_V(4); PG8_BAR;
        PG8_STAGE(PG8_SB(1, 0), cB + kstep, voffB); PG8_STAGE(PG8_SA(1, 0), cA + kstep, voffA); PG8_STAGE(PG8_SB(1, 1), cB + hstep + kstep, voffB);
        PG8_WAIT_V(6); PG8_BAR;
    }
    for (;;) {
        const bool has_next = S.next(ui + 1, nxt);
        const char* nA = has_next ? (const char*)g.A + (size_t)nxt.pm * tstep : cA; const char* nB = has_next ? (const char*)g.Bt + (size_t)nxt.pn * tstep : cB;
        for (int t = 0; t < nt; t += 2) {
            const bool last = (t == nt - 2);
            const char* a1 = cA + (size_t)(t + 1) * kstep;
            const char* a2 = last ? nA : cA + (size_t)(t + 2) * kstep; const char* b2 = last ? nB : cB + (size_t)(t + 2) * kstep;
            const char* a3 = a2 + kstep; const char* b3 = b2 + kstep;
            if (last && has_next) S.a_ready(nxt);
            if constexpr (SP2) {
            PG8_LDB(B0, 0, 0); PG8_LDB(B1, 0, 1); PG8_SCHED; PG8_LDA(At, 0, 0); PG8_STAGE(PG8_SA(1, 1), a1 + hstep, voffA);
            PG8_WAIT_V(8); PG8_WAIT_L(0); PG8_BAR; PG8_MMA(0, 0, At, B0); PG8_MMA(0, 1, At, B1); PG8_BAR; PG8_SCHED;
            PG8_LDA(At, 0, 1); PG8_STAGE(PG8_SB(0, 0), b2, voffB); PG8_STAGE(PG8_SB(0, 1), b2 + hstep, voffB); PG8_STAGE(PG8_SA(0, 0), a2, voffA);
            PG8_WAIT_V(8); PG8_WAIT_L(0); PG8_BAR; PG8_MMA(1, 0, At, B0); PG8_MMA(1, 1, At, B1); PG8_BAR; PG8_SCHED;
            PG8_LDB(B0, 1, 0); PG8_LDB(B1, 1, 1); PG8_SCHED; PG8_LDA(At, 1, 0); PG8_STAGE(PG8_SA(0, 1), a2 + hstep, voffA);
            PG8_WAIT_V(8); PG8_WAIT_L(0); PG8_BAR; PG8_MMA(0, 0, At, B0); PG8_MMA(0, 1, At, B1); PG8_BAR; PG8_SCHED;
            PG8_LDA(At, 1, 1); PG8_STAGE(PG8_SB(1, 0), b3, voffB); PG8_STAGE(PG8_SB(1, 1), b3 + hstep, voffB); PG8_STAGE(PG8_SA(1, 0), a3, voffA);
            PG8_WAIT_V(8); PG8_WAIT_L(0); PG8_BAR; PG8_MMA(1, 0, At, B0); PG8_MMA(1, 1, At, B1); PG8_BAR; PG8_SCHED;
            } else {
            PG8_LDB(B0, 0, 0); PG8_SCHED; PG8_LDA(At, 0, 0); PG8_STAGE(PG8_SA(1, 1), a1 + hstep, voffA);
            PG8_WAIT_L(8); PG8_BAR; PG8_WAIT_L(0); PG8_MMA(0, 0, At, B0); PG8_BAR; PG8_SCHED;
            PG8_LDB(B1, 0, 1); PG8_STAGE(PG8_SB(0, 0), b2, voffB);
            PG8_BAR; PG8_WAIT_L(0); PG8_MMA(0, 1, At, B1); PG8_BAR;
            PG8_LDA(At, 0, 1); PG8_STAGE(PG8_SA(0, 0), a2, voffA);
            PG8_BAR; PG8_WAIT_L(0); PG8_MMA(1, 0, At, B0); PG8_BAR; PG8_SCHED;
            PG8_STAGE(PG8_SB(0, 1), b2 + hstep, voffB);
            PG8_WAIT_V(6); PG8_BAR; PG8_MMA(1, 1, At, B1); PG8_BAR;
            PG8_LDB(B0, 1, 0); PG8_SCHED; PG8_LDA(At, 1, 0); PG8_STAGE(PG8_SA(0, 1), a2 + hstep, voffA);
            PG8_WAIT_L(8); PG8_BAR; PG8_WAIT_L(0); PG8_MMA(0, 0, At, B0); PG8_BAR; PG8_SCHED;
            PG8_LDB(B1, 1, 1); PG8_STAGE(PG8_SB(1, 0), b3, voffB);
            PG8_BAR; PG8_WAIT_L(0); PG8_MMA(0, 1, At, B1); PG8_BAR;
            PG8_LDA(At, 1, 1); PG8_STAGE(PG8_SA(1, 0), a3, voffA);
            PG8_BAR; PG8_WAIT_L(0); PG8_MMA(1, 0, At, B0); PG8_BAR; PG8_SCHED;
            PG8_STAGE(PG8_SB(1, 1), b3 + hstep, voffB);
            PG8_WAIT_V(6); PG8_BAR; PG8_MMA(1, 1, At, B1); PG8_BAR;
            }
        }
        if constexpr (ALIGN_EPI) { if (wr == 0) PG8_BAR; }
        if constexpr (!Epi::AFTER_DRAIN) { E(acc, cur, wr, wc, fr, fq); S.done(cur); }
#if defined(PROBE_EPI2B)
        { asm volatile("" ::: "memory");
#pragma unroll
        for (int a = 0; a < 2; ++a)
#pragma unroll
            for (int b = 0; b < 2; ++b)
#pragma unroll
                for (int m = 0; m < 4; ++m)
#pragma unroll
                    for (int n = 0; n < 2; ++n) asm volatile("" : "+v"(acc[a][b][m][n]));
        E(acc, cur, wr, wc, fr, fq); }
#endif
        if (!has_next) break;
#pragma unroll
        for (int a = 0; a < 2; ++a)
#pragma unroll
            for (int b = 0; b < 2; ++b)
#pragma unroll
                for (int m = 0; m < 4; ++m)
#pragma unroll
                    for (int n = 0; n < 2; ++n) acc[a][b][m][n] = (f32x4){0.f, 0.f, 0.f, 0.f};
        cur = nxt; cA = nA; cB = nB; ++ui;
        if constexpr (ALIGN_EPI) { if (wr == 1) PG8_BAR; }
    }
    PG8_WAIT_V(0);
    if constexpr (!ALIGN_EPI) { if (wr == 0) PG8_BAR; }
    PG8_BAR;
    if constexpr (Epi::AFTER_DRAIN) { E.fused(acc, cur, wr, wc, fr, fq, lds, wid, lane); S.done(cur); }
#undef PG8_SA
#undef PG8_SB
#undef PG8_STAGE
#undef PG8_LDA
#undef PG8_LDB
#undef PG8_MMA
#undef PG8_WAIT_V
#undef PG8_WAIT_L
#undef PG8_BAR
#undef PG8_SCHED
}
}

namespace pg8 {
template <class Epi, class Sched, bool I8 = false>
__device__ __forceinline__ void gemm_phase_g(PG8_LAS unsigned char* lds, const Gemm g, const Sched& S, const Epi& E) {
    int tid_ = threadIdx.x; asm volatile("" : "+v"(tid_));
    const int tid = tid_, wid = __builtin_amdgcn_readfirstlane(tid >> 6), lane = tid & 63, wr = wid >> 2, wc = wid & 3, fr = lane & 15, fq = lane >> 4;
    const int K = g.K, nt = K / BK;
#if defined(STAGGER_TICKS)
    { const unsigned dl = ((blockIdx.x >> 3) & 3u) * (unsigned)(STAGGER_TICKS); const unsigned long long t0_ = __builtin_amdgcn_s_memrealtime(); while ((unsigned)(__builtin_amdgcn_s_memrealtime() - t0_) < dl) __builtin_amdgcn_s_sleep(4); }
#endif
    unsigned voffB[2];
#pragma unroll
    for (int i = 0; i < 2; ++i) { int R, C; stage_rc(tid * 16 + i * 8192, R, C); const int Rb = Epi::PERM ? ((R & ~31) + perm32(R & 31)) : R; voffB[i] = (unsigned)(Rb * K + C) * 2u; }
    const size_t kstep = (size_t)(BK * 2);
    const size_t hstep = (size_t)HALF * K * 2;
    const size_t tstep = 2 * hstep;
    const unsigned ldsw = (unsigned)wid * 1024u;
    const int aoff = lds_byte(wr * 64 + fr, fq * 8), boff = lds_byte(wc * 32 + fr, fq * 8);
#define PG8_SA(b, h) (((b) * 2 + (h)) * HTB)
#define PG8_SB(b, h) ((4 + (b) * 2 + (h)) * HTB)
#define PG8_STAGE(bufoff, gbase, voff) do { _Pragma("unroll") for (int _i = 0; _i < 2; ++_i) \
        __builtin_amdgcn_global_load_lds((const unsigned*)((const char*)(gbase) + (voff)[_i]), (PG8_LAS unsigned*)(lds + (bufoff) + ldsw + _i * 8192), 16, 0, 0); } while (0)
#define PG8_STAGE2(bufoff, gbase, v0, v1) do { \
        __builtin_amdgcn_global_load_lds((const unsigned*)((const char*)(gbase) + (v0)), (PG8_LAS unsigned*)(lds + (bufoff) + ldsw), 16, 0, 0); \
        __builtin_amdgcn_global_load_lds((const unsigned*)((const char*)(gbase) + (v1)), (PG8_LAS unsigned*)(lds + (bufoff) + ldsw + 8192), 16, 0, 0); } while (0)
#define PG8_LDA(dst, b, h) do { _Pragma("unroll") for (int m = 0; m < 4; ++m) _Pragma("unroll") for (int k = 0; k < 2; ++k) dst[m][k] = *(const PG8_LAS bf16x8*)(lds + PG8_SA(b, h) + aoff + m * 2048 + k * 1024); } while (0)
#define PG8_LDB(dst, b, h) do { _Pragma("unroll") for (int n = 0; n < 2; ++n) _Pragma("unroll") for (int k = 0; k < 2; ++k) dst[n][k] = *(const PG8_LAS bf16x8*)(lds + PG8_SB(b, h) + boff + n * 2048 + k * 1024); } while (0)
#define PG8_MMA(ai, bj, At, Bt) do { __builtin_amdgcn_s_setprio(1); _Pragma("unroll") for (int m = 0; m < 4; ++m) _Pragma("unroll") for (int n = 0; n < 2; ++n) _Pragma("unroll") for (int k = 0; k < 2; ++k) \
        { if constexpr (I8) acc[ai][bj][m][n] = __builtin_bit_cast(f32x4, __builtin_amdgcn_mfma_i32_16x16x64_i8(__builtin_bit_cast(i32x4, Bt[n][k]), __builtin_bit_cast(i32x4, At[m][k]), __builtin_bit_cast(i32x4, acc[ai][bj][m][n]), 0, 0, 0)); \
          else acc[ai][bj][m][n] = __builtin_amdgcn_mfma_f32_16x16x32_bf16(Bt[n][k], At[m][k], acc[ai][bj][m][n], 0, 0, 0); } __builtin_amdgcn_s_setprio(0); } while (0)
#define PG8_WAIT_V(n) asm volatile("s_waitcnt vmcnt(" #n ")" ::: "memory")
#define PG8_WAIT_L(n) asm volatile("s_waitcnt lgkmcnt(" #n ")" ::: "memory")
#define PG8_BAR __builtin_amdgcn_s_barrier()
#define PG8_SCHED __builtin_amdgcn_sched_barrier(0)
#define PG8_TOKOFF(u, tz, h, i, dst) do { int R_, C_; stage_rc((tz) * 16 + (i) * 8192, R_, C_); dst = (unsigned)S.tok(u, (h) * HALF + R_) * (unsigned)(K * 2) + (unsigned)(C_ * 2); } while (0)
    Unit cur, nxt, nn; int ui = 0;
    if (!S.next(0, cur)) return;
    bool has_next = S.next(1, nxt);
    unsigned vc00, vc01, vc10, vc11, vn00, vn01, vn10, vn11;
    { int tz = tid_; asm volatile("" : "+v"(tz));
      PG8_TOKOFF(cur, tz, 0, 0, vc00); PG8_TOKOFF(cur, tz, 0, 1, vc01); PG8_TOKOFF(cur, tz, 1, 0, vc10); PG8_TOKOFF(cur, tz, 1, 1, vc11);
      if (has_next) { PG8_TOKOFF(nxt, tz, 0, 0, vn00); PG8_TOKOFF(nxt, tz, 0, 1, vn01); PG8_TOKOFF(nxt, tz, 1, 0, vn10); PG8_TOKOFF(nxt, tz, 1, 1, vn11); }
      else { vn00 = vc00; vn01 = vc01; vn10 = vc10; vn11 = vc11; } }
    f32x4 acc[2][2][4][2];
#pragma unroll
    for (int a = 0; a < 2; ++a)
#pragma unroll
        for (int b = 0; b < 2; ++b)
#pragma unroll
            for (int m = 0; m < 4; ++m)
#pragma unroll
                for (int n = 0; n < 2; ++n) acc[a][b][m][n] = (f32x4){0.f, 0.f, 0.f, 0.f};
    bf16x8 At[4][2], B0[2][2], B1[2][2];
    const char* const cA = (const char*)g.A;
    const char* cB = (const char*)g.Bt + (size_t)cur.pn * tstep;
    PG8_STAGE(PG8_SB(0, 0), cB, voffB); PG8_STAGE(PG8_SB(0, 1), cB + hstep, voffB); PG8_STAGE2(PG8_SA(0, 0), cA, vc00, vc01); PG8_STAGE2(PG8_SA(0, 1), cA, vc10, vc11);
    if (wr == 1) PG8_BAR;
    PG8_WAIT_V(2); PG8_BAR;
    PG8_STAGE(PG8_SB(1, 0), cB + kstep, voffB); PG8_STAGE2(PG8_SA(1, 0), cA + kstep, vc00, vc01); PG8_STAGE(PG8_SB(1, 1), cB + hstep + kstep, voffB);
    PG8_WAIT_V(6); PG8_BAR;
    for (;;) {
        const char* nB = has_next ? (const char*)g.Bt + (size_t)nxt.pn * tstep : cB;
        for (int t = 0; t < nt; t += 2) {
            const bool last = (t == nt - 2);
            const char* a1 = cA + (size_t)(t + 1) * kstep;
            const char* a2 = last ? cA : cA + (size_t)(t + 2) * kstep; const char* b2 = last ? nB : cB + (size_t)(t + 2) * kstep;
            const char* a3 = a2 + kstep; const char* b3 = b2 + kstep;
            const unsigned x00 = last ? vn00 : vc00, x01 = last ? vn01 : vc01, x10 = last ? vn10 : vc10, x11 = last ? vn11 : vc11;
            PG8_LDB(B0, 0, 0); PG8_LDB(B1, 0, 1); PG8_SCHED; PG8_LDA(At, 0, 0); PG8_STAGE2(PG8_SA(1, 1), a1, vc10, vc11);
            PG8_WAIT_V(8); PG8_WAIT_L(0); PG8_BAR; PG8_MMA(0, 0, At, B0); PG8_MMA(0, 1, At, B1); PG8_BAR; PG8_SCHED;
            PG8_LDA(At, 0, 1); PG8_STAGE(PG8_SB(0, 0), b2, voffB); PG8_STAGE(PG8_SB(0, 1), b2 + hstep, voffB); PG8_STAGE2(PG8_SA(0, 0), a2, x00, x01);
            PG8_WAIT_V(8); PG8_WAIT_L(0); PG8_BAR; PG8_MMA(1, 0, At, B0); PG8_MMA(1, 1, At, B1); PG8_BAR; PG8_SCHED;
            PG8_LDB(B0, 1, 0); PG8_LDB(B1, 1, 1); PG8_SCHED; PG8_LDA(At, 1, 0); PG8_STAGE2(PG8_SA(0, 1), a2, x10, x11);
            PG8_WAIT_V(8); PG8_WAIT_L(0); PG8_BAR; PG8_MMA(0, 0, At, B0); PG8_MMA(0, 1, At, B1); PG8_BAR; PG8_SCHED;
            PG8_LDA(At, 1, 1); PG8_STAGE(PG8_SB(1, 0), b3, voffB); PG8_STAGE(PG8_SB(1, 1), b3 + hstep, voffB); PG8_STAGE2(PG8_SA(1, 0), a3, x00, x01);
            PG8_WAIT_V(8); PG8_WAIT_L(0); PG8_BAR; PG8_MMA(1, 0, At, B0); PG8_MMA(1, 1, At, B1); PG8_BAR; PG8_SCHED;
        }
        if (wr == 0) PG8_BAR;
        const bool has_nn = has_next && S.next(ui + 2, nn);
        unsigned w00 = 0, w01 = 0, w10 = 0, w11 = 0;
        if (has_nn) { int tz = tid_; asm volatile("" : "+v"(tz)); PG8_TOKOFF(nn, tz, 0, 0, w00); PG8_TOKOFF(nn, tz, 0, 1, w01); PG8_TOKOFF(nn, tz, 1, 0, w10); PG8_TOKOFF(nn, tz, 1, 1, w11); }
        E(acc, cur, wr, wc, fr, fq); S.done(cur);
#if defined(PROBE_EPI2)
        asm volatile("" ::: "memory");
#pragma unroll
        for (int a = 0; a < 2; ++a)
#pragma unroll
            for (int b = 0; b < 2; ++b)
#pragma unroll
                for (int m = 0; m < 4; ++m)
#pragma unroll
                    for (int n = 0; n < 2; ++n) asm volatile("" : "+v"(acc[a][b][m][n]));
        E(acc, cur, wr, wc, fr, fq);
#endif
        if (!has_next) break;
#pragma unroll
        for (int a = 0; a < 2; ++a)
#pragma unroll
            for (int b = 0; b < 2; ++b)
#pragma unroll
                for (int m = 0; m < 4; ++m)
#pragma unroll
                    for (int n = 0; n < 2; ++n) acc[a][b][m][n] = (f32x4){0.f, 0.f, 0.f, 0.f};
        cur = nxt; cB = nB; ++ui;
        vc00 = vn00; vc01 = vn01; vc10 = vn10; vc11 = vn11;
        if (has_nn) { vn00 = w00; vn01 = w01; vn10 = w10; vn11 = w11; nxt = nn; }
        has_next = has_nn;
        if (wr == 1) PG8_BAR;
    }
    PG8_WAIT_V(0);
    PG8_BAR;
#undef PG8_SA
#undef PG8_SB
#undef PG8_STAGE
#undef PG8_STAGE2
#undef PG8_LDA
#undef PG8_LDB
#undef PG8_MMA
#undef PG8_WAIT_V
#undef PG8_WAIT_L
#undef PG8_BAR
#undef PG8_SCHED
#undef PG8_TOKOFF
}
}

#define GAS __attribute__((address_space(1)))
#define LAS __attribute__((address_space(3)))
typedef unsigned short bf16;
typedef unsigned v4u __attribute__((ext_vector_type(4)));
typedef unsigned v2u __attribute__((ext_vector_type(2)));
typedef float f32x4 __attribute__((ext_vector_type(4)));
typedef short bf16x8 __attribute__((ext_vector_type(8)));

constexpr int NWAVES = 8, NTHR = 512;
constexpr int NB = 2, SEQ = 16384, T = NB * SEQ, D = 1024;
constexpr int CONV_CH = 768, CONV_W = 31, AIN = 1792, KVW = 1536, NEXP = 32, DFF = 1024;
constexpr int MAXTILES = (T * 4) / 256 + NEXP;
constexpr int XROWS = MAXTILES * 256;
constexpr float DN_ALPHA = 1.681792830507429f;
constexpr float LN_EPS = 1e-5f;

constexpr size_t MiB = 1u << 20;
constexpr size_t al(size_t x) { return (x + MiB - 1) / MiB * MiB; }
constexpr size_t WS_CTL = 0, CTL_ZERO_BYTES = MiB;
constexpr size_t WS_ROT  = WS_CTL + MiB;
constexpr size_t WS_WIN  = WS_ROT  + al((size_t)T * 16 * 4);
constexpr size_t WS_WOA  = WS_WIN  + al((size_t)2 * AIN * D * 2);
constexpr size_t WS_WKV  = WS_WOA  + al((size_t)2 * D * D * 2);
constexpr size_t WS_WQ   = WS_WKV  + al((size_t)KVW * D * 2);
constexpr size_t WS_WOB  = WS_WQ   + al((size_t)2 * D * D * 2);
constexpr size_t WS_WMEM = WS_WOB  + al((size_t)2 * D * 512 * 2);
constexpr size_t WS_WUP  = WS_WMEM + al((size_t)4 * 512 * D * 2);
constexpr size_t WS_SBW  = WS_WUP  + al((size_t)4 * NEXP * 2 * DFF * D);
constexpr size_t WS_WDN  = WS_SBW  + al((size_t)4 * NEXP * 2 * DFF * 4);
constexpr size_t WS_MEMB = WS_WDN  + al((size_t)4 * NEXP * D * DFF * 2);
constexpr size_t WS_MEMKV= WS_MEMB + al((size_t)512 * D * 2);
constexpr size_t WS_XB   = WS_MEMKV+ al((size_t)512 * 2048 * 2);
constexpr size_t WS_X1B  = WS_XB   + al((size_t)T * D * 2);
constexpr size_t WS_XR1  = WS_X1B  + al((size_t)T * D * 2);
constexpr size_t WS_XR2  = WS_XR1  + al((size_t)T * D * 4);
constexpr size_t WS_Z    = WS_XR2  + al((size_t)T * D * 4);
constexpr size_t WS_HGLU = WS_Z    + al((size_t)T * D * 4);
constexpr size_t WS_QM   = WS_HGLU + al((size_t)T * CONV_CH * 2);
constexpr size_t WS_A2   = WS_QM   + al((size_t)T * 256 * 2);
constexpr size_t WS_QB   = WS_A2   + al((size_t)T * D * 2);
constexpr size_t WS_KVB  = WS_QB   + al((size_t)T * D * 2);
constexpr size_t WS_OG   = WS_KVB  + al((size_t)T * KVW * 2);
constexpr size_t WS_LSE  = WS_OG   + al((size_t)3 * T * 256 * 2);
constexpr size_t WS_TES  = WS_LSE  + al((size_t)3 * T * 4 * 4);
constexpr size_t WS_TGATE= WS_TES  + al((size_t)T * 4 * 4);
constexpr size_t WS_TROW = WS_TGATE+ al((size_t)T * 4 * 4);
constexpr size_t WS_RWT  = WS_TROW + al((size_t)T * 4 * 4);
constexpr size_t WS_RTOK = WS_RWT  + al((size_t)4 * NEXP * D * 4);
constexpr size_t WS_RSC  = WS_RTOK + al((size_t)NEXP * T * 4);
constexpr size_t WS_XSC  = WS_RSC  + al((size_t)NEXP * T * 4);
constexpr size_t WS_SBD  = WS_XSC  + al((size_t)T * 4);
constexpr size_t WS_H    = WS_SBD  + al((size_t)16384 * 4);
constexpr size_t WS_Y    = WS_H    + al((size_t)XROWS * DFF * 2);
constexpr size_t WS_END  = WS_Y    + al((size_t)XROWS * D * 2);
constexpr int CW_BAR = 4096;
constexpr int CW_CNT = 8192;
constexpr int LDS_SCR = 133120;
constexpr int LDS_MISC = LDS_SCR;
constexpr int LDS_TB = LDS_MISC + 64;
constexpr int LDS_TE = LDS_TB + 320;
constexpr int LDS_RT = LDS_TE + 2304;
constexpr int LDS_PTR = LDS_RT + 2304;
constexpr int LDS_SA = LDS_PTR + 256;
constexpr int LDS_BYTES = 147456;
static_assert(LDS_SA + 512 <= LDS_BYTES, "LDS map");

#define LDS_WAIT() asm volatile("s_waitcnt lgkmcnt(0)" ::: "memory")
#define VM_WAIT() asm volatile("s_waitcnt vmcnt(0)" ::: "memory")
__device__ __forceinline__ unsigned f2bf(float f) { unsigned u = __builtin_bit_cast(unsigned, f); return (u + 0x7fffu + ((u >> 16) & 1u)) >> 16; }
__device__ __forceinline__ unsigned pk2(float lo, float hi) { return f2bf(lo) | (f2bf(hi) << 16); }
__device__ __forceinline__ float bflo(unsigned w) { return __builtin_bit_cast(float, w << 16); }
__device__ __forceinline__ float bfhi(unsigned w) { return __builtin_bit_cast(float, w & 0xffff0000u); }
__device__ __forceinline__ float wave_sum(float v) {
#pragma unroll
    for (int o = 1; o < 64; o <<= 1) v += __shfl_xor(v, o);
    return v;
}
__device__ __forceinline__ float sigmoidf_(float x) { return __builtin_amdgcn_rcpf(1.0f + __builtin_amdgcn_exp2f(-1.4426950408889634f * x)); }
#define XB_TMO      128
#define XB_XCNT(j)  (256  + 64 * (j))
#define XB_XSUB(j)  (1280 + 64 * (j))
#define XB_XGEN(j)  (2304 + 64 * (j))
#define XB_TOP      3328
#define XB_TOPGEN   3392
#define XCD_BAR_WORDS 3456
#define XB_SPIN_CAP (1u << 18)

__device__ __forceinline__ unsigned xb_ld(unsigned* p)              { return __hip_atomic_load(p, __ATOMIC_RELAXED, __HIP_MEMORY_SCOPE_AGENT); }
__device__ __forceinline__ unsigned xb_add(unsigned* p, unsigned v) { return __hip_atomic_fetch_add(p, v, __ATOMIC_RELAXED, __HIP_MEMORY_SCOPE_AGENT); }
__device__ __forceinline__ unsigned xb_xcc_id() { return (unsigned)__builtin_amdgcn_s_getreg((3 << 11) | 20) & 0xFu; }
#define XB_SPIN(cond, bar) do { unsigned _sp = 0; while (cond) { __builtin_amdgcn_s_sleep(1); \
    if ((++_sp & 255u) == 0u) { if (xb_ld(&(bar)[XB_TMO])) break; if (_sp > XB_SPIN_CAP) { atomicAdd(&(bar)[XB_TMO], 1u); break; } } } } while (0)

struct XcdBarrier {
    unsigned* bar; unsigned x;
    volatile LAS unsigned* st;
};

__device__ __forceinline__ XcdBarrier xcd_barrier_post(unsigned* bar, volatile LAS unsigned* st) {
    XcdBarrier b; b.bar = bar; b.x = xb_xcc_id(); b.st = st;
    if (threadIdx.x == 0) (void)xb_add(&bar[XB_XCNT(b.x)], 1u);
    return b;
}
__device__ __forceinline__ void xcd_barrier_complete(unsigned* bar, unsigned x, unsigned& nloc, unsigned& nx) {
    const unsigned G = gridDim.x * gridDim.y * gridDim.z;
    unsigned sum, cnt, mine, sp = 0u;
    for (;;) {
        sum = 0u; cnt = 0u; mine = 0u;
#pragma unroll
        for (unsigned j = 0; j < 16; ++j) { const unsigned c = xb_ld(&bar[XB_XCNT(j)]); sum += c; cnt += (c > 0u) ? 1u : 0u; mine = (j == x) ? c : mine; }
        if (sum == G) break;
        __builtin_amdgcn_s_sleep(1);
        if ((++sp & 255u) == 0u) { if (xb_ld(&bar[XB_TMO])) break; if (sp > XB_SPIN_CAP) { atomicAdd(&bar[XB_TMO], 1u); break; } }
    }
    nloc = mine > 0u ? mine : 1u; nx = cnt > 0u ? cnt : 1u;
}

__device__ __forceinline__ void xcd_barrier(const XcdBarrier& b) {
    asm volatile("s_waitcnt vmcnt(0)" ::: "memory");
    __syncthreads();
    if (threadIdx.x == 0) {
        unsigned* bar = b.bar;
        __builtin_amdgcn_s_waitcnt(0);
        unsigned nloc = b.st[0], nx = b.st[1];
        if (nloc == 0u) { xcd_barrier_complete(bar, b.x, nloc, nx); b.st[0] = nloc; b.st[1] = nx; }
        const unsigned old = xb_add(&bar[XB_XSUB(b.x)], 1u);
        const unsigned gen = old / nloc;
        if (old + 1u == (gen + 1u) * nloc) {
            __builtin_amdgcn_fence(__ATOMIC_RELEASE, "agent");
            asm volatile("s_waitcnt vmcnt(0)" ::: "memory");
            const unsigned og = xb_add(&bar[XB_TOP], 1u);
            const unsigned tg = og / nx;
            if (og + 1u == (tg + 1u) * nx) xb_add(&bar[XB_TOPGEN], 1u);
            else XB_SPIN(xb_ld(&bar[XB_TOPGEN]) == tg, bar);
            __builtin_amdgcn_fence(__ATOMIC_ACQUIRE, "agent");
            xb_add(&bar[XB_XGEN(b.x)], 1u);
            asm volatile("s_waitcnt vmcnt(0)" ::: "memory");
        } else {
            XB_SPIN(xb_ld(&bar[XB_XGEN(b.x)]) == gen, bar);
            __builtin_amdgcn_fence(__ATOMIC_ACQUIRE, "agent");
            asm volatile("s_waitcnt vmcnt(0)" ::: "memory");
        }
    }
    __syncthreads();
}

using pg8::Unit; using pg8::cvt_pk_bf16; using pg8::BM; using pg8::HALF;
typedef unsigned u32x4 __attribute__((ext_vector_type(4)));
#if defined(EPI_NT)
#define EPI_ST(p, v) __builtin_nontemporal_store((v), (p))
#else
#define EPI_ST(p, v) (*(p) = (v))
#endif

struct EpiGluQ {
    static constexpr bool PERM = true, AFTER_DRAIN = false;
    bf16* hglu; bf16* qm; const float* bias;
    __device__ __forceinline__ void operator()(const f32x4 (&acc)[2][2][4][2], const Unit& u, int wr, int wc, int fr, int fq) const {
        const int row0 = u.pm * BM + wr * 64 + fr, cw = wc * 32 + 8 * fq;
        if (u.pn < 6) {
            f32x4 ba[2], bg[2];
#pragma unroll
            for (int n = 0; n < 2; ++n) { ba[n] = *(const f32x4*)(bias + u.pn * 128 + cw + 4 * n); bg[n] = *(const f32x4*)(bias + 768 + u.pn * 128 + cw + 4 * n); }
#pragma unroll
            for (int ai = 0; ai < 2; ++ai)
#pragma unroll
                for (int m = 0; m < 4; ++m) {
                    float o[8];
#pragma unroll
                    for (int n = 0; n < 2; ++n) { const f32x4 a = acc[ai][0][m][n] + ba[n], g = acc[ai][1][m][n] + bg[n];
#pragma unroll
                        for (int j = 0; j < 4; ++j) o[4 * n + j] = a[j] * sigmoidf_(g[j]); }
                    u32x4 w; w.x = cvt_pk_bf16(o[0], o[1]); w.y = cvt_pk_bf16(o[2], o[3]); w.z = cvt_pk_bf16(o[4], o[5]); w.w = cvt_pk_bf16(o[6], o[7]);
                    EPI_ST((u32x4*)(hglu + (size_t)(row0 + ai * HALF + m * 16) * CONV_CH + u.pn * 128 + cw), w);
                }
        } else {
            f32x4 bv[2][2];
#pragma unroll
            for (int bj = 0; bj < 2; ++bj)
#pragma unroll
                for (int n = 0; n < 2; ++n) bv[bj][n] = *(const f32x4*)(bias + 1536 + bj * HALF + cw + 4 * n);
#pragma unroll
            for (int ai = 0; ai < 2; ++ai)
#pragma unroll
                for (int m = 0; m < 4; ++m)
#pragma unroll
                    for (int bj = 0; bj < 2; ++bj) { const f32x4 v0 = acc[ai][bj][m][0] + bv[bj][0], v1 = acc[ai][bj][m][1] + bv[bj][1];
                        u32x4 w; w.x = cvt_pk_bf16(v0[0], v0[1]); w.y = cvt_pk_bf16(v0[2], v0[3]); w.z = cvt_pk_bf16(v1[0], v1[1]); w.w = cvt_pk_bf16(v1[2], v1[3]);
                        EPI_ST((u32x4*)(qm + (size_t)(row0 + ai * HALF + m * 16) * 256 + bj * HALF + cw), w); }
        }
    }
};

struct EpiGluQI8 {
    static constexpr bool PERM = true, AFTER_DRAIN = false;
    bf16* hglu; bf16* qm; const float* bias; const float* sa; const float* sb;
    __device__ __forceinline__ void operator()(const f32x4 (&acc)[2][2][4][2], const Unit& u, int wr, int wc, int fr, int fq) const {
        const int row0 = u.pm * BM + wr * 64 + fr, cw = wc * 32 + 8 * fq;
        f32x4 s0[2], s1[2];
#pragma unroll
        for (int n = 0; n < 2; ++n) { s0[n] = *(const f32x4*)(sb + u.pn * 256 + cw + 4 * n); s1[n] = *(const f32x4*)(sb + u.pn * 256 + 128 + cw + 4 * n); }
        if (u.pn < 6) {
            f32x4 ba[2], bg[2];
#pragma unroll
            for (int n = 0; n < 2; ++n) { ba[n] = *(const f32x4*)(bias + u.pn * 128 + cw + 4 * n); bg[n] = *(const f32x4*)(bias + 768 + u.pn * 128 + cw + 4 * n); }
#pragma unroll
            for (int ai = 0; ai < 2; ++ai)
#pragma unroll
                for (int m = 0; m < 4; ++m) {
                    const int row = row0 + ai * HALF + m * 16; const float a_ = sa[row];
                    float o[8];
#pragma unroll
                    for (int n = 0; n < 2; ++n)
#pragma unroll
                        for (int j = 0; j < 4; ++j) { const float a = (float)__float_as_int(acc[ai][0][m][n][j]) * (a_ * s0[n][j]) + ba[n][j], g = (float)__float_as_int(acc[ai][1][m][n][j]) * (a_ * s1[n][j]) + bg[n][j];
                            o[4 * n + j] = a * sigmoidf_(g); }
                    u32x4 w; w.x = cvt_pk_bf16(o[0], o[1]); w.y = cvt_pk_bf16(o[2], o[3]); w.z = cvt_pk_bf16(o[4], o[5]); w.w = cvt_pk_bf16(o[6], o[7]);
                    EPI_ST((u32x4*)(hglu + (size_t)row * CONV_CH + u.pn * 128 + cw), w);
                }
        } else {
            f32x4 bv[2][2];
#pragma unroll
            for (int bj = 0; bj < 2; ++bj)
#pragma unroll
                for (int n = 0; n < 2; ++n) bv[bj][n] = *(const f32x4*)(bias + 1536 + bj * HALF + cw + 4 * n);
#pragma unroll
            for (int ai = 0; ai < 2; ++ai)
#pragma unroll
                for (int m = 0; m < 4; ++m) {
                    const int row = row0 + ai * HALF + m * 16; const float a_ = sa[row];
#pragma unroll
                    for (int bj = 0; bj < 2; ++bj) { float o[8];
#pragma unroll
                        for (int n = 0; n < 2; ++n)
#pragma unroll
                            for (int j = 0; j < 4; ++j) o[4 * n + j] = (float)__float_as_int(acc[ai][bj][m][n][j]) * (a_ * (bj ? s1[n][j] : s0[n][j])) + bv[bj][n][j];
                        u32x4 w; w.x = cvt_pk_bf16(o[0], o[1]); w.y = cvt_pk_bf16(o[2], o[3]); w.z = cvt_pk_bf16(o[4], o[5]); w.w = cvt_pk_bf16(o[6], o[7]);
                        EPI_ST((u32x4*)(qm + (size_t)row * 256 + bj * HALF + cw), w); }
                }
        }
    }
};

struct EpiRes {
    static constexpr bool PERM = false, AFTER_DRAIN = false;
    float* Z; const float* xres; const float* bias;
    __device__ __forceinline__ void operator()(const f32x4 (&acc)[2][2][4][2], const Unit& u, int wr, int wc, int fr, int fq) const {
        const int row0 = u.pm * BM + wr * 64 + fr, col0 = u.pn * BM + wc * 32 + 4 * fq;
        f32x4 bv[2][2];
#pragma unroll
        for (int bj = 0; bj < 2; ++bj)
#pragma unroll
            for (int n = 0; n < 2; ++n) bv[bj][n] = *(const f32x4*)(bias + col0 + bj * HALF + n * 16);
#pragma unroll
        for (int ai = 0; ai < 2; ++ai)
#pragma unroll
            for (int m = 0; m < 4; ++m) { const size_t off = (size_t)(row0 + ai * HALF + m * 16) * D + col0;
#pragma unroll
                for (int bj = 0; bj < 2; ++bj)
#pragma unroll
                    for (int n = 0; n < 2; ++n) { const f32x4 xr = *(const f32x4*)(xres + off + bj * HALF + n * 16);
                        EPI_ST((f32x4*)(Z + off + bj * HALF + n * 16), xr * DN_ALPHA + acc[ai][bj][m][n] + bv[bj][n]); } }
    }
};

template <int MODE, bool I8 = false> struct EpiRot {
    static constexpr bool PERM = true, AFTER_DRAIN = false;
    bf16* O; int ldc; const float* rot;
    const float* sa; const float* sb;
    __device__ __forceinline__ void operator()(const f32x4 (&acc)[2][2][4][2], const Unit& u, int wr, int wc, int fr, int fq) const {
        const int row0 = u.pm * BM + wr * 64 + fr;
#pragma unroll
        for (int bj = 0; bj < 2; ++bj) {
            const int cb = u.pn * BM + bj * HALF;
            bool rotu = false;
            if (MODE == 0) rotu = (cb < 768) && ((wc & 1) == 0);
            if (MODE == 1) rotu = ((cb & 511) < 256) && ((wc & 1) == 0);
#pragma unroll
            for (int ai = 0; ai < 2; ++ai)
#pragma unroll
                for (int m = 0; m < 4; ++m) {
                    const int row = row0 + ai * HALF + m * 16;
                    float v[8];
#pragma unroll
                    for (int j = 0; j < 4; ++j) { v[j] = acc[ai][bj][m][0][j]; v[4 + j] = acc[ai][bj][m][1][j]; }
                    if constexpr (I8) { const float a_ = sa[row]; const f32x4 b0 = *(const f32x4*)(sb + cb + wc * 32 + 8 * fq), b1 = *(const f32x4*)(sb + cb + wc * 32 + 8 * fq + 4);
#pragma unroll
                        for (int j = 0; j < 4; ++j) { v[j] = (float)__float_as_int(v[j]) * (a_ * b0[j]); v[4 + j] = (float)__float_as_int(v[4 + j]) * (a_ * b1[j]); } }
                    if (rotu) {
                        float pv[8];
#pragma unroll
                        for (int j = 0; j < 8; ++j) pv[j] = __shfl_xor(v[j], 16);
                        if (fq < 2) {
                            const f32x4 c0 = *(const f32x4*)(rot + (size_t)row * 16), c1 = *(const f32x4*)(rot + (size_t)row * 16 + 4);
                            const f32x4 s0 = *(const f32x4*)(rot + (size_t)row * 16 + 8), s1 = *(const f32x4*)(rot + (size_t)row * 16 + 12);
                            const float sg = (fq == 0) ? -1.0f : 1.0f;
#pragma unroll
                            for (int j = 0; j < 4; ++j) { v[j] = v[j] * c0[j] + sg * pv[j] * s0[j]; v[4 + j] = v[4 + j] * c1[j] + sg * pv[4 + j] * s1[j]; }
                        }
                    }
                    u32x4 w; w.x = cvt_pk_bf16(v[0], v[1]); w.y = cvt_pk_bf16(v[2], v[3]); w.z = cvt_pk_bf16(v[4], v[5]); w.w = cvt_pk_bf16(v[6], v[7]);
                    EPI_ST((u32x4*)(O + (size_t)row * ldc + cb + wc * 32 + 8 * fq), w);
                }
        }
    }
};

struct EpiSwiglu {
    static constexpr bool PERM = true, AFTER_DRAIN = false;
    bf16* H; const float* bup;
    __device__ __forceinline__ void operator()(const f32x4 (&acc)[2][2][4][2], const Unit& u, int wr, int wc, int fr, int fq) const {
        const int e = u.pn >> 3, pn = u.pn & 7, row0 = u.pm * BM + wr * 64 + fr, cw = pn * 128 + wc * 32 + 8 * fq;
        f32x4 bg[2], bl[2];
#pragma unroll
        for (int n = 0; n < 2; ++n) { bg[n] = *(const f32x4*)(bup + (size_t)e * 2048 + cw + 4 * n); bl[n] = *(const f32x4*)(bup + (size_t)e * 2048 + 1024 + cw + 4 * n); }
#pragma unroll
        for (int ai = 0; ai < 2; ++ai)
#pragma unroll
            for (int m = 0; m < 4; ++m) {
                float o[8];
#pragma unroll
                for (int n = 0; n < 2; ++n) { const f32x4 g = acc[ai][0][m][n] + bg[n], li = acc[ai][1][m][n] + bl[n];
#pragma unroll
                    for (int j = 0; j < 4; ++j) { const float gg = fminf(g[j], 7.0f), ll = fminf(fmaxf(li[j], -7.0f), 7.0f); o[4 * n + j] = gg * sigmoidf_(1.702f * gg) * (ll + 1.0f); } }
                u32x4 w; w.x = cvt_pk_bf16(o[0], o[1]); w.y = cvt_pk_bf16(o[2], o[3]); w.z = cvt_pk_bf16(o[4], o[5]); w.w = cvt_pk_bf16(o[6], o[7]);
                EPI_ST((u32x4*)(H + (size_t)(row0 + ai * HALF + m * 16) * DFF + cw), w);
            }
    }
};

struct EpiSwigluI8 {
    static constexpr bool PERM = true, AFTER_DRAIN = false;
    bf16* H; const float* bup; const float* sbw; const float* rowsc; const LAS int* tbs;
    __device__ __forceinline__ void operator()(const f32x4 (&acc)[2][2][4][2], const Unit& u, int wr, int wc, int fr, int fq) const {
        const int e = u.pn >> 3, pn = u.pn & 7, row0 = u.pm * BM + wr * 64 + fr, cw = pn * 128 + wc * 32 + 8 * fq;
        const int slot0 = (u.pm - tbs[e]) * 256 + wr * 64 + fr;
        f32x4 bg[2], bl[2], sg[2], sl[2];
#pragma unroll
        for (int n = 0; n < 2; ++n) { bg[n] = *(const f32x4*)(bup + (size_t)e * 2048 + cw + 4 * n); bl[n] = *(const f32x4*)(bup + (size_t)e * 2048 + 1024 + cw + 4 * n);
            sg[n] = *(const f32x4*)(sbw + (size_t)e * 2048 + pn * 256 + wc * 32 + 8 * fq + 4 * n); sl[n] = *(const f32x4*)(sbw + (size_t)e * 2048 + pn * 256 + 128 + wc * 32 + 8 * fq + 4 * n); }
#pragma unroll
        for (int ai = 0; ai < 2; ++ai)
#pragma unroll
            for (int m = 0; m < 4; ++m) {
                const float sa = rowsc[(size_t)e * T + slot0 + ai * HALF + m * 16];
                float o[8];
#pragma unroll
                for (int n = 0; n < 2; ++n) {
#pragma unroll
                    for (int j = 0; j < 4; ++j) {
                        const float g = (float)__float_as_int(acc[ai][0][m][n][j]) * (sa * sg[n][j]) + bg[n][j], li = (float)__float_as_int(acc[ai][1][m][n][j]) * (sa * sl[n][j]) + bl[n][j];
                        const float gg = fminf(g, 7.0f), ll = fminf(fmaxf(li, -7.0f), 7.0f); o[4 * n + j] = gg * sigmoidf_(1.702f * gg) * (ll + 1.0f);
#if defined(PROBE_H) && (PROBE_H == 3 || PROBE_H >= 7)
                        o[4 * n + j] = (float)__float_as_int(acc[ai][0][m][n][j]);
#endif
                    } }
                u32x4 w; w.x = cvt_pk_bf16(o[0], o[1]); w.y = cvt_pk_bf16(o[2], o[3]); w.z = cvt_pk_bf16(o[4], o[5]); w.w = cvt_pk_bf16(o[6], o[7]);
                EPI_ST((u32x4*)(H + (size_t)(row0 + ai * HALF + m * 16) * DFF + cw), w);
            }
    }
};

struct EpiDown {
    static constexpr bool PERM = true, AFTER_DRAIN = false;
    bf16* Y; const float* bdn;
    __device__ __forceinline__ void operator()(const f32x4 (&acc)[2][2][4][2], const Unit& u, int wr, int wc, int fr, int fq) const {
        const int e = u.pn >> 2, pn = u.pn & 3, row0 = u.pm * BM + wr * 64 + fr, cw = pn * BM + wc * 32 + 8 * fq;
        f32x4 bv[2][2];
#pragma unroll
        for (int bj = 0; bj < 2; ++bj)
#pragma unroll
            for (int n = 0; n < 2; ++n) bv[bj][n] = *(const f32x4*)(bdn + (size_t)e * D + cw + bj * HALF + 4 * n);
#pragma unroll
        for (int ai = 0; ai < 2; ++ai)
#pragma unroll
            for (int m = 0; m < 4; ++m)
#pragma unroll
                for (int bj = 0; bj < 2; ++bj) { const f32x4 v0 = acc[ai][bj][m][0] + bv[bj][0], v1 = acc[ai][bj][m][1] + bv[bj][1];
                    u32x4 w; w.x = cvt_pk_bf16(v0[0], v0[1]); w.y = cvt_pk_bf16(v0[2], v0[3]); w.z = cvt_pk_bf16(v1[0], v1[1]); w.w = cvt_pk_bf16(v1[2], v1[3]);
                    EPI_ST((u32x4*)(Y + (size_t)(row0 + ai * HALF + m * 16) * D + cw + bj * HALF), w); }
    }
};

template <int NTN> struct MoeOrder {
    const LAS int* tile_e; const LAS int* tbs; const LAS int* cntl; const int* rowtok; int total, G, c;
    __device__ __forceinline__ bool next(int i, Unit& u) const {
#if defined(MOE_ORDER_B)
        const int L = i * G + c, grp = L / (8 * NTN), w = L % (8 * NTN), rt = grp * 8 + (w / NTN), pn = w % NTN;
#else
        const int L = i * G + c, grp = L / (8 * NTN), w = L % (8 * NTN), rt = grp * 8 + (w & 7), pn = w >> 3;
#endif
        if (rt >= total) return false;
        const int e = __builtin_amdgcn_readfirstlane(tile_e[rt]);
        u.pm = rt; u.pn = e * NTN + pn; return true;
    }
    __device__ __forceinline__ int tok(const Unit& u, int r) const {
        const int e = u.pn / NTN, slot = (u.pm - tbs[e]) * 256 + r; int t = 0;
        if (slot < cntl[e]) t = rowtok[(size_t)e * T + slot];
        return t;
    }
    __device__ __forceinline__ void a_ready(const Unit&) const {}
    __device__ __forceinline__ void done(const Unit&) const {}
};

struct Frame {
    LAS unsigned char* lds;
    int tid, lane, wave, G, gw, NGW;
};
__device__ __forceinline__ unsigned char* ptr_slot(const Frame& F, int k) {
    const unsigned long long v = *(const LAS unsigned long long*)(F.lds + LDS_PTR + 8 * k);
    const unsigned lo = __builtin_amdgcn_readfirstlane((unsigned)v), hi = __builtin_amdgcn_readfirstlane((unsigned)(v >> 32));
    return (unsigned char*)(GAS unsigned char*)(((unsigned long long)hi << 32) | lo);
}
__device__ __forceinline__ const float* inp(const Frame& F, int k) { return (const float*)ptr_slot(F, k); }
__device__ __forceinline__ unsigned char* wsp(const Frame& F) { return ptr_slot(F, 24); }

__device__ __forceinline__ void tr_item(const float* W, int N, bf16* WT, int K, int k0, int n0, int orow0, LAS float* scr, int lane) {
#if defined(P0_V2)
    { float tv_[64];
#pragma unroll
      for (int i = 0; i < 64; ++i) tv_[i] = __builtin_nontemporal_load(W + (size_t)(k0 + i) * N + n0 + lane);
#pragma unroll
      for (int i = 0; i < 64; ++i) scr[i * 65 + lane] = tv_[i]; }
#else
#pragma unroll 16
    for (int i = 0; i < 64; ++i) scr[i * 65 + lane] = W[(size_t)(k0 + i) * N + n0 + lane];
#endif
    LDS_WAIT(); asm volatile("" ::: "memory");
    const int c = lane & 7;
#pragma unroll
    for (int j = 0; j < 8; ++j) { const int n = (lane >> 3) + 8 * j; const LAS float* s = scr + (8 * c) * 65 + n;
        v4u o; o.x = pk2(s[0 * 65], s[1 * 65]); o.y = pk2(s[2 * 65], s[3 * 65]); o.z = pk2(s[4 * 65], s[5 * 65]); o.w = pk2(s[6 * 65], s[7 * 65]);
        *(v4u*)(WT + (size_t)(orow0 + n) * K + k0 + 8 * c) = o; }
    LDS_WAIT(); asm volatile("" ::: "memory");
}
template <int PERMT> __device__ __forceinline__ int perm_row(int n0) {
    if (PERMT == 1) { if (n0 >= 1536) return n0; const int bj = n0 / 768, r = n0 % 768; return (r / 128) * 256 + bj * 128 + (r % 128); }
    if (PERMT == 2) { const int bj = n0 / 1024, r = n0 % 1024; return (r / 128) * 256 + bj * 128 + (r % 128); }
    return n0;
}
template <int PERMT> __device__ __forceinline__ void conv_group(Frame& F, const float* src, bf16* dst, int K, int N, int nmat) {
    LAS float* scr = (LAS float*)(F.lds + F.wave * 16640);
    const int nkb = K / 64, nnb = N / 64, per = nkb * nnb, total = per * nmat;
    for (int it = F.gw; it < total; it += F.NGW) {
        const int mat = it / per, r = it % per, kb = r / nnb, nb = r % nnb;
        tr_item(src + (size_t)mat * K * N, N, dst + (size_t)mat * K * N, K, kb * 64, nb * 64, perm_row<PERMT>(nb * 64), scr, F.lane);
    }
}
__device__ __forceinline__ void quant_row_i8(const f32x4 (&v)[4], unsigned char* qrow, float* scale, int lane) {
    float amax = 0.f;
#pragma unroll
    for (int j = 0; j < 4; ++j) amax = fmaxf(amax, fmaxf(fmaxf(fabsf(v[j][0]), fabsf(v[j][1])), fmaxf(fabsf(v[j][2]), fabsf(v[j][3]))));
#pragma unroll
    for (int o = 1; o < 64; o <<= 1) amax = fmaxf(amax, __shfl_xor(amax, o));
    amax = fmaxf(amax, 1e-30f);
    const float qinv = 127.0f / amax;
    if (lane == 0) *scale = amax * (1.0f / 127.0f);
#pragma unroll
    for (int j = 0; j < 4; ++j) { const int q0 = (int)rintf(v[j][0] * qinv), q1 = (int)rintf(v[j][1] * qinv), q2 = (int)rintf(v[j][2] * qinv), q3 = (int)rintf(v[j][3] * qinv);
        *(unsigned*)(qrow + 4 * lane + 256 * j) = (unsigned)(q0 & 255) | ((unsigned)(q1 & 255) << 8) | ((unsigned)(q2 & 255) << 16) | ((unsigned)(q3 & 255) << 24); }
}
template <int PERMT> __device__ __forceinline__ void conv_i8(Frame& F, const float* src, unsigned char* dst, float* sbw, int N, int nmat) {
    constexpr int K = D; const int NSTRIP = N / 64, TOTAL = nmat * NSTRIP;
    LAS float* red = (LAS float*)F.lds;
    for (int it = blockIdx.x; it < TOTAL; it += F.G) {
        const int mat = it / NSTRIP, n0 = (it % NSTRIP) * 64;
        const float* W = src + (size_t)mat * K * N + (size_t)(128 * F.wave) * N + n0 + F.lane;
        float t[128];
#pragma unroll
        for (int i = 0; i < 128; ++i) t[i] = __builtin_nontemporal_load(W + (size_t)i * N);
        float mx = 0.f;
#pragma unroll
        for (int i = 0; i < 128; ++i) mx = fmaxf(mx, fabsf(t[i]));
        __syncthreads();
        red[F.wave * 64 + F.lane] = mx;
        __syncthreads();
#pragma unroll
        for (int w = 0; w < 8; ++w) mx = fmaxf(mx, red[w * 64 + F.lane]);
        mx = fmaxf(mx, 1e-30f);
        const float inv = 127.0f / mx;
        const int orow = perm_row<PERMT>(n0) + F.lane;
        if (F.wave == 0) sbw[(size_t)mat * N + orow] = mx * (1.0f / 127.0f);
        unsigned char* out = dst + ((size_t)mat * N + orow) * K + 128 * F.wave;
#pragma unroll
        for (int c = 0; c < 8; ++c) { unsigned pk[4];
#pragma unroll
            for (int i = 0; i < 4; ++i) { const int b = 16 * c + 4 * i; const int q0 = (int)rintf(t[b] * inv), q1 = (int)rintf(t[b + 1] * inv), q2 = (int)rintf(t[b + 2] * inv), q3 = (int)rintf(t[b + 3] * inv);
                pk[i] = (unsigned)(q0 & 255) | ((unsigned)(q1 & 255) << 8) | ((unsigned)(q2 & 255) << 16) | ((unsigned)(q3 & 255) << 24); }
            *(v4u*)(out + 16 * c) = (v4u){pk[0], pk[1], pk[2], pk[3]}; }
    }
    __syncthreads();
}
__device__ __forceinline__ void phase_prologue(Frame& F) {
    unsigned char* ws = wsp(F);
#if defined(PROBE_I8)
    if (blockIdx.x == 0 && F.wave == 0) {
        typedef int i32x4_ __attribute__((ext_vector_type(4)));
        const int i = F.lane & 15, g = F.lane >> 4;
        unsigned aw[4], bw[4];
        for (int w = 0; w < 4; ++w) { unsigned a = 0, b = 0; for (int t = 0; t < 4; ++t) { const int k = 16 * g + 4 * w + t; const int av = ((i * 7 + k * 3) % 11) - 5, bv = ((k * 5 + i * 2) % 13) - 6; a |= (unsigned)(av & 255) << (8 * t); b |= (unsigned)(bv & 255) << (8 * t); } aw[w] = a; bw[w] = b; }
        i32x4_ A = {(int)aw[0], (int)aw[1], (int)aw[2], (int)aw[3]}, B = {(int)bw[0], (int)bw[1], (int)bw[2], (int)bw[3]}, C = {0, 0, 0, 0};
        C = __builtin_amdgcn_mfma_i32_16x16x64_i8(A, B, C, 0, 0, 0);
        int bad = 0;
        for (int jj = 0; jj < 4; ++jj) { const int row = 4 * g + jj, col = i; int ref = 0; for (int k = 0; k < 64; ++k) ref += (((row * 7 + k * 3) % 11) - 5) * (((k * 5 + col * 2) % 13) - 6); if (ref != C[jj]) bad = 1; }
        const unsigned long long bm = __ballot(bad);
        if (F.lane == 0) ((float*)(ws + WS_CTL))[CW_CNT + 256] = bm ? 3.0f : 1.0f;
    }
#endif
    conv_i8<1>(F, inp(F, 3),  (unsigned char*)(ws + WS_WIN), (float*)(ws + WS_SBD), AIN, 2);
    conv_group<0>(F, inp(F, 9),  (bf16*)(ws + WS_WOA),  D, D, 2);
    conv_i8<0>(F, inp(F, 11), (unsigned char*)(ws + WS_WKV), (float*)(ws + WS_SBD) + 8192, KVW, 1);
    conv_i8<0>(F, inp(F, 12), (unsigned char*)(ws + WS_WQ),  (float*)(ws + WS_SBD) + 4096, D, 2);
    conv_group<0>(F, inp(F, 13), (bf16*)(ws + WS_WOB),  512, D, 2);
    conv_group<0>(F, inp(F, 15), (bf16*)(ws + WS_WMEM), D, 512, 4);
    conv_i8<2>(F, inp(F, 20), (unsigned char*)(ws + WS_WUP), (float*)(ws + WS_SBW), 2 * DFF, 4 * NEXP);
    conv_group<0>(F, inp(F, 22), (bf16*)(ws + WS_WDN),  DFF, D, 4 * NEXP);
    {
        const size_t gt = (size_t)blockIdx.x * NTHR + F.tid, NT_ = (size_t)F.G * NTHR;
        { const float* x = inp(F, 0); unsigned char* xq = (unsigned char*)(ws + WS_XB); float* xsc = (float*)(ws + WS_XSC);
          for (int t = F.gw; t < T; t += F.NGW) { f32x4 v[4];
#pragma unroll
              for (int j = 0; j < 4; ++j) v[j] = *(const f32x4*)(x + (size_t)t * D + 4 * F.lane + 256 * j);
              quant_row_i8(v, xq + (size_t)t * D, xsc + t, F.lane); } }
        const float* mem = inp(F, 1); bf16* mb = (bf16*)(ws + WS_MEMB);
        for (size_t i = gt; i < (size_t)512 * D / 8; i += NT_) { const f32x4 a = *(const f32x4*)(mem + i * 8), b = *(const f32x4*)(mem + i * 8 + 4);
            v4u o; o.x = pk2(a[0], a[1]); o.y = pk2(a[2], a[3]); o.z = pk2(b[0], b[1]); o.w = pk2(b[2], b[3]); *(v4u*)(mb + i * 8) = o; }
        { const float* rw = inp(F, 18); float* rwT = (float*)(ws + WS_RWT);
          for (size_t i = gt; i < (size_t)4 * NEXP * D; i += NT_) { const int l = (int)(i >> 15), e = (int)((i >> 10) & 31), c = (int)(i & 1023); rwT[i] = rw[((size_t)l * D + c) * NEXP + e]; } }
        const int* pos = (const int*)inp(F, 2); float* rot = (float*)(ws + WS_ROT);
        for (size_t i = gt; i < (size_t)T * 8; i += NT_) { const int t = (int)(i >> 3), k = (int)(i & 7);
            double f = 1.0;
            f = (k == 1) ? 0.19392274474868576 : f; f = (k == 2) ? 0.03760603093086393 : f; f = (k == 3) ? 0.007292664737217109 : f; f = (k == 4) ? 0.001414213562373095 : f;
            f = (k == 5) ? 0.0002742481756762073 : f; f = (k == 6) ? 5.318295896944988e-05 : f; f = (k == 7) ? 1.031338537721246e-05 : f;
            const double a = (double)pos[t] * f; const double rv = a * 0.15915494309189535; const double fr = rv - floor(rv);
            const float ang = (float)(fr * 6.283185307179586);
            rot[(size_t)t * 16 + k] = cosf(ang); rot[(size_t)t * 16 + 8 + k] = sinf(ang); }
    }
}

__device__ __forceinline__ void phase_conv(Frame& F, const bf16* hglu, const float* dw, const float* dwb, const float* cg, const float* cb, bf16* A2) {
    LAS bf16* tile = (LAS bf16*)F.lds;
    LAS float* red = (LAS float*)(F.lds + 46 * 768 * 2);
    const int L = F.tid & 255, tb = F.tid >> 8, wv = F.wave & 3;
    float w[31][3], bias[3], gg[3], bb[3];
#pragma unroll
    for (int p = 0; p < 3; ++p) { bias[p] = dwb[p * 256 + L]; gg[p] = cg[p * 256 + L]; bb[p] = cb[p * 256 + L];
#pragma unroll
        for (int j = 0; j < 31; ++j) w[j][p] = dw[j * CONV_CH + p * 256 + L]; }
    for (int ti = blockIdx.x; ti < T / 16; ti += F.G) {
        const int t0 = ti * 16, s0 = t0 & (SEQ - 1);
        __syncthreads();
        for (int i = F.tid; i < 46 * 96; i += NTHR) { const int r = i / 96, c = i % 96; v4u v = (v4u){0u, 0u, 0u, 0u};
            if (s0 - 30 + r >= 0) v = *(const v4u*)(hglu + (size_t)(t0 - 30 + r) * CONV_CH + c * 8);
            *(LAS v4u*)(tile + r * CONV_CH + c * 8) = v; }
        __syncthreads();
        float acc[8][3];
#pragma unroll
        for (int t = 0; t < 8; ++t)
#pragma unroll
            for (int p = 0; p < 3; ++p) acc[t][p] = bias[p];
#pragma unroll
        for (int r = 0; r < 38; ++r) {
            float x[3];
#pragma unroll
            for (int p = 0; p < 3; ++p) x[p] = bflo((unsigned)tile[(tb * 8 + r) * CONV_CH + p * 256 + L]);
#pragma unroll
            for (int t = 0; t < 8; ++t) { const int j = r - t; if (j >= 0 && j <= 30) {
#pragma unroll
                for (int p = 0; p < 3; ++p) acc[t][p] += x[p] * w[j][p]; } }
        }
        float mean[8], rstd[8];
#pragma unroll
        for (int t = 0; t < 8; ++t) { const float s = wave_sum(acc[t][0] + acc[t][1] + acc[t][2]); if (F.lane == 0) red[(tb * 4 + wv) * 8 + t] = s; }
        __syncthreads();
#pragma unroll
        for (int t = 0; t < 8; ++t) { const LAS float* rp = red + tb * 32 + t; mean[t] = (rp[0] + rp[8] + rp[16] + rp[24]) * (1.0f / CONV_CH); }
#pragma unroll
        for (int t = 0; t < 8; ++t) { const float d0 = acc[t][0] - mean[t], d1 = acc[t][1] - mean[t], d2 = acc[t][2] - mean[t];
            const float s = wave_sum(d0 * d0 + d1 * d1 + d2 * d2); if (F.lane == 0) red[64 + (tb * 4 + wv) * 8 + t] = s; }
        __syncthreads();
#pragma unroll
        for (int t = 0; t < 8; ++t) { const LAS float* rp = red + 64 + tb * 32 + t; rstd[t] = 1.0f / sqrtf((rp[0] + rp[8] + rp[16] + rp[24]) * (1.0f / CONV_CH) + LN_EPS); }
#pragma unroll
        for (int t = 0; t < 8; ++t)
#pragma unroll
            for (int p = 0; p < 3; ++p) { const float y = (acc[t][p] - mean[t]) * rstd[t] * gg[p] + bb[p]; const float o = y * sigmoidf_(y);
                A2[(size_t)(t0 + tb * 8 + t) * D + p * 256 + L] = (bf16)f2bf(o); }
    }
    __syncthreads();
}

constexpr int KPITCH = 144;
typedef short v4i16_t __attribute__((ext_vector_type(4)));
template <int NT, bool MASK>
__device__ __forceinline__ void attn_wave(const LAS unsigned char* Kl, const LAS unsigned char* Vl, int kt0, bf16x8 bq0, bf16x8 bq1, int lane, int qi, bool first, f32x4 (&o)[4], float& lse) {
    const int r = lane & 15, lg = lane >> 4;
    f32x4 s[NT];
#pragma unroll
    for (int t = 0; t < NT; ++t) {
        const LAS unsigned char* kp = Kl + ((kt0 + t) * 16 + r) * KPITCH + lg * 16;
        const bf16x8 a0 = *(const LAS bf16x8*)kp, a1 = *(const LAS bf16x8*)(kp + 64);
        f32x4 z = (f32x4){0.f, 0.f, 0.f, 0.f};
        z = __builtin_amdgcn_mfma_f32_16x16x32_bf16(a0, bq0, z, 0, 0, 0);
        s[t] = __builtin_amdgcn_mfma_f32_16x16x32_bf16(a1, bq1, z, 0, 0, 0);
    }
    float m = -INFINITY;
#pragma unroll
    for (int t = 0; t < NT; ++t)
#pragma unroll
        for (int j = 0; j < 4; ++j) {
            if (MASK) { const int ki = (kt0 + t) * 16 + 4 * lg + j, dist = qi + 128 - ki; const bool valid = (dist >= 0) && (dist <= 128) && (!first || ki >= 128); s[t][j] = valid ? s[t][j] : -INFINITY; }
            m = fmaxf(m, s[t][j]);
        }
    m = fmaxf(m, __shfl_xor(m, 16)); m = fmaxf(m, __shfl_xor(m, 32));
    const float c = 0.125f * 1.4426950408889634f;
    float sum = 0.f;
#pragma unroll
    for (int t = 0; t < NT; ++t)
#pragma unroll
        for (int j = 0; j < 4; ++j) { const float p = __builtin_amdgcn_exp2f((s[t][j] - m) * c); s[t][j] = p; sum += p; }
    sum += __shfl_xor(sum, 16); sum += __shfl_xor(sum, 32);
#pragma unroll
    for (int et = 0; et < 4; ++et) o[et] = (f32x4){0.f, 0.f, 0.f, 0.f};
    const LAS unsigned char* vbase = Vl + (kt0 * 16 + 4 * lg + ((lane & 15) >> 2)) * KPITCH + (lane & 3) * 8;
#pragma unroll
    for (int kk = 0; kk < NT / 2; ++kk) {
        v4u pw; pw.x = cvt_pk_bf16(s[2 * kk][0], s[2 * kk][1]); pw.y = cvt_pk_bf16(s[2 * kk][2], s[2 * kk][3]);
        pw.z = cvt_pk_bf16(s[2 * kk + 1][0], s[2 * kk + 1][1]); pw.w = cvt_pk_bf16(s[2 * kk + 1][2], s[2 * kk + 1][3]);
        const bf16x8 bp = __builtin_bit_cast(bf16x8, pw);
#pragma unroll
        for (int et = 0; et < 4; ++et) {
            const LAS unsigned char* vp = vbase + (32 * kk) * KPITCH + et * 32;
            const v4i16_t lo = __builtin_amdgcn_ds_read_tr16_b64_v4i16((LAS v4i16_t*)vp);
            const v4i16_t hi = __builtin_amdgcn_ds_read_tr16_b64_v4i16((LAS v4i16_t*)(vp + 16 * KPITCH));
            bf16x8 av; av[0] = lo[0]; av[1] = lo[1]; av[2] = lo[2]; av[3] = lo[3]; av[4] = hi[0]; av[5] = hi[1]; av[6] = hi[2]; av[7] = hi[3];
            o[et] = __builtin_amdgcn_mfma_f32_16x16x32_bf16(av, bp, o[et], 0, 0, 0);
        }
    }
    const float inv = __builtin_amdgcn_rcpf(sum);
#pragma unroll
    for (int et = 0; et < 4; ++et) o[et] = o[et] * inv;
    lse = m * 0.125f + __logf(sum);
}
constexpr int ATT_K_OFF = 0, ATT_V_OFF = 272 * KPITCH;

__device__ __forceinline__ void phase_memattn(Frame& F, const bf16* q, int qp, int qc0, const bf16* memkv, int l, bf16* out, int op, int oc0) {
    LAS unsigned char* Kl = F.lds + ATT_K_OFF; LAS unsigned char* Vl = F.lds + ATT_V_OFF;
    const int r = F.lane & 15, lg = F.lane >> 4;
    for (int u = blockIdx.x; u < 256; u += F.G) {
        const int b = u >> 7, h = (u >> 5) & 3, qc = u & 31;
        __syncthreads();
#pragma unroll
        for (int k = 0; k < 4; ++k) { const int i = F.tid + NTHR * k, ki = i >> 3, c = i & 7;
            const bf16* src = memkv + (size_t)(b * 256 + ki) * 2048 + l * 512 + h * 64 + c * 8;
            const v4u kv = *(const v4u*)src, vv = *(const v4u*)(src + 256);
            *(LAS v4u*)(Kl + ki * KPITCH + c * 16) = kv; *(LAS v4u*)(Vl + ki * KPITCH + c * 16) = vv; }
        bf16x8 nq0, nq1;
        { const bf16* qr = q + (size_t)(b * SEQ + qc * 512 + F.wave * 16 + r) * qp + qc0 + h * 64 + 8 * lg; nq0 = *(const bf16x8*)qr; nq1 = *(const bf16x8*)(qr + 32); }
        __syncthreads();
        for (int pass = 0; pass < 4; ++pass) {
            const int tok = b * SEQ + qc * 512 + pass * 128 + F.wave * 16 + r;
            const bf16x8 bq0 = nq0, bq1 = nq1;
            if (pass < 3) { const bf16* qr = q + (size_t)(tok + 128) * qp + qc0 + h * 64 + 8 * lg; nq0 = *(const bf16x8*)qr; nq1 = *(const bf16x8*)(qr + 32); }
            f32x4 o[4]; float lse;
            attn_wave<16, false>(Kl, Vl, 0, bq0, bq1, F.lane, 0, false, o, lse);
            bf16* orow = out + (size_t)tok * op + oc0 + h * 64 + 4 * lg;
#pragma unroll
            for (int et = 0; et < 4; ++et) { v2u w; w.x = cvt_pk_bf16(o[et][0], o[et][1]); w.y = cvt_pk_bf16(o[et][2], o[et][3]); *(v2u*)(orow + 16 * et) = w; }
        }
    }
    __syncthreads();
}

struct DilUnit { int b, grp, h, d, res, n; };
__device__ __forceinline__ DilUnit dil_unit(int u) {
    DilUnit x; x.b = u / 1536; const int rem = u % 1536; x.grp = rem >> 9; x.h = (rem >> 7) & 3; const int blk = rem & 127;
    const int dsh = 2 * x.grp; x.d = 1 << dsh; const int nblk = SEQ >> (7 + dsh); x.res = blk / nblk; x.n = blk % nblk; return x;
}
__device__ __forceinline__ void phase_dilated(Frame& F, const bf16* q  , const bf16* kv  , bf16* og  , float* lseo  ) {
    LAS unsigned char* Kl = F.lds + ATT_K_OFF; LAS unsigned char* Vl = F.lds + ATT_V_OFF;
    const int r16 = F.lane & 15, lg = F.lane >> 4;
    v4u kr[5], vr[5]; bf16x8 nq0, nq1; int ntok = 0;
#define DIL_PREFETCH(uu) do { const DilUnit x_ = dil_unit(uu); \
        _Pragma("unroll") for (int k_ = 0; k_ < 5; ++k_) { const int i_ = F.tid + NTHR * k_, ki_ = i_ >> 3, c_ = i_ & 7, mk_ = (x_.n - 1) * 128 + ki_; \
            kr[k_] = (v4u){0u, 0u, 0u, 0u}; vr[k_] = (v4u){0u, 0u, 0u, 0u}; \
            if (ki_ < 256 && mk_ >= 0) { const bf16* src_ = kv + (size_t)(x_.b * SEQ + mk_ * x_.d + x_.res) * KVW + x_.grp * 512 + x_.h * 64 + c_ * 8; kr[k_] = *(const v4u*)src_; vr[k_] = *(const v4u*)(src_ + 256); } } \
        ntok = x_.b * SEQ + (x_.n * 128 + F.wave * 16 + r16) * x_.d + x_.res; \
        { const bf16* qr_ = q + (size_t)ntok * D + x_.grp * 256 + x_.h * 64 + 8 * lg; nq0 = *(const bf16x8*)qr_; nq1 = *(const bf16x8*)(qr_ + 32); } } while (0)
    int u = blockIdx.x;
    if (u < 3072) DIL_PREFETCH(u);
    for (; u < 3072; u += F.G) {
        const DilUnit x = dil_unit(u);
        __syncthreads();
#pragma unroll
        for (int k = 0; k < 5; ++k) { const int i = F.tid + NTHR * k, ki = i >> 3, c = i & 7;
            if (ki < 272) { *(LAS v4u*)(Kl + ki * KPITCH + c * 16) = kr[k]; *(LAS v4u*)(Vl + ki * KPITCH + c * 16) = vr[k]; } }
        const bf16x8 bq0 = nq0, bq1 = nq1; const int tok = ntok;
        __syncthreads();
        if (u + F.G < 3072) DIL_PREFETCH(u + F.G);
        f32x4 o[4]; float lse;
        attn_wave<10, true>(Kl, Vl, F.wave, bq0, bq1, F.lane, F.wave * 16 + r16, x.n == 0, o, lse);
        bf16* orow = og + ((size_t)x.grp * T + tok) * 256 + x.h * 64 + 4 * lg;
#pragma unroll
        for (int et = 0; et < 4; ++et) { v2u w; w.x = cvt_pk_bf16(o[et][0], o[et][1]); w.y = cvt_pk_bf16(o[et][2], o[et][3]); *(v2u*)(orow + 16 * et) = w; }
        if (lg == 0) lseo[((size_t)x.grp * T + tok) * 4 + x.h] = lse;
    }
#undef DIL_PREFETCH
    __syncthreads();
}
__device__ __forceinline__ void phase_dil_combine(Frame& F, const bf16* og, const float* lse, bf16* A2b  ) {
    const size_t gt = (size_t)blockIdx.x * NTHR + F.tid, NT_ = (size_t)F.G * NTHR;
    for (size_t i = gt; i < (size_t)T * 32; i += NT_) {
        const int t = (int)(i >> 5), h = (int)((i >> 3) & 3), c8 = (int)(i & 7);
        const float l0 = lse[((size_t)0 * T + t) * 4 + h], l1 = lse[((size_t)1 * T + t) * 4 + h], l2 = lse[((size_t)2 * T + t) * 4 + h];
        const float mx = fmaxf(l0, fmaxf(l1, l2)); float w0 = __expf(l0 - mx), w1 = __expf(l1 - mx), w2 = __expf(l2 - mx); const float inv = 1.0f / (w0 + w1 + w2); w0 *= inv; w1 *= inv; w2 *= inv;
        const v4u a = *(const v4u*)(og + ((size_t)0 * T + t) * 256 + h * 64 + c8 * 8), bq = *(const v4u*)(og + ((size_t)1 * T + t) * 256 + h * 64 + c8 * 8), cq = *(const v4u*)(og + ((size_t)2 * T + t) * 256 + h * 64 + c8 * 8);
        v4u o;
        o.x = pk2(w0 * bflo(a.x) + w1 * bflo(bq.x) + w2 * bflo(cq.x), w0 * bfhi(a.x) + w1 * bfhi(bq.x) + w2 * bfhi(cq.x));
        o.y = pk2(w0 * bflo(a.y) + w1 * bflo(bq.y) + w2 * bflo(cq.y), w0 * bfhi(a.y) + w1 * bfhi(bq.y) + w2 * bfhi(cq.y));
        o.z = pk2(w0 * bflo(a.z) + w1 * bflo(bq.z) + w2 * bflo(cq.z), w0 * bfhi(a.z) + w1 * bfhi(bq.z) + w2 * bfhi(cq.z));
        o.w = pk2(w0 * bflo(a.w) + w1 * bflo(bq.w) + w2 * bflo(cq.w), w0 * bfhi(a.w) + w1 * bfhi(bq.w) + w2 * bfhi(cq.w));
        *(v4u*)(A2b + (size_t)t * 512 + h * 64 + c8 * 8) = o;
    }
}

__device__ __forceinline__ void phase_ln_route(Frame& F, const float* z, const float* g, const float* bt, const float* rwT, const float* rb,
                                               float* x1f, unsigned char* x1q, int* tok_es, float* tok_gate, int* rowtok, float* rowsc, unsigned* cnt_g) {
    LAS float* xt = (LAS float*)F.lds;
    LAS float* part = xt + 16 * 1028;
    LAS int* lcnt = (LAS int*)(F.lds + LDS_RT); LAS int* base = lcnt + 32; LAS int* rec = lcnt + 64;
    LAS float* lsa = (LAS float*)(F.lds + LDS_SA);
    const int r16 = F.lane & 15, kq = F.lane >> 4, w = F.wave;
    f32x4 Wr[2][8];
#pragma unroll
    for (int nt = 0; nt < 2; ++nt)
#pragma unroll
        for (int q = 0; q < 8; ++q) Wr[nt][q] = *(const f32x4*)(rwT + (size_t)(16 * nt + r16) * D + 128 * w + 16 * q + 4 * kq);
    f32x4 g4[4], b4[4];
#pragma unroll
    for (int j = 0; j < 4; ++j) { g4[j] = *(const f32x4*)(g + 4 * F.lane + 256 * j); b4[j] = *(const f32x4*)(bt + 4 * F.lane + 256 * j); }
    const int my_e = F.lane & 31, hh = F.lane >> 5; const float my_rb = rb[my_e];
    for (int chunk = blockIdx.x; chunk < T / 128; chunk += F.G) {
        __syncthreads();
        if (F.tid < 32) lcnt[F.tid] = 0;
        f32x4 zn[2][4];
#pragma unroll
        for (int u = 0; u < 2; ++u)
#pragma unroll
            for (int j = 0; j < 4; ++j) zn[u][j] = *(const f32x4*)(z + (size_t)(chunk * 128 + 2 * w + u) * D + 4 * F.lane + 256 * j);
        for (int rd = 0; rd < 8; ++rd) {
#pragma unroll
            for (int u = 0; u < 2; ++u) {
                const int t = chunk * 128 + rd * 16 + 2 * w + u;
                f32x4 v[4]; float s = 0.f;
#pragma unroll
                for (int j = 0; j < 4; ++j) { v[j] = zn[u][j]; s += (v[j][0] + v[j][1]) + (v[j][2] + v[j][3]); }
                const float mean = wave_sum(s) * (1.0f / D); float s2 = 0.f;
#pragma unroll
                for (int j = 0; j < 4; ++j) { v[j] = v[j] - mean; s2 += (v[j][0] * v[j][0] + v[j][1] * v[j][1]) + (v[j][2] * v[j][2] + v[j][3] * v[j][3]); }
                const float rstd = 1.0f / sqrtf(wave_sum(s2) * (1.0f / D) + LN_EPS);
                float amax = 0.f;
#pragma unroll
                for (int j = 0; j < 4; ++j) { v[j] = v[j] * rstd * g4[j] + b4[j];
                    *(f32x4*)(x1f + (size_t)t * D + 4 * F.lane + 256 * j) = v[j];
                    *(LAS f32x4*)(xt + (2 * w + u) * 1028 + 4 * F.lane + 256 * j) = v[j];
                    amax = fmaxf(amax, fmaxf(fmaxf(fabsf(v[j][0]), fabsf(v[j][1])), fmaxf(fabsf(v[j][2]), fabsf(v[j][3])))); }
#pragma unroll
                for (int o = 1; o < 64; o <<= 1) amax = fmaxf(amax, __shfl_xor(amax, o));
                amax = fmaxf(amax, 1e-30f);
                const float qinv = 127.0f / amax;
                if (F.lane == 0) lsa[rd * 16 + 2 * w + u] = amax * (1.0f / 127.0f);
#pragma unroll
                for (int j = 0; j < 4; ++j) { const int q0 = (int)rintf(v[j][0] * qinv), q1 = (int)rintf(v[j][1] * qinv), q2 = (int)rintf(v[j][2] * qinv), q3 = (int)rintf(v[j][3] * qinv);
                    unsigned pq = (unsigned)(q0 & 255) | ((unsigned)(q1 & 255) << 8) | ((unsigned)(q2 & 255) << 16) | ((unsigned)(q3 & 255) << 24);
#if defined(PROBE_H) && (PROBE_H >= 7)
                    pq = 0x01010101u;
#endif
                    *(unsigned*)(x1q + (size_t)t * D + 4 * F.lane + 256 * j) = pq; }
            }
            if (rd < 7) {
#pragma unroll
                for (int u = 0; u < 2; ++u)
#pragma unroll
                    for (int j = 0; j < 4; ++j) zn[u][j] = *(const f32x4*)(z + (size_t)(chunk * 128 + (rd + 1) * 16 + 2 * w + u) * D + 4 * F.lane + 256 * j);
            }
            __syncthreads();
            f32x4 a0 = (f32x4){0.f, 0.f, 0.f, 0.f}, a1 = (f32x4){0.f, 0.f, 0.f, 0.f};
#pragma unroll
            for (int q = 0; q < 8; ++q) { const f32x4 av = *(const LAS f32x4*)(xt + r16 * 1028 + 128 * w + 16 * q + 4 * kq);
#pragma unroll
                for (int j = 0; j < 4; ++j) { a0 = __builtin_amdgcn_mfma_f32_16x16x4f32(av[j], Wr[0][q][j], a0, 0, 0, 0); a1 = __builtin_amdgcn_mfma_f32_16x16x4f32(av[j], Wr[1][q][j], a1, 0, 0, 0); } }
#pragma unroll
            for (int jj = 0; jj < 4; ++jj) { part[(w * 16 + 4 * kq + jj) * 33 + r16] = a0[jj]; part[(w * 16 + 4 * kq + jj) * 33 + 16 + r16] = a1[jj]; }
            __syncthreads();
            {
                const int tokl = 2 * w + hh, tl = rd * 16 + tokl, t = chunk * 128 + tl;
                float val = my_rb;
#pragma unroll
                for (int ww = 0; ww < 8; ++ww) val += part[(ww * 16 + tokl) * 33 + my_e];
                float tv[4]; int ti[4];
#pragma unroll
                for (int k = 0; k < 4; ++k) { float kv = val; int ki = my_e;
#pragma unroll
                    for (int off = 1; off < 32; off <<= 1) { const float ov = __shfl_xor(kv, off); const int oi = __shfl_xor(ki, off); const bool take = (ov > kv) || (ov == kv && oi < ki); kv = take ? ov : kv; ki = take ? oi : ki; }
                    tv[k] = kv; ti[k] = ki; if (my_e == ki) val = -INFINITY; }
                const float e1 = __expf(tv[1] - tv[0]), e2 = __expf(tv[2] - tv[0]), e3 = __expf(tv[3] - tv[0]); const float inv = 1.0f / (1.0f + e1 + e2 + e3);
                if (my_e < 4) { const int k = my_e; const int ee = (k == 0) ? ti[0] : (k == 1) ? ti[1] : (k == 2) ? ti[2] : ti[3];
                    const float gk = ((k == 0) ? 1.0f : (k == 1) ? e1 : (k == 2) ? e2 : e3) * inv;
                    const int slot = __hip_atomic_fetch_add(lcnt + ee, 1, __ATOMIC_RELAXED, __HIP_MEMORY_SCOPE_WORKGROUP);
                    rec[tl * 4 + k] = ee | (slot << 8); tok_gate[(size_t)t * 4 + k] = gk; }
            }
        }
        __syncthreads();
        if (F.tid < 32) base[F.tid] = (int)__hip_atomic_fetch_add(cnt_g + F.tid, (unsigned)lcnt[F.tid], __ATOMIC_RELAXED, __HIP_MEMORY_SCOPE_AGENT);
        __syncthreads();
        { const int rr = rec[F.tid], e = rr & 255, slot = (rr >> 8) + base[e]; tok_es[(size_t)chunk * 512 + F.tid] = e | (slot << 8); rowtok[(size_t)e * T + slot] = chunk * 128 + (F.tid >> 2); rowsc[(size_t)e * T + slot] = lsa[F.tid >> 2]; }
    }
    __syncthreads();
}

__device__ __forceinline__ int build_tiles(Frame& F, const unsigned* cnt_g) {
    LAS int* tbs = (LAS int*)(F.lds + LDS_TB); LAS int* cl = tbs + 40; LAS int* te = (LAS int*)(F.lds + LDS_TE);
    __syncthreads();
    if (F.tid == 0) { int a = 0; for (int e = 0; e < NEXP; ++e) { const int c = (int)cnt_g[e]; tbs[e] = a; cl[e] = c; a += (c + 255) >> 8; } tbs[NEXP] = a; }
    __syncthreads();
    const int total = tbs[NEXP];
    for (int rt = F.tid; rt < total; rt += NTHR) { int e = 0; for (int k = 1; k < NEXP; ++k) e = (rt >= tbs[k]) ? k : e; te[rt] = e; }
    __syncthreads();
    return total;
}
__device__ __forceinline__ void phase_combine_ln(Frame& F, const unsigned* cnt_g, const float* x1f, const bf16* Y, const int* tok_es, const float* tok_gate, const float* g, const float* bt, float* xout, unsigned char* xq, float* xsc) {
    (void)build_tiles(F, cnt_g);
    const LAS int* tbs = (const LAS int*)(F.lds + LDS_TB);
    f32x4 g4[4], b4[4];
#pragma unroll
    for (int j = 0; j < 4; ++j) { g4[j] = *(const f32x4*)(g + 4 * F.lane + 256 * j); b4[j] = *(const f32x4*)(bt + 4 * F.lane + 256 * j); }
    for (int t = F.gw; t < T; t += F.NGW) {
        f32x4 v[4];
#pragma unroll
        for (int j = 0; j < 4; ++j) v[j] = *(const f32x4*)(x1f + (size_t)t * D + 4 * F.lane + 256 * j) * DN_ALPHA;
#pragma unroll
        for (int k = 0; k < 4; ++k) { const int es = tok_es[(size_t)t * 4 + k]; const int row = tbs[es & 255] * 256 + (es >> 8); const float gk = tok_gate[(size_t)t * 4 + k];
#pragma unroll
            for (int j = 0; j < 4; ++j) { const v2u w = *(const v2u*)(Y + (size_t)row * D + 4 * F.lane + 256 * j);
                v[j][0] += gk * bflo(w.x); v[j][1] += gk * bfhi(w.x); v[j][2] += gk * bflo(w.y); v[j][3] += gk * bfhi(w.y); } }
        float s = 0.f;
#pragma unroll
        for (int j = 0; j < 4; ++j) s += (v[j][0] + v[j][1]) + (v[j][2] + v[j][3]);
        const float mean = wave_sum(s) * (1.0f / D); float s2 = 0.f;
#pragma unroll
        for (int j = 0; j < 4; ++j) { v[j] = v[j] - mean; s2 += (v[j][0] * v[j][0] + v[j][1] * v[j][1]) + (v[j][2] * v[j][2] + v[j][3] * v[j][3]); }
        const float rstd = 1.0f / sqrtf(wave_sum(s2) * (1.0f / D) + LN_EPS);
#pragma unroll
        for (int j = 0; j < 4; ++j) { v[j] = v[j] * rstd * g4[j] + b4[j];
#if defined(PROBE_CLK) || defined(PROBE_I8) || defined(PROBE_H)
            { const float dv = ((const float*)cnt_g)[256 - 96]; if (dv != 0.f) v[j] = (f32x4){dv, dv, dv, dv}; }
#endif
            *(f32x4*)(xout + (size_t)t * D + 4 * F.lane + 256 * j) = v[j]; }
        quant_row_i8(v, xq + (size_t)t * D, xsc + t, F.lane);
    }
}
#ifndef REP_P0
#define REP_P0 1
#endif
#ifndef REP_A1
#define REP_A1 1
#endif
#ifndef REP_MKV
#define REP_MKV 1
#endif
#ifndef REP_CONV
#define REP_CONV 1
#endif
#ifndef REP_MATT
#define REP_MATT 1
#endif
#ifndef REP_A3
#define REP_A3 1
#endif
#ifndef REP_B1
#define REP_B1 1
#endif
#ifndef REP_B1KV
#define REP_B1KV 1
#endif
#ifndef REP_DIL
#define REP_DIL 1
#endif
#ifndef REP_DILC
#define REP_DILC 1
#endif
#ifndef REP_B4
#define REP_B4 1
#endif
#ifndef REP_M2
#define REP_M2 1
#endif
#ifndef REP_M3
#define REP_M3 1
#endif
#ifndef REP_M4
#define REP_M4 1
#endif
#ifndef REP_M5
#define REP_M5 1
#endif
#ifndef EN_ALL
#define EN_ALL 1
#endif
#ifndef EN_P0
#define EN_P0 EN_ALL
#endif
#ifndef EN_A1
#define EN_A1 EN_ALL
#endif
#ifndef EN_MKV
#define EN_MKV EN_ALL
#endif
#ifndef EN_CONV
#define EN_CONV EN_ALL
#endif
#ifndef EN_MATT
#define EN_MATT EN_ALL
#endif
#ifndef EN_A3
#define EN_A3 EN_ALL
#endif
#ifndef EN_B1
#define EN_B1 EN_ALL
#endif
#ifndef EN_B1KV
#define EN_B1KV EN_ALL
#endif
#ifndef EN_DIL
#define EN_DIL EN_ALL
#endif
#ifndef EN_DILC
#define EN_DILC EN_ALL
#endif
#ifndef EN_B4
#define EN_B4 EN_ALL
#endif
#ifndef EN_M1
#define EN_M1 EN_ALL
#endif
#ifndef EN_M2
#define EN_M2 EN_ALL
#endif
#ifndef EN_M3
#define EN_M3 EN_ALL
#endif
#ifndef EN_M4
#define EN_M4 EN_ALL
#endif
#ifndef EN_M5
#define EN_M5 EN_ALL
#endif

#ifndef MK_N_LAUNCHES
#define MK_N_LAUNCHES 1
#endif
constexpr int NPHASE = 1 + 2 * 7 + 2 * 8;
struct Args { const void* in[24]; float* out; unsigned char* ws; int ph_lo, ph_hi; };
static_assert(sizeof(Args) == 24 * 8 + 8 + 8 + 8, "Args has no padding");

__global__ void __launch_bounds__(NTHR, 2) fwd(Args args) {
    extern __shared__ __attribute__((aligned(16))) unsigned char lds_raw[];
    LAS unsigned char* const ldsb = (LAS unsigned char*)lds_raw;
    if (threadIdx.x < 16) ((LAS unsigned*)(ldsb + LDS_MISC))[threadIdx.x] = 0u;
    if (threadIdx.x == 0) {
        LAS unsigned long long* pt = (LAS unsigned long long*)(ldsb + LDS_PTR);
#pragma unroll
        for (int i = 0; i < 24; ++i) pt[i] = (unsigned long long)args.in[i];
        pt[24] = (unsigned long long)args.ws; pt[25] = (unsigned long long)args.out;
    }
    __syncthreads();
    const int lo = args.ph_lo, hi = args.ph_hi;
    const bool use_bar = (hi - lo) > 1;
    unsigned xcc = 0;
    if (use_bar) { const XcdBarrier b0 = xcd_barrier_post((unsigned*)(args.ws + WS_CTL) + CW_BAR, (volatile LAS unsigned*)(ldsb + LDS_MISC)); xcc = b0.x; }
#define IN(k) (lo <= (k) && (k) < hi)
#define FRAME() Frame F; { int t_ = threadIdx.x; asm volatile("" : "+v"(t_)); F.lds = ldsb; F.tid = t_; F.lane = t_ & 63; F.wave = __builtin_amdgcn_readfirstlane(t_ >> 6); \
                           F.G = gridDim.x; F.gw = blockIdx.x * NWAVES + F.wave; F.NGW = F.G * NWAVES; } unsigned char* ws = wsp(F); (void)ws
#define SEAM(k) do { if (IN(k) && IN((k) + 1)) { asm volatile("" ::: "memory"); Frame Fb; Fb.lds = ldsb; XcdBarrier b_; b_.bar = (unsigned*)(wsp(Fb) + WS_CTL) + CW_BAR; b_.x = xcc; b_.st = (volatile LAS unsigned*)(ldsb + LDS_MISC); xcd_barrier(b_); } } while (0)
#define WSB(T_, off) ((T_*)(ws + (off)))

    if (EN_P0 && IN(0)) { for (int rep_ = 0; rep_ < REP_P0; ++rep_) { FRAME(); phase_prologue(F); } }
    SEAM(0);

    for (int l = 0; l < 4; ++l) {
        const int pb = (l < 2) ? 1 + 7 * l : 15 + 8 * (l - 2);
        int pm;
        if (l < 2) {
            if (IN(pb + 0)) {
                for (int rep_ = 0; rep_ < REP_A1; ++rep_) if (EN_A1) { FRAME();
                  pg8::Gemm g{WSB(bf16, WS_XB), (const bf16*)(WSB(const unsigned char, WS_WIN) + (size_t)l * AIN * D), T, AIN, D / 2}; pg8::StaticOrder S; S.init(T, AIN, F.G, (int)blockIdx.x);
                  EpiGluQI8 E{WSB(bf16, WS_HGLU), WSB(bf16, WS_QM), inp(F, 4) + (size_t)l * AIN, WSB(const float, WS_XSC), WSB(const float, WS_SBD) + (size_t)l * AIN};
                  pg8::gemm_phase<EpiGluQI8, pg8::StaticOrder, true, true, true>(F.lds, g, S, E); }
                for (int rep_ = 0; rep_ < REP_MKV; ++rep_) if (EN_MKV && l == 0) { FRAME();
                  pg8::Gemm g{WSB(bf16, WS_MEMB), WSB(const bf16, WS_WMEM), 512, 2048, D}; pg8::StaticOrder S; S.init(512, 2048, F.G, (int)blockIdx.x);
                  EpiRot<2> E{WSB(bf16, WS_MEMKV), 2048, nullptr, nullptr, nullptr};
                  pg8::gemm_phase<EpiRot<2>, pg8::StaticOrder, true, true>(F.lds, g, S, E); }
            }
            SEAM(pb + 0);
            if (IN(pb + 1)) {
                for (int rep_ = 0; rep_ < REP_CONV; ++rep_) if (EN_CONV) { FRAME();
                  phase_conv(F, WSB(const bf16, WS_HGLU), inp(F, 5) + (size_t)l * CONV_W * CONV_CH, inp(F, 6) + (size_t)l * CONV_CH, inp(F, 7) + (size_t)l * CONV_CH, inp(F, 8) + (size_t)l * CONV_CH, WSB(bf16, WS_A2)); }
                for (int rep_ = 0; rep_ < REP_MATT; ++rep_) if (EN_MATT) { FRAME(); phase_memattn(F, WSB(const bf16, WS_QM), 256, 0, WSB(const bf16, WS_MEMKV), l, WSB(bf16, WS_A2), D, 768); }
            }
            SEAM(pb + 1);
            for (int rep_ = 0; rep_ < REP_A3; ++rep_) if (EN_A3 && IN(pb + 2)) { FRAME();
                pg8::Gemm g{WSB(bf16, WS_A2), WSB(const bf16, WS_WOA) + (size_t)l * D * D, T, D, D}; pg8::StaticOrder S; S.init(T, D, F.G, (int)blockIdx.x);
                EpiRes E{WSB(float, WS_Z), (l == 0) ? inp(F, 0) : WSB(const float, WS_XR2), inp(F, 10) + (size_t)l * D};
                pg8::gemm_phase<EpiRes, pg8::StaticOrder, true, true>(F.lds, g, S, E);
            }
            SEAM(pb + 2);
            pm = pb + 3;
        } else {
            const int j = l - 2;
            if (IN(pb + 0)) {
                for (int rep_ = 0; rep_ < REP_B1; ++rep_) if (EN_B1) { FRAME();
                  pg8::Gemm g{WSB(bf16, WS_XB), (const bf16*)(WSB(const unsigned char, WS_WQ) + (size_t)j * D * D), T, D, D / 2}; pg8::StaticOrder S; S.init(T, D, F.G, (int)blockIdx.x);
                  EpiRot<0, true> E{WSB(bf16, WS_QB), D, WSB(const float, WS_ROT), WSB(const float, WS_XSC), WSB(const float, WS_SBD) + 4096 + (size_t)j * D};
                  pg8::gemm_phase<EpiRot<0, true>, pg8::StaticOrder, true, true, true>(F.lds, g, S, E); }
                for (int rep_ = 0; rep_ < REP_B1KV; ++rep_) if (EN_B1KV && j == 0) { FRAME();
                  pg8::Gemm g{WSB(bf16, WS_XB), (const bf16*)WSB(const unsigned char, WS_WKV), T, KVW, D / 2}; pg8::StaticOrder S; S.init(T, KVW, F.G, (int)blockIdx.x);
                  EpiRot<1, true> E{WSB(bf16, WS_KVB), KVW, WSB(const float, WS_ROT), WSB(const float, WS_XSC), WSB(const float, WS_SBD) + 8192};
                  pg8::gemm_phase<EpiRot<1, true>, pg8::StaticOrder, true, true, true>(F.lds, g, S, E); }
            }
            SEAM(pb + 0);
            if (IN(pb + 1)) {
                for (int rep_ = 0; rep_ < REP_DIL; ++rep_) if (EN_DIL) { FRAME(); phase_dilated(F, WSB(const bf16, WS_QB), WSB(const bf16, WS_KVB), WSB(bf16, WS_OG), WSB(float, WS_LSE)); }
                for (int rep_ = 0; rep_ < REP_MATT; ++rep_) if (EN_MATT) { FRAME(); phase_memattn(F, WSB(const bf16, WS_QB), D, 768, WSB(const bf16, WS_MEMKV), l, WSB(bf16, WS_A2), 512, 256); }
            }
            SEAM(pb + 1);
            for (int rep_ = 0; rep_ < REP_DILC; ++rep_) if (EN_DILC && IN(pb + 2)) { FRAME(); phase_dil_combine(F, WSB(const bf16, WS_OG), WSB(const float, WS_LSE), WSB(bf16, WS_A2)); }
            SEAM(pb + 2);
            for (int rep_ = 0; rep_ < REP_B4; ++rep_) if (EN_B4 && IN(pb + 3)) { FRAME();
                pg8::Gemm g{WSB(bf16, WS_A2), WSB(const bf16, WS_WOB) + (size_t)j * D * 512, T, D, 512}; pg8::StaticOrder S; S.init(T, D, F.G, (int)blockIdx.x);
                EpiRes E{WSB(float, WS_Z), WSB(const float, WS_XR2), inp(F, 14) + (size_t)j * D};
                pg8::gemm_phase<EpiRes, pg8::StaticOrder, true, true>(F.lds, g, S, E);
            }
            SEAM(pb + 3);
            pm = pb + 4;
        }
        if (EN_M1 && IN(pm + 0)) { FRAME();
            phase_ln_route(F, WSB(const float, WS_Z), inp(F, 16) + (size_t)(l * 2 + 0) * D, inp(F, 17) + (size_t)(l * 2 + 0) * D, WSB(const float, WS_RWT) + (size_t)l * NEXP * D, inp(F, 19) + (size_t)l * NEXP,
                           WSB(float, WS_XR1), WSB(unsigned char, WS_X1B), WSB(int, WS_TES), WSB(float, WS_TGATE), WSB(int, WS_RTOK), WSB(float, WS_RSC), WSB(unsigned, WS_CTL) + CW_CNT + 32 * l);
        }
        SEAM(pm + 0);
        for (int rep_ = 0; rep_ < REP_M3; ++rep_) if (EN_M3 && IN(pm + 1)) { FRAME();
#if defined(PROBE_CLK)
            long long c0_ = clock64(), w0_ = wall_clock64();
#endif
            const int total = build_tiles(F, WSB(const unsigned, WS_CTL) + CW_CNT + 32 * l);
            pg8::Gemm g{WSB(bf16, WS_X1B), (const bf16*)(WSB(const unsigned char, WS_WUP) + (size_t)l * NEXP * 2 * DFF * D), XROWS, NEXP * 2 * DFF, D / 2};
            MoeOrder<8> S{(const LAS int*)(F.lds + LDS_TE), (const LAS int*)(F.lds + LDS_TB), (const LAS int*)(F.lds + LDS_TB) + 40, WSB(const int, WS_RTOK), total, F.G, (int)blockIdx.x};
            EpiSwigluI8 E{WSB(bf16, WS_H), inp(F, 21) + (size_t)l * NEXP * 2 * DFF, WSB(const float, WS_SBW) + (size_t)l * NEXP * 2 * DFF, WSB(const float, WS_RSC), (const LAS int*)(F.lds + LDS_TB)};
            pg8::gemm_phase_g<EpiSwigluI8, MoeOrder<8>, true>(F.lds, g, S, E);
#if defined(PROBE_CLK)
            if (l == 3 && blockIdx.x == 0 && threadIdx.x == 0) { const long long c1_ = clock64(), w1_ = wall_clock64(); WSB(float, WS_CTL)[CW_CNT + 256] = (float)(c1_ - c0_) / (float)(w1_ - w0_); }
#endif
        }
        SEAM(pm + 1);
        for (int rep_ = 0; rep_ < REP_M4; ++rep_) if (EN_M4 && IN(pm + 2)) { FRAME();
            const int total = build_tiles(F, WSB(const unsigned, WS_CTL) + CW_CNT + 32 * l);
#if defined(PROBE_H)
            if (l == 0) { __syncthreads(); asm volatile("s_waitcnt vmcnt(0)" ::: "memory");
              if (blockIdx.x == 0 && F.wave == 0) {
                const LAS int* tb_ = (const LAS int*)(F.lds + LDS_TB);
                const int tok_ = 1000 + (F.lane >> 3), c_ = ((F.lane & 7) * 137 + 5) & 1023;
                const int es_ = WSB(const int, WS_TES)[(size_t)tok_ * 4]; const int e_ = es_ & 255; const int r_ = tb_[e_] * 256 + (es_ >> 8);
                const float* x_ = WSB(const float, WS_XR1) + (size_t)tok_ * D; const float* wu_ = inp(F, 20) + (size_t)e_ * D * 2 * DFF; const float* bu_ = inp(F, 21) + (size_t)e_ * 2 * DFF;
                float g_ = bu_[c_], li_ = bu_[1024 + c_];
#if PROBE_H == 2
                { const signed char* xq_ = (const signed char*)WSB(const unsigned char, WS_X1B) + (size_t)tok_ * D; const int ng_ = (c_ >> 7) * 256 + (c_ & 127), nl_ = ng_ + 128;
                  const signed char* wg_ = (const signed char*)WSB(const unsigned char, WS_WUP) + ((size_t)e_ * 2048 + ng_) * D; const signed char* wl_ = (const signed char*)WSB(const unsigned char, WS_WUP) + ((size_t)e_ * 2048 + nl_) * D;
                  int ag_ = 0, al_ = 0; for (int k = 0; k < D; ++k) { ag_ += (int)xq_[k] * (int)wg_[k]; al_ += (int)xq_[k] * (int)wl_[k]; }
                  const float sa_ = WSB(const float, WS_RSC)[(size_t)e_ * T + (es_ >> 8)]; const float* sb_ = WSB(const float, WS_SBW) + (size_t)e_ * 2048;
                  g_ += (float)ag_ * sa_ * sb_[ng_]; li_ += (float)al_ * sa_ * sb_[nl_]; (void)x_; (void)wu_; }
#else
                for (int k = 0; k < D; ++k) { const float xv = x_[k]; g_ += xv * wu_[(size_t)k * 2048 + c_]; li_ += xv * wu_[(size_t)k * 2048 + 1024 + c_]; }
#endif
                const float gg = fminf(g_, 7.0f), ll = fminf(fmaxf(li_, -7.0f), 7.0f); float href = gg * (1.0f / (1.0f + __expf(-1.702f * gg))) * (ll + 1.0f);
#if PROBE_H == 3 || PROBE_H == 8
                { const signed char* xq_ = (const signed char*)WSB(const unsigned char, WS_X1B) + (size_t)tok_ * D; const int ng_ = (c_ >> 7) * 256 + (c_ & 127);
                  const signed char* wg_ = (const signed char*)WSB(const unsigned char, WS_WUP) + ((size_t)e_ * 2048 + ng_) * D;
                  int ag_ = 0; for (int k = 0; k < D; ++k) ag_ += (int)xq_[k] * (int)wg_[k]; href = (float)ag_; }
#endif
                const float hgot = bflo((unsigned)WSB(const bf16, WS_H)[(size_t)r_ * DFF + c_]);
                float df = fabsf(href - hgot);
#if PROBE_H == 9 || PROBE_H == 10
                { const int ng_ = (c_ >> 7) * 256 + (c_ & 127); const int expv = (PROBE_H == 9) ? (ng_ & 127) : (ng_ >> 4); const int gotv = (int)(hgot * (1.0f / 1024.0f) + 0.5f);
                  int dl = (gotv ^ expv) & 127; int dor = dl;
#pragma unroll
                  for (int o = 1; o < 64; o <<= 1) { dor |= __shfl_xor(dor, o); }
#if defined(PROBE_S)
                  if (F.lane == PROBE_S) WSB(float, WS_CTL)[CW_CNT + 256] = 1.0f + (float)((gotv & 3) * 4 + (expv & 3)); (void)dor; }
#else
                  if (F.lane == 0) WSB(float, WS_CTL)[CW_CNT + 256] = 1.0f + (float)dor; }
#endif
#endif
#if PROBE_H == 7
                { float hm = hgot;
#pragma unroll
                  for (int o = 1; o < 64; o <<= 1) hm = fmaxf(hm, __shfl_xor(hm, o));
                  float hn = hgot;
#pragma unroll
                  for (int o = 1; o < 64; o <<= 1) hn = fminf(hn, __shfl_xor(hn, o));
                  if (F.lane == 0) WSB(float, WS_CTL)[CW_CNT + 256] = 1.0f + hm * (1.0f / 128.0f) + ((hn != hm) ? 0.5f : 0.0f); }
#endif
#if PROBE_H == 5
                { const signed char* xq_ = (const signed char*)WSB(const unsigned char, WS_X1B) + (size_t)tok_ * D; const float sa_ = WSB(const float, WS_RSC)[(size_t)e_ * T + (es_ >> 8)];
                  df = 0.f; for (int k = 0; k < D; ++k) df = fmaxf(df, fabsf((float)xq_[k] * sa_ - x_[k])); df *= 10.0f; }
#endif
#if PROBE_H == 6
                { const int ng_ = (c_ >> 7) * 256 + (c_ & 127); const signed char* wg_ = (const signed char*)WSB(const unsigned char, WS_WUP) + ((size_t)e_ * 2048 + ng_) * D; const float sb_ = WSB(const float, WS_SBW)[(size_t)e_ * 2048 + ng_];
                  df = 0.f; for (int k = 0; k < D; ++k) df = fmaxf(df, fabsf((float)wg_[k] * sb_ - wu_[(size_t)k * 2048 + c_])); df *= 1000.0f; }
#endif
#if PROBE_H == 3 || PROBE_H == 8
                df = df / (fabsf(href) + 100.0f) * 10.0f;
#endif
#pragma unroll
                for (int o = 1; o < 64; o <<= 1) df = fmaxf(df, __shfl_xor(df, o));
                if (PROBE_H < 7 && F.lane == 0) WSB(float, WS_CTL)[CW_CNT + 256] = (df < 0.15f) ? 2.0f : (df < 0.5f) ? 3.0f : (df < 2.0f) ? 4.0f : (df < 10.0f) ? 5.0f : 6.0f;
              } }
#endif
            pg8::Gemm g{WSB(bf16, WS_H), WSB(const bf16, WS_WDN) + (size_t)l * NEXP * DFF * D, XROWS, NEXP * D, DFF};
            MoeOrder<4> S{(const LAS int*)(F.lds + LDS_TE), (const LAS int*)(F.lds + LDS_TB), (const LAS int*)(F.lds + LDS_TB) + 40, WSB(const int, WS_RTOK), total, F.G, (int)blockIdx.x};
            EpiDown E{WSB(bf16, WS_Y), inp(F, 23) + (size_t)l * NEXP * D};
            pg8::gemm_phase<EpiDown, MoeOrder<4>, true, true>(F.lds, g, S, E);
        }
        SEAM(pm + 2);
        for (int rep_ = 0; rep_ < REP_M5; ++rep_) if (EN_M5 && IN(pm + 3)) { FRAME();
            phase_combine_ln(F, WSB(const unsigned, WS_CTL) + CW_CNT + 32 * l, WSB(const float, WS_XR1), WSB(const bf16, WS_Y), WSB(const int, WS_TES), WSB(const float, WS_TGATE), inp(F, 16) + (size_t)(l * 2 + 1) * D, inp(F, 17) + (size_t)(l * 2 + 1) * D,
                             (l == 3) ? (float*)ptr_slot(F, 25) : WSB(float, WS_XR2), WSB(unsigned char, WS_XB), WSB(float, WS_XSC));
        }
        if (l < 3) SEAM(pm + 3);
    }
#undef IN
#undef SEAM
#undef WSB
#undef FRAME
}

extern "C" void kernel_launch(void* const* d_in, const int* in_sizes, int n_in, void* d_out, int out_size, void* d_ws, size_t ws_size, hipStream_t stream) {
    static int grid = 0;
    if (grid == 0) {
        if (n_in != 24 || in_sizes[0] != T * D || out_size != T * D || ws_size < WS_END) {
            fprintf(stderr, "kernel_launch: unexpected shapes (n_in %d, in0 %d, out %d, ws %zu < %zu); nothing launched\n", n_in, n_in > 0 ? in_sizes[0] : -1, out_size, ws_size, (size_t)WS_END); grid = -1; return; }
        if (hipFuncSetAttribute((const void*)fwd, hipFuncAttributeMaxDynamicSharedMemorySize, LDS_BYTES) != hipSuccess) { fprintf(stderr, "kernel_launch: hipFuncSetAttribute failed\n"); grid = -1; return; }
        int per_cu = 0;
        if (hipOccupancyMaxActiveBlocksPerMultiprocessor(&per_cu, (const void*)fwd, NTHR, LDS_BYTES) != hipSuccess || per_cu < 1) fprintf(stderr, "kernel_launch: note: occupancy query says %d\n", per_cu);
        (void)hipGetLastError();
        grid = 256;
    }
    if (grid < 0) return;
    (void)hipMemsetAsync((char*)d_ws + WS_CTL, 0, CTL_ZERO_BYTES, stream);
    Args a{};
    for (int i = 0; i < 24; ++i) a.in[i] = d_in[i];
    a.out = (float*)d_out; a.ws = (unsigned char*)d_ws;
#if MK_N_LAUNCHES == 1
    a.ph_lo = 0; a.ph_hi = NPHASE;
    hipLaunchKernelGGL(fwd, dim3(grid), dim3(NTHR), LDS_BYTES, stream, a);
#else
    for (int k = 0; k < NPHASE; ++k) { a.ph_lo = k; a.ph_hi = k + 1; hipLaunchKernelGGL(fwd, dim3(grid), dim3(NTHR), LDS_BYTES, stream, a); }
#endif
}
```
